# Optimizing an MI355X kernel written in HIP

```python
import math
import jax, jax.numpy as jnp
from jax import lax
import numpy as np

D_MODEL = 1024
BATCH = 8
SEQ = 4096
DEPTH = 1

MIX_WIDTH = D_MODEL
SGU_WIDTH = MIX_WIDTH // 2
SGU_GROUPS = 8
SGU_GROUP_DIM = SGU_WIDTH // SGU_GROUPS
CHUNK = 128
DIFF_WIDTH = MIX_WIDTH - SGU_WIDTH
DIFF_HEADS = 4
DIFF_HEAD_DIM = DIFF_WIDTH // (2 * DIFF_HEADS)
DIFF_V_DIM = 2 * DIFF_HEAD_DIM
Q_BLOCK = 128
REL_BUCKETS = 32
REL_MAX_DIST = 128
PEER_HEADS = 8
PEER_N_KEYS = 128
PEER_EXPERTS = PEER_N_KEYS * PEER_N_KEYS
PEER_TOPK = 16
PEER_KEY_DIM = 256
PEER_HALF = PEER_KEY_DIM // 2
PEER_TOKEN_BLOCK = 128
IN_COLS = 2 * SGU_WIDTH + 3 * DIFF_WIDTH
N_ADA = 6
EPS = 1e-6

kernel_name = "hybrid_sgu_diffattn_peer_block"


def rms_norm(x, g):
    xf = x.astype(jnp.float32)
    y = xf * lax.rsqrt(jnp.mean(xf * xf, axis=-1, keepdims=True) + EPS)
    return (y * g.astype(jnp.float32)).astype(x.dtype)


def layer_norm(x, g, b):
    xf = x.astype(jnp.float32)
    mu = jnp.mean(xf, axis=-1, keepdims=True)
    var = jnp.mean(jnp.square(xf - mu), axis=-1, keepdims=True)
    y = (xf - mu) * lax.rsqrt(var + EPS)
    return (y * g.astype(jnp.float32) + b.astype(jnp.float32)).astype(x.dtype)


def rel_bucket(dist):
    n = jnp.maximum(dist, 0)
    max_exact = REL_BUCKETS // 2
    nf = jnp.maximum(n, 1).astype(jnp.float32)
    large = max_exact + (jnp.log(nf / max_exact) / math.log(REL_MAX_DIST / max_exact)
                         * (REL_BUCKETS - max_exact)).astype(jnp.int32)
    large = jnp.minimum(large, REL_BUCKETS - 1)
    return jnp.where(n < max_exact, n, large)


def spatial_gating(u, v, ln_g, ln_b, w_s, b_s):
    B, S, _ = v.shape
    v = layer_norm(v, ln_g, ln_b)
    nc = S // CHUNK
    vc = v.reshape(B, nc, CHUNK, SGU_GROUPS, SGU_GROUP_DIM)
    w = w_s * jnp.tril(jnp.ones((CHUNK, CHUNK), w_s.dtype))
    mixed = jnp.einsum('gts,bcsgd->bctgd', w, vc) + b_s.T[None, None, :, :, None]
    return u * mixed.reshape(B, S, SGU_WIDTH)


def diff_attention(q, k, v, rel_bias, lam, subln_g, lam_init):
    B, S = q.shape[:2]
    nq = S // Q_BLOCK
    scale = DIFF_HEAD_DIM ** -0.5
    qb = q.reshape(B, nq, Q_BLOCK, DIFF_HEADS, 2, DIFF_HEAD_DIM).transpose(1, 0, 2, 3, 4, 5)
    k_pos = jnp.arange(S)

    def block(args):
        q_blk, i = args
        q_pos = i * Q_BLOCK + jnp.arange(Q_BLOCK)
        dist = q_pos[:, None] - k_pos[None, :]
        bias = rel_bias[rel_bucket(dist)].astype(jnp.float32)
        logits = jnp.einsum('bqhcd,bkhcd->bhcqk', q_blk, k).astype(jnp.float32) * scale
        logits = logits + bias.transpose(2, 0, 1)[None, :, None]
        logits = jnp.where((dist >= 0)[None, None, None], logits, -jnp.inf)
        p = jax.nn.softmax(logits, axis=-1)
        attn = p[:, :, 0] - lam * p[:, :, 1]
        return jnp.einsum('bhqk,bkhe->bqhe', attn.astype(v.dtype), v)

    out = lax.map(block, (qb, jnp.arange(nq)))
    out = out.transpose(1, 0, 2, 3, 4).reshape(B, S, DIFF_HEADS, DIFF_V_DIM)
    out = rms_norm(out, subln_g) * (1.0 - lam_init)
    return out.reshape(B, S, DIFF_HEADS * DIFF_V_DIM)


def peer(h, w_query, sub_keys, expert_u, expert_v):
    B, S, D = h.shape
    T = B * S
    hf = h.reshape(T, D)
    q = (hf @ w_query).reshape(T, PEER_HEADS, 2, PEER_HALF)
    scores = jnp.einsum('thcd,hcnd->thcn', q, sub_keys).astype(jnp.float32)
    s1, i1 = lax.top_k(scores[:, :, 0], PEER_TOPK)
    s2, i2 = lax.top_k(scores[:, :, 1], PEER_TOPK)
    cand_s = (s1[..., :, None] + s2[..., None, :]).reshape(T, PEER_HEADS, PEER_TOPK * PEER_TOPK)
    cand_i = (i1[..., :, None] * PEER_N_KEYS + i2[..., None, :]).reshape(T, PEER_HEADS, PEER_TOPK * PEER_TOPK)
    top_s, pos = lax.top_k(cand_s, PEER_TOPK)
    idx = jnp.take_along_axis(cand_i, pos, axis=-1)
    gates = jax.nn.softmax(top_s, axis=-1).astype(h.dtype)

    nb = T // PEER_TOKEN_BLOCK

    def block(args):
        x_b, idx_b, g_b = args
        u = expert_u[idx_b]
        act = jax.nn.gelu(jnp.einsum('thkd,td->thk', u, x_b))
        vv = expert_v[idx_b]
        return jnp.einsum('thk,thkd->td', g_b * act, vv)

    out = lax.map(block, (hf.reshape(nb, PEER_TOKEN_BLOCK, D),
                          idx.reshape(nb, PEER_TOKEN_BLOCK, PEER_HEADS, PEER_TOPK),
                          gates.reshape(nb, PEER_TOKEN_BLOCK, PEER_HEADS, PEER_TOPK)))
    return out.reshape(B, S, D)


def setup_inputs(seed: int = 0) -> dict:
    key = jax.random.key(seed)
    ks = jax.random.split(key, 20)
    f32 = jnp.float32
    D = D_MODEL
    nrm = lambda k, shape, s: jax.random.normal(k, shape, f32) * s
    return {
        "x": nrm(ks[0], (BATCH, SEQ, D), 1.0),
        "c": nrm(ks[1], (BATCH, D), 1.0),
        "w_ada": nrm(ks[2], (DEPTH, D, N_ADA * D), 0.5 * D ** -0.5),
        "b_ada": nrm(ks[3], (DEPTH, N_ADA * D), 0.01),
        "norm_g": 1.0 + nrm(ks[4], (DEPTH, 4, D), 0.05),
        "w_in": nrm(ks[5], (DEPTH, D, IN_COLS), D ** -0.5),
        "sgu_ln_g": 1.0 + nrm(ks[6], (DEPTH, SGU_WIDTH), 0.05),
        "sgu_ln_b": nrm(ks[7], (DEPTH, SGU_WIDTH), 0.01),
        "sgu_w": nrm(ks[8], (DEPTH, SGU_GROUPS, CHUNK, CHUNK), CHUNK ** -0.5),
        "sgu_b": 1.0 + nrm(ks[9], (DEPTH, SGU_GROUPS, CHUNK), 0.1),
        "diff_lambda": nrm(ks[10], (DEPTH, 4, DIFF_HEAD_DIM), 0.1),
        "diff_subln_g": 1.0 + nrm(ks[11], (DEPTH, DIFF_V_DIM), 0.05),
        "rel_bias": nrm(ks[12], (REL_BUCKETS, DIFF_HEADS), 0.5),
        "w_out": nrm(ks[13], (DEPTH, MIX_WIDTH, D), MIX_WIDTH ** -0.5),
        "peer_w_query": nrm(ks[14], (DEPTH, D, PEER_HEADS * PEER_KEY_DIM), D ** -0.5),
        "peer_sub_keys": nrm(ks[15], (DEPTH, PEER_HEADS, 2, PEER_N_KEYS, PEER_HALF), PEER_HALF ** -0.5),
        "peer_u": nrm(ks[16], (DEPTH, PEER_EXPERTS, D), D ** -0.5),
        "peer_v": nrm(ks[17], (DEPTH, PEER_EXPERTS, D), D ** -0.5),
    }


def reference(x, c, w_ada, b_ada, norm_g, w_in, sgu_ln_g, sgu_ln_b, sgu_w, sgu_b,
              diff_lambda, diff_subln_g, rel_bias, w_out, peer_w_query, peer_sub_keys,
              peer_u, peer_v):
    B, S, D = x.shape
    for l in range(DEPTH):
        mod = (jax.nn.silu(c) @ w_ada[l] + b_ada[l]).reshape(B, N_ADA, D)
        shift1, scale1, gate1, shift2, scale2, gate2 = [mod[:, i, None, :] for i in range(N_ADA)]

        h = rms_norm(x, norm_g[l, 0]) * (1.0 + scale1) + shift1
        z = h @ w_in[l]
        zs = jax.nn.gelu(z[..., :2 * SGU_WIDTH])
        a_out = spatial_gating(zs[..., :SGU_WIDTH], zs[..., SGU_WIDTH:],
                               sgu_ln_g[l], sgu_ln_b[l], sgu_w[l], sgu_b[l])
        zd = z[..., 2 * SGU_WIDTH:]
        q = zd[..., :DIFF_WIDTH].reshape(B, S, DIFF_HEADS, 2, DIFF_HEAD_DIM)
        k = zd[..., DIFF_WIDTH:2 * DIFF_WIDTH].reshape(B, S, DIFF_HEADS, 2, DIFF_HEAD_DIM)
        v = zd[..., 2 * DIFF_WIDTH:].reshape(B, S, DIFF_HEADS, DIFF_V_DIM)
        lam_init = 0.8 - 0.6 * math.exp(-0.3 * l)
        lp = diff_lambda[l].astype(jnp.float32)
        lam = jnp.exp(jnp.sum(lp[0] * lp[1])) - jnp.exp(jnp.sum(lp[2] * lp[3])) + lam_init
        b_out = diff_attention(q, k, v, rel_bias, lam, diff_subln_g[l], lam_init)
        y = jnp.concatenate([a_out, b_out], axis=-1) @ w_out[l]
        x = x + gate1 * rms_norm(y, norm_g[l, 1])

        h = rms_norm(x, norm_g[l, 2]) * (1.0 + scale2) + shift2
        y = peer(h, peer_w_query[l], peer_sub_keys[l], peer_u[l], peer_v[l])
        x = x + gate2 * rms_norm(y, norm_g[l, 3])
    return x
```

```cpp
#define MK_PER_PHASE 0
#include <hip/hip_runtime.h>
#include <cstdio>
#include <cstdint>
namespace pg8 {
#define PG8_LAS __attribute__((address_space(3)))
typedef unsigned short bf16_t;
typedef short bf16x8 __attribute__((ext_vector_type(8)));
typedef float f32x4 __attribute__((ext_vector_type(4)));
typedef unsigned u32x4 __attribute__((ext_vector_type(4)));
constexpr int BM = 256, BK = 64, HALF = 128, HTB = HALF * BK * 2  , STAGE_BYTES = 8 * HTB, NXCD = 8, WGM = 4;

__host__ __device__ __forceinline__ int lds_byte(int r, int c) { const int st = (r >> 4) * 2 + (c >> 5), rr = r & 15, cc = c & 31, ob = rr * 64 + cc * 2; return st * 1024 + (ob ^ (((ob >> 9) & 1) << 5)); }
__host__ __device__ __forceinline__ void stage_rc(int b, int& R, int& C) { const int st = b / 1024, sb = b % 1024, swz = sb ^ (((sb >> 9) & 1) << 5); R = (st >> 1) * 16 + swz / 64; C = (st & 1) * 32 + (swz % 64) / 2; }
__host__ __device__ __forceinline__ int perm32(int rho) { const int n = rho >> 4, i = rho & 15; return 8 * (i >> 2) + 4 * n + (i & 3); }

struct Unit { int pm, pn; };
struct Gemm { const bf16_t* A; const bf16_t* Bt; int M, N, K; };

struct StaticOrder {
    int nM, nN, nwg, G, c;
    __host__ __device__ void init(int M, int N, int G_, int c_) { nM = M / BM; nN = N / BM; nwg = nM * nN; G = G_; c = c_; }
    __host__ __device__ bool next(int i, Unit& u) const {
        const long L = (long)i * G + c; if (L >= nwg) return false;
        int wgid = (int)L; { const int q = nwg / NXCD, r = nwg % NXCD, xcd = wgid % NXCD, off = wgid / NXCD; wgid = (xcd < r ? xcd * (q + 1) : r * (q + 1) + (xcd - r) * q) + off; }
        const int nig = WGM * nN, gid = wgid / nig, fm = gid * WGM, gsz = (nM - fm) < WGM ? (nM - fm) : WGM;
        u.pm = fm + ((wgid % nig) % gsz); u.pn = (wgid % nig) / gsz; return true;
    }
    __device__ __forceinline__ void a_ready(const Unit&) const {}
    __device__ __forceinline__ void done(const Unit&) const {}
};

__device__ __forceinline__ unsigned cvt_pk_bf16(float lo, float hi) { unsigned r; asm volatile("v_cvt_pk_bf16_f32 %0, %1, %2" : "=v"(r) : "v"(lo), "v"(hi)); return r; }
typedef float f32x2 __attribute__((ext_vector_type(2)));
__device__ __forceinline__ f32x2 gelu_pk(f32x2 v) {
    const f32x2 u = v * (v * v * 0.044715f + 1.0f);
    const f32x2 s = u * (-2.302208198f);
    f32x2 e; e.x = __builtin_amdgcn_exp2f(s.x); e.y = __builtin_amdgcn_exp2f(s.y);
    const f32x2 d = e + 1.0f;
    f32x2 r; r.x = __builtin_amdgcn_rcpf(d.x); r.y = __builtin_amdgcn_rcpf(d.y);
    return v * r;
}

template <int ACT  > struct EpiBf16 {
    static constexpr bool PERM = true, AFTER_DRAIN = false;
    bf16_t* O; int ldc; const float* bias; int split_cols; size_t split_stride; float scale0; int act_cols;
    __device__ __forceinline__ void operator()(const f32x4 (&acc)[2][2][4][2], const Unit& u, int wr, int wc, int fr, int fq) const {
        const int row0 = u.pm * BM + wr * 64 + fr; int colt = u.pn * BM; bf16_t* base = O;
        float sc = 1.f; if (split_cols) { const int t = colt / split_cols; base += (size_t)t * split_stride; colt -= t * split_cols; if (t == 0) sc = scale0; }
        const int col0 = colt + wc * 32 + 8 * fq, bcol0 = u.pn * BM + wc * 32 + 8 * fq;
        f32x4 bv[2][2];
#pragma unroll
        for (int bj = 0; bj < 2; ++bj)
#pragma unroll
            for (int n = 0; n < 2; ++n) bv[bj][n] = bias ? *(const f32x4*)(bias + bcol0 + bj * HALF + 4 * n) : (f32x4){0.f, 0.f, 0.f, 0.f};
#pragma unroll
        for (int ai = 0; ai < 2; ++ai)
#pragma unroll
            for (int m = 0; m < 4; ++m) { bf16_t* rowp = base + (size_t)(row0 + ai * HALF + m * 16) * ldc + col0;
#pragma unroll
                for (int bj = 0; bj < 2; ++bj) { f32x4 v0 = acc[ai][bj][m][0] + bv[bj][0], v1 = acc[ai][bj][m][1] + bv[bj][1];
                    if (ACT == 1 && u.pn * BM < act_cols) { f32x2 a = gelu_pk((f32x2){v0[0], v0[1]}), b = gelu_pk((f32x2){v0[2], v0[3]}), c = gelu_pk((f32x2){v1[0], v1[1]}), d = gelu_pk((f32x2){v1[2], v1[3]});
                        v0 = (f32x4){a.x, a.y, b.x, b.y}; v1 = (f32x4){c.x, c.y, d.x, d.y}; }
                    v0 = v0 * sc; v1 = v1 * sc; u32x4 w; w.x = cvt_pk_bf16(v0[0], v0[1]); w.y = cvt_pk_bf16(v0[2], v0[3]); w.z = cvt_pk_bf16(v1[0], v1[1]); w.w = cvt_pk_bf16(v1[2], v1[3]);
                    *(u32x4*)(rowp + bj * HALF) = w; } }
    }
};

template <class Epi, class Sched, bool ALIGN_EPI = false, bool SP2 = false>
__device__ __forceinline__ void gemm_phase(PG8_LAS unsigned char* lds, const Gemm g, const Sched& S, const Epi& E, const int wid  ) {
    const int lane = (int)__builtin_amdgcn_mbcnt_hi(~0u, __builtin_amdgcn_mbcnt_lo(~0u, 0u)), tid = wid * 64 + lane, wr = wid >> 2, wc = wid & 3, fr = lane & 15, fq = lane >> 4;
    const int K = g.K, nt = K / BK;
    unsigned voffA[2], voffB[2];
#pragma unroll
    for (int i = 0; i < 2; ++i) { int R, C; stage_rc(tid * 16 + i * 8192, R, C); const int Rb = Epi::PERM ? ((R & ~31) + perm32(R & 31)) : R;
        voffA[i] = (unsigned)(R * K + C) * 2u; voffB[i] = (unsigned)(Rb * K + C) * 2u; }
    const size_t kstep = (size_t)(BK * 2);
    const size_t hstep = (size_t)HALF * K * 2;
    const size_t tstep = 2 * hstep;
    const unsigned ldsw = (unsigned)wid * 1024u;
    const int aoff = lds_byte(wr * 64 + fr, fq * 8), boff = lds_byte(wc * 32 + fr, fq * 8);
#define PG8_SA(b, h) (((b) * 2 + (h)) * HTB)
#define PG8_SB(b, h) ((4 + (b) * 2 + (h)) * HTB)
#define PG8_STAGE(bufoff, gbase, voff) do { _Pragma("unroll") for (int _i = 0; _i < 2; ++_i) \
        __builtin_amdgcn_global_load_lds((const unsigned*)((const char*)(gbase) + (voff)[_i]), (PG8_LAS unsigned*)(lds + (bufoff) + ldsw + _i * 8192), 16, 0, 0); } while (0)
#define PG8_LDA(dst, b, h) do { _Pragma("unroll") for (int m = 0; m < 4; ++m) _Pragma("unroll") for (int k = 0; k < 2; ++k) dst[m][k] = *(const PG8_LAS bf16x8*)(lds + PG8_SA(b, h) + aoff + m * 2048 + k * 1024); } while (0)
#define PG8_LDB(dst, b, h) do { _Pragma("unroll") for (int n = 0; n < 2; ++n) _Pragma("unroll") for (int k = 0; k < 2; ++k) dst[n][k] = *(const PG8_LAS bf16x8*)(lds + PG8_SB(b, h) + boff + n * 2048 + k * 1024); } while (0)
#define PG8_MMA(ai, bj, At, Bt) do { __builtin_amdgcn_s_setprio(1); _Pragma("unroll") for (int m = 0; m < 4; ++m) _Pragma("unroll") for (int n = 0; n < 2; ++n) _Pragma("unroll") for (int k = 0; k < 2; ++k) \
        acc[ai][bj][m][n] = __builtin_amdgcn_mfma_f32_16x16x32_bf16(Bt[n][k], At[m][k], acc[ai][bj][m][n], 0, 0, 0); __builtin_amdgcn_s_setprio(0); } while (0)
#define PG8_WAIT_V(n) asm volatile("s_waitcnt vmcnt(" #n ")" ::: "memory")
#define PG8_WAIT_L(n) asm volatile("s_waitcnt lgkmcnt(" #n ")" ::: "memory")
#define PG8_BAR __builtin_amdgcn_s_barrier()
#define PG8_SCHED __builtin_amdgcn_sched_barrier(0)
    Unit cur, nxt; int ui = 0;
    if (!S.next(0, cur)) return;
    f32x4 acc[2][2][4][2];
#pragma unroll
    for (int a = 0; a < 2; ++a)
#pragma unroll
        for (int b = 0; b < 2; ++b)
#pragma unroll
            for (int m = 0; m < 4; ++m)
#pragma unroll
                for (int n = 0; n < 2; ++n) acc[a][b][m][n] = (f32x4){0.f, 0.f, 0.f, 0.f};
    bf16x8 At[4][2], B0[2][2], B1[2][2];
    const char* cA = (const char*)g.A + (size_t)cur.pm * tstep; const char* cB = (const char*)g.Bt + (size_t)cur.pn * tstep;
    S.a_ready(cur);
    if constexpr (SP2) {
        PG8_STAGE(PG8_SB(0, 0), cB, voffB); PG8_STAGE(PG8_SB(0, 1), cB + hstep, voffB); PG8_STAGE(PG8_SA(0, 0), cA, voffA); PG8_STAGE(PG8_SA(0, 1), cA + hstep, voffA);
        if (wr == 1) PG8_BAR;
        PG8_WAIT_V(2); PG8_BAR;
        PG8_STAGE(PG8_SB(1, 0), cB + kstep, voffB); PG8_STAGE(PG8_SA(1, 0), cA + kstep, voffA); PG8_STAGE(PG8_SB(1, 1), cB + hstep + kstep, voffB);
        PG8_WAIT_V(6); PG8_BAR;
    } else {
        PG8_STAGE(PG8_SB(0, 0), cB, voffB); PG8_STAGE(PG8_SA(0, 0), cA, voffA); PG8_STAGE(PG8_SB(0, 1), cB + hstep, voffB); PG8_STAGE(PG8_SA(0, 1), cA + hstep, voffA);
        if (wr == 1) PG8_BAR;
        PG8_WAIT_V(4); PG8_BAR;
        PG8_STAGE(PG8_SB(1, 0), cB + kstep, voffB); PG8_STAGE(PG8_SA(1, 0), cA + kstep, voffA); PG8_STAGE(PG8_SB(1, 1), cB + hstep + kstep, voffB);
        PG8_WAIT_V(6); PG8_BAR;
    }
    for (;;) {
        const bool has_next = S.next(ui + 1, nxt);
        const char* nA = has_next ? (const char*)g.A + (size_t)nxt.pm * tstep : cA; const char* nB = has_next ? (const char*)g.Bt + (size_t)nxt.pn * tstep : cB;
        for (int t = 0; t < nt; t += 2) {
            const bool last = (t == nt - 2);
            const char* a1 = cA + (size_t)(t + 1) * kstep;
            const char* a2 = last ? nA : cA + (size_t)(t + 2) * kstep; const char* b2 = last ? nB : cB + (size_t)(t + 2) * kstep;
            const char* a3 = a2 + kstep; const char* b3 = b2 + kstep;
            if (last && has_next) S.a_ready(nxt);
            if constexpr (SP2) {
            PG8_LDB(B0, 0, 0); PG8_LDB(B1, 0, 1); PG8_SCHED; PG8_LDA(At, 0, 0); PG8_STAGE(PG8_SA(1, 1), a1 + hstep, voffA);
            PG8_WAIT_V(8); PG8_WAIT_L(0); PG8_BAR; PG8_MMA(0, 0, At, B0); PG8_MMA(0, 1, At, B1); PG8_BAR; PG8_SCHED;
            PG8_LDA(At, 0, 1); PG8_STAGE(PG8_SB(0, 0), b2, voffB); PG8_STAGE(PG8_SB(0, 1), b2 + hstep, voffB); PG8_STAGE(PG8_SA(0, 0), a2, voffA);
            PG8_WAIT_V(8); PG8_WAIT_L(0); PG8_BAR; PG8_MMA(1, 0, At, B0); PG8_MMA(1, 1, At, B1); PG8_BAR; PG8_SCHED;
            PG8_LDB(B0, 1, 0); PG8_LDB(B1, 1, 1); PG8_SCHED; PG8_LDA(At, 1, 0); PG8_STAGE(PG8_SA(0, 1), a2 + hstep, voffA);
            PG8_WAIT_V(8); PG8_WAIT_L(0); PG8_BAR; PG8_MMA(0, 0, At, B0); PG8_MMA(0, 1, At, B1); PG8_BAR; PG8_SCHED;
            PG8_LDA(At, 1, 1); PG8_STAGE(PG8_SB(1, 0), b3, voffB); PG8_STAGE(PG8_SB(1, 1), b3 + hstep, voffB); PG8_STAGE(PG8_SA(1, 0), a3, voffA);
            PG8_WAIT_V(8); PG8_WAIT_L(0); PG8_BAR; PG8_MMA(1, 0, At, B0); PG8_MMA(1, 1, At, B1); PG8_BAR; PG8_SCHED;
            } else {
            PG8_LDB(B0, 0, 0); PG8_SCHED; PG8_LDA(At, 0, 0); PG8_STAGE(PG8_SA(1, 1), a1 + hstep, voffA);
            PG8_WAIT_L(8); PG8_BAR; PG8_WAIT_L(0); PG8_MMA(0, 0, At, B0); PG8_BAR; PG8_SCHED;
            PG8_LDB(B1, 0, 1); PG8_STAGE(PG8_SB(0, 0), b2, voffB);
            PG8_BAR; PG8_WAIT_L(0); PG8_MMA(0, 1, At, B1); PG8_BAR;
            PG8_LDA(At, 0, 1); PG8_STAGE(PG8_SA(0, 0), a2, voffA);
            PG8_BAR; PG8_WAIT_L(0); PG8_MMA(1, 0, At, B0); PG8_BAR; PG8_SCHED;
            PG8_STAGE(PG8_SB(0, 1), b2 + hstep, voffB);
            PG8_WAIT_V(6); PG8_BAR; PG8_MMA(1, 1, At, B1); PG8_BAR;
            PG8_LDB(B0, 1, 0); PG8_SCHED; PG8_LDA(At, 1, 0); PG8_STAGE(PG8_SA(0, 1), a2 + hstep, voffA);
            PG8_WAIT_L(8); PG8_BAR; PG8_WAIT_L(0); PG8_MMA(0, 0, At, B0); PG8_BAR; PG8_SCHED;
            PG8_LDB(B1, 1, 1); PG8_STAGE(PG8_SB(1, 0), b3, voffB);
            PG8_BAR; PG8_WAIT_L(0); PG8_MMA(0, 1, At, B1); PG8_BAR;
            PG8_LDA(At, 1, 1); PG8_STAGE(PG8_SA(1, 0), a3, voffA);
            PG8_BAR; PG8_WAIT_L(0); PG8_MMA(1, 0, At, B0); PG8_BAR; PG8_SCHED;
            PG8_STAGE(PG8_SB(1, 1), b3 + hstep, voffB);
            PG8_WAIT_V(6); PG8_BAR; PG8_MMA(1, 1, At, B1); PG8_BAR;
            }
        }
        if constexpr (ALIGN_EPI) { if (wr == 0) PG8_BAR; }
        if constexpr (!Epi::AFTER_DRAIN) { E(acc, cur, wr, wc, fr, fq); S.done(cur); }
        if (!has_next) break;
#pragma unroll
        for (int a = 0; a < 2; ++a)
#pragma unroll
            for (int b = 0; b < 2; ++b)
#pragma unroll
                for (int m = 0; m < 4; ++m)
#pragma unroll
                    for (int n = 0; n < 2; ++n) acc[a][b][m][n] = (f32x4){0.f, 0.f, 0.f, 0.f};
        cur = nxt; cA = nA; cB = nB; ++ui;
        if constexpr (ALIGN_EPI) { if (wr == 1) PG8_BAR; }
    }
    PG8_WAIT_V(0);
    if constexpr (!ALIGN_EPI) { if (wr == 0) PG8_BAR; }
    PG8_BAR;
    if constexpr (Epi::AFTER_DRAIN) { E.fused(acc, cur, wr, wc, fr, fq, lds, wid, lane); S.done(cur); }
#undef PG8_SA
#undef PG8_SB
#undef PG8_STAGE
#undef PG8_LDA
#undef PG8_LDB
#undef PG8_MMA
#undef PG8_WAIT_V
#undef PG8_WAIT_L
#undef PG8_BAR
#undef PG8_SCHED
}
}
#ifndef MK_PER_PHASE
#define MK_PER_PHASE 0
#endif
#ifndef PROBE_PHASE
#define PROBE_PHASE -1
#endif
#ifndef X1_NR
#define X1_NR 2
#endif
#ifndef TABLES_IN_PHASE
#define TABLES_IN_PHASE 0
#endif
constexpr int NWAVES = 8, NTHR = NWAVES * 64;
constexpr int BATCH = 8, SEQ = 4096, D = 1024, M = BATCH * SEQ;
constexpr int INC = 2560;
constexpr int NEXP = 16384, PKN = 128;
constexpr int NQ = 2048;
constexpr float EPS = 1e-6f;
constexpr size_t MiB = 1u << 20;
constexpr size_t WS_CTL = 0, CTL_ZERO_BYTES = MK_PER_PHASE ? (1u << 20) : 64 * 1024;
constexpr size_t WS_MOD = 1 * MiB, WS_WIN = 2 * MiB, WS_WOUT = 7 * MiB, WS_WQ = 9 * MiB, WS_KEYS = 13 * MiB, WS_SGW = 13 * MiB + 512 * 1024;
constexpr size_t WS_SU = 14 * MiB, WS_UT = 16 * MiB, WS_VT = 48 * MiB, WS_H = 80 * MiB, WS_Y = 144 * MiB, WS_OATT = 80 * MiB, WS_Z = 208 * MiB, WS_QP = 208 * MiB;
constexpr size_t WS_H8 = 336 * MiB;
constexpr size_t WS_CAT = 368 * MiB, WS_IDX = 432 * MiB, WS_GATE = 448 * MiB, WS_END = 464 * MiB;
constexpr int CW_BAR = 4096;
constexpr int RING_BYTES = 131072, LDSCTL_OFF = RING_BYTES, MISC_OFF = LDSCTL_OFF + 320, LDS_BYTES = 147456;
constexpr int NPHASE = 10;

#define GAS __attribute__((address_space(1)))
#define LAS __attribute__((address_space(3)))
typedef unsigned short bf16;
typedef unsigned v4u __attribute__((ext_vector_type(4)));
typedef unsigned v2u __attribute__((ext_vector_type(2)));
typedef float f32x4 __attribute__((ext_vector_type(4)));
typedef short bf16x8 __attribute__((ext_vector_type(8)));
typedef GAS unsigned gu32;
typedef GAS unsigned long long gu64;
#define RLX_AGENT __ATOMIC_RELAXED, __HIP_MEMORY_SCOPE_AGENT
#define LDS_WAIT() asm volatile("s_waitcnt lgkmcnt(0)" ::: "memory")
#define VM_WAIT() asm volatile("s_waitcnt vmcnt(0)" ::: "memory")
__device__ __forceinline__ unsigned f2bf(float f) { unsigned u = __builtin_bit_cast(unsigned, f); return (u + 0x7fffu + ((u >> 16) & 1u)) >> 16; }
__device__ __forceinline__ unsigned pk2(float lo, float hi) { return f2bf(lo) | (f2bf(hi) << 16); }
__device__ __forceinline__ float bflo(unsigned w) { return __uint_as_float(w << 16); }
__device__ __forceinline__ float bfhi(unsigned w) { return __uint_as_float(w & 0xffff0000u); }
__device__ __forceinline__ float bf2f(bf16 b) { return __uint_as_float((unsigned)b << 16); }
typedef __bf16 bf16x2_t __attribute__((ext_vector_type(2)));
__device__ __forceinline__ float dot2(unsigned a, unsigned b, float acc) { return __builtin_amdgcn_fdot2_f32_bf16(__builtin_bit_cast(bf16x2_t, a), __builtin_bit_cast(bf16x2_t, b), acc, false); }
__device__ __forceinline__ float gelu_t(float v) { const float u = v * (1.f + 0.044715f * v * v); return v * __builtin_amdgcn_rcpf(1.f + __builtin_amdgcn_exp2f(-2.302208198f * u)); }
__device__ __forceinline__ int lane_id() { return (int)__builtin_amdgcn_mbcnt_hi(~0u, __builtin_amdgcn_mbcnt_lo(~0u, 0u)); }
__device__ __forceinline__ float wave_sum(float v) {
#pragma unroll
    for (int o = 1; o < 64; o <<= 1) v += __shfl_xor(v, o);
    return v;
}
#define DPP_SUM_ROW(v) do { v += __uint_as_float((unsigned)__builtin_amdgcn_update_dpp(0, (int)__float_as_uint(v), 0xB1, 0xF, 0xF, false)); \
        v += __uint_as_float((unsigned)__builtin_amdgcn_update_dpp(0, (int)__float_as_uint(v), 0x4E, 0xF, 0xF, false)); \
        v += __uint_as_float((unsigned)__builtin_amdgcn_update_dpp(0, (int)__float_as_uint(v), 0x141, 0xF, 0xF, false)); \
        v += __uint_as_float((unsigned)__builtin_amdgcn_update_dpp(0, (int)__float_as_uint(v), 0x140, 0xF, 0xF, false)); } while (0)
__device__ __forceinline__ float dpp_xor1(float v) { return __uint_as_float((unsigned)__builtin_amdgcn_update_dpp(0, (int)__float_as_uint(v), 0xB1, 0xF, 0xF, false)); }
__device__ __forceinline__ float wave_sum_dpp(float v) {
    DPP_SUM_ROW(v);
    const float r0 = __uint_as_float(__builtin_amdgcn_readlane(__float_as_uint(v), 0)), r1 = __uint_as_float(__builtin_amdgcn_readlane(__float_as_uint(v), 16));
    const float r2 = __uint_as_float(__builtin_amdgcn_readlane(__float_as_uint(v), 32)), r3 = __uint_as_float(__builtin_amdgcn_readlane(__float_as_uint(v), 48));
    return (r0 + r1) + (r2 + r3);
}
__device__ __forceinline__ float wave_max_dpp(float v) {
    v = fmaxf(v, __uint_as_float((unsigned)__builtin_amdgcn_update_dpp(0, (int)__float_as_uint(v), 0xB1, 0xF, 0xF, false)));
    v = fmaxf(v, __uint_as_float((unsigned)__builtin_amdgcn_update_dpp(0, (int)__float_as_uint(v), 0x4E, 0xF, 0xF, false)));
    v = fmaxf(v, __uint_as_float((unsigned)__builtin_amdgcn_update_dpp(0, (int)__float_as_uint(v), 0x141, 0xF, 0xF, false)));
    v = fmaxf(v, __uint_as_float((unsigned)__builtin_amdgcn_update_dpp(0, (int)__float_as_uint(v), 0x140, 0xF, 0xF, false)));
    const float r0 = __uint_as_float(__builtin_amdgcn_readlane(__float_as_uint(v), 0)), r1 = __uint_as_float(__builtin_amdgcn_readlane(__float_as_uint(v), 16));
    const float r2 = __uint_as_float(__builtin_amdgcn_readlane(__float_as_uint(v), 32)), r3 = __uint_as_float(__builtin_amdgcn_readlane(__float_as_uint(v), 48));
    return fmaxf(fmaxf(r0, r1), fmaxf(r2, r3));
}
__device__ __forceinline__ float half_max_dpp(float v) {
    v = fmaxf(v, __uint_as_float((unsigned)__builtin_amdgcn_update_dpp(0, (int)__float_as_uint(v), 0xB1, 0xF, 0xF, false)));
    v = fmaxf(v, __uint_as_float((unsigned)__builtin_amdgcn_update_dpp(0, (int)__float_as_uint(v), 0x4E, 0xF, 0xF, false)));
    v = fmaxf(v, __uint_as_float((unsigned)__builtin_amdgcn_update_dpp(0, (int)__float_as_uint(v), 0x141, 0xF, 0xF, false)));
    v = fmaxf(v, __uint_as_float((unsigned)__builtin_amdgcn_update_dpp(0, (int)__float_as_uint(v), 0x140, 0xF, 0xF, false)));
    const float r0 = __uint_as_float(__builtin_amdgcn_readlane(__float_as_uint(v), 0)), r1 = __uint_as_float(__builtin_amdgcn_readlane(__float_as_uint(v), 16));
    const float r2 = __uint_as_float(__builtin_amdgcn_readlane(__float_as_uint(v), 32)), r3 = __uint_as_float(__builtin_amdgcn_readlane(__float_as_uint(v), 48));
    return (lane_id() < 32) ? fmaxf(r0, r1) : fmaxf(r2, r3);
}
__device__ __forceinline__ float wave_max(float v) {
#pragma unroll
    for (int o = 1; o < 64; o <<= 1) v = fmaxf(v, __shfl_xor(v, o));
    return v;
}
#define XB_TMO      128
#define XB_XCNT(j)  (256  + 64 * (j))
#define XB_XSUB(j)  (1280 + 64 * (j))
#define XB_XGEN(j)  (2304 + 64 * (j))
#define XB_TOP      3328
#define XB_TOPGEN   3392
#define XCD_BAR_WORDS 3456
#define XB_SPIN_CAP (1u << 18)

__device__ __forceinline__ unsigned xb_ld(unsigned* p)              { return __hip_atomic_load(p, __ATOMIC_RELAXED, __HIP_MEMORY_SCOPE_AGENT); }
__device__ __forceinline__ unsigned xb_add(unsigned* p, unsigned v) { return __hip_atomic_fetch_add(p, v, __ATOMIC_RELAXED, __HIP_MEMORY_SCOPE_AGENT); }
__device__ __forceinline__ unsigned xb_xcc_id() { return (unsigned)__builtin_amdgcn_s_getreg((3 << 11) | 20) & 0xFu; }
#define XB_SPIN(cond, bar) do { unsigned _sp = 0; while (cond) { __builtin_amdgcn_s_sleep(1); \
    if ((++_sp & 255u) == 0u) { if (xb_ld(&(bar)[XB_TMO])) break; if (_sp > XB_SPIN_CAP) { atomicAdd(&(bar)[XB_TMO], 1u); break; } } } } while (0)

struct XcdBarrier {
    unsigned* bar; unsigned x;
    volatile LAS unsigned* st;
};

__device__ __forceinline__ XcdBarrier xcd_barrier_post(unsigned* bar, volatile LAS unsigned* st) {
    XcdBarrier b; b.bar = bar; b.x = xb_xcc_id(); b.st = st;
    if (threadIdx.x == 0) (void)xb_add(&bar[XB_XCNT(b.x)], 1u);
    return b;
}
__device__ __forceinline__ void xcd_barrier_complete(unsigned* bar, unsigned x, unsigned& nloc, unsigned& nx) {
    const unsigned G = gridDim.x * gridDim.y * gridDim.z;
    unsigned sum, cnt, mine, sp = 0u;
    for (;;) {
        sum = 0u; cnt = 0u; mine = 0u;
#pragma unroll
        for (unsigned j = 0; j < 16; ++j) { const unsigned c = xb_ld(&bar[XB_XCNT(j)]); sum += c; cnt += (c > 0u) ? 1u : 0u; mine = (j == x) ? c : mine; }
        if (sum == G) break;
        __builtin_amdgcn_s_sleep(1);
        if ((++sp & 255u) == 0u) { if (xb_ld(&bar[XB_TMO])) break; if (sp > XB_SPIN_CAP) { atomicAdd(&bar[XB_TMO], 1u); break; } }
    }
    nloc = mine > 0u ? mine : 1u; nx = cnt > 0u ? cnt : 1u;
}

__device__ __forceinline__ void xcd_barrier(const XcdBarrier& b) {
    asm volatile("s_waitcnt vmcnt(0)" ::: "memory");
    __syncthreads();
    if (threadIdx.x == 0) {
        unsigned* bar = b.bar;
        __builtin_amdgcn_s_waitcnt(0);
        unsigned nloc = b.st[0], nx = b.st[1];
        if (nloc == 0u) { xcd_barrier_complete(bar, b.x, nloc, nx); b.st[0] = nloc; b.st[1] = nx; }
        const unsigned old = xb_add(&bar[XB_XSUB(b.x)], 1u);
        const unsigned gen = old / nloc;
        if (old + 1u == (gen + 1u) * nloc) {
            __builtin_amdgcn_fence(__ATOMIC_RELEASE, "agent");
            asm volatile("s_waitcnt vmcnt(0)" ::: "memory");
            const unsigned og = xb_add(&bar[XB_TOP], 1u);
            const unsigned tg = og / nx;
            if (og + 1u == (tg + 1u) * nx) xb_add(&bar[XB_TOPGEN], 1u);
            else XB_SPIN(xb_ld(&bar[XB_TOPGEN]) == tg, bar);
            __builtin_amdgcn_fence(__ATOMIC_ACQUIRE, "agent");
            xb_add(&bar[XB_XGEN(b.x)], 1u);
            asm volatile("s_waitcnt vmcnt(0)" ::: "memory");
        } else {
            XB_SPIN(xb_ld(&bar[XB_XGEN(b.x)]) == gen, bar);
            __builtin_amdgcn_fence(__ATOMIC_ACQUIRE, "agent");
            asm volatile("s_waitcnt vmcnt(0)" ::: "memory");
        }
    }
    __syncthreads();
}
struct Frame {
    LAS unsigned char* lds;
    volatile LAS unsigned* MISC;
    gu32* ctl;
    int wave, G;
    const float *x, *c, *w_ada, *b_ada, *norm_g, *w_in, *sgu_ln_g, *sgu_ln_b, *sgu_w, *sgu_b, *diff_lambda, *subln_g, *rel_bias, *w_out, *w_query, *sub_keys, *peer_u, *peer_v;
    float* out;
    float* mod; bf16 *WIN, *WOUT, *WQ, *KEYS, *SGW, *H, *Y, *Z, *QP, *CAT; unsigned char *UT8, *VT6, *H8; float* HS; float *SU, *SV, *PART; unsigned* STASH; int* IDX; float* GATE;
};

__device__ __forceinline__ void p0_transpose_item(const float* W, int K, int N, bf16* WT, int row_off, LAS float* scr, int item, int lane) {
    const int nblk = N / 32, kb = item / nblk, nb = item % nblk, k0 = 64 * kb, n0 = 32 * nb;
#pragma unroll 8
    for (int i = 0; i < 32; ++i) { const int kk = 2 * i + (lane >> 5); scr[kk * 33 + (lane & 31)] = W[(size_t)(k0 + kk) * N + n0 + (lane & 31)]; }
    LDS_WAIT(); asm volatile("" ::: "memory");
    const int c = lane & 7;
#pragma unroll
    for (int j = 0; j < 4; ++j) { const int n = (lane >> 3) + 8 * j; const LAS float* s = scr + (8 * c) * 33 + n;
        v4u o; o.x = pk2(s[0 * 33], s[1 * 33]); o.y = pk2(s[2 * 33], s[3 * 33]); o.z = pk2(s[4 * 33], s[5 * 33]); o.w = pk2(s[6 * 33], s[7 * 33]);
        *(GAS v4u*)(WT + (size_t)(row_off + n0 + n) * K + k0 + 8 * c) = o; }
    LDS_WAIT(); asm volatile("" ::: "memory");
}

__device__ __forceinline__ void prologue_tables_fwd(Frame& F, int gw, int NGW, int lane);
__device__ __forceinline__ void ph_prologue(Frame& F) {
    const int lane = lane_id(), wave = F.wave, tid = wave * 64 + lane, G = F.G;
    const int gw = blockIdx.x * NWAVES + wave, NGW = G * NWAVES;
    for (int rep_ = 0; rep_ < (PROBE_PHASE == 100 ? 2 : 1); ++rep_) {
        LAS float* sil = (LAS float*)F.lds;
        LAS float* red = sil + 8192;
        for (int i = tid; i < 8192; i += NTHR) { const float cv = F.c[i]; sil[i] = cv / (1.f + __expf(-cv)); }
        __syncthreads();
        for (int u = blockIdx.x; u < 384; u += G) {
            const int j = u * 16 + (lane & 15), kr = lane >> 4, k0 = wave * 128;
            float acc[8];
#pragma unroll
            for (int b = 0; b < 8; ++b) acc[b] = 0.f;
            const float* wp = F.w_ada + (size_t)(k0 + kr) * 6144 + j;
#pragma unroll 16
            for (int i = 0; i < 32; ++i) { const float w = wp[(size_t)i * 4 * 6144]; const int k = k0 + 4 * i + kr;
#pragma unroll
                for (int b = 0; b < 8; ++b) acc[b] += sil[b * 1024 + k] * w; }
#pragma unroll
            for (int b = 0; b < 8; ++b) { acc[b] += __shfl_xor(acc[b], 16); acc[b] += __shfl_xor(acc[b], 32); }
            if (lane < 16) {
#pragma unroll
                for (int b = 0; b < 8; ++b) red[(wave * 8 + b) * 16 + lane] = acc[b]; }
            __syncthreads();
            if (tid < 128) { const int b = tid >> 4, c = tid & 15; float s = 0.f;
#pragma unroll
                for (int w = 0; w < 8; ++w) s += red[(w * 8 + b) * 16 + c];
                F.mod[b * 6144 + u * 16 + c] = s + F.b_ada[u * 16 + c]; }
            __syncthreads();
        }
    }
    LAS float* scr = (LAS float*)(F.lds + wave * 16384);
    constexpr int I_IN = (D / 64) * (INC / 32), I_OUT = (D / 64) * (D / 32), I_Q = (D / 64) * (NQ / 32);
    for (int rep_ = 0; rep_ < (PROBE_PHASE == 101 ? 2 : 1); ++rep_)
    for (int it = gw; it < I_IN + I_OUT + I_Q; it += NGW) {
        int r = it;
        if (r < I_IN) { p0_transpose_item(F.w_in, D, INC, F.WIN, 0, scr, r, lane); continue; } r -= I_IN;
        if (r < I_OUT) { p0_transpose_item(F.w_out, D, D, F.WOUT, 0, scr, r, lane); continue; } r -= I_OUT;
        p0_transpose_item(F.w_query, D, NQ, F.WQ, 0, scr, r, lane);
    }
    const int gt = blockIdx.x * NTHR + tid, NT = G * NTHR;
    if (TABLES_IN_PHASE == 0) for (int rep_ = 0; rep_ < (PROBE_PHASE == 102 ? 2 : 1); ++rep_) prologue_tables_fwd(F, gw, NGW, lane);
    for (int i = gt; i < 16 * 16 * 128; i += NT) {
        const int hc = i >> 11, dg = (i >> 7) & 15, n = i & 127;
        const float* s = F.sub_keys + ((size_t)(hc * 128 + n)) * 128 + dg * 8;
        const f32x4 a = *(const f32x4*)s, b = *(const f32x4*)(s + 4);
        v4u o; o.x = pk2(a.x, a.y); o.y = pk2(a.z, a.w); o.z = pk2(b.x, b.y); o.w = pk2(b.z, b.w); ((v4u*)F.KEYS)[i] = o;
    }
    for (int i = gt; i < 8 * 128 * 16; i += NT) {
        const int t = (i >> 4) & 127, s0 = (i & 15) * 8;
        const float* s = F.sgu_w + (size_t)i * 8;
        const f32x4 a = *(const f32x4*)s, b = *(const f32x4*)(s + 4);
        float f[8] = {a.x, a.y, a.z, a.w, b.x, b.y, b.z, b.w};
#pragma unroll
        for (int e = 0; e < 8; ++e) f[e] = (s0 + e <= t) ? f[e] : 0.f;
        v4u o; o.x = pk2(f[0], f[1]); o.y = pk2(f[2], f[3]); o.z = pk2(f[4], f[5]); o.w = pk2(f[6], f[7]); ((v4u*)F.SGW)[i] = o;
    }
}

__device__ __forceinline__ void ph_hrows(Frame& F) {
    const int lane = lane_id(); const int gw = blockIdx.x * NWAVES + F.wave, NGW = F.G * NWAVES;
    for (int m0 = gw; m0 < M; m0 += 2 * NGW) {
        const int m1 = (m0 + NGW < M) ? m0 + NGW : m0;
        f32x4 v[2][4]; float ss[2] = {0.f, 0.f};
#pragma unroll
        for (int u = 0; u < 2; ++u) { const f32x4* xr = (const f32x4*)(F.x + (size_t)(u ? m1 : m0) * D) + lane;
#pragma unroll
            for (int j = 0; j < 4; ++j) v[u][j] = xr[64 * j]; }
#pragma unroll
        for (int u = 0; u < 2; ++u)
#pragma unroll
            for (int j = 0; j < 4; ++j) ss[u] += (v[u][j].x * v[u][j].x + v[u][j].y * v[u][j].y) + (v[u][j].z * v[u][j].z + v[u][j].w * v[u][j].w);
        const float r0 = rsqrtf(wave_sum_dpp(ss[0]) * (1.f / D) + EPS), r1 = rsqrtf(wave_sum_dpp(ss[1]) * (1.f / D) + EPS);
#pragma unroll
        for (int u = 0; u < 2; ++u) { const int m = u ? m1 : m0; const float rstd = u ? r1 : r0;
            const float* md = F.mod + (m >> 12) * 6144;
            v2u* o8 = (v2u*)(F.H + (size_t)m * D) + lane;
#pragma unroll
            for (int j = 0; j < 4; ++j) { const int c = 256 * j + 4 * lane;
                const f32x4 g = *(const f32x4*)(F.norm_g + c), sc = *(const f32x4*)(md + 1024 + c), sh = *(const f32x4*)(md + c);
                const f32x4 hv = v[u][j] * rstd * g * (sc + 1.f) + sh;
                v2u w; w.x = pk2(hv.x, hv.y); w.y = pk2(hv.z, hv.w); if (u == 0 || m1 != m0) o8[64 * j] = w; } }
    }
}

__device__ __forceinline__ void ph_x1rows(Frame& F) {
    const int lane = lane_id(); const int gw = blockIdx.x * NWAVES + F.wave, NGW = F.G * NWAVES;
    constexpr int NR = X1_NR;
    for (int m0 = gw; m0 < M; m0 += NR * NGW) {
        int mr[NR]; bool ok[NR];
#pragma unroll
        for (int u = 0; u < NR; ++u) { ok[u] = (m0 + u * NGW < M); mr[u] = ok[u] ? m0 + u * NGW : m0; }
        f32x4 xv[NR][4], yv[NR][4]; float ss[NR];
#pragma unroll
        for (int u = 0; u < NR; ++u) { const int m = mr[u]; ss[u] = 0.f;
            const f32x4* xr = (const f32x4*)(F.x + (size_t)m * D) + lane; const v2u* yr = (const v2u*)(F.Y + (size_t)m * D) + lane;
#pragma unroll
            for (int j = 0; j < 4; ++j) { xv[u][j] = xr[64 * j]; const v2u w = yr[64 * j]; yv[u][j] = (f32x4){bflo(w.x), bfhi(w.x), bflo(w.y), bfhi(w.y)}; } }
#pragma unroll
        for (int u = 0; u < NR; ++u)
#pragma unroll
            for (int j = 0; j < 4; ++j) ss[u] += (yv[u][j].x * yv[u][j].x + yv[u][j].y * yv[u][j].y) + (yv[u][j].z * yv[u][j].z + yv[u][j].w * yv[u][j].w);
        float rs[NR], s1[NR];
#pragma unroll
        for (int u = 0; u < NR; ++u) { rs[u] = rsqrtf(wave_sum_dpp(ss[u]) * (1.f / D) + EPS); s1[u] = 0.f; }
#pragma unroll
        for (int u = 0; u < NR; ++u) { const int m = mr[u]; const float* md = F.mod + (m >> 12) * 6144; const float rstd = rs[u];
            f32x4* orow = (f32x4*)(F.out + (size_t)m * D) + lane;
#pragma unroll
            for (int j = 0; j < 4; ++j) { const int c = 256 * j + 4 * lane;
                const f32x4 g1 = *(const f32x4*)(F.norm_g + 1024 + c), gt = *(const f32x4*)(md + 2048 + c);
                xv[u][j] = xv[u][j] + gt * (yv[u][j] * rstd * g1); if (ok[u]) orow[64 * j] = xv[u][j];
                s1[u] += (xv[u][j].x * xv[u][j].x + xv[u][j].y * xv[u][j].y) + (xv[u][j].z * xv[u][j].z + xv[u][j].w * xv[u][j].w); } }
        float r1v[NR];
#pragma unroll
        for (int u = 0; u < NR; ++u) r1v[u] = rsqrtf(wave_sum_dpp(s1[u]) * (1.f / D) + EPS);
#pragma unroll
        for (int u = 0; u < NR; ++u) { const int m = mr[u]; const float* md = F.mod + (m >> 12) * 6144; const float r1 = r1v[u];
            v2u* o8 = (v2u*)(F.H + (size_t)m * D) + lane;
#pragma unroll
            for (int j = 0; j < 4; ++j) { const int c = 256 * j + 4 * lane;
                const f32x4 g2 = *(const f32x4*)(F.norm_g + 2048 + c), sc = *(const f32x4*)(md + 4096 + c), sh = *(const f32x4*)(md + 3072 + c);
                const f32x4 hv = xv[u][j] * r1 * g2 * (sc + 1.f) + sh; xv[u][j] = hv;
                v2u w; w.x = pk2(hv.x, hv.y); w.y = pk2(hv.z, hv.w); if (ok[u]) o8[64 * j] = w; }
            float am = 0.f;
#pragma unroll
            for (int j = 0; j < 4; ++j) am = fmaxf(am, fmaxf(fmaxf(fabsf(xv[u][j].x), fabsf(xv[u][j].y)), fmaxf(fabsf(xv[u][j].z), fabsf(xv[u][j].w))));
            am = wave_max_dpp(am);
            const float s8 = am > 0.f ? 127.f / am : 1.f;
            unsigned* h8 = (unsigned*)(F.H8 + (size_t)m * D) + lane;
#pragma unroll
            for (int j = 0; j < 4; ++j) { const int q0 = (int)rintf(xv[u][j].x * s8), q1 = (int)rintf(xv[u][j].y * s8), q2 = (int)rintf(xv[u][j].z * s8), q3 = (int)rintf(xv[u][j].w * s8);
                if (ok[u]) h8[64 * j] = (unsigned)((q0 & 255) | ((q1 & 255) << 8) | ((q2 & 255) << 16) | (q3 << 24)); }
            if (lane == 0 && ok[u]) F.HS[m] = 1.f / s8; }
    }
}

namespace att {
typedef float f32x16 __attribute__((ext_vector_type(16)));
typedef short s16x4 __attribute__((ext_vector_type(4)));
constexpr int QB = 256, KVB = 64;
constexpr int NS = 4;
constexpr int BTO = 288, BTN = 416;
constexpr int L_V = 0, L_K = NS * 16384, L_WS = L_K + NS * 8192, L_BT = L_WS + 2048, L_END = L_BT + 2048;
constexpr float C2 = 0.125f * 1.4426950408889634f;
__device__ __forceinline__ int v_st(int k, int c) { const int kk = (k & ~0xC) | ((k & 4) << 1) | ((k & 8) >> 1); return ((kk >> 3) * 4 + (c >> 5)) * 512 + ((kk & 7) * 32 + (c & 31)) * 2; }
__device__ __forceinline__ int v_rd_base(int lane) { return ((lane & 3) << 3) | (((lane >> 2) & 3) << 6) | (((lane >> 4) & 1) << 5) | (((lane >> 5) & 1) << 8); }
__device__ __forceinline__ unsigned v_src(int p) { const int sub = p >> 5, q = p & 31, kk = (sub >> 2) * 8 + (q >> 2), c = (sub & 3) * 32 + (q & 3) * 8;
    const int k = (kk & ~0xC) | ((kk & 4) << 1) | ((kk & 8) >> 1); return (unsigned)(k * INC + c) * 2u; }
__device__ __forceinline__ int crow(int r, int hi) { return (r & 3) + 8 * (r >> 2) + 4 * hi; }
typedef float f32x2_t __attribute__((ext_vector_type(2))); typedef __bf16 bf16x2_t __attribute__((ext_vector_type(2)));
__device__ __forceinline__ unsigned cvtpk(float lo, float hi) { const f32x2_t v = {lo, hi}; const bf16x2_t b = __builtin_convertvector(v, bf16x2_t); return __builtin_bit_cast(unsigned, b); }

__device__ __forceinline__ void attn_unit(Frame& F, int b, int h, int qb, float lam) {
    int tid = F.wave * 64 + lane_id(); asm volatile("" : "+v"(tid));
    const int lane = tid & 63, wid = F.wave, r32 = lane & 31, hi = lane >> 5;
    LAS unsigned char* lds = F.lds;
    LAS float* wsf = (LAS float*)(lds + L_WS) + wid * 64;
    const LAS float* bt = (const LAS float*)(lds + L_BT);
    const int q0 = qb * QB, qlo = q0 + wid * 32, qpos = qlo + r32;
    const size_t rowb = (size_t)b * SEQ;
    const int NT = (q0 + QB) / KVB;
    const unsigned kdoff = (unsigned)((tid >> 3) * INC + (((tid & 7) ^ ((tid >> 3) & 7)) * 8)) * 2u;
    const unsigned vdoff0 = v_src(tid), vdoff1 = v_src(tid + 512);
    const unsigned qoff = (unsigned)(r32 * INC + hi * 8) * 2u;
#define DMA_K(t_, buf_) __builtin_amdgcn_global_load_lds((const unsigned*)(Kb + (size_t)(t_) * (KVB * INC * 2) + kdoff), (LAS unsigned*)(lds + L_K + (buf_) * 8192 + wid * 1024), 16, 0, 0)
#define DMA_V(t_, buf_) do { __builtin_amdgcn_global_load_lds((const unsigned*)(Vb + (size_t)(t_) * (KVB * INC * 2) + vdoff0), (LAS unsigned*)(lds + L_V + (buf_) * 16384 + wid * 1024), 16, 0, 0); \
        __builtin_amdgcn_global_load_lds((const unsigned*)(Vb + (size_t)(t_) * (KVB * INC * 2) + vdoff1), (LAS unsigned*)(lds + L_V + (buf_) * 16384 + 8192 + wid * 1024), 16, 0, 0); } while (0)
#define DMA_TILE(t_) do { const int sl_ = (t_) & (NS - 1); DMA_K(t_, sl_); DMA_V(t_, sl_); } while (0)
#define ABAR() do { asm volatile("s_waitcnt lgkmcnt(0)" ::: "memory"); __builtin_amdgcn_s_barrier(); asm volatile("" ::: "memory"); } while (0)
    const int vbase = (int)(uintptr_t)(lds + L_V) + v_rd_base(lane);
    const int kroff = r32 * 128, kx = (r32 & 7) << 4;
    v4u* o0st = (v4u*)(F.STASH + ((size_t)blockIdx.x * NTHR + tid) * 32);
#pragma unroll
    for (int c = 0; c < 2; ++c) {
        const char* Kb = (const char*)(F.Z + rowb * INC + 1536 + h * 128 + c * 64);
        const char* Vb = (const char*)(F.Z + rowb * INC + 2048 + h * 128);
        const char* Qb = (const char*)(F.Z + (rowb + qlo) * INC + 1024 + h * 128 + c * 64);
        bf16x8 qr[4];
#pragma unroll
        for (int d0 = 0; d0 < 4; ++d0) qr[d0] = *(const bf16x8*)(Qb + d0 * 32 + qoff);
        DMA_TILE(0); DMA_TILE(1); DMA_TILE(2);
        asm volatile("s_waitcnt vmcnt(3)" ::: "memory");
        ABAR();
        float m = -1e30f, l = 0.f;
        f32x16 o[4];
#pragma unroll
        for (int d0 = 0; d0 < 4; ++d0) o[d0] = f32x16{};
        bf16x8 pa0, pa1, pa2, pa3;
#define QK_TILE(N0, N1, su) do { N0 = f32x16{}; N1 = f32x16{}; const LAS unsigned char* kb_ = lds + L_K + (su) * 8192 + kroff; \
        _Pragma("unroll") for (int d0 = 0; d0 < 4; ++d0) { const LAS unsigned char* a_ = kb_ + ((d0 * 32 + hi * 16) ^ kx); \
            const bf16x8 b0_ = *(const LAS bf16x8*)a_, b1_ = *(const LAS bf16x8*)(a_ + 4096); \
            N0 = __builtin_amdgcn_mfma_f32_32x32x16_bf16(b0_, qr[d0], N0, 0, 0, 0); N1 = __builtin_amdgcn_mfma_f32_32x32x16_bf16(b1_, qr[d0], N1, 0, 0, 0); } } while (0)
#define FIX_TILE(N0, N1, u) do { if (qlo - (u) * KVB - 63 < 113) { const int dq_ = qpos - (u) * KVB - 4 * hi + BTO; \
        _Pragma("unroll") for (int r = 0; r < 16; ++r) { const int i0_ = dq_ - ((r & 3) + 8 * (r >> 2)), i1_ = i0_ - 32; \
            N0[r] += bt[i0_ > BTN - 1 ? BTN - 1 : i0_]; N1[r] += bt[i1_ > BTN - 1 ? BTN - 1 : (i1_ < 0 ? 0 : i1_)]; } } } while (0)
#define MAX_TILE(N0, N1, ALN, GRN) do { float pm_ = fmaxf(N0[0], N1[0]); \
        _Pragma("unroll") for (int r = 1; r < 16; ++r) pm_ = fmaxf(fmaxf(pm_, N0[r]), N1[r]); \
        { auto rr_ = __builtin_amdgcn_permlane32_swap(__float_as_uint(pm_), __float_as_uint(pm_), false, false); pm_ = fmaxf(__uint_as_float(rr_[0]), __uint_as_float(rr_[1])); } \
        pm_ *= C2; GRN = __any(pm_ > m + 8.0f); const float mn_ = GRN ? fmaxf(m, pm_) : m; ALN = GRN ? __builtin_amdgcn_exp2f(m - mn_) : 1.0f; m = mn_; } while (0)
#define PK4(P, B_, OUT) do { const unsigned a0 = cvtpk(P[B_ + 0], P[B_ + 1]), a1 = cvtpk(P[B_ + 2], P[B_ + 3]); \
        const unsigned b0 = cvtpk(P[B_ + 4], P[B_ + 5]), b1 = cvtpk(P[B_ + 6], P[B_ + 7]); \
        auto r0 = __builtin_amdgcn_permlane32_swap(a0, b0, false, false); auto r1 = __builtin_amdgcn_permlane32_swap(a1, b1, false, false); \
        v4u w = {r0[0], r1[0], r0[1], r1[1]}; OUT = __builtin_bit_cast(bf16x8, w); } while (0)
#define EXP_TILE(C0, C1, ALC) do { const float nm_ = -m; \
        _Pragma("unroll") for (int r = 0; r < 16; ++r) { C0[r] = __builtin_amdgcn_exp2f(fmaf(C0[r], C2, nm_)); C1[r] = __builtin_amdgcn_exp2f(fmaf(C1[r], C2, nm_)); } \
        float ps_ = 0.f; _Pragma("unroll") for (int r = 0; r < 16; ++r) ps_ += C0[r] + C1[r]; \
        { auto rr_ = __builtin_amdgcn_permlane32_swap(__float_as_uint(ps_), __float_as_uint(ps_), false, false); ps_ = __uint_as_float(rr_[0]) + __uint_as_float(rr_[1]); } \
        l = l * (ALC) + ps_; PK4(C0, 0, pa0); PK4(C0, 8, pa1); PK4(C1, 0, pa2); PK4(C1, 8, pa3); } while (0)
#define RESC(ALC) do { if (hi == 0) wsf[r32] = (ALC); \
        _Pragma("unroll") for (int r = 0; r < 16; ++r) { const float a_ = wsf[crow(r, hi)]; _Pragma("unroll") for (int d0 = 0; d0 < 4; ++d0) o[d0][r] *= a_; } } while (0)
#define TRRD(dst, off) asm volatile("ds_read_b64_tr_b16 %0, %1 offset:%2" : "=&v"(dst) : "v"(vb0), "i"(off) : "memory")
#define PV_RD(L, H, d0) do { constexpr int b_ = (d0) * 512; TRRD(L[0], b_); TRRD(H[0], b_ + 2048); TRRD(L[1], b_ + 4096); TRRD(H[1], b_ + 6144); TRRD(L[2], b_ + 8192); TRRD(H[2], b_ + 10240); TRRD(L[3], b_ + 12288); TRRD(H[3], b_ + 14336); } while (0)
#define PV_MM(L, H, d0) do { \
        o[d0] = __builtin_amdgcn_mfma_f32_32x32x16_bf16(pa0, (bf16x8){L[0][0], L[0][1], L[0][2], L[0][3], H[0][0], H[0][1], H[0][2], H[0][3]}, o[d0], 0, 0, 0); \
        o[d0] = __builtin_amdgcn_mfma_f32_32x32x16_bf16(pa1, (bf16x8){L[1][0], L[1][1], L[1][2], L[1][3], H[1][0], H[1][1], H[1][2], H[1][3]}, o[d0], 0, 0, 0); \
        o[d0] = __builtin_amdgcn_mfma_f32_32x32x16_bf16(pa2, (bf16x8){L[2][0], L[2][1], L[2][2], L[2][3], H[2][0], H[2][1], H[2][2], H[2][3]}, o[d0], 0, 0, 0); \
        o[d0] = __builtin_amdgcn_mfma_f32_32x32x16_bf16(pa3, (bf16x8){L[3][0], L[3][1], L[3][2], L[3][3], H[3][0], H[3][1], H[3][2], H[3][3]}, o[d0], 0, 0, 0); } while (0)
#define LGK(n) do { asm volatile("s_waitcnt lgkmcnt(" #n ")" ::: "memory"); __builtin_amdgcn_sched_barrier(0); } while (0)
#define ITER(C0, C1, ALC, GRC, N0, N1, ALN, GRN, t) do { \
        if ((t) + 3 < NT) DMA_TILE((t) + 3);                      \
        QK_TILE(N0, N1, ((t) + 1) & (NS - 1));                    \
        EXP_TILE(C0, C1, ALC); \
        _Pragma("unroll") for (int i_ = 0; i_ < 4; ++i_) { __builtin_amdgcn_sched_group_barrier(0x100, 2, 0); __builtin_amdgcn_sched_group_barrier(0x008, 1, 0); __builtin_amdgcn_sched_group_barrier(0x002, 18, 0); \
            __builtin_amdgcn_sched_group_barrier(0x008, 1, 0); __builtin_amdgcn_sched_group_barrier(0x002, 18, 0); }     \
        if (GRC) RESC(ALC); \
        if ((t) + 1 < NT) FIX_TILE(N0, N1, (t) + 1); \
        { const int vb0 = vbase + ((t) & (NS - 1)) * 16384; \
          s16x4 la[4], ha[4], lb[4], hb[4];                    \
          PV_RD(la, ha, 0); PV_RD(lb, hb, 1); LGK(8); PV_MM(la, ha, 0); \
          if ((t) + 1 < NT) MAX_TILE(N0, N1, ALN, GRN); \
          PV_RD(la, ha, 2); LGK(8); PV_MM(lb, hb, 1); PV_RD(lb, hb, 3); LGK(8); PV_MM(la, ha, 2); LGK(0); PV_MM(lb, hb, 3); } \
        if ((t) + 3 < NT) asm volatile("s_waitcnt vmcnt(3)" ::: "memory"); else asm volatile("s_waitcnt vmcnt(0)" ::: "memory");     \
        ABAR(); } while (0)
        if (wid >= 4) __builtin_amdgcn_s_setprio(1);
        f32x16 sa0, sa1, sb0, sb1; float alA = 1.f, alB = 1.f; bool grA = false, grB = false;
        QK_TILE(sa0, sa1, 0); FIX_TILE(sa0, sa1, 0); MAX_TILE(sa0, sa1, alA, grA);
        for (int t = 0; t < NT; t += 2) {
            ITER(sa0, sa1, alA, grA, sb0, sb1, alB, grB, t);
            ITER(sb0, sb1, alB, grB, sa0, sa1, alA, grA, t + 1);
        }
        __builtin_amdgcn_s_setprio(0);
#undef QK_TILE
#undef FIX_TILE
#undef MAX_TILE
#undef PK4
#undef EXP_TILE
#undef RESC
#undef TRRD
#undef PV_RD
#undef PV_MM
#undef LGK
#undef ITER
        if (hi == 0) wsf[32 + r32] = l;
        float rl[16];
#pragma unroll
        for (int r = 0; r < 16; ++r) rl[r] = __builtin_amdgcn_rcpf(wsf[32 + crow(r, hi)]);
        if (c == 0) {
#pragma unroll
            for (int d0 = 0; d0 < 4; ++d0)
#pragma unroll
                for (int j = 0; j < 2; ++j) { v4u w;
                    w.x = cvtpk(o[d0][8 * j + 0] * rl[8 * j + 0], o[d0][8 * j + 1] * rl[8 * j + 1]); w.y = cvtpk(o[d0][8 * j + 2] * rl[8 * j + 2], o[d0][8 * j + 3] * rl[8 * j + 3]);
                    w.z = cvtpk(o[d0][8 * j + 4] * rl[8 * j + 4], o[d0][8 * j + 5] * rl[8 * j + 5]); w.w = cvtpk(o[d0][8 * j + 6] * rl[8 * j + 6], o[d0][8 * j + 7] * rl[8 * j + 7]);
                    o0st[d0 * 2 + j] = w; }
        } else {
            float ss[16];
#pragma unroll
            for (int r = 0; r < 16; ++r) ss[r] = 0.f;
#pragma unroll
            for (int d0 = 0; d0 < 4; ++d0)
#pragma unroll
                for (int j = 0; j < 2; ++j) { const v4u w = o0st[d0 * 2 + j]; const unsigned ww[4] = {w.x, w.y, w.z, w.w};
#pragma unroll
                    for (int k = 0; k < 4; ++k) { const int i = 4 * j + k;
                        const float a0 = bflo(ww[k]) - lam * (o[d0][2 * i] * rl[2 * i]), a1 = bfhi(ww[k]) - lam * (o[d0][2 * i + 1] * rl[2 * i + 1]);
                        o[d0][2 * i] = a0; o[d0][2 * i + 1] = a1; ss[2 * i] += a0 * a0; ss[2 * i + 1] += a1 * a1; } }
#pragma unroll
            for (int r = 0; r < 16; ++r) {
                { DPP_SUM_ROW(ss[r]); ss[r] += __shfl_xor(ss[r], 16); }
                ss[r] = rsqrtf(ss[r] * (1.f / 128.f) + EPS) * 0.8f;
            }
            bf16* Cw = F.CAT + (rowb + qlo) * 1024 + 512 + h * 128;
#pragma unroll
            for (int d0 = 0; d0 < 4; ++d0) { const float g = F.subln_g[d0 * 32 + r32];
#pragma unroll
                for (int r = 0; r < 16; ++r) { const float v = o[d0][r] * ss[r] * g; const float vn = dpp_xor1(v);
                    if ((r32 & 1) == 0) *(unsigned*)(Cw + (size_t)crow(r, hi) * 1024 + d0 * 32 + r32) = cvtpk(v, vn); } }
        }
        __syncthreads();
    }
#undef DMA_K
#undef DMA_V
#undef DMA_TILE
#undef ABAR
}

__device__ __forceinline__ void attn_phase(Frame& F) {
    const int lane = lane_id(), tid = F.wave * 64 + lane;
    const float s01 = wave_sum(F.diff_lambda[lane] * F.diff_lambda[64 + lane]), s23 = wave_sum(F.diff_lambda[128 + lane] * F.diff_lambda[192 + lane]);
    const float lam = __expf(s01) - __expf(s23) + 0.2f;
    const int G = F.G;
    for (int it = ((G % 8 == 0) ? ((int)(blockIdx.x % 8) * (G / 8) + (int)blockIdx.x / 8) : (int)blockIdx.x); it < 256; it += G) {
        const int bh = it >> 3, x = it & 7, b = bh >> 2, h = bh & 3;
        LAS float* bt = (LAS float*)(F.lds + L_BT);
        __syncthreads();
        if (tid < BTN) { const int d = tid - BTO; int bk = d; if (d >= 16) { bk = 16 + (int)(__log2f((float)d * (1.f / 16.f)) * (16.f / 3.f)); bk = bk > 31 ? 31 : bk; }
            bt[tid] = d < 0 ? -__builtin_inff() : (F.rel_bias[bk * 4 + h] - F.rel_bias[31 * 4 + h]) * (1.4426950408889634f / C2); }
        __syncthreads();
        attn_unit(F, b, h, x, lam);
        attn_unit(F, b, h, 15 - x, lam);
    }
}
}

namespace sgu {
typedef float f32x16 __attribute__((ext_vector_type(16)));
typedef short s16x4 __attribute__((ext_vector_type(4)));
constexpr int L_T = 0, L_ST = 65536;
__device__ __forceinline__ void sgu_chunk(Frame& F, int chunk) {
    int tid = F.wave * 64 + lane_id(); asm volatile("" : "+v"(tid));
    const int lane = tid & 63, g = F.wave, r32 = lane & 31, hi = lane >> 5;
    LAS unsigned char* lds = F.lds;
    LAS float* st = (LAS float*)(lds + L_ST);
    const size_t t0 = (size_t)chunk * 128;
    for (int i = 0; i < 16; i += 2) {
        v4u raw[2];
#pragma unroll
        for (int u = 0; u < 2; ++u) raw[u] = *(const v4u*)(F.Z + (t0 + g * 16 + i + u) * INC + 512 + lane * 8);
#pragma unroll
        for (int u = 0; u < 2; ++u) { const int tl = g * 16 + i + u;
            float f[8] = {bflo(raw[u].x), bfhi(raw[u].x), bflo(raw[u].y), bfhi(raw[u].y), bflo(raw[u].z), bfhi(raw[u].z), bflo(raw[u].w), bfhi(raw[u].w)};
            float s = 0.f;
#pragma unroll
            for (int e = 0; e < 8; ++e) s += f[e];
            const float mean = wave_sum_dpp(s) * (1.f / 512.f); float q = 0.f;
#pragma unroll
            for (int e = 0; e < 8; ++e) { f[e] -= mean; q += f[e] * f[e]; }
            const float rstd = rsqrtf(wave_sum_dpp(q) * (1.f / 512.f) + EPS);
            if (lane == 0) { st[2 * tl] = mean; st[2 * tl + 1] = rstd; } }
    }
    __syncthreads();
    f32x16 acc[2][2];
    const int sr = tid >> 4, sc = (tid & 15) * 8;
    const int vb0 = (int)(uintptr_t)(lds + L_T) + (g >> 1) * 16384 + att::v_rd_base(lane);
#define SGU_STAGE(sh) do { _Pragma("unroll") for (int tile = 0; tile < 4; ++tile) { const int ch = tile * 128 + sc; \
            const f32x4 g0 = *(const f32x4*)(F.sgu_ln_g + ch), g1 = *(const f32x4*)(F.sgu_ln_g + ch + 4), b0 = *(const f32x4*)(F.sgu_ln_b + ch), b1 = *(const f32x4*)(F.sgu_ln_b + ch + 4); \
            _Pragma("unroll") for (int rr = 0; rr < 2; ++rr) { const int s = (sh) * 64 + sr + 32 * rr; \
                const v4u raw = *(const v4u*)(F.Z + (t0 + s) * INC + 512 + ch); const float mean = st[2 * s], rstd = st[2 * s + 1]; v4u o; \
                o.x = pk2((bflo(raw.x) - mean) * rstd * g0.x + b0.x, (bfhi(raw.x) - mean) * rstd * g0.y + b0.y); \
                o.y = pk2((bflo(raw.y) - mean) * rstd * g0.z + b0.z, (bfhi(raw.y) - mean) * rstd * g0.w + b0.w); \
                o.z = pk2((bflo(raw.z) - mean) * rstd * g1.x + b1.x, (bfhi(raw.z) - mean) * rstd * g1.y + b1.y); \
                o.w = pk2((bflo(raw.w) - mean) * rstd * g1.z + b1.z, (bfhi(raw.w) - mean) * rstd * g1.w + b1.w); \
                *(LAS v4u*)(lds + L_T + tile * 16384 + att::v_st(sr + 32 * rr, sc)) = o; } } } while (0)
#define TRRD(dst, off) asm volatile("ds_read_b64_tr_b16 %0, %1 offset:%2" : "=&v"(dst) : "v"(vb0), "i"(off) : "memory")
#define SGU_MMA(sh, tb0) do { _Pragma("unroll") for (int ks = 0; ks < 4; ++ks) { s16x4 l0, h0, l1, h1; \
            if ((g & 1) == 0) { TRRD(l0, 0 * 512 + ks * 4096); TRRD(h0, 0 * 512 + ks * 4096 + 2048); TRRD(l1, 1 * 512 + ks * 4096); TRRD(h1, 1 * 512 + ks * 4096 + 2048); } \
            else              { TRRD(l0, 2 * 512 + ks * 4096); TRRD(h0, 2 * 512 + ks * 4096 + 2048); TRRD(l1, 3 * 512 + ks * 4096); TRRD(h1, 3 * 512 + ks * 4096 + 2048); } \
            asm volatile("s_waitcnt lgkmcnt(0)" ::: "memory"); __builtin_amdgcn_sched_barrier(0); \
            const bf16x8 B0 = (bf16x8){l0[0], l0[1], l0[2], l0[3], h0[0], h0[1], h0[2], h0[3]}, B1 = (bf16x8){l1[0], l1[1], l1[2], l1[3], h1[0], h1[1], h1[2], h1[3]}; \
            _Pragma("unroll") for (int tl = 0; tl < 2; ++tl) { const int tb = (tb0) + tl; if ((sh) * 64 + 16 * ks > tb * 32 + 31) continue; \
                const bf16x8 A = *(const bf16x8*)(F.SGW + ((size_t)(g * 128 + tb * 32 + r32)) * 128 + (sh) * 64 + 16 * ks + 8 * hi); \
                acc[tl][0] = __builtin_amdgcn_mfma_f32_32x32x16_bf16(A, B0, acc[tl][0], 0, 0, 0); \
                acc[tl][1] = __builtin_amdgcn_mfma_f32_32x32x16_bf16(A, B1, acc[tl][1], 0, 0, 0); } } } while (0)
#define SGU_EPI(tb0) do { _Pragma("unroll") for (int tl = 0; tl < 2; ++tl) _Pragma("unroll") for (int r = 0; r < 16; ++r) { \
            const int t = ((tb0) + tl) * 32 + att::crow(r, hi); const float bs = F.sgu_b[g * 128 + t]; \
            _Pragma("unroll") for (int db = 0; db < 2; ++db) { const int ch = g * 64 + db * 32 + r32; \
                const float u = bf2f(F.Z[(t0 + t) * INC + ch]); const float v = u * (acc[tl][db][r] + bs); const float vn = dpp_xor1(v); \
                if ((r32 & 1) == 0) *(unsigned*)(F.CAT + (t0 + t) * 1024 + ch) = att::cvtpk(v, vn); } } } while (0)
#define SGU_ZERO() do { acc[0][0] = f32x16{}; acc[0][1] = f32x16{}; acc[1][0] = f32x16{}; acc[1][1] = f32x16{}; } while (0)
    SGU_STAGE(0);
    __syncthreads();
    SGU_ZERO(); SGU_MMA(0, 0); SGU_EPI(0);
    SGU_ZERO(); SGU_MMA(0, 2);
    __syncthreads();
    SGU_STAGE(1);
    __syncthreads();
    SGU_MMA(1, 2); SGU_EPI(2);
#undef SGU_STAGE
#undef TRRD
#undef SGU_MMA
#undef SGU_EPI
#undef SGU_ZERO
}
__device__ __forceinline__ void sgu_phase(Frame& F) { for (int ck = blockIdx.x; ck < M / 128; ck += F.G) { sgu_chunk(F, ck); __syncthreads(); } }
}

namespace tk {
typedef float f32x16 __attribute__((ext_vector_type(16)));
__device__ __forceinline__ float vmax(float a, float b) { float r; asm("v_max_f32 %0, %1, %2" : "=v"(r) : "v"(a), "v"(b)); return r; }
__device__ __forceinline__ float vmin(float a, float b) { float r; asm("v_min_f32 %0, %1, %2" : "=v"(r) : "v"(a), "v"(b)); return r; }
#define TK_CE(a, b) do { const float _mx = vmax(a, b), _mn = vmin(a, b); a = _mx; b = _mn; } while (0)
template <int N> __device__ __forceinline__ void sort_desc(float (&a)[N]) {
#pragma unroll
    for (int k = 2; k <= N; k <<= 1)
#pragma unroll
        for (int j = k >> 1; j > 0; j >>= 1)
#pragma unroll
            for (int i = 0; i < N; ++i) { const int l = i ^ j; if (l > i) { if ((i & k) == 0) TK_CE(a[i], a[l]); else TK_CE(a[l], a[i]); } }
}
template <int N> __device__ __forceinline__ void merge_desc(float (&a)[N]) {
#pragma unroll
    for (int j = N >> 1; j > 0; j >>= 1)
#pragma unroll
        for (int i = 0; i < N; ++i) { const int l = i ^ j; if (l > i) TK_CE(a[i], a[l]); }
}
__device__ __forceinline__ void top16_merge(float (&a)[16], const float (&b)[16]) {
#pragma unroll
    for (int i = 0; i < 16; ++i) a[i] = vmax(a[i], b[15 - i]);
    merge_desc<16>(a);
}
__device__ __forceinline__ float embed(float v, unsigned mask, unsigned code) { return __uint_as_float((__float_as_uint(v) & mask) | code); }

__device__ __forceinline__ void topk_phase(Frame& F) {
    int lane = lane_id(); asm volatile("" : "+v"(lane));
    const int r32 = lane & 31, hi = lane >> 5;
    const int gw = blockIdx.x * NWAVES + F.wave, NGW = F.G * NWAVES;
    LAS unsigned* tab = (LAS unsigned*)(F.lds + F.wave * 8192) + lane;
    const float NEG = -__builtin_inff();
    constexpr int NTASK = (M / 32) * 8; const int per = (NTASK + NGW - 1) / NGW;
    unsigned code16[16];
#pragma unroll
    for (int r = 0; r < 16; ++r) code16[r] = (unsigned)((r & 3) + 8 * (r >> 2) + 4 * hi);
    const unsigned qoff = (unsigned)(r32 * NQ + hi * 8), koff = (unsigned)((hi * 128 + r32) * 8);
#define TK_QP(task_, c_) (F.QP + (size_t)((task_) >> 3) * 32 * NQ + ((task_) & 7) * 256 + (c_) * 128)
#define TK_KP(task_, c_) (F.KEYS + (size_t)((((task_) & 7) * 2 + (c_)) * 16) * 128 * 8)
#define TK_LDQ(dst, task_, c_) do { const bf16* qp_ = TK_QP(task_, c_); _Pragma("unroll") for (int ks = 0; ks < 8; ++ks) dst[ks] = *(const bf16x8*)(qp_ + ks * 16 + qoff); } while (0)
#define TK_LDK(dst, task_, c_, nb_) do { const bf16* kp_ = TK_KP(task_, c_); _Pragma("unroll") for (int ks = 0; ks < 8; ++ks) dst[ks] = *(const bf16x8*)(kp_ + ((2 * ks) * 128 + (nb_) * 32) * 8 + koff); } while (0)
    const int task_beg = gw * per, task_end = (gw * per + per < NTASK) ? gw * per + per : NTASK;
    bf16x8 qcur[8], kcur[8];
    if (task_beg < task_end) { TK_LDQ(qcur, task_beg, 0); TK_LDK(kcur, task_beg, 0, 0); }
    for (int task = task_beg; task < task_end; ++task) {
        const int tb = task >> 3, h = task & 7;
        const size_t trow = (size_t)tb * 32 + r32;
        float sk[2][16];
        float best[16];
#pragma unroll
        for (int st = 0; st < 8; ++st) {
            const int c = st >> 2, nb = st & 3;
            bf16x8 knxt[8], qnxt[8];
            if (st < 7) TK_LDK(knxt, task, (st + 1) >> 2, (st + 1) & 3);
            if (st == 3) TK_LDQ(qnxt, task, 1);
            f32x16 acc = f32x16{};
#pragma unroll
            for (int ks = 0; ks < 8; ++ks) acc = __builtin_amdgcn_mfma_f32_32x32x16_bf16(kcur[ks], qcur[ks], acc, 0, 0, 0);
            float cur[16];
#pragma unroll
            for (int r = 0; r < 16; ++r) { cur[r] = embed(acc[r], 0xFFFFFF80u, code16[r]); if (nb) cur[r] = __uint_as_float(__float_as_uint(cur[r]) | (unsigned)(nb * 32)); }
            sort_desc<16>(cur);
            if (nb == 0) {
#pragma unroll
                for (int i = 0; i < 16; ++i) best[i] = cur[i];
            } else top16_merge(best, cur);
            if (st < 7) {
#pragma unroll
                for (int ks = 0; ks < 8; ++ks) kcur[ks] = knxt[ks];
            }
            if (st == 3) {
#pragma unroll
                for (int ks = 0; ks < 8; ++ks) qcur[ks] = qnxt[ks];
            }
            if (nb == 3) {
                float pr[16];
#pragma unroll
                for (int i = 0; i < 16; ++i) { auto rr = __builtin_amdgcn_permlane32_swap(__float_as_uint(best[i]), __float_as_uint(best[i]), false, false);
                    pr[i] = __uint_as_float(hi ? rr[0] : rr[1]); }
                top16_merge(best, pr);
#pragma unroll
                for (int i = 0; i < 16; ++i) sk[c][i] = best[i];
            }
            __builtin_amdgcn_sched_barrier(0);
        }
        { const int tn = (task + 1 < task_end) ? task + 1 : task; TK_LDQ(qcur, tn, 0); TK_LDK(kcur, tn, 0, 0); }
#pragma unroll
        for (int i = 0; i < 16; ++i) { tab[i * 64] = __float_as_uint(sk[0][i]); tab[(16 + i) * 64] = __float_as_uint(sk[1][i]); }
        float T[16], G1[16], G2[16];
#pragma unroll
        for (int j = 0; j < 16; ++j) T[j] = embed(sk[0][0] + sk[1][j], 0xFFFFFF00u, (unsigned)j);
#pragma unroll
        for (int j = 0; j < 8; ++j) { G1[j] = embed(sk[0][1] + sk[1][j], 0xFFFFFF00u, (unsigned)(16 + j)); G1[8 + j] = embed(sk[0][15 - j] + sk[1][0], 0xFFFFFF00u, (unsigned)((15 - j) << 4)); }
        merge_desc<16>(G1);
        top16_merge(T, G1);
#pragma unroll
        for (int j = 0; j < 5; ++j) G2[j] = embed(sk[0][2] + sk[1][j], 0xFFFFFF00u, (unsigned)(32 + j));
#pragma unroll
        for (int j = 0; j < 4; ++j) G2[5 + j] = embed(sk[0][3] + sk[1][j], 0xFFFFFF00u, (unsigned)(48 + j));
#pragma unroll
        for (int j = 0; j < 3; ++j) G2[9 + j] = embed(sk[0][4] + sk[1][j], 0xFFFFFF00u, (unsigned)(64 + j));
#pragma unroll
        for (int j = 0; j < 2; ++j) { G2[12 + j] = embed(sk[0][5] + sk[1][j], 0xFFFFFF00u, (unsigned)(80 + j)); G2[14 + j] = embed(sk[0][6] + sk[1][j], 0xFFFFFF00u, (unsigned)(96 + j)); }
        sort_desc<16>(G2);
        top16_merge(T, G2);
        T[15] = vmax(T[15], embed(sk[0][7] + sk[1][0], 0xFFFFFF00u, 112u)); T[14] = vmax(T[14], embed(sk[0][7] + sk[1][1], 0xFFFFFF00u, 113u));
        merge_desc<16>(T);
        const float mx = __uint_as_float(__float_as_uint(T[0]) & 0xFFFFFF00u);
        float e[16]; float den = 0.f;
#pragma unroll
        for (int k = 0; k < 16; ++k) { e[k] = __builtin_amdgcn_exp2f((__uint_as_float(__float_as_uint(T[k]) & 0xFFFFFF00u) - mx) * 1.4426950408889634f); den += e[k]; }
        const float rden = 1.f / den;
        int eo[8]; float go[8];
#pragma unroll
        for (int k = 0; k < 8; ++k) {
            const unsigned code = __float_as_uint(hi ? T[k + 8] : T[k]) & 255u;
            const unsigned a1 = tab[(code >> 4) * 64] & 127u, a2 = tab[(16 + (code & 15u)) * 64] & 127u;
            eo[k] = (int)(a1 * 128u + a2); go[k] = (hi ? e[k + 8] : e[k]) * rden;
        }
        int* ip = F.IDX + trow * PKN + h * 16 + hi * 8; float* gp = F.GATE + trow * PKN + h * 16 + hi * 8;
        *(v4u*)ip = (v4u){(unsigned)eo[0], (unsigned)eo[1], (unsigned)eo[2], (unsigned)eo[3]}; *(v4u*)(ip + 4) = (v4u){(unsigned)eo[4], (unsigned)eo[5], (unsigned)eo[6], (unsigned)eo[7]};
        *(f32x4*)gp = (f32x4){go[0], go[1], go[2], go[3]}; *(f32x4*)(gp + 4) = (f32x4){go[4], go[5], go[6], go[7]};
    }
    (void)NEG;
}
#undef TK_CE
#undef TK_QP
#undef TK_KP
#undef TK_LDQ
#undef TK_LDK
}

namespace pe {
typedef float f32x2 __attribute__((ext_vector_type(2)));
__device__ __forceinline__ f32x2 cvlo(unsigned w) { return __builtin_amdgcn_cvt_pk_f32_fp8((int)w, false); }
__device__ __forceinline__ f32x2 cvhi(unsigned w) { return __builtin_amdgcn_cvt_pk_f32_fp8((int)w, true); }
__device__ __forceinline__ float dot16(const v4u r, const f32x2 (&hf)[8]) {
    f32x2 a = cvlo(r.x) * hf[0]; f32x2 b = cvhi(r.x) * hf[1];
    a = cvlo(r.y) * hf[2] + a; b = cvhi(r.y) * hf[3] + b; a = cvlo(r.z) * hf[4] + a; b = cvhi(r.z) * hf[5] + b; a = cvlo(r.w) * hf[6] + a; b = cvhi(r.w) * hf[7] + b;
    a = a + b; return a.x + a.y;
}
#define PE_W(WREG, i) __uint_as_float(__builtin_amdgcn_readlane(__float_as_uint(WREG), (i)))
#ifndef FP6_INTERLEAVED
#define FP6_INTERLEAVED 1
#endif
typedef unsigned v6u __attribute__((ext_vector_type(6)));
typedef float v32f __attribute__((ext_vector_type(32)));
typedef float v16f __attribute__((ext_vector_type(16)));
struct Row6 { v4u q4; v2u q2; };
#ifndef PV6_G
#define PV6_G 2
#endif
#define PV6_LOAD(dst, EREG, i) do { const int ea_ = __builtin_amdgcn_readlane(EREG, 2 * (i)), eb_ = __builtin_amdgcn_readlane(EREG, 2 * (i) + 1); \
        const unsigned char* rp_ = F.VT6 + (size_t)(half ? eb_ : ea_) * 768; dst.q4 = *(const v4u*)(rp_ + l16); dst.q2 = *(const v2u*)(rp_ + 512 + l8); } while (0)
#define PV6_ACC(src, WREG, i) do { const float wa_ = PE_W(WREG, 2 * (i)), wb_ = PE_W(WREG, 2 * (i) + 1); const float w_ = half ? wb_ : wa_; const f32x2 ww_ = {w_, w_}; \
        const v6u pk_ = {src.q4.x, src.q4.y, src.q4.z, src.q4.w, src.q2.x, src.q2.y}; const v32f d_ = __builtin_amdgcn_cvt_scalef32_pk32_f32_fp6(pk_, 1.0f); \
        _Pragma("unroll") for (int k = 0; k < 16; ++k) acc[k] = (f32x2){d_[2 * k], d_[2 * k + 1]} * ww_ + acc[k]; __builtin_amdgcn_sched_barrier(0); } while (0)
#define PV6_BATCH(EREG, WREG) do { Row6 bufA[PV6_G], bufB[PV6_G];             \
        _Pragma("unroll") for (int i = 0; i < PV6_G; ++i) PV6_LOAD(bufA[i], EREG, i); \
        _Pragma("unroll") for (int gq = 0; gq < 32 / PV6_G; gq += 2) { \
            _Pragma("unroll") for (int i = 0; i < PV6_G; ++i) PV6_LOAD(bufB[i], EREG, (gq + 1) * PV6_G + i); \
            _Pragma("unroll") for (int i = 0; i < PV6_G; ++i) PV6_ACC(bufA[i], WREG, gq * PV6_G + i); \
            if (gq + 2 < 32 / PV6_G) { _Pragma("unroll") for (int i = 0; i < PV6_G; ++i) PV6_LOAD(bufA[i], EREG, (gq + 2) * PV6_G + i); } \
            _Pragma("unroll") for (int i = 0; i < PV6_G; ++i) PV6_ACC(bufB[i], WREG, (gq + 1) * PV6_G + i); } } while (0)

#define PU_IDX(dst, tt) do { const v4u* ip_ = (const v4u*)(F.IDX + (size_t)(tt) * PKN + (lane >> 3) * 16); _Pragma("unroll") for (int q_ = 0; q_ < 4; ++q_) { const v4u w_ = ip_[q_]; dst[4 * q_] = (int)w_.x; dst[4 * q_ + 1] = (int)w_.y; dst[4 * q_ + 2] = (int)w_.z; dst[4 * q_ + 3] = (int)w_.w; } } while (0)
#define PU_GATHER(dst, idx) do { _Pragma("unroll") for (int i = 0; i < 16; ++i) dst[i] = *(const v4u*)(ub + (unsigned)idx[i] * 128u + coff); } while (0)
#define PU_HS(dst, tt) do { dst[0] = *(const v4u*)(F.H8 + (size_t)(tt) * D + x * 128 + (lane & 7) * 16); } while (0)
#define PU_COMPUTE(seg, hraw, tt) do { int p[16]; \
        _Pragma("unroll") for (int i = 0; i < 16; ++i) { int a_ = __builtin_amdgcn_sdot4((int)seg[i].x, (int)hraw[0].x, 0, false); a_ = __builtin_amdgcn_sdot4((int)seg[i].y, (int)hraw[0].y, a_, false); \
            a_ = __builtin_amdgcn_sdot4((int)seg[i].z, (int)hraw[0].z, a_, false); p[i] = __builtin_amdgcn_sdot4((int)seg[i].w, (int)hraw[0].w, a_, false); }     \
          \
        _Pragma("unroll") for (int i = 0; i < 8; ++i) { const bool bt = (lane & 4) != 0; const int sd = bt ? p[i] : p[i + 8], kp = bt ? p[i + 8] : p[i]; p[i] = kp + __builtin_amdgcn_update_dpp(0, sd, 0x141, 0xF, 0xF, false); } \
        _Pragma("unroll") for (int i = 0; i < 4; ++i) { const bool bt = (lane & 2) != 0; const int sd = bt ? p[i] : p[i + 4], kp = bt ? p[i + 4] : p[i]; p[i] = kp + __builtin_amdgcn_update_dpp(0, sd, 0x4E, 0xF, 0xF, false); } \
        _Pragma("unroll") for (int i = 0; i < 2; ++i) { const bool bt = (lane & 1) != 0; const int sd = bt ? p[i] : p[i + 2], kp = bt ? p[i + 2] : p[i]; p[i] = kp + __builtin_amdgcn_update_dpp(0, sd, 0xB1, 0xF, 0xF, false); } \
        ((unsigned*)F.PART)[((size_t)x * M + (tt)) * 64 + lane] = att::cvtpk((float)p[0], (float)p[1]); } while (0)
__device__ __forceinline__ void peer_u_phase(Frame& F, const int c0, const int cn, const int w0, const int nw) {
    int lane = lane_id(); asm volatile("" : "+v"(lane));
    const int wave = F.wave;
    if (wave < w0 || wave >= w0 + nw) return;
    const unsigned coff = (unsigned)(lane & 7) * 16u;
    const int per_blk = cn / 32, per_wave = per_blk / nw;
    for (int unit = blockIdx.x; unit < 256; unit += F.G) {
        const int x = unit & 7, rk = unit >> 3;
        const unsigned char* ub = F.UT8 + (size_t)x * NEXP * 128;
        const int tbeg = c0 + rk * per_blk + (wave - w0) * per_wave, tend = tbeg + per_wave;
        int idxA[16], idxB[16]; v4u segA[16], segB[16]; v4u hA[1], hB[1];
        PU_IDX(idxA, tbeg); PU_GATHER(segA, idxA); PU_HS(hA, tbeg); PU_IDX(idxB, tbeg + 1);
        for (int t = tbeg; t < tend; t += 2) {
            PU_GATHER(segB, idxB); PU_HS(hB, t + 1);
            { const int tn = (t + 2 < tend) ? t + 2 : t; PU_IDX(idxA, tn); }
            PU_COMPUTE(segA, hA, t);
            { const int tn = (t + 2 < tend) ? t + 2 : t; PU_GATHER(segA, idxA); PU_HS(hA, tn); }
            { const int tn = (t + 3 < tend) ? t + 3 : t + 1; PU_IDX(idxB, tn); }
            PU_COMPUTE(segB, hB, t + 1);
        }
    }
}
#undef PU_IDX
#undef PU_GATHER
#undef PU_HS
#undef PU_COMPUTE

template <bool DRY> __device__ __forceinline__ void peer_phase(Frame& F, const int c0, const int cn, const int w0, const int nw) {
    int lane = lane_id(); asm volatile("" : "+v"(lane));
    if (F.wave < w0 || F.wave >= w0 + nw) return;
    const int gw = blockIdx.x * nw + (F.wave - w0), NGW = F.G * nw;
    const int half = lane >> 5; const unsigned l16 = (unsigned)(lane & 31) * 16u, l8 = (unsigned)(lane & 31) * 8u;
    for (int t = c0 + gw; t < c0 + cn; t += NGW) {
        const int b = t >> 12;
        const int e0 = F.IDX[(size_t)t * PKN + lane], e1 = F.IDX[(size_t)t * PKN + 64 + lane];
        const float g0 = F.GATE[(size_t)t * PKN + lane], g1 = F.GATE[(size_t)t * PKN + 64 + lane];
        const float su0 = F.SU[e0], su1 = F.SU[e1], sv0 = F.SV[e0], sv1 = F.SV[e1];
        float tot0 = 0.f, tot1 = 0.f;
#pragma unroll
        for (int x = 0; x < 8; ++x) { const bf16* pp = (const bf16*)F.PART + ((size_t)x * M + t) * PKN; tot0 += bf2f(pp[lane]); tot1 += bf2f(pp[64 + lane]); }
        const float hs = F.HS[t];
        const float w0 = gelu_t(tot0 * (su0 * hs)) * g0 * sv0, w1 = gelu_t(tot1 * (su1 * hs)) * g1 * sv1;
        f32x2 acc[16];
#pragma unroll
        for (int i = 0; i < 16; ++i) acc[i] = (f32x2){0.f, 0.f};
        PV6_BATCH(e0, w0);
        PV6_BATCH(e1, w1);
#pragma unroll
        for (int i = 0; i < 16; ++i) {
            auto rx = __builtin_amdgcn_permlane32_swap(__float_as_uint(acc[i].x), __float_as_uint(acc[i].x), false, false);
            auto ry = __builtin_amdgcn_permlane32_swap(__float_as_uint(acc[i].y), __float_as_uint(acc[i].y), false, false);
            acc[i] = (f32x2){__uint_as_float(rx[0]) + __uint_as_float(rx[1]), __uint_as_float(ry[0]) + __uint_as_float(ry[1])};
        }
        float y[16];
#pragma unroll
        for (int j = 0; j < 16; ++j) {
#if FP6_INTERLEAVED
            const float lo = (j & 1) ? acc[j].x : acc[j].x;
            const float hi_ = acc[j].y;
            y[j] = half ? hi_ : lo;
#else
            const float lo = (j & 1) ? acc[j >> 1].y : acc[j >> 1].x;
            const float hi_ = (j & 1) ? acc[8 + (j >> 1)].y : acc[8 + (j >> 1)].x;
            y[j] = half ? hi_ : lo;
#endif
        }
        float ss = 0.f;
#pragma unroll
        for (int j = 0; j < 16; ++j) ss += y[j] * y[j];
        const float rstd = rsqrtf(wave_sum_dpp(ss) * (1.f / D) + EPS);
        const float* md = F.mod + b * 6144 + 5120;
        const float* g3 = F.norm_g + 3072;
        int lane_e = lane; asm volatile("" : "+v"(lane_e));
        const int col0 = (lane_e & 31) * 32 + (lane_e >> 5) * 16;
        float* orow = F.out + (size_t)t * D + col0;
#pragma unroll
        for (int q4 = 0; q4 < 4; ++q4) { const int c = col0 + q4 * 4;
            const f32x4 x1 = *(const f32x4*)(orow + q4 * 4), gt = *(const f32x4*)(md + c), gg = *(const f32x4*)(g3 + c);
            const f32x4 yv = (f32x4){y[q4 * 4], y[q4 * 4 + 1], y[q4 * 4 + 2], y[q4 * 4 + 3]};
            if (!DRY) *(f32x4*)(orow + q4 * 4) = x1 + gt * (yv * rstd * gg); else if (rstd == 123.456f) *(f32x4*)(orow + q4 * 4) = yv; }
    }
}
#undef PE_W
#undef PV6_LOAD
#undef PV6_ACC
#undef PV6_BATCH

__device__ __forceinline__ void u_rows4(Frame& F, int r0, int stride, int nvalid, int lane) {
    f32x4 v[4][4];
#pragma unroll
    for (int q = 0; q < 4; ++q) { const int row = r0 + (q < nvalid ? q : 0) * stride; const f32x4* s = (const f32x4*)(F.peer_u + (size_t)row * D) + lane * 4;
#pragma unroll
        for (int i = 0; i < 4; ++i) v[q][i] = s[i]; }
#pragma unroll
    for (int q = 0; q < 4; ++q) { if (q >= nvalid) break; const int row = r0 + q * stride;
        float am = 0.f;
#pragma unroll
        for (int i = 0; i < 4; ++i) am = fmaxf(am, fmaxf(fmaxf(fabsf(v[q][i].x), fabsf(v[q][i].y)), fmaxf(fabsf(v[q][i].z), fabsf(v[q][i].w))));
        am = wave_max_dpp(am);
        const float sc = am > 0.f ? 127.f / am : 1.f;
        int w[4];
#pragma unroll
        for (int i = 0; i < 4; ++i) { const int q0 = (int)rintf(v[q][i].x * sc), q1 = (int)rintf(v[q][i].y * sc), q2 = (int)rintf(v[q][i].z * sc), q3 = (int)rintf(v[q][i].w * sc);
            w[i] = (q0 & 255) | ((q1 & 255) << 8) | ((q2 & 255) << 16) | (q3 << 24); }
        *(v4u*)(F.UT8 + (size_t)(lane >> 3) * NEXP * 128 + (size_t)row * 128 + (lane & 7) * 16) = (v4u){(unsigned)w[0], (unsigned)w[1], (unsigned)w[2], (unsigned)w[3]};
        if (lane == 0) F.SU[row] = 1.f / sc; }
}
__device__ __forceinline__ void v_pairs2(Frame& F, int p0, int stride, int nvalid, int lane) {
    const int L = lane & 31, hf = lane >> 5;
    f32x4 f[2][8];
#pragma unroll
    for (int q = 0; q < 2; ++q) { const int row = 2 * (p0 + (q < nvalid ? q : 0) * stride) + hf; const f32x4* sp = (const f32x4*)(F.peer_v + (size_t)row * D + L * 32);
#pragma unroll
        for (int i = 0; i < 8; ++i) f[q][i] = sp[i]; }
#pragma unroll
    for (int q = 0; q < 2; ++q) { if (q >= nvalid) break; const int row = 2 * (p0 + q * stride) + hf;
        float am = 0.f;
#pragma unroll
        for (int i = 0; i < 8; ++i) am = fmaxf(am, fmaxf(fmaxf(fabsf(f[q][i].x), fabsf(f[q][i].y)), fmaxf(fabsf(f[q][i].z), fabsf(f[q][i].w))));
        am = half_max_dpp(am);
        const float sc = am > 0.f ? exp2f(floorf(log2f(7.0f / am))) : 1.f;
        v16f a, b;
#pragma unroll
        for (int i = 0; i < 4; ++i) { a[4 * i] = f[q][i].x * sc; a[4 * i + 1] = f[q][i].y * sc; a[4 * i + 2] = f[q][i].z * sc; a[4 * i + 3] = f[q][i].w * sc;
            b[4 * i] = f[q][4 + i].x * sc; b[4 * i + 1] = f[q][4 + i].y * sc; b[4 * i + 2] = f[q][4 + i].z * sc; b[4 * i + 3] = f[q][4 + i].w * sc; }
        const v6u w = __builtin_amdgcn_cvt_scalef32_2xpk16_fp6_f32(a, b, 1.0f);
        unsigned char* rp = F.VT6 + (size_t)row * 768;
        *(v4u*)(rp + L * 16) = (v4u){w[0], w[1], w[2], w[3]};
        *(v2u*)(rp + 512 + L * 8) = (v2u){w[4], w[5]};
        if (L == 0) F.SV[row] = 1.f / sc; }
}
__device__ __forceinline__ void prologue_tables(Frame& F, int gw, int NGW, int lane) {
    for (int r = gw; r < NEXP; r += 4 * NGW) { const int left = (NEXP - r + NGW - 1) / NGW; u_rows4(F, r, NGW, left < 4 ? left : 4, lane); }
    for (int p = gw; p < NEXP / 2; p += 2 * NGW) { const int left = (NEXP / 2 - p + NGW - 1) / NGW; v_pairs2(F, p, NGW, left < 2 ? left : 2, lane); }
}
}

__device__ __forceinline__ void prologue_tables_fwd(Frame& F, int gw, int NGW, int lane) { pe::prologue_tables(F, gw, NGW, lane); }
struct Args { const float* in[18]; float* out; unsigned char* ws; int ph_lo, ph_hi, li, pad; };
__global__ void __launch_bounds__(NTHR, 2) fwd(Args args) {
    extern __shared__ __attribute__((aligned(16))) unsigned char lds[];
    Frame F;
    F.lds = (LAS unsigned char*)lds;
    F.MISC = (volatile LAS unsigned*)(F.lds + MISC_OFF);
    F.wave = __builtin_amdgcn_readfirstlane((int)threadIdx.x >> 6); F.G = gridDim.x;
    unsigned char* ws = args.ws;
    F.ctl = (gu32*)(ws + WS_CTL);
    F.x = args.in[0]; F.c = args.in[1]; F.w_ada = args.in[2]; F.b_ada = args.in[3]; F.norm_g = args.in[4]; F.w_in = args.in[5]; F.sgu_ln_g = args.in[6]; F.sgu_ln_b = args.in[7];
    F.sgu_w = args.in[8]; F.sgu_b = args.in[9]; F.diff_lambda = args.in[10]; F.subln_g = args.in[11]; F.rel_bias = args.in[12]; F.w_out = args.in[13]; F.w_query = args.in[14];
    F.sub_keys = args.in[15]; F.peer_u = args.in[16]; F.peer_v = args.in[17]; F.out = args.out;
    F.mod = (float*)(ws + WS_MOD); F.WIN = (bf16*)(ws + WS_WIN); F.WOUT = (bf16*)(ws + WS_WOUT); F.WQ = (bf16*)(ws + WS_WQ); F.KEYS = (bf16*)(ws + WS_KEYS); F.SGW = (bf16*)(ws + WS_SGW);
    F.UT8 = ws + WS_UT; F.H8 = ws + WS_H8; F.HS = (float*)(ws + WS_SU) + 2 * NEXP; F.VT6 = ws + WS_VT; F.PART = (float*)(ws + WS_QP); F.STASH = (unsigned*)(ws + WS_H); F.SU = (float*)(ws + WS_SU); F.SV = (float*)(ws + WS_SU) + NEXP; F.H = (bf16*)(ws + WS_H); F.Y = (bf16*)(ws + WS_Y); F.Z = (bf16*)(ws + WS_Z); F.QP = (bf16*)(ws + WS_QP); F.CAT = (bf16*)(ws + WS_CAT);
    F.IDX = (int*)(ws + WS_IDX); F.GATE = (float*)(ws + WS_GATE);
    for (int u = threadIdx.x; u < (LDS_BYTES - LDSCTL_OFF) / 4; u += NTHR) ((LAS unsigned*)(F.lds + LDSCTL_OFF))[u] = 0u;
    __syncthreads();
    XcdBarrier bar = xcd_barrier_post((unsigned*)(F.ctl + CW_BAR) + args.li * XCD_BAR_WORDS, F.MISC + 8);
    const int lo = args.ph_lo, hi = args.ph_hi;
#ifndef ONLY_PHASE
#define ONLY_PHASE -1
#endif
#define IN(k) (lo <= (k) && (k) < hi && (ONLY_PHASE < 0 || ONLY_PHASE == (k)))
#define SEAM(k) do { if ((k) + 1 < hi) xcd_barrier(bar); } while (0)
    if (IN(0)) { for (int rep = 0; rep < (PROBE_PHASE == 0 ? 2 : 1); ++rep) ph_prologue(F); SEAM(0); }
    if (IN(1)) { for (int rep = 0; rep < (PROBE_PHASE == 1 ? 2 : 1); ++rep) ph_hrows(F); SEAM(1); }
    if (IN(2)) {
        pg8::Gemm g{F.H, F.WIN, M, INC, D}; pg8::StaticOrder S; S.init(M, INC, F.G, (int)blockIdx.x);
        pg8::EpiBf16<1> E{F.Z, INC, nullptr, 0, 0, 1.f, 1024};
        for (int rep = 0; rep < (PROBE_PHASE == 2 ? 2 : 1); ++rep) pg8::gemm_phase<pg8::EpiBf16<1>, pg8::StaticOrder, true, true>(F.lds, g, S, E, F.wave);
        SEAM(2);
    }
    if (IN(3)) { for (int rep = 0; rep < (PROBE_PHASE == 30 ? 2 : 1); ++rep) sgu::sgu_phase(F); for (int rep = 0; rep < (PROBE_PHASE == 3 ? 2 : 1); ++rep) att::attn_phase(F); SEAM(3); }
    if (IN(4)) {
        pg8::Gemm g{F.CAT, F.WOUT, M, D, D}; pg8::StaticOrder S; S.init(M, D, F.G, (int)blockIdx.x);
        pg8::EpiBf16<0> E{F.Y, D, nullptr, 0, 0, 1.f, 0};
        for (int rep = 0; rep < (PROBE_PHASE == 4 ? 2 : 1); ++rep) pg8::gemm_phase<pg8::EpiBf16<0>, pg8::StaticOrder, true, true>(F.lds, g, S, E, F.wave);
        SEAM(4);
    }
    if (IN(5)) { for (int rep = 0; rep < (PROBE_PHASE == 5 ? 2 : 1); ++rep) ph_x1rows(F); SEAM(5); }
    if (IN(6)) {
        pg8::Gemm g{F.H, F.WQ, M, NQ, D}; pg8::StaticOrder S; S.init(M, NQ, F.G, (int)blockIdx.x);
        pg8::EpiBf16<0> E{F.QP, NQ, nullptr, 0, 0, 1.f, 0};
        for (int rep = 0; rep < (PROBE_PHASE == 6 ? 2 : 1); ++rep) pg8::gemm_phase<pg8::EpiBf16<0>, pg8::StaticOrder, true, true>(F.lds, g, S, E, F.wave);
        SEAM(6);
    }
    if (IN(7)) { if (TABLES_IN_PHASE == 7) prologue_tables_fwd(F, blockIdx.x * NWAVES + F.wave, F.G * NWAVES, lane_id()); for (int rep = 0; rep < (PROBE_PHASE == 7 ? 2 : 1); ++rep) tk::topk_phase(F); SEAM(7); }
    if (IN(8)) { for (int rep = 0; rep < (PROBE_PHASE == 8 ? 2 : 1); ++rep) pe::peer_u_phase(F, 0, M, 0, 8); SEAM(8); }
    if (IN(9)) { if (PROBE_PHASE == 9) pe::peer_phase<true>(F, 0, M, 0, 8); pe::peer_phase<false>(F, 0, M, 0, 8); }
#undef IN
#undef SEAM
}

extern "C" void kernel_launch(void* const* d_in, const int* in_sizes, int n_in, void* d_out, int out_size, void* d_ws, size_t ws_size, hipStream_t stream) {
    static int grid = 0;
    if (grid == 0) {
        if (n_in != 18 || in_sizes[0] != M * D || out_size != M * D || ws_size < WS_END) { fprintf(stderr, "kernel_launch: unexpected shapes (n_in %d, in0 %d, out %d, ws %zu)\n", n_in, n_in > 0 ? in_sizes[0] : -1, out_size, ws_size); grid = -1; return; }
        int dev = 0, cus = 0, per_cu = 0;
        if (hipGetDevice(&dev) != hipSuccess || hipDeviceGetAttribute(&cus, hipDeviceAttributeMultiprocessorCount, dev) != hipSuccess) { grid = -1; return; }
        if (hipFuncSetAttribute((const void*)fwd, hipFuncAttributeMaxDynamicSharedMemorySize, LDS_BYTES) != hipSuccess) { fprintf(stderr, "kernel_launch: hipFuncSetAttribute failed\n"); grid = -1; return; }
        if (hipOccupancyMaxActiveBlocksPerMultiprocessor(&per_cu, (const void*)fwd, NTHR, LDS_BYTES) != hipSuccess || per_cu < 1) fprintf(stderr, "kernel_launch: occupancy query reports %d\n", per_cu);
        (void)hipGetLastError();
        grid = cus;
    }
    if (grid < 0) return;
    if (hipMemsetAsync((char*)d_ws + WS_CTL, 0, CTL_ZERO_BYTES, stream) != hipSuccess) return;
    Args a{};
    for (int i = 0; i < 18; ++i) a.in[i] = (const float*)d_in[i];
    a.out = (float*)d_out; a.ws = (unsigned char*)d_ws;
#if MK_PER_PHASE
    for (int p = 0; p < NPHASE; ++p) { a.ph_lo = p; a.ph_hi = p + 1; a.li = p; hipLaunchKernelGGL(fwd, dim3(grid), dim3(NTHR), LDS_BYTES, stream, a); }
#else
    a.ph_lo = 0; a.ph_hi = NPHASE; a.li = 0; hipLaunchKernelGGL(fwd, dim3(grid), dim3(NTHR), LDS_BYTES, stream, a);
#endif
}
```

```cpp
#define MK_PER_PHASE 0
#include <hip/hip_runtime.h>
#include <cstdio>
#include <cstdint>
namespace pg8 {
#define PG8_LAS __attribute__((address_space(3)))
typedef unsigned short bf16_t;
typedef short bf16x8 __attribute__((ext_vector_type(8)));
typedef float f32x4 __attribute__((ext_vector_type(4)));
typedef unsigned u32x4 __attribute__((ext_vector_type(4)));
typedef int i32x4 __attribute__((ext_vector_type(4)));
constexpr int BM = 256, BK = 64, HALF = 128, HTB = HALF * BK * 2  , STAGE_BYTES = 8 * HTB, NXCD = 8, WGM = 8;

__host__ __device__ __forceinline__ int lds_byte(int r, int c) { const int st = (r >> 4) * 2 + (c >> 5), rr = r & 15, cc = c & 31, ob = rr * 64 + cc * 2; return st * 1024 + (ob ^ (((ob >> 9) & 1) << 5)); }
__host__ __device__ __forceinline__ void stage_rc(int b, int& R, int& C) { const int st = b / 1024, sb = b % 1024, swz = sb ^ (((sb >> 9) & 1) << 5); R = (st >> 1) * 16 + swz / 64; C = (st & 1) * 32 + (swz % 64) / 2; }
__host__ __device__ __forceinline__ int perm32(int rho) { const int n = rho >> 4, i = rho & 15; return 8 * (i >> 2) + 4 * n + (i & 3); }

struct Unit { int pm, pn; };
struct Gemm { const bf16_t* A; const bf16_t* Bt; int M, N, K; };

struct StaticOrder {
    int nM, nN, nwg, G, c;
    __host__ __device__ void init(int M, int N, int G_, int c_) { nM = M / BM; nN = N / BM; nwg = nM * nN; G = G_; c = c_; }
    __host__ __device__ bool next(int i, Unit& u) const {
        const long L = (long)i * G + c; if (L >= nwg) return false;
        int wgid = (int)L; { const int q = nwg / NXCD, r = nwg % NXCD, xcd = wgid % NXCD, off = wgid / NXCD; wgid = (xcd < r ? xcd * (q + 1) : r * (q + 1) + (xcd - r) * q) + off; }
        const int nig = WGM * nN, gid = wgid / nig, fm = gid * WGM, gsz = (nM - fm) < WGM ? (nM - fm) : WGM;
        u.pm = fm + ((wgid % nig) % gsz); u.pn = (wgid % nig) / gsz; return true;
    }
    __device__ __forceinline__ void a_ready(const Unit&) const {}
    __device__ __forceinline__ void done(const Unit&) const {}
};

__device__ __forceinline__ unsigned cvt_pk_bf16(float lo, float hi) { unsigned r; asm volatile("v_cvt_pk_bf16_f32 %0, %1, %2" : "=v"(r) : "v"(lo), "v"(hi)); return r; }
typedef float f32x2 __attribute__((ext_vector_type(2)));
__device__ __forceinline__ f32x2 gelu_pk(f32x2 v) {
    const f32x2 u = v * (v * v * 0.044715f + 1.0f);
    const f32x2 s = u * (-2.302208198f);
    f32x2 e; e.x = __builtin_amdgcn_exp2f(s.x); e.y = __builtin_amdgcn_exp2f(s.y);
    const f32x2 d = e + 1.0f;
    f32x2 r; r.x = __builtin_amdgcn_rcpf(d.x); r.y = __builtin_amdgcn_rcpf(d.y);
    return v * r;
}

template <int ACT  > struct EpiBf16 {
    static constexpr bool PERM = true, AFTER_DRAIN = false; typedef f32x4 acc_t;
    bf16_t* O; int ldc; const float* bias; int split_cols; size_t split_stride; float scale0; int act_cols;
    __device__ __forceinline__ void operator()(const f32x4 (&acc)[2][2][4][2], const Unit& u, int wr, int wc, int fr, int fq) const {
        const int row0 = u.pm * BM + wr * 64 + fr; int colt = u.pn * BM; bf16_t* base = O;
        float sc = 1.f; if (split_cols) { const int t = colt / split_cols; base += (size_t)t * split_stride; colt -= t * split_cols; if (t == 0) sc = scale0; }
        const int col0 = colt + wc * 32 + 8 * fq, bcol0 = u.pn * BM + wc * 32 + 8 * fq;
        f32x4 bv[2][2];
#pragma unroll
        for (int bj = 0; bj < 2; ++bj)
#pragma unroll
            for (int n = 0; n < 2; ++n) bv[bj][n] = bias ? *(const f32x4*)(bias + bcol0 + bj * HALF + 4 * n) : (f32x4){0.f, 0.f, 0.f, 0.f};
#pragma unroll
        for (int ai = 0; ai < 2; ++ai)
#pragma unroll
            for (int m = 0; m < 4; ++m) { bf16_t* rowp = base + (size_t)(row0 + ai * HALF + m * 16) * ldc + col0;
#pragma unroll
                for (int bj = 0; bj < 2; ++bj) { f32x4 v0 = acc[ai][bj][m][0] + bv[bj][0], v1 = acc[ai][bj][m][1] + bv[bj][1];
                    if (ACT == 1 && u.pn * BM < act_cols) { f32x2 a = gelu_pk((f32x2){v0[0], v0[1]}), b = gelu_pk((f32x2){v0[2], v0[3]}), c = gelu_pk((f32x2){v1[0], v1[1]}), d = gelu_pk((f32x2){v1[2], v1[3]});
                        v0 = (f32x4){a.x, a.y, b.x, b.y}; v1 = (f32x4){c.x, c.y, d.x, d.y}; }
                    v0 = v0 * sc; v1 = v1 * sc; u32x4 w; w.x = cvt_pk_bf16(v0[0], v0[1]); w.y = cvt_pk_bf16(v0[2], v0[3]); w.z = cvt_pk_bf16(v1[0], v1[1]); w.w = cvt_pk_bf16(v1[2], v1[3]);
                    *(u32x4*)(rowp + bj * HALF) = w; } }
    }
};


template <int ACT> struct EpiI8 {
    static constexpr bool PERM = true, AFTER_DRAIN = false; typedef i32x4 acc_t;
    bf16_t* O; int ldc; const float* rs; const float* cs; int act_cols;
    __device__ __forceinline__ void operator()(const i32x4 (&acc)[2][2][4][2], const Unit& u, int wr, int wc, int fr, int fq) const {
        const int row0 = u.pm * BM + wr * 64 + fr, col0 = u.pn * BM + wc * 32 + 8 * fq;
        f32x4 cv[2][2];
#pragma unroll
        for (int bj = 0; bj < 2; ++bj)
#pragma unroll
            for (int n = 0; n < 2; ++n) cv[bj][n] = *(const f32x4*)(cs + col0 + bj * HALF + 4 * n);
#pragma unroll
        for (int ai = 0; ai < 2; ++ai)
#pragma unroll
            for (int m = 0; m < 4; ++m) { const int row = row0 + ai * HALF + m * 16; const float ra = rs[row]; bf16_t* rowp = O + (size_t)row * ldc + col0;
#pragma unroll
                for (int bj = 0; bj < 2; ++bj) {
                    f32x4 v0 = __builtin_convertvector(acc[ai][bj][m][0], f32x4) * ra * cv[bj][0], v1 = __builtin_convertvector(acc[ai][bj][m][1], f32x4) * ra * cv[bj][1];
                    if (ACT == 1 && u.pn * BM < act_cols) { f32x2 a = gelu_pk((f32x2){v0[0], v0[1]}), b = gelu_pk((f32x2){v0[2], v0[3]}), c = gelu_pk((f32x2){v1[0], v1[1]}), d = gelu_pk((f32x2){v1[2], v1[3]});
                        v0 = (f32x4){a.x, a.y, b.x, b.y}; v1 = (f32x4){c.x, c.y, d.x, d.y}; }
                    u32x4 w; w.x = cvt_pk_bf16(v0[0], v0[1]); w.y = cvt_pk_bf16(v0[2], v0[3]); w.z = cvt_pk_bf16(v1[0], v1[1]); w.w = cvt_pk_bf16(v1[2], v1[3]);
                    *(u32x4*)(rowp + bj * HALF) = w; } }
    }
};

__device__ __forceinline__ f32x4 mma16(bf16x8 a, bf16x8 b, f32x4 c) { return __builtin_amdgcn_mfma_f32_16x16x32_bf16(a, b, c, 0, 0, 0); }
__device__ __forceinline__ i32x4 mma16(bf16x8 a, bf16x8 b, i32x4 c) { return __builtin_amdgcn_mfma_i32_16x16x64_i8(__builtin_bit_cast(i32x4, a), __builtin_bit_cast(i32x4, b), c, 0, 0, 0); }
template <class Epi, class Sched, bool ALIGN_EPI = false, bool SP2 = false>
__device__ __forceinline__ void gemm_phase(PG8_LAS unsigned char* lds, const Gemm g, const Sched& S, const Epi& E, const int wid  ) {
    const int lane = (int)__builtin_amdgcn_mbcnt_hi(~0u, __builtin_amdgcn_mbcnt_lo(~0u, 0u)), tid = wid * 64 + lane, wr = wid >> 2, wc = wid & 3, fr = lane & 15, fq = lane >> 4;
    const int K = g.K, nt = K / BK;
    unsigned voffA[2], voffB[2];
#pragma unroll
    for (int i = 0; i < 2; ++i) { int R, C; stage_rc(tid * 16 + i * 8192, R, C); const int Rb = Epi::PERM ? ((R & ~31) + perm32(R & 31)) : R;
        voffA[i] = (unsigned)(R * K + C) * 2u; voffB[i] = (unsigned)(Rb * K + C) * 2u; }
    const size_t kstep = (size_t)(BK * 2);
    const size_t hstep = (size_t)HALF * K * 2;
    const size_t tstep = 2 * hstep;
    const unsigned ldsw = (unsigned)wid * 1024u;
    const int aoff = lds_byte(wr * 64 + fr, fq * 8), boff = lds_byte(wc * 32 + fr, fq * 8);
#define PG8_SA(b, h) (((b) * 2 + (h)) * HTB)
#define PG8_SB(b, h) ((4 + (b) * 2 + (h)) * HTB)
#define PG8_STAGE(bufoff, gbase, voff) do { _Pragma("unroll") for (int _i = 0; _i < 2; ++_i) \
        __builtin_amdgcn_global_load_lds((const unsigned*)((const char*)(gbase) + (voff)[_i]), (PG8_LAS unsigned*)(lds + (bufoff) + ldsw + _i * 8192), 16, 0, 0); } while (0)
#define PG8_LDA(dst, b, h) do { _Pragma("unroll") for (int m = 0; m < 4; ++m) _Pragma("unroll") for (int k = 0; k < 2; ++k) dst[m][k] = *(const PG8_LAS bf16x8*)(lds + PG8_SA(b, h) + aoff + m * 2048 + k * 1024); } while (0)
#define PG8_LDB(dst, b, h) do { _Pragma("unroll") for (int n = 0; n < 2; ++n) _Pragma("unroll") for (int k = 0; k < 2; ++k) dst[n][k] = *(const PG8_LAS bf16x8*)(lds + PG8_SB(b, h) + boff + n * 2048 + k * 1024); } while (0)
#define PG8_MMA(ai, bj, At, Bt) do { __builtin_amdgcn_s_setprio(1); _Pragma("unroll") for (int m = 0; m < 4; ++m) _Pragma("unroll") for (int n = 0; n < 2; ++n) _Pragma("unroll") for (int k = 0; k < 2; ++k) \
        acc[ai][bj][m][n] = mma16(Bt[n][k], At[m][k], acc[ai][bj][m][n]); __builtin_amdgcn_s_setprio(0); } while (0)
#define PG8_WAIT_V(n) asm volatile("s_waitcnt vmcnt(" #n ")" ::: "memory")
#define PG8_WAIT_L(n) asm volatile("s_waitcnt lgkmcnt(" #n ")" ::: "memory")
#define PG8_BAR __builtin_amdgcn_s_barrier()
#define PG8_SCHED __builtin_amdgcn_sched_barrier(0)
    Unit cur, nxt; int ui = 0;
    if (!S.next(0, cur)) return;
    typedef typename Epi::acc_t acc_t;
    acc_t acc[2][2][4][2];
#pragma unroll
    for (int a = 0; a < 2; ++a)
#pragma unroll
        for (int b = 0; b < 2; ++b)
#pragma unroll
            for (int m = 0; m < 4; ++m)
#pragma unroll
                for (int n = 0; n < 2; ++n) acc[a][b][m][n] = acc_t{};
    bf16x8 At[4][2], B0[2][2], B1[2][2];
    const char* cA = (const char*)g.A + (size_t)cur.pm * tstep; const char* cB = (const char*)g.Bt + (size_t)cur.pn * tstep;
    S.a_ready(cur);
    if constexpr (SP2) {
        PG8_STAGE(PG8_SB(0, 0), cB, voffB); PG8_STAGE(PG8_SB(0, 1), cB + hstep, voffB); PG8_STAGE(PG8_SA(0, 0), cA, voffA); PG8_STAGE(PG8_SA(0, 1), cA + hstep, voffA);
        if (wr == 1) PG8_BAR;
        PG8_WAIT_V(2); PG8_BAR;
        PG8_STAGE(PG8_SB(1, 0), cB + kstep, voffB); PG8_STAGE(PG8_SA(1, 0), cA + kstep, voffA); PG8_STAGE(PG8_SB(1, 1), cB + hstep + kstep, voffB);
        PG8_WAIT_V(6); PG8_BAR;
    } else {
        PG8_STAGE(PG8_SB(0, 0), cB, voffB); PG8_STAGE(PG8_SA(0, 0), cA, voffA); PG8_STAGE(PG8_SB(0, 1), cB + hstep, voffB); PG8_STAGE(PG8_SA(0, 1), cA + hstep, voffA);
        if (wr == 1) PG8_BAR;
        PG8_WAIT_V(4); PG8_BAR;
        PG8_STAGE(PG8_SB(1, 0), cB + kstep, voffB); PG8_STAGE(PG8_SA(1, 0), cA + kstep, voffA); PG8_STAGE(PG8_SB(1, 1), cB + hstep + kstep, voffB);
        PG8_WAIT_V(6); PG8_BAR;
    }
    for (;;) {
        const bool has_next = S.next(ui + 1, nxt);
        const char* nA = has_next ? (const char*)g.A + (size_t)nxt.pm * tstep : cA; const char* nB = has_next ? (const char*)g.Bt + (size_t)nxt.pn * tstep : cB;
        for (int t = 0; t < nt; t += 2) {
            const bool last = (t == nt - 2);
            const char* a1 = cA + (size_t)(t + 1) * kstep;
            const char* a2 = last ? nA : cA + (size_t)(t + 2) * kstep; const char* b2 = last ? nB : cB + (size_t)(t + 2) * kstep;
            const char* a3 = a2 + kstep; const char* b3 = b2 + kstep;
            if (last && has_next) S.a_ready(nxt);
            if constexpr (SP2) {
            PG8_LDB(B0, 0, 0); PG8_LDB(B1, 0, 1); PG8_SCHED; PG8_LDA(At, 0, 0); PG8_STAGE(PG8_SA(1, 1), a1 + hstep, voffA);
            PG8_WAIT_V(8); PG8_WAIT_L(0); PG8_BAR; PG8_MMA(0, 0, At, B0); PG8_MMA(0, 1, At, B1); PG8_BAR; PG8_SCHED;
            PG8_LDA(At, 0, 1); PG8_STAGE(PG8_SB(0, 0), b2, voffB); PG8_STAGE(PG8_SB(0, 1), b2 + hstep, voffB); PG8_STAGE(PG8_SA(0, 0), a2, voffA);
            PG8_WAIT_V(8); PG8_WAIT_L(0); PG8_BAR; PG8_MMA(1, 0, At, B0); PG8_MMA(1, 1, At, B1); PG8_BAR; PG8_SCHED;
            PG8_LDB(B0, 1, 0); PG8_LDB(B1, 1, 1); PG8_SCHED; PG8_LDA(At, 1, 0); PG8_STAGE(PG8_SA(0, 1), a2 + hstep, voffA);
            PG8_WAIT_V(8); PG8_WAIT_L(0); PG8_BAR; PG8_MMA(0, 0, At, B0); PG8_MMA(0, 1, At, B1); PG8_BAR; PG8_SCHED;
            PG8_LDA(At, 1, 1); PG8_STAGE(PG8_SB(1, 0), b3, voffB); PG8_STAGE(PG8_SB(1, 1), b3 + hstep, voffB); PG8_STAGE(PG8_SA(1, 0), a3, voffA);
            PG8_WAIT_V(8); PG8_WAIT_L(0); PG8_BAR; PG8_MMA(1, 0, At, B0); PG8_MMA(1, 1, At, B1); PG8_BAR; PG8_SCHED;
            } else {
            PG8_LDB(B0, 0, 0); PG8_SCHED; PG8_LDA(At, 0, 0); PG8_STAGE(PG8_SA(1, 1), a1 + hstep, voffA);
            PG8_WAIT_L(8); PG8_BAR; PG8_WAIT_L(0); PG8_MMA(0, 0, At, B0); PG8_BAR; PG8_SCHED;
            PG8_LDB(B1, 0, 1); PG8_STAGE(PG8_SB(0, 0), b2, voffB);
            PG8_BAR; PG8_WAIT_L(0); PG8_MMA(0, 1, At, B1); PG8_BAR;
            PG8_LDA(At, 0, 1); PG8_STAGE(PG8_SA(0, 0), a2, voffA);
            PG8_BAR; PG8_WAIT_L(0); PG8_MMA(1, 0, At, B0); PG8_BAR; PG8_SCHED;
            PG8_STAGE(PG8_SB(0, 1), b2 + hstep, voffB);
            PG8_WAIT_V(6); PG8_BAR; PG8_MMA(1, 1, At, B1); PG8_BAR;
            PG8_LDB(B0, 1, 0); PG8_SCHED; PG8_LDA(At, 1, 0); PG8_STAGE(PG8_SA(0, 1), a2 + hstep, voffA);
            PG8_WAIT_L(8); PG8_BAR; PG8_WAIT_L(0); PG8_MMA(0, 0, At, B0); PG8_BAR; PG8_SCHED;
            PG8_LDB(B1, 1, 1); PG8_STAGE(PG8_SB(1, 0), b3, voffB);
            PG8_BAR; PG8_WAIT_L(0); PG8_MMA(0, 1, At, B1); PG8_BAR;
            PG8_LDA(At, 1, 1); PG8_STAGE(PG8_SA(1, 0), a3, voffA);
            PG8_BAR; PG8_WAIT_L(0); PG8_MMA(1, 0, At, B0); PG8_BAR; PG8_SCHED;
            PG8_STAGE(PG8_SB(1, 1), b3 + hstep, voffB);
            PG8_WAIT_V(6); PG8_BAR; PG8_MMA(1, 1, At, B1); PG8_BAR;
            }
        }
        if constexpr (ALIGN_EPI) { if (wr == 0) PG8_BAR; }
        if constexpr (!Epi::AFTER_DRAIN) { E(acc, cur, wr, wc, fr, fq); S.done(cur); }
        if (!has_next) break;
#pragma unroll
        for (int a = 0; a < 2; ++a)
#pragma unroll
            for (int b = 0; b < 2; ++b)
#pragma unroll
                for (int m = 0; m < 4; ++m)
#pragma unroll
                    for (int n = 0; n < 2; ++n) acc[a][b][m][n] = acc_t{};
        cur = nxt; cA = nA; cB = nB; ++ui;
        if constexpr (ALIGN_EPI) { if (wr == 1) PG8_BAR; }
    }
    PG8_WAIT_V(0);
    if constexpr (!ALIGN_EPI) { if (wr == 0) PG8_BAR; }
    PG8_BAR;
    if constexpr (Epi::AFTER_DRAIN) { E.fused(acc, cur, wr, wc, fr, fq, lds, wid, lane); S.done(cur); }
#undef PG8_SA
#undef PG8_SB
#undef PG8_STAGE
#undef PG8_LDA
#undef PG8_LDB
#undef PG8_MMA
#undef PG8_WAIT_V
#undef PG8_WAIT_L
#undef PG8_BAR
#undef PG8_SCHED
}
}
#ifndef MK_PER_PHASE
#define MK_PER_PHASE 0
#endif
#ifndef PROBE_PHASE
#define PROBE_PHASE -1
#endif
#ifndef X1_NR
#define X1_NR 2
#endif
#ifndef TABLES_IN_PHASE
#define TABLES_IN_PHASE 0
#endif
constexpr int NWAVES = 8, NTHR = NWAVES * 64;
constexpr int BATCH = 8, SEQ = 4096, D = 1024, M = BATCH * SEQ;
constexpr int INC = 2560;
constexpr int NEXP = 16384, PKN = 128;
constexpr int NQ = 2048;
constexpr float EPS = 1e-6f;
constexpr size_t MiB = 1u << 20;
constexpr size_t WS_CTL = 0, CTL_ZERO_BYTES = MK_PER_PHASE ? (1u << 20) : 64 * 1024;
constexpr size_t WS_MOD = 1 * MiB, WS_WIN = 2 * MiB, WS_WOUT = 7 * MiB, WS_WQ = 9 * MiB, WS_KEYS = 13 * MiB, WS_SGW = 13 * MiB + 512 * 1024;
constexpr size_t WS_SU = 14 * MiB, WS_UT = 16 * MiB, WS_VT = 48 * MiB, WS_H = 80 * MiB, WS_Y = 144 * MiB, WS_OATT = 80 * MiB, WS_Z = 208 * MiB, WS_QP = 208 * MiB;
constexpr size_t WS_H8 = 336 * MiB;
constexpr size_t WS_CAT = 368 * MiB, WS_IDX = 432 * MiB, WS_GATE = 448 * MiB, WS_END = 464 * MiB;
constexpr int CW_BAR = 4096;
constexpr int RING_BYTES = 131072, LDSCTL_OFF = RING_BYTES, MISC_OFF = LDSCTL_OFF + 320, LDS_BYTES = 147456;
constexpr int NPHASE = 10;

#define GAS __attribute__((address_space(1)))
#define LAS __attribute__((address_space(3)))
typedef unsigned short bf16;
typedef unsigned v4u __attribute__((ext_vector_type(4)));
typedef unsigned v2u __attribute__((ext_vector_type(2)));
typedef float f32x4 __attribute__((ext_vector_type(4)));
typedef short bf16x8 __attribute__((ext_vector_type(8)));
typedef GAS unsigned gu32;
typedef GAS unsigned long long gu64;
#define RLX_AGENT __ATOMIC_RELAXED, __HIP_MEMORY_SCOPE_AGENT
#define LDS_WAIT() asm volatile("s_waitcnt lgkmcnt(0)" ::: "memory")
#define VM_WAIT() asm volatile("s_waitcnt vmcnt(0)" ::: "memory")
__device__ __forceinline__ unsigned f2bf(float f) { unsigned u = __builtin_bit_cast(unsigned, f); return (u + 0x7fffu + ((u >> 16) & 1u)) >> 16; }
__device__ __forceinline__ unsigned pk2(float lo, float hi) { return f2bf(lo) | (f2bf(hi) << 16); }
__device__ __forceinline__ float bflo(unsigned w) { return __uint_as_float(w << 16); }
__device__ __forceinline__ float bfhi(unsigned w) { return __uint_as_float(w & 0xffff0000u); }
__device__ __forceinline__ float bf2f(bf16 b) { return __uint_as_float((unsigned)b << 16); }
typedef __bf16 bf16x2_t __attribute__((ext_vector_type(2)));
__device__ __forceinline__ float dot2(unsigned a, unsigned b, float acc) { return __builtin_amdgcn_fdot2_f32_bf16(__builtin_bit_cast(bf16x2_t, a), __builtin_bit_cast(bf16x2_t, b), acc, false); }
__device__ __forceinline__ float gelu_t(float v) { const float u = v * (1.f + 0.044715f * v * v); return v * __builtin_amdgcn_rcpf(1.f + __builtin_amdgcn_exp2f(-2.302208198f * u)); }
__device__ __forceinline__ int lane_id() { return (int)__builtin_amdgcn_mbcnt_hi(~0u, __builtin_amdgcn_mbcnt_lo(~0u, 0u)); }
__device__ __forceinline__ float wave_sum(float v) {
#pragma unroll
    for (int o = 1; o < 64; o <<= 1) v += __shfl_xor(v, o);
    return v;
}
#define DPP_SUM_ROW(v) do { v += __uint_as_float((unsigned)__builtin_amdgcn_update_dpp(0, (int)__float_as_uint(v), 0xB1, 0xF, 0xF, false)); \
        v += __uint_as_float((unsigned)__builtin_amdgcn_update_dpp(0, (int)__float_as_uint(v), 0x4E, 0xF, 0xF, false)); \
        v += __uint_as_float((unsigned)__builtin_amdgcn_update_dpp(0, (int)__float_as_uint(v), 0x141, 0xF, 0xF, false)); \
        v += __uint_as_float((unsigned)__builtin_amdgcn_update_dpp(0, (int)__float_as_uint(v), 0x140, 0xF, 0xF, false)); } while (0)
__device__ __forceinline__ float dpp_xor1(float v) { return __uint_as_float((unsigned)__builtin_amdgcn_update_dpp(0, (int)__float_as_uint(v), 0xB1, 0xF, 0xF, false)); }
__device__ __forceinline__ float wave_sum_dpp(float v) {
    DPP_SUM_ROW(v);
    const float r0 = __uint_as_float(__builtin_amdgcn_readlane(__float_as_uint(v), 0)), r1 = __uint_as_float(__builtin_amdgcn_readlane(__float_as_uint(v), 16));
    const float r2 = __uint_as_float(__builtin_amdgcn_readlane(__float_as_uint(v), 32)), r3 = __uint_as_float(__builtin_amdgcn_readlane(__float_as_uint(v), 48));
    return (r0 + r1) + (r2 + r3);
}
__device__ __forceinline__ float wave_max_dpp(float v) {
    v = fmaxf(v, __uint_as_float((unsigned)__builtin_amdgcn_update_dpp(0, (int)__float_as_uint(v), 0xB1, 0xF, 0xF, false)));
    v = fmaxf(v, __uint_as_float((unsigned)__builtin_amdgcn_update_dpp(0, (int)__float_as_uint(v), 0x4E, 0xF, 0xF, false)));
    v = fmaxf(v, __uint_as_float((unsigned)__builtin_amdgcn_update_dpp(0, (int)__float_as_uint(v), 0x141, 0xF, 0xF, false)));
    v = fmaxf(v, __uint_as_float((unsigned)__builtin_amdgcn_update_dpp(0, (int)__float_as_uint(v), 0x140, 0xF, 0xF, false)));
    const float r0 = __uint_as_float(__builtin_amdgcn_readlane(__float_as_uint(v), 0)), r1 = __uint_as_float(__builtin_amdgcn_readlane(__float_as_uint(v), 16));
    const float r2 = __uint_as_float(__builtin_amdgcn_readlane(__float_as_uint(v), 32)), r3 = __uint_as_float(__builtin_amdgcn_readlane(__float_as_uint(v), 48));
    return fmaxf(fmaxf(r0, r1), fmaxf(r2, r3));
}
__device__ __forceinline__ float half_max_dpp(float v) {
    v = fmaxf(v, __uint_as_float((unsigned)__builtin_amdgcn_update_dpp(0, (int)__float_as_uint(v), 0xB1, 0xF, 0xF, false)));
    v = fmaxf(v, __uint_as_float((unsigned)__builtin_amdgcn_update_dpp(0, (int)__float_as_uint(v), 0x4E, 0xF, 0xF, false)));
    v = fmaxf(v, __uint_as_float((unsigned)__builtin_amdgcn_update_dpp(0, (int)__float_as_uint(v), 0x141, 0xF, 0xF, false)));
    v = fmaxf(v, __uint_as_float((unsigned)__builtin_amdgcn_update_dpp(0, (int)__float_as_uint(v), 0x140, 0xF, 0xF, false)));
    const float r0 = __uint_as_float(__builtin_amdgcn_readlane(__float_as_uint(v), 0)), r1 = __uint_as_float(__builtin_amdgcn_readlane(__float_as_uint(v), 16));
    const float r2 = __uint_as_float(__builtin_amdgcn_readlane(__float_as_uint(v), 32)), r3 = __uint_as_float(__builtin_amdgcn_readlane(__float_as_uint(v), 48));
    return (lane_id() < 32) ? fmaxf(r0, r1) : fmaxf(r2, r3);
}
__device__ __forceinline__ float wave_max(float v) {
#pragma unroll
    for (int o = 1; o < 64; o <<= 1) v = fmaxf(v, __shfl_xor(v, o));
    return v;
}
#define XB_TMO      128
#define XB_XCNT(j)  (256  + 64 * (j))
#define XB_XSUB(j)  (1280 + 64 * (j))
#define XB_XGEN(j)  (2304 + 64 * (j))
#define XB_TOP      3328
#define XB_TOPGEN   3392
#define XCD_BAR_WORDS 3456
#define XB_SPIN_CAP (1u << 18)

__device__ __forceinline__ unsigned xb_ld(unsigned* p)              { return __hip_atomic_load(p, __ATOMIC_RELAXED, __HIP_MEMORY_SCOPE_AGENT); }
__device__ __forceinline__ unsigned xb_add(unsigned* p, unsigned v) { return __hip_atomic_fetch_add(p, v, __ATOMIC_RELAXED, __HIP_MEMORY_SCOPE_AGENT); }
__device__ __forceinline__ unsigned xb_xcc_id() { return (unsigned)__builtin_amdgcn_s_getreg((3 << 11) | 20) & 0xFu; }
#define XB_SPIN(cond, bar) do { unsigned _sp = 0; while (cond) { __builtin_amdgcn_s_sleep(1); \
    if ((++_sp & 255u) == 0u) { if (xb_ld(&(bar)[XB_TMO])) break; if (_sp > XB_SPIN_CAP) { atomicAdd(&(bar)[XB_TMO], 1u); break; } } } } while (0)

struct XcdBarrier {
    unsigned* bar; unsigned x;
    volatile LAS unsigned* st;
};

__device__ __forceinline__ XcdBarrier xcd_barrier_post(unsigned* bar, volatile LAS unsigned* st) {
    XcdBarrier b; b.bar = bar; b.x = xb_xcc_id(); b.st = st;
    if (threadIdx.x == 0) (void)xb_add(&bar[XB_XCNT(b.x)], 1u);
    return b;
}
__device__ __forceinline__ void xcd_barrier_complete(unsigned* bar, unsigned x, unsigned& nloc, unsigned& nx) {
    const unsigned G = gridDim.x * gridDim.y * gridDim.z;
    unsigned sum, cnt, mine, sp = 0u;
    for (;;) {
        sum = 0u; cnt = 0u; mine = 0u;
#pragma unroll
        for (unsigned j = 0; j < 16; ++j) { const unsigned c = xb_ld(&bar[XB_XCNT(j)]); sum += c; cnt += (c > 0u) ? 1u : 0u; mine = (j == x) ? c : mine; }
        if (sum == G) break;
        __builtin_amdgcn_s_sleep(1);
        if ((++sp & 255u) == 0u) { if (xb_ld(&bar[XB_TMO])) break; if (sp > XB_SPIN_CAP) { atomicAdd(&bar[XB_TMO], 1u); break; } }
    }
    nloc = mine > 0u ? mine : 1u; nx = cnt > 0u ? cnt : 1u;
}

__device__ __forceinline__ void xcd_barrier(const XcdBarrier& b) {
    asm volatile("s_waitcnt vmcnt(0)" ::: "memory");
    __syncthreads();
    if (threadIdx.x == 0) {
        unsigned* bar = b.bar;
        __builtin_amdgcn_s_waitcnt(0);
        unsigned nloc = b.st[0], nx = b.st[1];
        if (nloc == 0u) { xcd_barrier_complete(bar, b.x, nloc, nx); b.st[0] = nloc; b.st[1] = nx; }
        const unsigned old = xb_add(&bar[XB_XSUB(b.x)], 1u);
        const unsigned gen = old / nloc;
        if (old + 1u == (gen + 1u) * nloc) {
            __builtin_amdgcn_fence(__ATOMIC_RELEASE, "agent");
            asm volatile("s_waitcnt vmcnt(0)" ::: "memory");
            const unsigned og = xb_add(&bar[XB_TOP], 1u);
            const unsigned tg = og / nx;
            if (og + 1u == (tg + 1u) * nx) xb_add(&bar[XB_TOPGEN], 1u);
            else XB_SPIN(xb_ld(&bar[XB_TOPGEN]) == tg, bar);
            __builtin_amdgcn_fence(__ATOMIC_ACQUIRE, "agent");
            xb_add(&bar[XB_XGEN(b.x)], 1u);
            asm volatile("s_waitcnt vmcnt(0)" ::: "memory");
        } else {
            XB_SPIN(xb_ld(&bar[XB_XGEN(b.x)]) == gen, bar);
            __builtin_amdgcn_fence(__ATOMIC_ACQUIRE, "agent");
            asm volatile("s_waitcnt vmcnt(0)" ::: "memory");
        }
    }
    __syncthreads();
}
struct Frame {
    LAS unsigned char* lds;
    volatile LAS unsigned* MISC;
    gu32* ctl;
    int wave, G;
    const float *x, *c, *w_ada, *b_ada, *norm_g, *w_in, *sgu_ln_g, *sgu_ln_b, *sgu_w, *sgu_b, *diff_lambda, *subln_g, *rel_bias, *w_out, *w_query, *sub_keys, *peer_u, *peer_v;
    float* out;
    float* mod; bf16 *WIN, *WOUT, *WQ, *KEYS, *SGW, *H, *Y, *Z, *QP, *CAT; unsigned char *UT8, *VT6, *H8, *HA8, *W8; float *HS, *HAS, *WS8; float *SU, *SV, *PART; unsigned* STASH; int* IDX; float* GATE;
};

__device__ __forceinline__ void p0_transpose_item(const float* W, int K, int N, bf16* WT, int row_off, LAS float* scr, int item, int lane) {
    const int nblk = N / 32, kb = item / nblk, nb = item % nblk, k0 = 64 * kb, n0 = 32 * nb;
#pragma unroll 8
    for (int i = 0; i < 32; ++i) { const int kk = 2 * i + (lane >> 5); scr[kk * 33 + (lane & 31)] = W[(size_t)(k0 + kk) * N + n0 + (lane & 31)]; }
    LDS_WAIT(); asm volatile("" ::: "memory");
    const int c = lane & 7;
#pragma unroll
    for (int j = 0; j < 4; ++j) { const int n = (lane >> 3) + 8 * j; const LAS float* s = scr + (8 * c) * 33 + n;
        v4u o; o.x = pk2(s[0 * 33], s[1 * 33]); o.y = pk2(s[2 * 33], s[3 * 33]); o.z = pk2(s[4 * 33], s[5 * 33]); o.w = pk2(s[6 * 33], s[7 * 33]);
        *(GAS v4u*)(WT + (size_t)(row_off + n0 + n) * K + k0 + 8 * c) = o; }
    LDS_WAIT(); asm volatile("" ::: "memory");
}

__device__ __forceinline__ void prologue_tables_fwd(Frame& F, int gw, int NGW, int lane);
__device__ __forceinline__ void ph_prologue(Frame& F) {
    const int lane = lane_id(), wave = F.wave, tid = wave * 64 + lane, G = F.G;
    const int gw = blockIdx.x * NWAVES + wave, NGW = G * NWAVES;
    for (int rep_ = 0; rep_ < (PROBE_PHASE == 100 ? 2 : 1); ++rep_) {
        LAS float* sil = (LAS float*)F.lds;
        LAS float* red = sil + 8192;
        for (int i = tid; i < 8192; i += NTHR) { const float cv = F.c[i]; sil[i] = cv / (1.f + __expf(-cv)); }
        __syncthreads();
        for (int u = blockIdx.x; u < 384; u += G) {
            const int j = u * 16 + (lane & 15), kr = lane >> 4, k0 = wave * 128;
            float acc[8];
#pragma unroll
            for (int b = 0; b < 8; ++b) acc[b] = 0.f;
            const float* wp = F.w_ada + (size_t)(k0 + kr) * 6144 + j;
#pragma unroll 16
            for (int i = 0; i < 32; ++i) { const float w = wp[(size_t)i * 4 * 6144]; const int k = k0 + 4 * i + kr;
#pragma unroll
                for (int b = 0; b < 8; ++b) acc[b] += sil[b * 1024 + k] * w; }
#pragma unroll
            for (int b = 0; b < 8; ++b) { acc[b] += __shfl_xor(acc[b], 16); acc[b] += __shfl_xor(acc[b], 32); }
            if (lane < 16) {
#pragma unroll
                for (int b = 0; b < 8; ++b) red[(wave * 8 + b) * 16 + lane] = acc[b]; }
            __syncthreads();
            if (tid < 128) { const int b = tid >> 4, c = tid & 15; float s = 0.f;
#pragma unroll
                for (int w = 0; w < 8; ++w) s += red[(w * 8 + b) * 16 + c];
                F.mod[b * 6144 + u * 16 + c] = s + F.b_ada[u * 16 + c]; }
            __syncthreads();
        }
    }
    LAS float* scr = (LAS float*)(F.lds + wave * 16384);
    {
        LAS float* part = (LAS float*)(F.lds + 7 * 16384 + 8704);
        LAS float* fin = part + 256;
        const int n = lane & 31, hf = lane >> 5;
        for (int u = blockIdx.x; u < INC / 32; u += G) {
            const int n0 = u * 32;
            float am = 0.f;
            { const float* wp = F.w_in + (size_t)(wave * 128 + hf) * INC + n0 + n;
#pragma unroll 16
              for (int i = 0; i < 64; ++i) am = fmaxf(am, fabsf(wp[(size_t)(2 * i) * INC])); }
            { auto rr = __builtin_amdgcn_permlane32_swap(__float_as_uint(am), __float_as_uint(am), false, false); am = fmaxf(__uint_as_float(rr[0]), __uint_as_float(rr[1])); }
            if (lane < 32) part[wave * 32 + lane] = am;
            __syncthreads();
            if (tid < 32) { float mx = 0.f;
#pragma unroll
                for (int w = 0; w < 8; ++w) mx = fmaxf(mx, part[w * 32 + tid]);
                fin[tid] = mx; F.WS8[n0 + tid] = mx > 0.f ? mx * (1.f / 127.f) : 1.f; }
            __syncthreads();
            const float cmx = fin[n]; const float sc = cmx > 0.f ? 127.f / cmx : 1.f;
#pragma unroll 1
            for (int q = 0; q < 2; ++q) { const int k0 = (wave * 2 + q) * 64;
#pragma unroll 8
                for (int i = 0; i < 32; ++i) { const int kk = 2 * i + hf; scr[kk * 33 + n] = F.w_in[(size_t)(k0 + kk) * INC + n0 + n]; }
                LDS_WAIT(); asm volatile("" ::: "memory");
                unsigned w8[8];
#pragma unroll
                for (int d = 0; d < 8; ++d) { const LAS float* s = scr + (32 * hf + 4 * d) * 33 + n;
                    const int q0 = (int)rintf(s[0] * sc), q1 = (int)rintf(s[33] * sc), q2 = (int)rintf(s[66] * sc), q3 = (int)rintf(s[99] * sc);
                    w8[d] = (unsigned)((q0 & 255) | ((q1 & 255) << 8) | ((q2 & 255) << 16) | (q3 << 24)); }
                unsigned char* op = F.W8 + (size_t)(n0 + n) * D + k0 + 32 * hf;
                *(GAS v4u*)op = (v4u){w8[0], w8[1], w8[2], w8[3]}; *(GAS v4u*)(op + 16) = (v4u){w8[4], w8[5], w8[6], w8[7]};
                LDS_WAIT(); asm volatile("" ::: "memory"); }
            __syncthreads();
        }
    }
    constexpr int I_IN = 0, I_OUT = (D / 64) * (D / 32), I_Q = (D / 64) * (NQ / 32);
    for (int rep_ = 0; rep_ < (PROBE_PHASE == 101 ? 2 : 1); ++rep_)
    for (int it = gw; it < I_IN + I_OUT + I_Q; it += NGW) {
        int r = it;
        if (r < I_IN) { p0_transpose_item(F.w_in, D, INC, F.WIN, 0, scr, r, lane); continue; } r -= I_IN;
        if (r < I_OUT) { p0_transpose_item(F.w_out, D, D, F.WOUT, 0, scr, r, lane); continue; } r -= I_OUT;
        p0_transpose_item(F.w_query, D, NQ, F.WQ, 0, scr, r, lane);
    }
    const int gt = blockIdx.x * NTHR + tid, NT = G * NTHR;
    if (TABLES_IN_PHASE == 0) for (int rep_ = 0; rep_ < (PROBE_PHASE == 102 ? 2 : 1); ++rep_) prologue_tables_fwd(F, gw, NGW, lane);
    for (int i = gt; i < 16 * 16 * 128; i += NT) {
        const int hc = i >> 11, dg = (i >> 7) & 15, n = i & 127;
        const float* s = F.sub_keys + ((size_t)(hc * 128 + n)) * 128 + dg * 8;
        const f32x4 a = *(const f32x4*)s, b = *(const f32x4*)(s + 4);
        v4u o; o.x = pk2(a.x, a.y); o.y = pk2(a.z, a.w); o.z = pk2(b.x, b.y); o.w = pk2(b.z, b.w); ((v4u*)F.KEYS)[i] = o;
    }
    for (int i = gt; i < 8 * 128 * 16; i += NT) {
        const int t = (i >> 4) & 127, s0 = (i & 15) * 8;
        const float* s = F.sgu_w + (size_t)i * 8;
        const f32x4 a = *(const f32x4*)s, b = *(const f32x4*)(s + 4);
        float f[8] = {a.x, a.y, a.z, a.w, b.x, b.y, b.z, b.w};
#pragma unroll
        for (int e = 0; e < 8; ++e) f[e] = (s0 + e <= t) ? f[e] : 0.f;
        v4u o; o.x = pk2(f[0], f[1]); o.y = pk2(f[2], f[3]); o.z = pk2(f[4], f[5]); o.w = pk2(f[6], f[7]); ((v4u*)F.SGW)[i] = o;
    }
}

__device__ __forceinline__ void ph_hrows(Frame& F) {
    const int lane = lane_id(); const int gw = blockIdx.x * NWAVES + F.wave, NGW = F.G * NWAVES;
    for (int m0 = gw; m0 < M; m0 += 2 * NGW) {
        const int m1 = (m0 + NGW < M) ? m0 + NGW : m0;
        f32x4 v[2][4]; float ss[2] = {0.f, 0.f};
#pragma unroll
        for (int u = 0; u < 2; ++u) { const f32x4* xr = (const f32x4*)(F.x + (size_t)(u ? m1 : m0) * D) + lane;
#pragma unroll
            for (int j = 0; j < 4; ++j) v[u][j] = xr[64 * j]; }
#pragma unroll
        for (int u = 0; u < 2; ++u)
#pragma unroll
            for (int j = 0; j < 4; ++j) ss[u] += (v[u][j].x * v[u][j].x + v[u][j].y * v[u][j].y) + (v[u][j].z * v[u][j].z + v[u][j].w * v[u][j].w);
        const float r0 = rsqrtf(wave_sum_dpp(ss[0]) * (1.f / D) + EPS), r1 = rsqrtf(wave_sum_dpp(ss[1]) * (1.f / D) + EPS);
#pragma unroll
        for (int u = 0; u < 2; ++u) { const int m = u ? m1 : m0; const float rstd = u ? r1 : r0;
            const float* md = F.mod + (m >> 12) * 6144;
            float am = 0.f;
#pragma unroll
            for (int j = 0; j < 4; ++j) { const int c = 256 * j + 4 * lane;
                const f32x4 g = *(const f32x4*)(F.norm_g + c), sc = *(const f32x4*)(md + 1024 + c), sh = *(const f32x4*)(md + c);
                const f32x4 hv = v[u][j] * rstd * g * (sc + 1.f) + sh; v[u][j] = hv;
                am = fmaxf(am, fmaxf(fmaxf(fabsf(hv.x), fabsf(hv.y)), fmaxf(fabsf(hv.z), fabsf(hv.w)))); }
            am = wave_max_dpp(am);
            const float s8 = am > 0.f ? 127.f / am : 1.f;
            unsigned* h8 = (unsigned*)(F.HA8 + (size_t)m * D) + lane;
#pragma unroll
            for (int j = 0; j < 4; ++j) { const int q0 = (int)rintf(v[u][j].x * s8), q1 = (int)rintf(v[u][j].y * s8), q2 = (int)rintf(v[u][j].z * s8), q3 = (int)rintf(v[u][j].w * s8);
                if (u == 0 || m1 != m0) h8[64 * j] = (unsigned)((q0 & 255) | ((q1 & 255) << 8) | ((q2 & 255) << 16) | (q3 << 24)); }
            if (lane == 0 && (u == 0 || m1 != m0)) F.HAS[m] = 1.f / s8; }
    }
}

__device__ __forceinline__ void ph_x1rows(Frame& F) {
    const int lane = lane_id(); const int gw = blockIdx.x * NWAVES + F.wave, NGW = F.G * NWAVES;
    constexpr int NR = X1_NR;
    for (int m0 = gw; m0 < M; m0 += NR * NGW) {
        int mr[NR]; bool ok[NR];
#pragma unroll
        for (int u = 0; u < NR; ++u) { ok[u] = (m0 + u * NGW < M); mr[u] = ok[u] ? m0 + u * NGW : m0; }
        f32x4 xv[NR][4], yv[NR][4]; float ss[NR];
#pragma unroll
        for (int u = 0; u < NR; ++u) { const int m = mr[u]; ss[u] = 0.f;
            const f32x4* xr = (const f32x4*)(F.x + (size_t)m * D) + lane; const v2u* yr = (const v2u*)(F.Y + (size_t)m * D) + lane;
#pragma unroll
            for (int j = 0; j < 4; ++j) { xv[u][j] = xr[64 * j]; const v2u w = yr[64 * j]; yv[u][j] = (f32x4){bflo(w.x), bfhi(w.x), bflo(w.y), bfhi(w.y)}; } }
#pragma unroll
        for (int u = 0; u < NR; ++u)
#pragma unroll
            for (int j = 0; j < 4; ++j) ss[u] += (yv[u][j].x * yv[u][j].x + yv[u][j].y * yv[u][j].y) + (yv[u][j].z * yv[u][j].z + yv[u][j].w * yv[u][j].w);
        float rs[NR], s1[NR];
#pragma unroll
        for (int u = 0; u < NR; ++u) { rs[u] = rsqrtf(wave_sum_dpp(ss[u]) * (1.f / D) + EPS); s1[u] = 0.f; }
#pragma unroll
        for (int u = 0; u < NR; ++u) { const int m = mr[u]; const float* md = F.mod + (m >> 12) * 6144; const float rstd = rs[u];
            f32x4* orow = (f32x4*)(F.out + (size_t)m * D) + lane;
#pragma unroll
            for (int j = 0; j < 4; ++j) { const int c = 256 * j + 4 * lane;
                const f32x4 g1 = *(const f32x4*)(F.norm_g + 1024 + c), gt = *(const f32x4*)(md + 2048 + c);
                xv[u][j] = xv[u][j] + gt * (yv[u][j] * rstd * g1); if (ok[u]) orow[64 * j] = xv[u][j];
                s1[u] += (xv[u][j].x * xv[u][j].x + xv[u][j].y * xv[u][j].y) + (xv[u][j].z * xv[u][j].z + xv[u][j].w * xv[u][j].w); } }
        float r1v[NR];
#pragma unroll
        for (int u = 0; u < NR; ++u) r1v[u] = rsqrtf(wave_sum_dpp(s1[u]) * (1.f / D) + EPS);
#pragma unroll
        for (int u = 0; u < NR; ++u) { const int m = mr[u]; const float* md = F.mod + (m >> 12) * 6144; const float r1 = r1v[u];
            v2u* o8 = (v2u*)(F.H + (size_t)m * D) + lane;
#pragma unroll
            for (int j = 0; j < 4; ++j) { const int c = 256 * j + 4 * lane;
                const f32x4 g2 = *(const f32x4*)(F.norm_g + 2048 + c), sc = *(const f32x4*)(md + 4096 + c), sh = *(const f32x4*)(md + 3072 + c);
                const f32x4 hv = xv[u][j] * r1 * g2 * (sc + 1.f) + sh; xv[u][j] = hv;
                v2u w; w.x = pk2(hv.x, hv.y); w.y = pk2(hv.z, hv.w); if (ok[u]) o8[64 * j] = w; }
            float am = 0.f;
#pragma unroll
            for (int j = 0; j < 4; ++j) am = fmaxf(am, fmaxf(fmaxf(fabsf(xv[u][j].x), fabsf(xv[u][j].y)), fmaxf(fabsf(xv[u][j].z), fabsf(xv[u][j].w))));
            am = wave_max_dpp(am);
            const float s8 = am > 0.f ? 127.f / am : 1.f;
            unsigned* h8 = (unsigned*)(F.H8 + (size_t)m * D) + lane;
#pragma unroll
            for (int j = 0; j < 4; ++j) { const int q0 = (int)rintf(xv[u][j].x * s8), q1 = (int)rintf(xv[u][j].y * s8), q2 = (int)rintf(xv[u][j].z * s8), q3 = (int)rintf(xv[u][j].w * s8);
                if (ok[u]) h8[64 * j] = (unsigned)((q0 & 255) | ((q1 & 255) << 8) | ((q2 & 255) << 16) | (q3 << 24)); }
            if (lane == 0 && ok[u]) F.HS[m] = 1.f / s8; }
    }
}

namespace att {
typedef float f32x16 __attribute__((ext_vector_type(16)));
typedef short s16x4 __attribute__((ext_vector_type(4)));
constexpr int QB = 256, KVB = 64;
constexpr int NS = 4;
constexpr int BTO = 288, BTN = 416;
constexpr int L_V = 0, L_K = NS * 16384, L_WS = L_K + NS * 8192, L_BT = L_WS + 2048, L_END = L_BT + 2048;
constexpr float C2 = 0.125f * 1.4426950408889634f;
__device__ __forceinline__ int v_st(int k, int c) { const int kk = (k & ~0xC) | ((k & 4) << 1) | ((k & 8) >> 1); return ((kk >> 3) * 4 + (c >> 5)) * 512 + ((kk & 7) * 32 + (c & 31)) * 2; }
__device__ __forceinline__ int v_rd_base(int lane) { return ((lane & 3) << 3) | (((lane >> 2) & 3) << 6) | (((lane >> 4) & 1) << 5) | (((lane >> 5) & 1) << 8); }
__device__ __forceinline__ unsigned v_src(int p) { const int sub = p >> 5, q = p & 31, kk = (sub >> 2) * 8 + (q >> 2), c = (sub & 3) * 32 + (q & 3) * 8;
    const int k = (kk & ~0xC) | ((kk & 4) << 1) | ((kk & 8) >> 1); return (unsigned)(k * INC + c) * 2u; }
__device__ __forceinline__ int crow(int r, int hi) { return (r & 3) + 8 * (r >> 2) + 4 * hi; }
typedef float f32x2_t __attribute__((ext_vector_type(2))); typedef __bf16 bf16x2_t __attribute__((ext_vector_type(2)));
__device__ __forceinline__ unsigned cvtpk(float lo, float hi) { const f32x2_t v = {lo, hi}; const bf16x2_t b = __builtin_convertvector(v, bf16x2_t); return __builtin_bit_cast(unsigned, b); }

__device__ __forceinline__ void attn_unit(Frame& F, int b, int h, int qb, float lam) {
    int tid = F.wave * 64 + lane_id(); asm volatile("" : "+v"(tid));
    const int lane = tid & 63, wid = F.wave, r32 = lane & 31, hi = lane >> 5;
    LAS unsigned char* lds = F.lds;
    LAS float* wsf = (LAS float*)(lds + L_WS) + wid * 64;
    const LAS float* bt = (const LAS float*)(lds + L_BT);
    const int q0 = qb * QB, qlo = q0 + wid * 32, qpos = qlo + r32;
    const size_t rowb = (size_t)b * SEQ;
    const int NT = (q0 + QB) / KVB;
    const unsigned kdoff = (unsigned)((tid >> 3) * INC + (((tid & 7) ^ ((tid >> 3) & 7)) * 8)) * 2u;
    const unsigned vdoff0 = v_src(tid), vdoff1 = v_src(tid + 512);
    const unsigned qoff = (unsigned)(r32 * INC + hi * 8) * 2u;
#define DMA_K(t_, buf_) __builtin_amdgcn_global_load_lds((const unsigned*)(Kb + (size_t)(t_) * (KVB * INC * 2) + kdoff), (LAS unsigned*)(lds + L_K + (buf_) * 8192 + wid * 1024), 16, 0, 0)
#define DMA_V(t_, buf_) do { __builtin_amdgcn_global_load_lds((const unsigned*)(Vb + (size_t)(t_) * (KVB * INC * 2) + vdoff0), (LAS unsigned*)(lds + L_V + (buf_) * 16384 + wid * 1024), 16, 0, 0); \
        __builtin_amdgcn_global_load_lds((const unsigned*)(Vb + (size_t)(t_) * (KVB * INC * 2) + vdoff1), (LAS unsigned*)(lds + L_V + (buf_) * 16384 + 8192 + wid * 1024), 16, 0, 0); } while (0)
#define DMA_TILE(t_) do { const int sl_ = (t_) & (NS - 1); DMA_K(t_, sl_); DMA_V(t_, sl_); } while (0)
#define ABAR() do { asm volatile("s_waitcnt lgkmcnt(0)" ::: "memory"); __builtin_amdgcn_s_barrier(); asm volatile("" ::: "memory"); } while (0)
    const int vbase = (int)(uintptr_t)(lds + L_V) + v_rd_base(lane);
    const int kroff = r32 * 128, kx = (r32 & 7) << 4;
    v4u* o0st = (v4u*)(F.STASH + ((size_t)blockIdx.x * NTHR + tid) * 32);
#pragma unroll
    for (int c = 0; c < 2; ++c) {
        const char* Kb = (const char*)(F.Z + rowb * INC + 1536 + h * 128 + c * 64);
        const char* Vb = (const char*)(F.Z + rowb * INC + 2048 + h * 128);
        const char* Qb = (const char*)(F.Z + (rowb + qlo) * INC + 1024 + h * 128 + c * 64);
        bf16x8 qr[4];
#pragma unroll
        for (int d0 = 0; d0 < 4; ++d0) qr[d0] = *(const bf16x8*)(Qb + d0 * 32 + qoff);
        DMA_TILE(0); DMA_TILE(1); DMA_TILE(2);
        asm volatile("s_waitcnt vmcnt(3)" ::: "memory");
        ABAR();
        float m = -1e30f, l = 0.f;
        f32x16 o[4];
#pragma unroll
        for (int d0 = 0; d0 < 4; ++d0) o[d0] = f32x16{};
        bf16x8 pa0, pa1, pa2, pa3;
#define QK_TILE(N0, N1, su) do { N0 = f32x16{}; N1 = f32x16{}; const LAS unsigned char* kb_ = lds + L_K + (su) * 8192 + kroff; \
        _Pragma("unroll") for (int d0 = 0; d0 < 4; ++d0) { const LAS unsigned char* a_ = kb_ + ((d0 * 32 + hi * 16) ^ kx); \
            const bf16x8 b0_ = *(const LAS bf16x8*)a_, b1_ = *(const LAS bf16x8*)(a_ + 4096); \
            N0 = __builtin_amdgcn_mfma_f32_32x32x16_bf16(b0_, qr[d0], N0, 0, 0, 0); N1 = __builtin_amdgcn_mfma_f32_32x32x16_bf16(b1_, qr[d0], N1, 0, 0, 0); } } while (0)
#define FIX_TILE(N0, N1, u) do { if (qlo - (u) * KVB - 63 < 113) { const int dq_ = qpos - (u) * KVB - 4 * hi + BTO; \
        _Pragma("unroll") for (int r = 0; r < 16; ++r) { const int i0_ = dq_ - ((r & 3) + 8 * (r >> 2)), i1_ = i0_ - 32; \
            N0[r] += bt[i0_ > BTN - 1 ? BTN - 1 : i0_]; N1[r] += bt[i1_ > BTN - 1 ? BTN - 1 : (i1_ < 0 ? 0 : i1_)]; } } } while (0)
#define MAX_TILE(N0, N1, ALN, GRN) do { float pm_ = fmaxf(N0[0], N1[0]); \
        _Pragma("unroll") for (int r = 1; r < 16; ++r) pm_ = fmaxf(fmaxf(pm_, N0[r]), N1[r]); \
        { auto rr_ = __builtin_amdgcn_permlane32_swap(__float_as_uint(pm_), __float_as_uint(pm_), false, false); pm_ = fmaxf(__uint_as_float(rr_[0]), __uint_as_float(rr_[1])); } \
        pm_ *= C2; GRN = __any(pm_ > m + 8.0f); const float mn_ = GRN ? fmaxf(m, pm_) : m; ALN = GRN ? __builtin_amdgcn_exp2f(m - mn_) : 1.0f; m = mn_; } while (0)
#define PK4(P, B_, OUT) do { const unsigned a0 = cvtpk(P[B_ + 0], P[B_ + 1]), a1 = cvtpk(P[B_ + 2], P[B_ + 3]); \
        const unsigned b0 = cvtpk(P[B_ + 4], P[B_ + 5]), b1 = cvtpk(P[B_ + 6], P[B_ + 7]); \
        auto r0 = __builtin_amdgcn_permlane32_swap(a0, b0, false, false); auto r1 = __builtin_amdgcn_permlane32_swap(a1, b1, false, false); \
        v4u w = {r0[0], r1[0], r0[1], r1[1]}; OUT = __builtin_bit_cast(bf16x8, w); } while (0)
#define EXP_TILE(C0, C1, ALC) do { const float nm_ = -m; \
        _Pragma("unroll") for (int r = 0; r < 16; ++r) { C0[r] = __builtin_amdgcn_exp2f(fmaf(C0[r], C2, nm_)); C1[r] = __builtin_amdgcn_exp2f(fmaf(C1[r], C2, nm_)); } \
        float ps_ = 0.f; _Pragma("unroll") for (int r = 0; r < 16; ++r) ps_ += C0[r] + C1[r]; \
        { auto rr_ = __builtin_amdgcn_permlane32_swap(__float_as_uint(ps_), __float_as_uint(ps_), false, false); ps_ = __uint_as_float(rr_[0]) + __uint_as_float(rr_[1]); } \
        l = l * (ALC) + ps_; PK4(C0, 0, pa0); PK4(C0, 8, pa1); PK4(C1, 0, pa2); PK4(C1, 8, pa3); } while (0)
#define RESC(ALC) do { if (hi == 0) wsf[r32] = (ALC); \
        _Pragma("unroll") for (int r = 0; r < 16; ++r) { const float a_ = wsf[crow(r, hi)]; _Pragma("unroll") for (int d0 = 0; d0 < 4; ++d0) o[d0][r] *= a_; } } while (0)
#define TRRD(dst, off) asm volatile("ds_read_b64_tr_b16 %0, %1 offset:%2" : "=&v"(dst) : "v"(vb0), "i"(off) : "memory")
#define PV_RD(L, H, d0) do { constexpr int b_ = (d0) * 512; TRRD(L[0], b_); TRRD(H[0], b_ + 2048); TRRD(L[1], b_ + 4096); TRRD(H[1], b_ + 6144); TRRD(L[2], b_ + 8192); TRRD(H[2], b_ + 10240); TRRD(L[3], b_ + 12288); TRRD(H[3], b_ + 14336); } while (0)
#define PV_MM(L, H, d0) do { \
        o[d0] = __builtin_amdgcn_mfma_f32_32x32x16_bf16(pa0, (bf16x8){L[0][0], L[0][1], L[0][2], L[0][3], H[0][0], H[0][1], H[0][2], H[0][3]}, o[d0], 0, 0, 0); \
        o[d0] = __builtin_amdgcn_mfma_f32_32x32x16_bf16(pa1, (bf16x8){L[1][0], L[1][1], L[1][2], L[1][3], H[1][0], H[1][1], H[1][2], H[1][3]}, o[d0], 0, 0, 0); \
        o[d0] = __builtin_amdgcn_mfma_f32_32x32x16_bf16(pa2, (bf16x8){L[2][0], L[2][1], L[2][2], L[2][3], H[2][0], H[2][1], H[2][2], H[2][3]}, o[d0], 0, 0, 0); \
        o[d0] = __builtin_amdgcn_mfma_f32_32x32x16_bf16(pa3, (bf16x8){L[3][0], L[3][1], L[3][2], L[3][3], H[3][0], H[3][1], H[3][2], H[3][3]}, o[d0], 0, 0, 0); } while (0)
#define LGK(n) do { asm volatile("s_waitcnt lgkmcnt(" #n ")" ::: "memory"); __builtin_amdgcn_sched_barrier(0); } while (0)
#define ITER(C0, C1, ALC, GRC, N0, N1, ALN, GRN, t) do { \
        if ((t) + 3 < NT) DMA_TILE((t) + 3);                      \
        QK_TILE(N0, N1, ((t) + 1) & (NS - 1));                    \
        EXP_TILE(C0, C1, ALC); \
        _Pragma("unroll") for (int i_ = 0; i_ < 4; ++i_) { __builtin_amdgcn_sched_group_barrier(0x100, 2, 0); __builtin_amdgcn_sched_group_barrier(0x008, 1, 0); __builtin_amdgcn_sched_group_barrier(0x002, 18, 0); \
            __builtin_amdgcn_sched_group_barrier(0x008, 1, 0); __builtin_amdgcn_sched_group_barrier(0x002, 18, 0); }     \
        if (GRC) RESC(ALC); \
        if ((t) + 1 < NT) FIX_TILE(N0, N1, (t) + 1); \
        { const int vb0 = vbase + ((t) & (NS - 1)) * 16384; \
          s16x4 la[4], ha[4], lb[4], hb[4];                    \
          PV_RD(la, ha, 0); PV_RD(lb, hb, 1); LGK(8); PV_MM(la, ha, 0); \
          if ((t) + 1 < NT) MAX_TILE(N0, N1, ALN, GRN); \
          PV_RD(la, ha, 2); LGK(8); PV_MM(lb, hb, 1); PV_RD(lb, hb, 3); LGK(8); PV_MM(la, ha, 2); LGK(0); PV_MM(lb, hb, 3); } \
        if ((t) + 3 < NT) asm volatile("s_waitcnt vmcnt(3)" ::: "memory"); else asm volatile("s_waitcnt vmcnt(0)" ::: "memory");     \
        ABAR(); } while (0)
        if (wid >= 4) __builtin_amdgcn_s_setprio(1);
        f32x16 sa0, sa1, sb0, sb1; float alA = 1.f, alB = 1.f; bool grA = false, grB = false;
        QK_TILE(sa0, sa1, 0); FIX_TILE(sa0, sa1, 0); MAX_TILE(sa0, sa1, alA, grA);
        for (int t = 0; t < NT; t += 2) {
            ITER(sa0, sa1, alA, grA, sb0, sb1, alB, grB, t);
            ITER(sb0, sb1, alB, grB, sa0, sa1, alA, grA, t + 1);
        }
        __builtin_amdgcn_s_setprio(0);
#undef QK_TILE
#undef FIX_TILE
#undef MAX_TILE
#undef PK4
#undef EXP_TILE
#undef RESC
#undef TRRD
#undef PV_RD
#undef PV_MM
#undef LGK
#undef ITER
        if (hi == 0) wsf[32 + r32] = l;
        float rl[16];
#pragma unroll
        for (int r = 0; r < 16; ++r) rl[r] = __builtin_amdgcn_rcpf(wsf[32 + crow(r, hi)]);
        if (c == 0) {
#pragma unroll
            for (int d0 = 0; d0 < 4; ++d0)
#pragma unroll
                for (int j = 0; j < 2; ++j) { v4u w;
                    w.x = cvtpk(o[d0][8 * j + 0] * rl[8 * j + 0], o[d0][8 * j + 1] * rl[8 * j + 1]); w.y = cvtpk(o[d0][8 * j + 2] * rl[8 * j + 2], o[d0][8 * j + 3] * rl[8 * j + 3]);
                    w.z = cvtpk(o[d0][8 * j + 4] * rl[8 * j + 4], o[d0][8 * j + 5] * rl[8 * j + 5]); w.w = cvtpk(o[d0][8 * j + 6] * rl[8 * j + 6], o[d0][8 * j + 7] * rl[8 * j + 7]);
                    o0st[d0 * 2 + j] = w; }
        } else {
            float ss[16];
#pragma unroll
            for (int r = 0; r < 16; ++r) ss[r] = 0.f;
#pragma unroll
            for (int d0 = 0; d0 < 4; ++d0)
#pragma unroll
                for (int j = 0; j < 2; ++j) { const v4u w = o0st[d0 * 2 + j]; const unsigned ww[4] = {w.x, w.y, w.z, w.w};
#pragma unroll
                    for (int k = 0; k < 4; ++k) { const int i = 4 * j + k;
                        const float a0 = bflo(ww[k]) - lam * (o[d0][2 * i] * rl[2 * i]), a1 = bfhi(ww[k]) - lam * (o[d0][2 * i + 1] * rl[2 * i + 1]);
                        o[d0][2 * i] = a0; o[d0][2 * i + 1] = a1; ss[2 * i] += a0 * a0; ss[2 * i + 1] += a1 * a1; } }
#pragma unroll
            for (int r = 0; r < 16; ++r) {
                { DPP_SUM_ROW(ss[r]); ss[r] += __shfl_xor(ss[r], 16); }
                ss[r] = rsqrtf(ss[r] * (1.f / 128.f) + EPS) * 0.8f;
            }
            bf16* Cw = F.CAT + (rowb + qlo) * 1024 + 512 + h * 128;
#pragma unroll
            for (int d0 = 0; d0 < 4; ++d0) { const float g = F.subln_g[d0 * 32 + r32];
#pragma unroll
                for (int r = 0; r < 16; ++r) { const float v = o[d0][r] * ss[r] * g; const float vn = dpp_xor1(v);
                    if ((r32 & 1) == 0) *(unsigned*)(Cw + (size_t)crow(r, hi) * 1024 + d0 * 32 + r32) = cvtpk(v, vn); } }
        }
        __syncthreads();
    }
#undef DMA_K
#undef DMA_V
#undef DMA_TILE
#undef ABAR
}

__device__ __forceinline__ void attn_phase(Frame& F) {
    const int lane = lane_id(), tid = F.wave * 64 + lane;
    const float s01 = wave_sum(F.diff_lambda[lane] * F.diff_lambda[64 + lane]), s23 = wave_sum(F.diff_lambda[128 + lane] * F.diff_lambda[192 + lane]);
    const float lam = __expf(s01) - __expf(s23) + 0.2f;
    const int G = F.G;
    for (int it = ((G % 8 == 0) ? ((int)(blockIdx.x % 8) * (G / 8) + (int)blockIdx.x / 8) : (int)blockIdx.x); it < 256; it += G) {
        const int bh = it >> 3, x = it & 7, b = bh >> 2, h = bh & 3;
        LAS float* bt = (LAS float*)(F.lds + L_BT);
        __syncthreads();
        if (tid < BTN) { const int d = tid - BTO; int bk = d; if (d >= 16) { bk = 16 + (int)(__log2f((float)d * (1.f / 16.f)) * (16.f / 3.f)); bk = bk > 31 ? 31 : bk; }
            bt[tid] = d < 0 ? -__builtin_inff() : (F.rel_bias[bk * 4 + h] - F.rel_bias[31 * 4 + h]) * (1.4426950408889634f / C2); }
        __syncthreads();
        attn_unit(F, b, h, x, lam);
        attn_unit(F, b, h, 15 - x, lam);
    }
}
}

namespace sgu {
typedef float f32x16 __attribute__((ext_vector_type(16)));
typedef short s16x4 __attribute__((ext_vector_type(4)));
constexpr int L_T = 0, L_ST = 65536;
__device__ __forceinline__ void sgu_chunk(Frame& F, int chunk) {
    int tid = F.wave * 64 + lane_id(); asm volatile("" : "+v"(tid));
    const int lane = tid & 63, g = F.wave, r32 = lane & 31, hi = lane >> 5;
    LAS unsigned char* lds = F.lds;
    LAS float* st = (LAS float*)(lds + L_ST);
    const size_t t0 = (size_t)chunk * 128;
    for (int i = 0; i < 16; i += 2) {
        v4u raw[2];
#pragma unroll
        for (int u = 0; u < 2; ++u) raw[u] = *(const v4u*)(F.Z + (t0 + g * 16 + i + u) * INC + 512 + lane * 8);
#pragma unroll
        for (int u = 0; u < 2; ++u) { const int tl = g * 16 + i + u;
            float f[8] = {bflo(raw[u].x), bfhi(raw[u].x), bflo(raw[u].y), bfhi(raw[u].y), bflo(raw[u].z), bfhi(raw[u].z), bflo(raw[u].w), bfhi(raw[u].w)};
            float s = 0.f;
#pragma unroll
            for (int e = 0; e < 8; ++e) s += f[e];
            const float mean = wave_sum_dpp(s) * (1.f / 512.f); float q = 0.f;
#pragma unroll
            for (int e = 0; e < 8; ++e) { f[e] -= mean; q += f[e] * f[e]; }
            const float rstd = rsqrtf(wave_sum_dpp(q) * (1.f / 512.f) + EPS);
            if (lane == 0) { st[2 * tl] = mean; st[2 * tl + 1] = rstd; } }
    }
    __syncthreads();
    f32x16 acc[2][2];
    const int sr = tid >> 4, sc = (tid & 15) * 8;
    const int vb0 = (int)(uintptr_t)(lds + L_T) + (g >> 1) * 16384 + att::v_rd_base(lane);
#define SGU_STAGE(sh) do { _Pragma("unroll") for (int tile = 0; tile < 4; ++tile) { const int ch = tile * 128 + sc; \
            const f32x4 g0 = *(const f32x4*)(F.sgu_ln_g + ch), g1 = *(const f32x4*)(F.sgu_ln_g + ch + 4), b0 = *(const f32x4*)(F.sgu_ln_b + ch), b1 = *(const f32x4*)(F.sgu_ln_b + ch + 4); \
            _Pragma("unroll") for (int rr = 0; rr < 2; ++rr) { const int s = (sh) * 64 + sr + 32 * rr; \
                const v4u raw = *(const v4u*)(F.Z + (t0 + s) * INC + 512 + ch); const float mean = st[2 * s], rstd = st[2 * s + 1]; v4u o; \
                o.x = pk2((bflo(raw.x) - mean) * rstd * g0.x + b0.x, (bfhi(raw.x) - mean) * rstd * g0.y + b0.y); \
                o.y = pk2((bflo(raw.y) - mean) * rstd * g0.z + b0.z, (bfhi(raw.y) - mean) * rstd * g0.w + b0.w); \
                o.z = pk2((bflo(raw.z) - mean) * rstd * g1.x + b1.x, (bfhi(raw.z) - mean) * rstd * g1.y + b1.y); \
                o.w = pk2((bflo(raw.w) - mean) * rstd * g1.z + b1.z, (bfhi(raw.w) - mean) * rstd * g1.w + b1.w); \
                *(LAS v4u*)(lds + L_T + tile * 16384 + att::v_st(sr + 32 * rr, sc)) = o; } } } while (0)
#define TRRD(dst, off) asm volatile("ds_read_b64_tr_b16 %0, %1 offset:%2" : "=&v"(dst) : "v"(vb0), "i"(off) : "memory")
#define SGU_MMA(sh, tb0) do { _Pragma("unroll") for (int ks = 0; ks < 4; ++ks) { s16x4 l0, h0, l1, h1; \
            if ((g & 1) == 0) { TRRD(l0, 0 * 512 + ks * 4096); TRRD(h0, 0 * 512 + ks * 4096 + 2048); TRRD(l1, 1 * 512 + ks * 4096); TRRD(h1, 1 * 512 + ks * 4096 + 2048); } \
            else              { TRRD(l0, 2 * 512 + ks * 4096); TRRD(h0, 2 * 512 + ks * 4096 + 2048); TRRD(l1, 3 * 512 + ks * 4096); TRRD(h1, 3 * 512 + ks * 4096 + 2048); } \
            asm volatile("s_waitcnt lgkmcnt(0)" ::: "memory"); __builtin_amdgcn_sched_barrier(0); \
            const bf16x8 B0 = (bf16x8){l0[0], l0[1], l0[2], l0[3], h0[0], h0[1], h0[2], h0[3]}, B1 = (bf16x8){l1[0], l1[1], l1[2], l1[3], h1[0], h1[1], h1[2], h1[3]}; \
            _Pragma("unroll") for (int tl = 0; tl < 2; ++tl) { const int tb = (tb0) + tl; if ((sh) * 64 + 16 * ks > tb * 32 + 31) continue; \
                const bf16x8 A = *(const bf16x8*)(F.SGW + ((size_t)(g * 128 + tb * 32 + r32)) * 128 + (sh) * 64 + 16 * ks + 8 * hi); \
                acc[tl][0] = __builtin_amdgcn_mfma_f32_32x32x16_bf16(A, B0, acc[tl][0], 0, 0, 0); \
                acc[tl][1] = __builtin_amdgcn_mfma_f32_32x32x16_bf16(A, B1, acc[tl][1], 0, 0, 0); } } } while (0)
#define SGU_EPI(tb0) do { _Pragma("unroll") for (int tl = 0; tl < 2; ++tl) _Pragma("unroll") for (int r = 0; r < 16; ++r) { \
            const int t = ((tb0) + tl) * 32 + att::crow(r, hi); const float bs = F.sgu_b[g * 128 + t]; \
            _Pragma("unroll") for (int db = 0; db < 2; ++db) { const int ch = g * 64 + db * 32 + r32; \
                const float u = bf2f(F.Z[(t0 + t) * INC + ch]); const float v = u * (acc[tl][db][r] + bs); const float vn = dpp_xor1(v); \
                if ((r32 & 1) == 0) *(unsigned*)(F.CAT + (t0 + t) * 1024 + ch) = att::cvtpk(v, vn); } } } while (0)
#define SGU_ZERO() do { acc[0][0] = f32x16{}; acc[0][1] = f32x16{}; acc[1][0] = f32x16{}; acc[1][1] = f32x16{}; } while (0)
    SGU_STAGE(0);
    __syncthreads();
    SGU_ZERO(); SGU_MMA(0, 0); SGU_EPI(0);
    SGU_ZERO(); SGU_MMA(0, 2);
    __syncthreads();
    SGU_STAGE(1);
    __syncthreads();
    SGU_MMA(1, 2); SGU_EPI(2);
#undef SGU_STAGE
#undef TRRD
#undef SGU_MMA
#undef SGU_EPI
#undef SGU_ZERO
}
__device__ __forceinline__ void sgu_phase(Frame& F) { for (int ck = blockIdx.x; ck < M / 128; ck += F.G) { sgu_chunk(F, ck); __syncthreads(); } }
}

namespace tk {
typedef float f32x16 __attribute__((ext_vector_type(16)));
__device__ __forceinline__ float vmax(float a, float b) { float r; asm("v_max_f32 %0, %1, %2" : "=v"(r) : "v"(a), "v"(b)); return r; }
__device__ __forceinline__ float vmin(float a, float b) { float r; asm("v_min_f32 %0, %1, %2" : "=v"(r) : "v"(a), "v"(b)); return r; }
#define TK_CE(a, b) do { const float _mx = vmax(a, b), _mn = vmin(a, b); a = _mx; b = _mn; } while (0)
template <int N> __device__ __forceinline__ void sort_desc(float (&a)[N]) {
#pragma unroll
    for (int k = 2; k <= N; k <<= 1)
#pragma unroll
        for (int j = k >> 1; j > 0; j >>= 1)
#pragma unroll
            for (int i = 0; i < N; ++i) { const int l = i ^ j; if (l > i) { if ((i & k) == 0) TK_CE(a[i], a[l]); else TK_CE(a[l], a[i]); } }
}
template <int N> __device__ __forceinline__ void merge_desc(float (&a)[N]) {
#pragma unroll
    for (int j = N >> 1; j > 0; j >>= 1)
#pragma unroll
        for (int i = 0; i < N; ++i) { const int l = i ^ j; if (l > i) TK_CE(a[i], a[l]); }
}
__device__ __forceinline__ void top16_merge(float (&a)[16], const float (&b)[16]) {
#pragma unroll
    for (int i = 0; i < 16; ++i) a[i] = vmax(a[i], b[15 - i]);
    merge_desc<16>(a);
}
__device__ __forceinline__ float embed(float v, unsigned mask, unsigned code) { return __uint_as_float((__float_as_uint(v) & mask) | code); }

__device__ __forceinline__ void topk_phase(Frame& F) {
    int lane = lane_id(); asm volatile("" : "+v"(lane));
    const int r32 = lane & 31, hi = lane >> 5;
    const int gw = blockIdx.x * NWAVES + F.wave, NGW = F.G * NWAVES;
    LAS unsigned* tab = (LAS unsigned*)(F.lds + F.wave * 8192) + lane;
    const float NEG = -__builtin_inff();
    constexpr int NTASK = (M / 32) * 8; const int per = (NTASK + NGW - 1) / NGW;
    unsigned code16[16];
#pragma unroll
    for (int r = 0; r < 16; ++r) code16[r] = (unsigned)((r & 3) + 8 * (r >> 2) + 4 * hi);
    const unsigned qoff = (unsigned)(r32 * NQ + hi * 8), koff = (unsigned)((hi * 128 + r32) * 8);
#define TK_QP(task_, c_) (F.QP + (size_t)((task_) >> 3) * 32 * NQ + ((task_) & 7) * 256 + (c_) * 128)
#define TK_KP(task_, c_) (F.KEYS + (size_t)((((task_) & 7) * 2 + (c_)) * 16) * 128 * 8)
#define TK_LDQ(dst, task_, c_) do { const bf16* qp_ = TK_QP(task_, c_); _Pragma("unroll") for (int ks = 0; ks < 8; ++ks) dst[ks] = *(const bf16x8*)(qp_ + ks * 16 + qoff); } while (0)
#define TK_LDK(dst, task_, c_, nb_) do { const bf16* kp_ = TK_KP(task_, c_); _Pragma("unroll") for (int ks = 0; ks < 8; ++ks) dst[ks] = *(const bf16x8*)(kp_ + ((2 * ks) * 128 + (nb_) * 32) * 8 + koff); } while (0)
    const int task_beg = gw * per, task_end = (gw * per + per < NTASK) ? gw * per + per : NTASK;
    bf16x8 qcur[8], kcur[8];
    if (task_beg < task_end) { TK_LDQ(qcur, task_beg, 0); TK_LDK(kcur, task_beg, 0, 0); }
    for (int task = task_beg; task < task_end; ++task) {
        const int tb = task >> 3, h = task & 7;
        const size_t trow = (size_t)tb * 32 + r32;
        float sk[2][16];
        float best[16];
#pragma unroll
        for (int st = 0; st < 8; ++st) {
            const int c = st >> 2, nb = st & 3;
            bf16x8 knxt[8], qnxt[8];
            if (st < 7) TK_LDK(knxt, task, (st + 1) >> 2, (st + 1) & 3);
            if (st == 3) TK_LDQ(qnxt, task, 1);
            f32x16 acc = f32x16{};
#pragma unroll
            for (int ks = 0; ks < 8; ++ks) acc = __builtin_amdgcn_mfma_f32_32x32x16_bf16(kcur[ks], qcur[ks], acc, 0, 0, 0);
            float cur[16];
#pragma unroll
            for (int r = 0; r < 16; ++r) { cur[r] = embed(acc[r], 0xFFFFFF80u, code16[r]); if (nb) cur[r] = __uint_as_float(__float_as_uint(cur[r]) | (unsigned)(nb * 32)); }
            sort_desc<16>(cur);
            if (nb == 0) {
#pragma unroll
                for (int i = 0; i < 16; ++i) best[i] = cur[i];
            } else top16_merge(best, cur);
            if (st < 7) {
#pragma unroll
                for (int ks = 0; ks < 8; ++ks) kcur[ks] = knxt[ks];
            }
            if (st == 3) {
#pragma unroll
                for (int ks = 0; ks < 8; ++ks) qcur[ks] = qnxt[ks];
            }
            if (nb == 3) {
                float pr[16];
#pragma unroll
                for (int i = 0; i < 16; ++i) { auto rr = __builtin_amdgcn_permlane32_swap(__float_as_uint(best[i]), __float_as_uint(best[i]), false, false);
                    pr[i] = __uint_as_float(hi ? rr[0] : rr[1]); }
                top16_merge(best, pr);
#pragma unroll
                for (int i = 0; i < 16; ++i) sk[c][i] = best[i];
            }
            __builtin_amdgcn_sched_barrier(0);
        }
        { const int tn = (task + 1 < task_end) ? task + 1 : task; TK_LDQ(qcur, tn, 0); TK_LDK(kcur, tn, 0, 0); }
#pragma unroll
        for (int i = 0; i < 16; ++i) { tab[i * 64] = __float_as_uint(sk[0][i]); tab[(16 + i) * 64] = __float_as_uint(sk[1][i]); }
        float T[16], G1[16], G2[16];
#pragma unroll
        for (int j = 0; j < 16; ++j) T[j] = embed(sk[0][0] + sk[1][j], 0xFFFFFF00u, (unsigned)j);
#pragma unroll
        for (int j = 0; j < 8; ++j) { G1[j] = embed(sk[0][1] + sk[1][j], 0xFFFFFF00u, (unsigned)(16 + j)); G1[8 + j] = embed(sk[0][15 - j] + sk[1][0], 0xFFFFFF00u, (unsigned)((15 - j) << 4)); }
        merge_desc<16>(G1);
        top16_merge(T, G1);
#pragma unroll
        for (int j = 0; j < 5; ++j) G2[j] = embed(sk[0][2] + sk[1][j], 0xFFFFFF00u, (unsigned)(32 + j));
#pragma unroll
        for (int j = 0; j < 4; ++j) G2[5 + j] = embed(sk[0][3] + sk[1][j], 0xFFFFFF00u, (unsigned)(48 + j));
#pragma unroll
        for (int j = 0; j < 3; ++j) G2[9 + j] = embed(sk[0][4] + sk[1][j], 0xFFFFFF00u, (unsigned)(64 + j));
#pragma unroll
        for (int j = 0; j < 2; ++j) { G2[12 + j] = embed(sk[0][5] + sk[1][j], 0xFFFFFF00u, (unsigned)(80 + j)); G2[14 + j] = embed(sk[0][6] + sk[1][j], 0xFFFFFF00u, (unsigned)(96 + j)); }
        sort_desc<16>(G2);
        top16_merge(T, G2);
        T[15] = vmax(T[15], embed(sk[0][7] + sk[1][0], 0xFFFFFF00u, 112u)); T[14] = vmax(T[14], embed(sk[0][7] + sk[1][1], 0xFFFFFF00u, 113u));
        merge_desc<16>(T);
        const float mx = __uint_as_float(__float_as_uint(T[0]) & 0xFFFFFF00u);
        float e[16]; float den = 0.f;
#pragma unroll
        for (int k = 0; k < 16; ++k) { e[k] = __builtin_amdgcn_exp2f((__uint_as_float(__float_as_uint(T[k]) & 0xFFFFFF00u) - mx) * 1.4426950408889634f); den += e[k]; }
        const float rden = 1.f / den;
        int eo[8]; float go[8];
#pragma unroll
        for (int k = 0; k < 8; ++k) {
            const unsigned code = __float_as_uint(hi ? T[k + 8] : T[k]) & 255u;
            const unsigned a1 = tab[(code >> 4) * 64] & 127u, a2 = tab[(16 + (code & 15u)) * 64] & 127u;
            eo[k] = (int)(a1 * 128u + a2); go[k] = (hi ? e[k + 8] : e[k]) * rden;
        }
        int* ip = F.IDX + trow * PKN + h * 16 + hi * 8; float* gp = F.GATE + trow * PKN + h * 16 + hi * 8;
        *(v4u*)ip = (v4u){(unsigned)eo[0], (unsigned)eo[1], (unsigned)eo[2], (unsigned)eo[3]}; *(v4u*)(ip + 4) = (v4u){(unsigned)eo[4], (unsigned)eo[5], (unsigned)eo[6], (unsigned)eo[7]};
        *(f32x4*)gp = (f32x4){go[0], go[1], go[2], go[3]}; *(f32x4*)(gp + 4) = (f32x4){go[4], go[5], go[6], go[7]};
    }
    (void)NEG;
}
#undef TK_CE
#undef TK_QP
#undef TK_KP
#undef TK_LDQ
#undef TK_LDK
}

namespace pe {
typedef float f32x2 __attribute__((ext_vector_type(2)));
__device__ __forceinline__ f32x2 cvlo(unsigned w) { return __builtin_amdgcn_cvt_pk_f32_fp8((int)w, false); }
__device__ __forceinline__ f32x2 cvhi(unsigned w) { return __builtin_amdgcn_cvt_pk_f32_fp8((int)w, true); }
__device__ __forceinline__ float dot16(const v4u r, const f32x2 (&hf)[8]) {
    f32x2 a = cvlo(r.x) * hf[0]; f32x2 b = cvhi(r.x) * hf[1];
    a = cvlo(r.y) * hf[2] + a; b = cvhi(r.y) * hf[3] + b; a = cvlo(r.z) * hf[4] + a; b = cvhi(r.z) * hf[5] + b; a = cvlo(r.w) * hf[6] + a; b = cvhi(r.w) * hf[7] + b;
    a = a + b; return a.x + a.y;
}
#define PE_W(WREG, i) __uint_as_float(__builtin_amdgcn_readlane(__float_as_uint(WREG), (i)))
#ifndef FP6_INTERLEAVED
#define FP6_INTERLEAVED 1
#endif
typedef unsigned v6u __attribute__((ext_vector_type(6)));
typedef float v32f __attribute__((ext_vector_type(32)));
typedef float v16f __attribute__((ext_vector_type(16)));
struct Row6 { v4u q4; v2u q2; };
#ifndef PV6_G
#define PV6_G 2
#endif
#define PV6_LOAD(dst, EREG, i) do { const int ea_ = __builtin_amdgcn_readlane(EREG, 2 * (i)), eb_ = __builtin_amdgcn_readlane(EREG, 2 * (i) + 1); \
        const unsigned char* rp_ = F.VT6 + (size_t)(half ? eb_ : ea_) * 768; dst.q4 = *(const v4u*)(rp_ + l16); dst.q2 = *(const v2u*)(rp_ + 512 + l8); } while (0)
#define PV6_ACC(src, WREG, i) do { const float wa_ = PE_W(WREG, 2 * (i)), wb_ = PE_W(WREG, 2 * (i) + 1); const float w_ = half ? wb_ : wa_; const f32x2 ww_ = {w_, w_}; \
        const v6u pk_ = {src.q4.x, src.q4.y, src.q4.z, src.q4.w, src.q2.x, src.q2.y}; const v32f d_ = __builtin_amdgcn_cvt_scalef32_pk32_f32_fp6(pk_, 1.0f); \
        _Pragma("unroll") for (int k = 0; k < 16; ++k) acc[k] = (f32x2){d_[2 * k], d_[2 * k + 1]} * ww_ + acc[k]; __builtin_amdgcn_sched_barrier(0); } while (0)
#define PV6_BATCH(EREG, WREG) do { Row6 bufA[PV6_G], bufB[PV6_G];             \
        _Pragma("unroll") for (int i = 0; i < PV6_G; ++i) PV6_LOAD(bufA[i], EREG, i); \
        _Pragma("unroll") for (int gq = 0; gq < 32 / PV6_G; gq += 2) { \
            _Pragma("unroll") for (int i = 0; i < PV6_G; ++i) PV6_LOAD(bufB[i], EREG, (gq + 1) * PV6_G + i); \
            _Pragma("unroll") for (int i = 0; i < PV6_G; ++i) PV6_ACC(bufA[i], WREG, gq * PV6_G + i); \
            if (gq + 2 < 32 / PV6_G) { _Pragma("unroll") for (int i = 0; i < PV6_G; ++i) PV6_LOAD(bufA[i], EREG, (gq + 2) * PV6_G + i); } \
            _Pragma("unroll") for (int i = 0; i < PV6_G; ++i) PV6_ACC(bufB[i], WREG, (gq + 1) * PV6_G + i); } } while (0)

#define PU_IDX(dst, tt) do { const v4u* ip_ = (const v4u*)(F.IDX + (size_t)(tt) * PKN + (lane >> 3) * 16); _Pragma("unroll") for (int q_ = 0; q_ < 4; ++q_) { const v4u w_ = ip_[q_]; dst[4 * q_] = (int)w_.x; dst[4 * q_ + 1] = (int)w_.y; dst[4 * q_ + 2] = (int)w_.z; dst[4 * q_ + 3] = (int)w_.w; } } while (0)
#define PU_GATHER(dst, idx) do { _Pragma("unroll") for (int i = 0; i < 16; ++i) dst[i] = *(const v4u*)(ub + (unsigned)idx[i] * 128u + coff); } while (0)
#define PU_HS(dst, tt) do { dst[0] = *(const v4u*)(F.H8 + (size_t)(tt) * D + x * 128 + (lane & 7) * 16); } while (0)
#define PU_COMPUTE(seg, hraw, tt) do { int p[16]; \
        _Pragma("unroll") for (int i = 0; i < 16; ++i) { int a_ = __builtin_amdgcn_sdot4((int)seg[i].x, (int)hraw[0].x, 0, false); a_ = __builtin_amdgcn_sdot4((int)seg[i].y, (int)hraw[0].y, a_, false); \
            a_ = __builtin_amdgcn_sdot4((int)seg[i].z, (int)hraw[0].z, a_, false); p[i] = __builtin_amdgcn_sdot4((int)seg[i].w, (int)hraw[0].w, a_, false); }     \
          \
        _Pragma("unroll") for (int i = 0; i < 8; ++i) { const bool bt = (lane & 4) != 0; const int sd = bt ? p[i] : p[i + 8], kp = bt ? p[i + 8] : p[i]; p[i] = kp + __builtin_amdgcn_update_dpp(0, sd, 0x141, 0xF, 0xF, false); } \
        _Pragma("unroll") for (int i = 0; i < 4; ++i) { const bool bt = (lane & 2) != 0; const int sd = bt ? p[i] : p[i + 4], kp = bt ? p[i + 4] : p[i]; p[i] = kp + __builtin_amdgcn_update_dpp(0, sd, 0x4E, 0xF, 0xF, false); } \
        _Pragma("unroll") for (int i = 0; i < 2; ++i) { const bool bt = (lane & 1) != 0; const int sd = bt ? p[i] : p[i + 2], kp = bt ? p[i + 2] : p[i]; p[i] = kp + __builtin_amdgcn_update_dpp(0, sd, 0xB1, 0xF, 0xF, false); } \
        ((unsigned*)F.PART)[((size_t)x * M + (tt)) * 64 + lane] = att::cvtpk((float)p[0], (float)p[1]); } while (0)
__device__ __forceinline__ void peer_u_phase(Frame& F, const int c0, const int cn, const int w0, const int nw) {
    int lane = lane_id(); asm volatile("" : "+v"(lane));
    const int wave = F.wave;
    if (wave < w0 || wave >= w0 + nw) return;
    const unsigned coff = (unsigned)(lane & 7) * 16u;
    const int per_blk = cn / 32, per_wave = per_blk / nw;
    for (int unit = blockIdx.x; unit < 256; unit += F.G) {
        const int x = unit & 7, rk = unit >> 3;
        const unsigned char* ub = F.UT8 + (size_t)x * NEXP * 128;
        const int tbeg = c0 + rk * per_blk + (wave - w0) * per_wave, tend = tbeg + per_wave;
        int idxA[16], idxB[16]; v4u segA[16], segB[16]; v4u hA[1], hB[1];
        PU_IDX(idxA, tbeg); PU_GATHER(segA, idxA); PU_HS(hA, tbeg); PU_IDX(idxB, tbeg + 1);
        for (int t = tbeg; t < tend; t += 2) {
            PU_GATHER(segB, idxB); PU_HS(hB, t + 1);
            { const int tn = (t + 2 < tend) ? t + 2 : t; PU_IDX(idxA, tn); }
            PU_COMPUTE(segA, hA, t);
            { const int tn = (t + 2 < tend) ? t + 2 : t; PU_GATHER(segA, idxA); PU_HS(hA, tn); }
            { const int tn = (t + 3 < tend) ? t + 3 : t + 1; PU_IDX(idxB, tn); }
            PU_COMPUTE(segB, hB, t + 1);
        }
    }
}
#undef PU_IDX
#undef PU_GATHER
#undef PU_HS
#undef PU_COMPUTE

template <bool DRY> __device__ __forceinline__ void peer_phase(Frame& F, const int c0, const int cn, const int w0, const int nw) {
    int lane = lane_id(); asm volatile("" : "+v"(lane));
    if (F.wave < w0 || F.wave >= w0 + nw) return;
    const int gw = blockIdx.x * nw + (F.wave - w0), NGW = F.G * nw;
    const int half = lane >> 5; const unsigned l16 = (unsigned)(lane & 31) * 16u, l8 = (unsigned)(lane & 31) * 8u;
    for (int t = c0 + gw; t < c0 + cn; t += NGW) {
        const int b = t >> 12;
        const int e0 = F.IDX[(size_t)t * PKN + lane], e1 = F.IDX[(size_t)t * PKN + 64 + lane];
        const float g0 = F.GATE[(size_t)t * PKN + lane], g1 = F.GATE[(size_t)t * PKN + 64 + lane];
        const float su0 = F.SU[e0], su1 = F.SU[e1], sv0 = F.SV[e0], sv1 = F.SV[e1];
        float tot0 = 0.f, tot1 = 0.f;
#pragma unroll
        for (int x = 0; x < 8; ++x) { const bf16* pp = (const bf16*)F.PART + ((size_t)x * M + t) * PKN; tot0 += bf2f(pp[lane]); tot1 += bf2f(pp[64 + lane]); }
        const float hs = F.HS[t];
        const float w0 = gelu_t(tot0 * (su0 * hs)) * g0 * sv0, w1 = gelu_t(tot1 * (su1 * hs)) * g1 * sv1;
        f32x2 acc[16];
#pragma unroll
        for (int i = 0; i < 16; ++i) acc[i] = (f32x2){0.f, 0.f};
        PV6_BATCH(e0, w0);
        PV6_BATCH(e1, w1);
#pragma unroll
        for (int i = 0; i < 16; ++i) {
            auto rx = __builtin_amdgcn_permlane32_swap(__float_as_uint(acc[i].x), __float_as_uint(acc[i].x), false, false);
            auto ry = __builtin_amdgcn_permlane32_swap(__float_as_uint(acc[i].y), __float_as_uint(acc[i].y), false, false);
            acc[i] = (f32x2){__uint_as_float(rx[0]) + __uint_as_float(rx[1]), __uint_as_float(ry[0]) + __uint_as_float(ry[1])};
        }
        float y[16];
#pragma unroll
        for (int j = 0; j < 16; ++j) {
#if FP6_INTERLEAVED
            const float lo = (j & 1) ? acc[j].x : acc[j].x;
            const float hi_ = acc[j].y;
            y[j] = half ? hi_ : lo;
#else
            const float lo = (j & 1) ? acc[j >> 1].y : acc[j >> 1].x;
            const float hi_ = (j & 1) ? acc[8 + (j >> 1)].y : acc[8 + (j >> 1)].x;
            y[j] = half ? hi_ : lo;
#endif
        }
        float ss = 0.f;
#pragma unroll
        for (int j = 0; j < 16; ++j) ss += y[j] * y[j];
        const float rstd = rsqrtf(wave_sum_dpp(ss) * (1.f / D) + EPS);
        const float* md = F.mod + b * 6144 + 5120;
        const float* g3 = F.norm_g + 3072;
        int lane_e = lane; asm volatile("" : "+v"(lane_e));
        const int col0 = (lane_e & 31) * 32 + (lane_e >> 5) * 16;
        float* orow = F.out + (size_t)t * D + col0;
#pragma unroll
        for (int q4 = 0; q4 < 4; ++q4) { const int c = col0 + q4 * 4;
            const f32x4 x1 = *(const f32x4*)(orow + q4 * 4), gt = *(const f32x4*)(md + c), gg = *(const f32x4*)(g3 + c);
            const f32x4 yv = (f32x4){y[q4 * 4], y[q4 * 4 + 1], y[q4 * 4 + 2], y[q4 * 4 + 3]};
            if (!DRY) *(f32x4*)(orow + q4 * 4) = x1 + gt * (yv * rstd * gg); else if (rstd == 123.456f) *(f32x4*)(orow + q4 * 4) = yv; }
    }
}
#undef PE_W
#undef PV6_LOAD
#undef PV6_ACC
#undef PV6_BATCH

__device__ __forceinline__ void u_rows4(Frame& F, int r0, int stride, int nvalid, int lane) {
    f32x4 v[4][4];
#pragma unroll
    for (int q = 0; q < 4; ++q) { const int row = r0 + (q < nvalid ? q : 0) * stride; const f32x4* s = (const f32x4*)(F.peer_u + (size_t)row * D) + lane * 4;
#pragma unroll
        for (int i = 0; i < 4; ++i) v[q][i] = s[i]; }
#pragma unroll
    for (int q = 0; q < 4; ++q) { if (q >= nvalid) break; const int row = r0 + q * stride;
        float am = 0.f;
#pragma unroll
        for (int i = 0; i < 4; ++i) am = fmaxf(am, fmaxf(fmaxf(fabsf(v[q][i].x), fabsf(v[q][i].y)), fmaxf(fabsf(v[q][i].z), fabsf(v[q][i].w))));
        am = wave_max_dpp(am);
        const float sc = am > 0.f ? 127.f / am : 1.f;
        int w[4];
#pragma unroll
        for (int i = 0; i < 4; ++i) { const int q0 = (int)rintf(v[q][i].x * sc), q1 = (int)rintf(v[q][i].y * sc), q2 = (int)rintf(v[q][i].z * sc), q3 = (int)rintf(v[q][i].w * sc);
            w[i] = (q0 & 255) | ((q1 & 255) << 8) | ((q2 & 255) << 16) | (q3 << 24); }
        *(v4u*)(F.UT8 + (size_t)(lane >> 3) * NEXP * 128 + (size_t)row * 128 + (lane & 7) * 16) = (v4u){(unsigned)w[0], (unsigned)w[1], (unsigned)w[2], (unsigned)w[3]};
        if (lane == 0) F.SU[row] = 1.f / sc; }
}
__device__ __forceinline__ void v_pairs2(Frame& F, int p0, int stride, int nvalid, int lane) {
    const int L = lane & 31, hf = lane >> 5;
    f32x4 f[2][8];
#pragma unroll
    for (int q = 0; q < 2; ++q) { const int row = 2 * (p0 + (q < nvalid ? q : 0) * stride) + hf; const f32x4* sp = (const f32x4*)(F.peer_v + (size_t)row * D + L * 32);
#pragma unroll
        for (int i = 0; i < 8; ++i) f[q][i] = sp[i]; }
#pragma unroll
    for (int q = 0; q < 2; ++q) { if (q >= nvalid) break; const int row = 2 * (p0 + q * stride) + hf;
        float am = 0.f;
#pragma unroll
        for (int i = 0; i < 8; ++i) am = fmaxf(am, fmaxf(fmaxf(fabsf(f[q][i].x), fabsf(f[q][i].y)), fmaxf(fabsf(f[q][i].z), fabsf(f[q][i].w))));
        am = half_max_dpp(am);
        const float sc = am > 0.f ? exp2f(floorf(log2f(7.0f / am))) : 1.f;
        v16f a, b;
#pragma unroll
        for (int i = 0; i < 4; ++i) { a[4 * i] = f[q][i].x * sc; a[4 * i + 1] = f[q][i].y * sc; a[4 * i + 2] = f[q][i].z * sc; a[4 * i + 3] = f[q][i].w * sc;
            b[4 * i] = f[q][4 + i].x * sc; b[4 * i + 1] = f[q][4 + i].y * sc; b[4 * i + 2] = f[q][4 + i].z * sc; b[4 * i + 3] = f[q][4 + i].w * sc; }
        const v6u w = __builtin_amdgcn_cvt_scalef32_2xpk16_fp6_f32(a, b, 1.0f);
        unsigned char* rp = F.VT6 + (size_t)row * 768;
        *(v4u*)(rp + L * 16) = (v4u){w[0], w[1], w[2], w[3]};
        *(v2u*)(rp + 512 + L * 8) = (v2u){w[4], w[5]};
        if (L == 0) F.SV[row] = 1.f / sc; }
}
__device__ __forceinline__ void prologue_tables(Frame& F, int gw, int NGW, int lane) {
    for (int r = gw; r < NEXP; r += 4 * NGW) { const int left = (NEXP - r + NGW - 1) / NGW; u_rows4(F, r, NGW, left < 4 ? left : 4, lane); }
    for (int p = gw; p < NEXP / 2; p += 2 * NGW) { const int left = (NEXP / 2 - p + NGW - 1) / NGW; v_pairs2(F, p, NGW, left < 2 ? left : 2, lane); }
}
}

__device__ __forceinline__ void prologue_tables_fwd(Frame& F, int gw, int NGW, int lane) { pe::prologue_tables(F, gw, NGW, lane); }
struct Args { const float* in[18]; float* out; unsigned char* ws; int ph_lo, ph_hi, li, pad; };
__global__ void __launch_bounds__(NTHR, 2) fwd(Args args) {
    extern __shared__ __attribute__((aligned(16))) unsigned char lds[];
    Frame F;
    F.lds = (LAS unsigned char*)lds;
    F.MISC = (volatile LAS unsigned*)(F.lds + MISC_OFF);
    F.wave = __builtin_amdgcn_readfirstlane((int)threadIdx.x >> 6); F.G = gridDim.x;
    unsigned char* ws = args.ws;
    F.ctl = (gu32*)(ws + WS_CTL);
    F.x = args.in[0]; F.c = args.in[1]; F.w_ada = args.in[2]; F.b_ada = args.in[3]; F.norm_g = args.in[4]; F.w_in = args.in[5]; F.sgu_ln_g = args.in[6]; F.sgu_ln_b = args.in[7];
    F.sgu_w = args.in[8]; F.sgu_b = args.in[9]; F.diff_lambda = args.in[10]; F.subln_g = args.in[11]; F.rel_bias = args.in[12]; F.w_out = args.in[13]; F.w_query = args.in[14];
    F.sub_keys = args.in[15]; F.peer_u = args.in[16]; F.peer_v = args.in[17]; F.out = args.out;
    F.mod = (float*)(ws + WS_MOD); F.WIN = (bf16*)(ws + WS_WIN); F.WOUT = (bf16*)(ws + WS_WOUT); F.WQ = (bf16*)(ws + WS_WQ); F.KEYS = (bf16*)(ws + WS_KEYS); F.SGW = (bf16*)(ws + WS_SGW);
    F.UT8 = ws + WS_UT; F.H8 = ws + WS_H8; F.HS = (float*)(ws + WS_SU) + 2 * NEXP; F.HAS = (float*)(ws + WS_SU) + 2 * NEXP + M; F.WS8 = (float*)(ws + WS_SU) + 2 * NEXP + 2 * M; F.HA8 = ws + WS_H; F.W8 = ws + WS_WIN; F.VT6 = ws + WS_VT; F.PART = (float*)(ws + WS_QP); F.STASH = (unsigned*)(ws + WS_H); F.SU = (float*)(ws + WS_SU); F.SV = (float*)(ws + WS_SU) + NEXP; F.H = (bf16*)(ws + WS_H); F.Y = (bf16*)(ws + WS_Y); F.Z = (bf16*)(ws + WS_Z); F.QP = (bf16*)(ws + WS_QP); F.CAT = (bf16*)(ws + WS_CAT);
    F.IDX = (int*)(ws + WS_IDX); F.GATE = (float*)(ws + WS_GATE);
    for (int u = threadIdx.x; u < (LDS_BYTES - LDSCTL_OFF) / 4; u += NTHR) ((LAS unsigned*)(F.lds + LDSCTL_OFF))[u] = 0u;
    __syncthreads();
    XcdBarrier bar = xcd_barrier_post((unsigned*)(F.ctl + CW_BAR) + args.li * XCD_BAR_WORDS, F.MISC + 8);
    const int lo = args.ph_lo, hi = args.ph_hi;
#ifndef ONLY_PHASE
#define ONLY_PHASE -1
#endif
#define IN(k) (lo <= (k) && (k) < hi && (ONLY_PHASE < 0 || ONLY_PHASE == (k)))
#define SEAM(k) do { if ((k) + 1 < hi) xcd_barrier(bar); } while (0)
    if (IN(0)) { for (int rep = 0; rep < (PROBE_PHASE == 0 ? 2 : 1); ++rep) ph_prologue(F); SEAM(0); }
    if (IN(1)) { for (int rep = 0; rep < (PROBE_PHASE == 1 ? 2 : 1); ++rep) ph_hrows(F); SEAM(1); }
    if (IN(2)) {
        pg8::Gemm g{(const pg8::bf16_t*)F.HA8, (const pg8::bf16_t*)F.W8, M, INC, D / 2}; pg8::StaticOrder S; S.init(M, INC, F.G, (int)blockIdx.x);
        pg8::EpiI8<1> E{F.Z, INC, F.HAS, F.WS8, 1024};
        for (int rep = 0; rep < (PROBE_PHASE == 2 ? 2 : 1); ++rep) pg8::gemm_phase<pg8::EpiI8<1>, pg8::StaticOrder, true, true>(F.lds, g, S, E, F.wave);
        SEAM(2);
    }
    if (IN(3)) { for (int rep = 0; rep < (PROBE_PHASE == 30 ? 2 : 1); ++rep) sgu::sgu_phase(F); for (int rep = 0; rep < (PROBE_PHASE == 3 ? 2 : 1); ++rep) att::attn_phase(F); SEAM(3); }
    if (IN(4)) {
        pg8::Gemm g{F.CAT, F.WOUT, M, D, D}; pg8::StaticOrder S; S.init(M, D, F.G, (int)blockIdx.x);
        pg8::EpiBf16<0> E{F.Y, D, nullptr, 0, 0, 1.f, 0};
        for (int rep = 0; rep < (PROBE_PHASE == 4 ? 2 : 1); ++rep) pg8::gemm_phase<pg8::EpiBf16<0>, pg8::StaticOrder, true, true>(F.lds, g, S, E, F.wave);
        SEAM(4);
    }
    if (IN(5)) { for (int rep = 0; rep < (PROBE_PHASE == 5 ? 2 : 1); ++rep) ph_x1rows(F); SEAM(5); }
    if (IN(6)) {
        pg8::Gemm g{F.H, F.WQ, M, NQ, D}; pg8::StaticOrder S; S.init(M, NQ, F.G, (int)blockIdx.x);
        pg8::EpiBf16<0> E{F.QP, NQ, nullptr, 0, 0, 1.f, 0};
        for (int rep = 0; rep < (PROBE_PHASE == 6 ? 2 : 1); ++rep) pg8::gemm_phase<pg8::EpiBf16<0>, pg8::StaticOrder, true, true>(F.lds, g, S, E, F.wave);
        SEAM(6);
    }
    if (IN(7)) { if (TABLES_IN_PHASE == 7) prologue_tables_fwd(F, blockIdx.x * NWAVES + F.wave, F.G * NWAVES, lane_id()); for (int rep = 0; rep < (PROBE_PHASE == 7 ? 2 : 1); ++rep) tk::topk_phase(F); SEAM(7); }
    if (IN(8)) { for (int rep = 0; rep < (PROBE_PHASE == 8 ? 2 : 1); ++rep) pe::peer_u_phase(F, 0, M, 0, 8); SEAM(8); }
    if (IN(9)) { if (PROBE_PHASE == 9) pe::peer_phase<true>(F, 0, M, 0, 8); pe::peer_phase<false>(F, 0, M, 0, 8); }
#undef IN
#undef SEAM
}

extern "C" void kernel_launch(void* const* d_in, const int* in_sizes, int n_in, void* d_out, int out_size, void* d_ws, size_t ws_size, hipStream_t stream) {
    static int grid = 0;
    if (grid == 0) {
        if (n_in != 18 || in_sizes[0] != M * D || out_size != M * D || ws_size < WS_END) { fprintf(stderr, "kernel_launch: unexpected shapes (n_in %d, in0 %d, out %d, ws %zu)\n", n_in, n_in > 0 ? in_sizes[0] : -1, out_size, ws_size); grid = -1; return; }
        int dev = 0, cus = 0, per_cu = 0;
        if (hipGetDevice(&dev) != hipSuccess || hipDeviceGetAttribute(&cus, hipDeviceAttributeMultiprocessorCount, dev) != hipSuccess) { grid = -1; return; }
        if (hipFuncSetAttribute((const void*)fwd, hipFuncAttributeMaxDynamicSharedMemorySize, LDS_BYTES) != hipSuccess) { fprintf(stderr, "kernel_launch: hipFuncSetAttribute failed\n"); grid = -1; return; }
        if (hipOccupancyMaxActiveBlocksPerMultiprocessor(&per_cu, (const void*)fwd, NTHR, LDS_BYTES) != hipSuccess || per_cu < 1) fprintf(stderr, "kernel_launch: occupancy query reports %d\n", per_cu);
        (void)hipGetLastError();
        grid = cus;
    }
    if (grid < 0) return;
    if (hipMemsetAsync((char*)d_ws + WS_CTL, 0, CTL_ZERO_BYTES, stream) != hipSuccess) return;
    Args a{};
    for (int i = 0; i < 18; ++i) a.in[i] = (const float*)d_in[i];
    a.out = (float*)d_out; a.ws = (unsigned char*)d_ws;
#if MK_PER_PHASE
    for (int p = 0; p < NPHASE; ++p) { a.ph_lo = p; a.ph_hi = p + 1; a.li = p; hipLaunchKernelGGL(fwd, dim3(grid), dim3(NTHR), LDS_BYTES, stream, a); }
#else
    a.ph_lo = 0; a.ph_hi = NPHASE; a.li = 0; hipLaunchKernelGGL(fwd, dim3(grid), dim3(NTHR), LDS_BYTES, stream, a);
#endif
}
```

```cpp
#define MK_PER_PHASE 0
#include <hip/hip_runtime.h>
#include <cstdio>
#include <cstdint>
namespace pg8 {
#define PG8_LAS __attribute__((address_space(3)))
typedef unsigned short bf16_t;
typedef short bf16x8 __attribute__((ext_vector_type(8)));
typedef float f32x4 __attribute__((ext_vector_type(4)));
typedef unsigned u32x4 __attribute__((ext_vector_type(4)));
typedef int i32x4 __attribute__((ext_vector_type(4)));
constexpr int BM = 256, BK = 64, HALF = 128, HTB = HALF * BK * 2  , STAGE_BYTES = 8 * HTB, NXCD = 8, WGM = 8;

__host__ __device__ __forceinline__ int lds_byte(int r, int c) { const int st = (r >> 4) * 2 + (c >> 5), rr = r & 15, cc = c & 31, ob = rr * 64 + cc * 2; return st * 1024 + (ob ^ (((ob >> 9) & 1) << 5)); }
__host__ __device__ __forceinline__ void stage_rc(int b, int& R, int& C) { const int st = b / 1024, sb = b % 1024, swz = sb ^ (((sb >> 9) & 1) << 5); R = (st >> 1) * 16 + swz / 64; C = (st & 1) * 32 + (swz % 64) / 2; }
__host__ __device__ __forceinline__ int perm32(int rho) { const int n = rho >> 4, i = rho & 15; return 8 * (i >> 2) + 4 * n + (i & 3); }

struct Unit { int pm, pn; };
struct Gemm { const bf16_t* A; const bf16_t* Bt; int M, N, K; };

struct StaticOrder {
    int nM, nN, nwg, G, c;
    __host__ __device__ void init(int M, int N, int G_, int c_) { nM = M / BM; nN = N / BM; nwg = nM * nN; G = G_; c = c_; }
    __host__ __device__ bool next(int i, Unit& u) const {
        const long L = (long)i * G + c; if (L >= nwg) return false;
        int wgid = (int)L; { const int q = nwg / NXCD, r = nwg % NXCD, xcd = wgid % NXCD, off = wgid / NXCD; wgid = (xcd < r ? xcd * (q + 1) : r * (q + 1) + (xcd - r) * q) + off; }
        const int nig = WGM * nN, gid = wgid / nig, fm = gid * WGM, gsz = (nM - fm) < WGM ? (nM - fm) : WGM;
        u.pm = fm + ((wgid % nig) % gsz); u.pn = (wgid % nig) / gsz; return true;
    }
    __device__ __forceinline__ void a_ready(const Unit&) const {}
    __device__ __forceinline__ void done(const Unit&) const {}
};

__device__ __forceinline__ unsigned cvt_pk_bf16(float lo, float hi) { unsigned r; asm volatile("v_cvt_pk_bf16_f32 %0, %1, %2" : "=v"(r) : "v"(lo), "v"(hi)); return r; }
typedef float f32x2 __attribute__((ext_vector_type(2)));
__device__ __forceinline__ f32x2 gelu_pk(f32x2 v) {
    const f32x2 u = v * (v * v * 0.044715f + 1.0f);
    const f32x2 s = u * (-2.302208198f);
    f32x2 e; e.x = __builtin_amdgcn_exp2f(s.x); e.y = __builtin_amdgcn_exp2f(s.y);
    const f32x2 d = e + 1.0f;
    f32x2 r; r.x = __builtin_amdgcn_rcpf(d.x); r.y = __builtin_amdgcn_rcpf(d.y);
    return v * r;
}

template <int ACT  > struct EpiBf16 {
    static constexpr bool PERM = true, AFTER_DRAIN = false; typedef f32x4 acc_t;
    bf16_t* O; int ldc; const float* bias; int split_cols; size_t split_stride; float scale0; int act_cols;
    __device__ __forceinline__ void operator()(const f32x4 (&acc)[2][2][4][2], const Unit& u, int wr, int wc, int fr, int fq) const {
        const int row0 = u.pm * BM + wr * 64 + fr; int colt = u.pn * BM; bf16_t* base = O;
        float sc = 1.f; if (split_cols) { const int t = colt / split_cols; base += (size_t)t * split_stride; colt -= t * split_cols; if (t == 0) sc = scale0; }
        const int col0 = colt + wc * 32 + 8 * fq, bcol0 = u.pn * BM + wc * 32 + 8 * fq;
        f32x4 bv[2][2];
#pragma unroll
        for (int bj = 0; bj < 2; ++bj)
#pragma unroll
            for (int n = 0; n < 2; ++n) bv[bj][n] = bias ? *(const f32x4*)(bias + bcol0 + bj * HALF + 4 * n) : (f32x4){0.f, 0.f, 0.f, 0.f};
#pragma unroll
        for (int ai = 0; ai < 2; ++ai)
#pragma unroll
            for (int m = 0; m < 4; ++m) { bf16_t* rowp = base + (size_t)(row0 + ai * HALF + m * 16) * ldc + col0;
#pragma unroll
                for (int bj = 0; bj < 2; ++bj) { f32x4 v0 = acc[ai][bj][m][0] + bv[bj][0], v1 = acc[ai][bj][m][1] + bv[bj][1];
                    if (ACT == 1 && u.pn * BM < act_cols) { f32x2 a = gelu_pk((f32x2){v0[0], v0[1]}), b = gelu_pk((f32x2){v0[2], v0[3]}), c = gelu_pk((f32x2){v1[0], v1[1]}), d = gelu_pk((f32x2){v1[2], v1[3]});
                        v0 = (f32x4){a.x, a.y, b.x, b.y}; v1 = (f32x4){c.x, c.y, d.x, d.y}; }
                    v0 = v0 * sc; v1 = v1 * sc; u32x4 w; w.x = cvt_pk_bf16(v0[0], v0[1]); w.y = cvt_pk_bf16(v0[2], v0[3]); w.z = cvt_pk_bf16(v1[0], v1[1]); w.w = cvt_pk_bf16(v1[2], v1[3]);
                    *(u32x4*)(rowp + bj * HALF) = w; } }
    }
};


template <int ACT> struct EpiI8 {
    static constexpr bool PERM = true, AFTER_DRAIN = false; typedef i32x4 acc_t;
    bf16_t* O; int ldc; const float* rs; const float* cs; int act_cols;
    __device__ __forceinline__ void operator()(const i32x4 (&acc)[2][2][4][2], const Unit& u, int wr, int wc, int fr, int fq) const {
        const int row0 = u.pm * BM + wr * 64 + fr, col0 = u.pn * BM + wc * 32 + 8 * fq;
        f32x4 cv[2][2];
#pragma unroll
        for (int bj = 0; bj < 2; ++bj)
#pragma unroll
            for (int n = 0; n < 2; ++n) cv[bj][n] = *(const f32x4*)(cs + col0 + bj * HALF + 4 * n);
#pragma unroll
        for (int ai = 0; ai < 2; ++ai)
#pragma unroll
            for (int m = 0; m < 4; ++m) { const int row = row0 + ai * HALF + m * 16; const float ra = rs[row]; bf16_t* rowp = O + (size_t)row * ldc + col0;
#pragma unroll
                for (int bj = 0; bj < 2; ++bj) {
                    f32x4 v0 = __builtin_convertvector(acc[ai][bj][m][0], f32x4) * ra * cv[bj][0], v1 = __builtin_convertvector(acc[ai][bj][m][1], f32x4) * ra * cv[bj][1];
                    if (ACT == 1 && u.pn * BM < act_cols) { f32x2 a = gelu_pk((f32x2){v0[0], v0[1]}), b = gelu_pk((f32x2){v0[2], v0[3]}), c = gelu_pk((f32x2){v1[0], v1[1]}), d = gelu_pk((f32x2){v1[2], v1[3]});
                        v0 = (f32x4){a.x, a.y, b.x, b.y}; v1 = (f32x4){c.x, c.y, d.x, d.y}; }
                    u32x4 w; w.x = cvt_pk_bf16(v0[0], v0[1]); w.y = cvt_pk_bf16(v0[2], v0[3]); w.z = cvt_pk_bf16(v1[0], v1[1]); w.w = cvt_pk_bf16(v1[2], v1[3]);
                    *(u32x4*)(rowp + bj * HALF) = w; } }
    }
};

__device__ __forceinline__ f32x4 mma16(bf16x8 a, bf16x8 b, f32x4 c) { return __builtin_amdgcn_mfma_f32_16x16x32_bf16(a, b, c, 0, 0, 0); }
__device__ __forceinline__ i32x4 mma16(bf16x8 a, bf16x8 b, i32x4 c) { return __builtin_amdgcn_mfma_i32_16x16x64_i8(__builtin_bit_cast(i32x4, a), __builtin_bit_cast(i32x4, b), c, 0, 0, 0); }
template <class Epi, class Sched, bool ALIGN_EPI = false, bool SP2 = false>
__device__ __forceinline__ void gemm_phase(PG8_LAS unsigned char* lds, const Gemm g, const Sched& S, const Epi& E, const int wid  ) {
    const int lane = (int)__builtin_amdgcn_mbcnt_hi(~0u, __builtin_amdgcn_mbcnt_lo(~0u, 0u)), tid = wid * 64 + lane, wr = wid >> 2, wc = wid & 3, fr = lane & 15, fq = lane >> 4;
    const int K = g.K, nt = K / BK;
    unsigned voffA[2], voffB[2];
#pragma unroll
    for (int i = 0; i < 2; ++i) { int R, C; stage_rc(tid * 16 + i * 8192, R, C); const int Rb = Epi::PERM ? ((R & ~31) + perm32(R & 31)) : R;
        voffA[i] = (unsigned)(R * K + C) * 2u; voffB[i] = (unsigned)(Rb * K + C) * 2u; }
    const size_t kstep = (size_t)(BK * 2);
    const size_t hstep = (size_t)HALF * K * 2;
    const size_t tstep = 2 * hstep;
    const unsigned ldsw = (unsigned)wid * 1024u;
    const int aoff = lds_byte(wr * 64 + fr, fq * 8), boff = lds_byte(wc * 32 + fr, fq * 8);
#define PG8_SA(b, h) (((b) * 2 + (h)) * HTB)
#define PG8_SB(b, h) ((4 + (b) * 2 + (h)) * HTB)
#define PG8_STAGE(bufoff, gbase, voff) do { _Pragma("unroll") for (int _i = 0; _i < 2; ++_i) \
        __builtin_amdgcn_global_load_lds((const unsigned*)((const char*)(gbase) + (voff)[_i]), (PG8_LAS unsigned*)(lds + (bufoff) + ldsw + _i * 8192), 16, 0, 0); } while (0)
#define PG8_LDA(dst, b, h) do { _Pragma("unroll") for (int m = 0; m < 4; ++m) _Pragma("unroll") for (int k = 0; k < 2; ++k) dst[m][k] = *(const PG8_LAS bf16x8*)(lds + PG8_SA(b, h) + aoff + m * 2048 + k * 1024); } while (0)
#define PG8_LDB(dst, b, h) do { _Pragma("unroll") for (int n = 0; n < 2; ++n) _Pragma("unroll") for (int k = 0; k < 2; ++k) dst[n][k] = *(const PG8_LAS bf16x8*)(lds + PG8_SB(b, h) + boff + n * 2048 + k * 1024); } while (0)
#define PG8_MMA(ai, bj, At, Bt) do { __builtin_amdgcn_s_setprio(1); _Pragma("unroll") for (int m = 0; m < 4; ++m) _Pragma("unroll") for (int n = 0; n < 2; ++n) _Pragma("unroll") for (int k = 0; k < 2; ++k) \
        acc[ai][bj][m][n] = mma16(Bt[n][k], At[m][k], acc[ai][bj][m][n]); __builtin_amdgcn_s_setprio(0); } while (0)
#define PG8_WAIT_V(n) asm volatile("s_waitcnt vmcnt(" #n ")" ::: "memory")
#define PG8_WAIT_L(n) asm volatile("s_waitcnt lgkmcnt(" #n ")" ::: "memory")
#define PG8_BAR __builtin_amdgcn_s_barrier()
#define PG8_SCHED __builtin_amdgcn_sched_barrier(0)
    Unit cur, nxt; int ui = 0;
    if (!S.next(0, cur)) return;
    typedef typename Epi::acc_t acc_t;
    acc_t acc[2][2][4][2];
#pragma unroll
    for (int a = 0; a < 2; ++a)
#pragma unroll
        for (int b = 0; b < 2; ++b)
#pragma unroll
            for (int m = 0; m < 4; ++m)
#pragma unroll
                for (int n = 0; n < 2; ++n) acc[a][b][m][n] = acc_t{};
    bf16x8 At[4][2], B0[2][2], B1[2][2];
    const char* cA = (const char*)g.A + (size_t)cur.pm * tstep; const char* cB = (const char*)g.Bt + (size_t)cur.pn * tstep;
    S.a_ready(cur);
    if constexpr (SP2) {
        PG8_STAGE(PG8_SB(0, 0), cB, voffB); PG8_STAGE(PG8_SB(0, 1), cB + hstep, voffB); PG8_STAGE(PG8_SA(0, 0), cA, voffA); PG8_STAGE(PG8_SA(0, 1), cA + hstep, voffA);
        if (wr == 1) PG8_BAR;
        PG8_WAIT_V(2); PG8_BAR;
        PG8_STAGE(PG8_SB(1, 0), cB + kstep, voffB); PG8_STAGE(PG8_SA(1, 0), cA + kstep, voffA); PG8_STAGE(PG8_SB(1, 1), cB + hstep + kstep, voffB);
        PG8_WAIT_V(6); PG8_BAR;
    } else {
        PG8_STAGE(PG8_SB(0, 0), cB, voffB); PG8_STAGE(PG8_SA(0, 0), cA, voffA); PG8_STAGE(PG8_SB(0, 1), cB + hstep, voffB); PG8_STAGE(PG8_SA(0, 1), cA + hstep, voffA);
        if (wr == 1) PG8_BAR;
        PG8_WAIT_V(4); PG8_BAR;
        PG8_STAGE(PG8_SB(1, 0), cB + kstep, voffB); PG8_STAGE(PG8_SA(1, 0), cA + kstep, voffA); PG8_STAGE(PG8_SB(1, 1), cB + hstep + kstep, voffB);
        PG8_WAIT_V(6); PG8_BAR;
    }
    for (;;) {
        const bool has_next = S.next(ui + 1, nxt);
        const char* nA = has_next ? (const char*)g.A + (size_t)nxt.pm * tstep : cA; const char* nB = has_next ? (const char*)g.Bt + (size_t)nxt.pn * tstep : cB;
        for (int t = 0; t < nt; t += 2) {
            const bool last = (t == nt - 2);
            const char* a1 = cA + (size_t)(t + 1) * kstep;
            const char* a2 = last ? nA : cA + (size_t)(t + 2) * kstep; const char* b2 = last ? nB : cB + (size_t)(t + 2) * kstep;
            const char* a3 = a2 + kstep; const char* b3 = b2 + kstep;
            if (last && has_next) S.a_ready(nxt);
            if constexpr (SP2) {
            PG8_LDB(B0, 0, 0); PG8_LDB(B1, 0, 1); PG8_SCHED; PG8_LDA(At, 0, 0); PG8_STAGE(PG8_SA(1, 1), a1 + hstep, voffA);
            PG8_WAIT_V(8); PG8_WAIT_L(0); PG8_BAR; PG8_MMA(0, 0, At, B0); PG8_MMA(0, 1, At, B1); PG8_BAR; PG8_SCHED;
            PG8_LDA(At, 0, 1); PG8_STAGE(PG8_SB(0, 0), b2, voffB); PG8_STAGE(PG8_SB(0, 1), b2 + hstep, voffB); PG8_STAGE(PG8_SA(0, 0), a2, voffA);
            PG8_WAIT_V(8); PG8_WAIT_L(0); PG8_BAR; PG8_MMA(1, 0, At, B0); PG8_MMA(1, 1, At, B1); PG8_BAR; PG8_SCHED;
            PG8_LDB(B0, 1, 0); PG8_LDB(B1, 1, 1); PG8_SCHED; PG8_LDA(At, 1, 0); PG8_STAGE(PG8_SA(0, 1), a2 + hstep, voffA);
            PG8_WAIT_V(8); PG8_WAIT_L(0); PG8_BAR; PG8_MMA(0, 0, At, B0); PG8_MMA(0, 1, At, B1); PG8_BAR; PG8_SCHED;
            PG8_LDA(At, 1, 1); PG8_STAGE(PG8_SB(1, 0), b3, voffB); PG8_STAGE(PG8_SB(1, 1), b3 + hstep, voffB); PG8_STAGE(PG8_SA(1, 0), a3, voffA);
            PG8_WAIT_V(8); PG8_WAIT_L(0); PG8_BAR; PG8_MMA(1, 0, At, B0); PG8_MMA(1, 1, At, B1); PG8_BAR; PG8_SCHED;
            } else {
            PG8_LDB(B0, 0, 0); PG8_SCHED; PG8_LDA(At, 0, 0); PG8_STAGE(PG8_SA(1, 1), a1 + hstep, voffA);
            PG8_WAIT_L(8); PG8_BAR; PG8_WAIT_L(0); PG8_MMA(0, 0, At, B0); PG8_BAR; PG8_SCHED;
            PG8_LDB(B1, 0, 1); PG8_STAGE(PG8_SB(0, 0), b2, voffB);
            PG8_BAR; PG8_WAIT_L(0); PG8_MMA(0, 1, At, B1); PG8_BAR;
            PG8_LDA(At, 0, 1); PG8_STAGE(PG8_SA(0, 0), a2, voffA);
            PG8_BAR; PG8_WAIT_L(0); PG8_MMA(1, 0, At, B0); PG8_BAR; PG8_SCHED;
            PG8_STAGE(PG8_SB(0, 1), b2 + hstep, voffB);
            PG8_WAIT_V(6); PG8_BAR; PG8_MMA(1, 1, At, B1); PG8_BAR;
            PG8_LDB(B0, 1, 0); PG8_SCHED; PG8_LDA(At, 1, 0); PG8_STAGE(PG8_SA(0, 1), a2 + hstep, voffA);
            PG8_WAIT_L(8); PG8_BAR; PG8_WAIT_L(0); PG8_MMA(0, 0, At, B0); PG8_BAR; PG8_SCHED;
            PG8_LDB(B1, 1, 1); PG8_STAGE(PG8_SB(1, 0), b3, voffB);
            PG8_BAR; PG8_WAIT_L(0); PG8_MMA(0, 1, At, B1); PG8_BAR;
            PG8_LDA(At, 1, 1); PG8_STAGE(PG8_SA(1, 0), a3, voffA);
            PG8_BAR; PG8_WAIT_L(0); PG8_MMA(1, 0, At, B0); PG8_BAR; PG8_SCHED;
            PG8_STAGE(PG8_SB(1, 1), b3 + hstep, voffB);
            PG8_WAIT_V(6); PG8_BAR; PG8_MMA(1, 1, At, B1); PG8_BAR;
            }
        }
        if constexpr (ALIGN_EPI) { if (wr == 0) PG8_BAR; }
        if constexpr (!Epi::AFTER_DRAIN) { E(acc, cur, wr, wc, fr, fq); S.done(cur); }
        if (!has_next) break;
#pragma unroll
        for (int a = 0; a < 2; ++a)
#pragma unroll
            for (int b = 0; b < 2; ++b)
#pragma unroll
                for (int m = 0; m < 4; ++m)
#pragma unroll
                    for (int n = 0; n < 2; ++n) acc[a][b][m][n] = acc_t{};
        cur = nxt; cA = nA; cB = nB; ++ui;
        if constexpr (ALIGN_EPI) { if (wr == 1) PG8_BAR; }
    }
    PG8_WAIT_V(0);
    if constexpr (!ALIGN_EPI) { if (wr == 0) PG8_BAR; }
    PG8_BAR;
    if constexpr (Epi::AFTER_DRAIN) { E.fused(acc, cur, wr, wc, fr, fq, lds, wid, lane); S.done(cur); }
#undef PG8_SA
#undef PG8_SB
#undef PG8_STAGE
#undef PG8_LDA
#undef PG8_LDB
#undef PG8_MMA
#undef PG8_WAIT_V
#undef PG8_WAIT_L
#undef PG8_BAR
#undef PG8_SCHED
}
}
#ifndef MK_PER_PHASE
#define MK_PER_PHASE 0
#endif
#ifndef PROBE_PHASE
#define PROBE_PHASE -1
#endif
#ifndef X1_NR
#define X1_NR 2
#endif
#ifndef TABLES_IN_PHASE
#define TABLES_IN_PHASE 0
#endif
constexpr int NWAVES = 8, NTHR = NWAVES * 64;
constexpr int BATCH = 8, SEQ = 4096, D = 1024, M = BATCH * SEQ;
constexpr int INC = 2560;
constexpr int NEXP = 16384, PKN = 128;
constexpr int NQ = 2048;
constexpr float EPS = 1e-6f;
constexpr size_t MiB = 1u << 20;
constexpr size_t WS_CTL = 0, CTL_ZERO_BYTES = MK_PER_PHASE ? (1u << 20) : 64 * 1024;
constexpr size_t WS_MOD = 1 * MiB, WS_WIN = 2 * MiB, WS_WOUT = 7 * MiB, WS_WQ = 9 * MiB, WS_KEYS = 13 * MiB, WS_SGW = 13 * MiB + 512 * 1024;
constexpr size_t WS_SU = 14 * MiB, WS_UT = 16 * MiB, WS_VT = 48 * MiB, WS_H = 80 * MiB, WS_Y = 144 * MiB, WS_OATT = 80 * MiB, WS_Z = 208 * MiB, WS_QP = 208 * MiB;
constexpr size_t WS_H8 = 336 * MiB;
constexpr size_t WS_CAT = 368 * MiB, WS_IDX = 432 * MiB, WS_GATE = 448 * MiB, WS_END = 464 * MiB;
constexpr int CW_BAR = 4096;
constexpr int RING_BYTES = 131072, LDSCTL_OFF = RING_BYTES, MISC_OFF = LDSCTL_OFF + 320, LDS_BYTES = 147456;
constexpr int NPHASE = 10;

#define GAS __attribute__((address_space(1)))
#define LAS __attribute__((address_space(3)))
typedef unsigned short bf16;
typedef unsigned v4u __attribute__((ext_vector_type(4)));
typedef unsigned v2u __attribute__((ext_vector_type(2)));
typedef float f32x4 __attribute__((ext_vector_type(4)));
typedef short bf16x8 __attribute__((ext_vector_type(8)));
typedef GAS unsigned gu32;
typedef GAS unsigned long long gu64;
#define RLX_AGENT __ATOMIC_RELAXED, __HIP_MEMORY_SCOPE_AGENT
#define LDS_WAIT() asm volatile("s_waitcnt lgkmcnt(0)" ::: "memory")
#define VM_WAIT() asm volatile("s_waitcnt vmcnt(0)" ::: "memory")
__device__ __forceinline__ unsigned f2bf(float f) { unsigned u = __builtin_bit_cast(unsigned, f); return (u + 0x7fffu + ((u >> 16) & 1u)) >> 16; }
__device__ __forceinline__ unsigned pk2(float lo, float hi) { return f2bf(lo) | (f2bf(hi) << 16); }
__device__ __forceinline__ float bflo(unsigned w) { return __uint_as_float(w << 16); }
__device__ __forceinline__ float bfhi(unsigned w) { return __uint_as_float(w & 0xffff0000u); }
__device__ __forceinline__ float bf2f(bf16 b) { return __uint_as_float((unsigned)b << 16); }
typedef __bf16 bf16x2_t __attribute__((ext_vector_type(2)));
__device__ __forceinline__ float dot2(unsigned a, unsigned b, float acc) { return __builtin_amdgcn_fdot2_f32_bf16(__builtin_bit_cast(bf16x2_t, a), __builtin_bit_cast(bf16x2_t, b), acc, false); }
__device__ __forceinline__ float gelu_t(float v) { const float u = v * (1.f + 0.044715f * v * v); return v * __builtin_amdgcn_rcpf(1.f + __builtin_amdgcn_exp2f(-2.302208198f * u)); }
__device__ __forceinline__ int lane_id() { return (int)__builtin_amdgcn_mbcnt_hi(~0u, __builtin_amdgcn_mbcnt_lo(~0u, 0u)); }
__device__ __forceinline__ float wave_sum(float v) {
#pragma unroll
    for (int o = 1; o < 64; o <<= 1) v += __shfl_xor(v, o);
    return v;
}
#define DPP_SUM_ROW(v) do { v += __uint_as_float((unsigned)__builtin_amdgcn_update_dpp(0, (int)__float_as_uint(v), 0xB1, 0xF, 0xF, false)); \
        v += __uint_as_float((unsigned)__builtin_amdgcn_update_dpp(0, (int)__float_as_uint(v), 0x4E, 0xF, 0xF, false)); \
        v += __uint_as_float((unsigned)__builtin_amdgcn_update_dpp(0, (int)__float_as_uint(v), 0x141, 0xF, 0xF, false)); \
        v += __uint_as_float((unsigned)__builtin_amdgcn_update_dpp(0, (int)__float_as_uint(v), 0x140, 0xF, 0xF, false)); } while (0)
__device__ __forceinline__ float dpp_xor1(float v) { return __uint_as_float((unsigned)__builtin_amdgcn_update_dpp(0, (int)__float_as_uint(v), 0xB1, 0xF, 0xF, false)); }
__device__ __forceinline__ float wave_sum_dpp(float v) {
    DPP_SUM_ROW(v);
    const float r0 = __uint_as_float(__builtin_amdgcn_readlane(__float_as_uint(v), 0)), r1 = __uint_as_float(__builtin_amdgcn_readlane(__float_as_uint(v), 16));
    const float r2 = __uint_as_float(__builtin_amdgcn_readlane(__float_as_uint(v), 32)), r3 = __uint_as_float(__builtin_amdgcn_readlane(__float_as_uint(v), 48));
    return (r0 + r1) + (r2 + r3);
}
__device__ __forceinline__ float wave_max_dpp(float v) {
    v = fmaxf(v, __uint_as_float((unsigned)__builtin_amdgcn_update_dpp(0, (int)__float_as_uint(v), 0xB1, 0xF, 0xF, false)));
    v = fmaxf(v, __uint_as_float((unsigned)__builtin_amdgcn_update_dpp(0, (int)__float_as_uint(v), 0x4E, 0xF, 0xF, false)));
    v = fmaxf(v, __uint_as_float((unsigned)__builtin_amdgcn_update_dpp(0, (int)__float_as_uint(v), 0x141, 0xF, 0xF, false)));
    v = fmaxf(v, __uint_as_float((unsigned)__builtin_amdgcn_update_dpp(0, (int)__float_as_uint(v), 0x140, 0xF, 0xF, false)));
    const float r0 = __uint_as_float(__builtin_amdgcn_readlane(__float_as_uint(v), 0)), r1 = __uint_as_float(__builtin_amdgcn_readlane(__float_as_uint(v), 16));
    const float r2 = __uint_as_float(__builtin_amdgcn_readlane(__float_as_uint(v), 32)), r3 = __uint_as_float(__builtin_amdgcn_readlane(__float_as_uint(v), 48));
    return fmaxf(fmaxf(r0, r1), fmaxf(r2, r3));
}
__device__ __forceinline__ float half_max_dpp(float v) {
    v = fmaxf(v, __uint_as_float((unsigned)__builtin_amdgcn_update_dpp(0, (int)__float_as_uint(v), 0xB1, 0xF, 0xF, false)));
    v = fmaxf(v, __uint_as_float((unsigned)__builtin_amdgcn_update_dpp(0, (int)__float_as_uint(v), 0x4E, 0xF, 0xF, false)));
    v = fmaxf(v, __uint_as_float((unsigned)__builtin_amdgcn_update_dpp(0, (int)__float_as_uint(v), 0x141, 0xF, 0xF, false)));
    v = fmaxf(v, __uint_as_float((unsigned)__builtin_amdgcn_update_dpp(0, (int)__float_as_uint(v), 0x140, 0xF, 0xF, false)));
    const float r0 = __uint_as_float(__builtin_amdgcn_readlane(__float_as_uint(v), 0)), r1 = __uint_as_float(__builtin_amdgcn_readlane(__float_as_uint(v), 16));
    const float r2 = __uint_as_float(__builtin_amdgcn_readlane(__float_as_uint(v), 32)), r3 = __uint_as_float(__builtin_amdgcn_readlane(__float_as_uint(v), 48));
    return (lane_id() < 32) ? fmaxf(r0, r1) : fmaxf(r2, r3);
}
__device__ __forceinline__ float wave_max(float v) {
#pragma unroll
    for (int o = 1; o < 64; o <<= 1) v = fmaxf(v, __shfl_xor(v, o));
    return v;
}
#define XB_TMO      128
#define XB_XCNT(j)  (256  + 64 * (j))
#define XB_XSUB(j)  (1280 + 64 * (j))
#define XB_XGEN(j)  (2304 + 64 * (j))
#define XB_TOP      3328
#define XB_TOPGEN   3392
#define XCD_BAR_WORDS 3456
#define XB_SPIN_CAP (1u << 18)

__device__ __forceinline__ unsigned xb_ld(unsigned* p)              { return __hip_atomic_load(p, __ATOMIC_RELAXED, __HIP_MEMORY_SCOPE_AGENT); }
__device__ __forceinline__ unsigned xb_add(unsigned* p, unsigned v) { return __hip_atomic_fetch_add(p, v, __ATOMIC_RELAXED, __HIP_MEMORY_SCOPE_AGENT); }
__device__ __forceinline__ unsigned xb_xcc_id() { return (unsigned)__builtin_amdgcn_s_getreg((3 << 11) | 20) & 0xFu; }
#define XB_SPIN(cond, bar) do { unsigned _sp = 0; while (cond) { __builtin_amdgcn_s_sleep(1); \
    if ((++_sp & 255u) == 0u) { if (xb_ld(&(bar)[XB_TMO])) break; if (_sp > XB_SPIN_CAP) { atomicAdd(&(bar)[XB_TMO], 1u); break; } } } } while (0)

struct XcdBarrier {
    unsigned* bar; unsigned x;
    volatile LAS unsigned* st;
};

__device__ __forceinline__ XcdBarrier xcd_barrier_post(unsigned* bar, volatile LAS unsigned* st) {
    XcdBarrier b; b.bar = bar; b.x = xb_xcc_id(); b.st = st;
    if (threadIdx.x == 0) (void)xb_add(&bar[XB_XCNT(b.x)], 1u);
    return b;
}
__device__ __forceinline__ void xcd_barrier_complete(unsigned* bar, unsigned x, unsigned& nloc, unsigned& nx) {
    const unsigned G = gridDim.x * gridDim.y * gridDim.z;
    unsigned sum, cnt, mine, sp = 0u;
    for (;;) {
        sum = 0u; cnt = 0u; mine = 0u;
#pragma unroll
        for (unsigned j = 0; j < 16; ++j) { const unsigned c = xb_ld(&bar[XB_XCNT(j)]); sum += c; cnt += (c > 0u) ? 1u : 0u; mine = (j == x) ? c : mine; }
        if (sum == G) break;
        __builtin_amdgcn_s_sleep(1);
        if ((++sp & 255u) == 0u) { if (xb_ld(&bar[XB_TMO])) break; if (sp > XB_SPIN_CAP) { atomicAdd(&bar[XB_TMO], 1u); break; } }
    }
    nloc = mine > 0u ? mine : 1u; nx = cnt > 0u ? cnt : 1u;
}

__device__ __forceinline__ void xcd_barrier(const XcdBarrier& b) {
    asm volatile("s_waitcnt vmcnt(0)" ::: "memory");
    __syncthreads();
    if (threadIdx.x == 0) {
        unsigned* bar = b.bar;
        __builtin_amdgcn_s_waitcnt(0);
        unsigned nloc = b.st[0], nx = b.st[1];
        if (nloc == 0u) { xcd_barrier_complete(bar, b.x, nloc, nx); b.st[0] = nloc; b.st[1] = nx; }
        const unsigned old = xb_add(&bar[XB_XSUB(b.x)], 1u);
        const unsigned gen = old / nloc;
        if (old + 1u == (gen + 1u) * nloc) {
            __builtin_amdgcn_fence(__ATOMIC_RELEASE, "agent");
            asm volatile("s_waitcnt vmcnt(0)" ::: "memory");
            const unsigned og = xb_add(&bar[XB_TOP], 1u);
            const unsigned tg = og / nx;
            if (og + 1u == (tg + 1u) * nx) xb_add(&bar[XB_TOPGEN], 1u);
            else XB_SPIN(xb_ld(&bar[XB_TOPGEN]) == tg, bar);
            __builtin_amdgcn_fence(__ATOMIC_ACQUIRE, "agent");
            xb_add(&bar[XB_XGEN(b.x)], 1u);
            asm volatile("s_waitcnt vmcnt(0)" ::: "memory");
        } else {
            XB_SPIN(xb_ld(&bar[XB_XGEN(b.x)]) == gen, bar);
            __builtin_amdgcn_fence(__ATOMIC_ACQUIRE, "agent");
            asm volatile("s_waitcnt vmcnt(0)" ::: "memory");
        }
    }
    __syncthreads();
}
struct Frame {
    LAS unsigned char* lds;
    volatile LAS unsigned* MISC;
    gu32* ctl;
    int wave, G;
    const float *x, *c, *w_ada, *b_ada, *norm_g, *w_in, *sgu_ln_g, *sgu_ln_b, *sgu_w, *sgu_b, *diff_lambda, *subln_g, *rel_bias, *w_out, *w_query, *sub_keys, *peer_u, *peer_v;
    float* out;
    float* mod; bf16 *WIN, *WOUT, *WQ, *KEYS, *SGW, *H, *Y, *Z, *QP, *CAT; unsigned char *UT8, *VT6, *H8, *HA8, *W8, *WQ8; float *HS, *HAS, *WS8, *WQS8; float *SU, *SV, *PART; unsigned* STASH; int* IDX; float* GATE;
};

__device__ __forceinline__ void p0_transpose_item(const float* W, int K, int N, bf16* WT, int row_off, LAS float* scr, int item, int lane) {
    const int nblk = N / 32, kb = item / nblk, nb = item % nblk, k0 = 64 * kb, n0 = 32 * nb;
#pragma unroll 8
    for (int i = 0; i < 32; ++i) { const int kk = 2 * i + (lane >> 5); scr[kk * 33 + (lane & 31)] = W[(size_t)(k0 + kk) * N + n0 + (lane & 31)]; }
    LDS_WAIT(); asm volatile("" ::: "memory");
    const int c = lane & 7;
#pragma unroll
    for (int j = 0; j < 4; ++j) { const int n = (lane >> 3) + 8 * j; const LAS float* s = scr + (8 * c) * 33 + n;
        v4u o; o.x = pk2(s[0 * 33], s[1 * 33]); o.y = pk2(s[2 * 33], s[3 * 33]); o.z = pk2(s[4 * 33], s[5 * 33]); o.w = pk2(s[6 * 33], s[7 * 33]);
        *(GAS v4u*)(WT + (size_t)(row_off + n0 + n) * K + k0 + 8 * c) = o; }
    LDS_WAIT(); asm volatile("" ::: "memory");
}

__device__ __forceinline__ void prologue_tables_fwd(Frame& F, int gw, int NGW, int lane);
__device__ __forceinline__ void ph_prologue(Frame& F) {
    const int lane = lane_id(), wave = F.wave, tid = wave * 64 + lane, G = F.G;
    const int gw = blockIdx.x * NWAVES + wave, NGW = G * NWAVES;
    for (int rep_ = 0; rep_ < (PROBE_PHASE == 100 ? 2 : 1); ++rep_) {
        LAS float* sil = (LAS float*)F.lds;
        LAS float* red = sil + 8192;
        for (int i = tid; i < 8192; i += NTHR) { const float cv = F.c[i]; sil[i] = cv / (1.f + __expf(-cv)); }
        __syncthreads();
        for (int u = blockIdx.x; u < 384; u += G) {
            const int j = u * 16 + (lane & 15), kr = lane >> 4, k0 = wave * 128;
            float acc[8];
#pragma unroll
            for (int b = 0; b < 8; ++b) acc[b] = 0.f;
            const float* wp = F.w_ada + (size_t)(k0 + kr) * 6144 + j;
#pragma unroll 16
            for (int i = 0; i < 32; ++i) { const float w = wp[(size_t)i * 4 * 6144]; const int k = k0 + 4 * i + kr;
#pragma unroll
                for (int b = 0; b < 8; ++b) acc[b] += sil[b * 1024 + k] * w; }
#pragma unroll
            for (int b = 0; b < 8; ++b) { acc[b] += __shfl_xor(acc[b], 16); acc[b] += __shfl_xor(acc[b], 32); }
            if (lane < 16) {
#pragma unroll
                for (int b = 0; b < 8; ++b) red[(wave * 8 + b) * 16 + lane] = acc[b]; }
            __syncthreads();
            if (tid < 128) { const int b = tid >> 4, c = tid & 15; float s = 0.f;
#pragma unroll
                for (int w = 0; w < 8; ++w) s += red[(w * 8 + b) * 16 + c];
                F.mod[b * 6144 + u * 16 + c] = s + F.b_ada[u * 16 + c]; }
            __syncthreads();
        }
    }
    LAS float* scr = (LAS float*)(F.lds + wave * 16384);
    {
        LAS float* part = (LAS float*)(F.lds + 7 * 16384 + 8704);
        LAS float* fin = part + 256;
        const int n = lane & 31, hf = lane >> 5;
        for (int u = blockIdx.x; u < (INC + NQ) / 32; u += G) {
            const bool isq = u >= INC / 32;
            const float* Wsrc = isq ? F.w_query : F.w_in; const int Nw = isq ? NQ : INC; unsigned char* Wdst = isq ? F.WQ8 : F.W8; float* Sdst = isq ? F.WQS8 : F.WS8;
            const int n0 = (isq ? u - INC / 32 : u) * 32;
            float am = 0.f;
            { const float* wp = Wsrc + (size_t)(wave * 128 + hf) * Nw + n0 + n;
#pragma unroll 16
              for (int i = 0; i < 64; ++i) am = fmaxf(am, fabsf(wp[(size_t)(2 * i) * Nw])); }
            { auto rr = __builtin_amdgcn_permlane32_swap(__float_as_uint(am), __float_as_uint(am), false, false); am = fmaxf(__uint_as_float(rr[0]), __uint_as_float(rr[1])); }
            if (lane < 32) part[wave * 32 + lane] = am;
            __syncthreads();
            if (tid < 32) { float mx = 0.f;
#pragma unroll
                for (int w = 0; w < 8; ++w) mx = fmaxf(mx, part[w * 32 + tid]);
                fin[tid] = mx; Sdst[n0 + tid] = mx > 0.f ? mx * (1.f / 127.f) : 1.f; }
            __syncthreads();
            const float cmx = fin[n]; const float sc = cmx > 0.f ? 127.f / cmx : 1.f;
#pragma unroll 1
            for (int q = 0; q < 2; ++q) { const int k0 = (wave * 2 + q) * 64;
#pragma unroll 8
                for (int i = 0; i < 32; ++i) { const int kk = 2 * i + hf; scr[kk * 33 + n] = Wsrc[(size_t)(k0 + kk) * Nw + n0 + n]; }
                LDS_WAIT(); asm volatile("" ::: "memory");
                unsigned w8[8];
#pragma unroll
                for (int d = 0; d < 8; ++d) { const LAS float* s = scr + (32 * hf + 4 * d) * 33 + n;
                    const int q0 = (int)rintf(s[0] * sc), q1 = (int)rintf(s[33] * sc), q2 = (int)rintf(s[66] * sc), q3 = (int)rintf(s[99] * sc);
                    w8[d] = (unsigned)((q0 & 255) | ((q1 & 255) << 8) | ((q2 & 255) << 16) | (q3 << 24)); }
                unsigned char* op = Wdst + (size_t)(n0 + n) * D + k0 + 32 * hf;
                *(GAS v4u*)op = (v4u){w8[0], w8[1], w8[2], w8[3]}; *(GAS v4u*)(op + 16) = (v4u){w8[4], w8[5], w8[6], w8[7]};
                LDS_WAIT(); asm volatile("" ::: "memory"); }
            __syncthreads();
        }
    }
    constexpr int I_IN = 0, I_OUT = (D / 64) * (D / 32), I_Q = 0;
    for (int rep_ = 0; rep_ < (PROBE_PHASE == 101 ? 2 : 1); ++rep_)
    for (int it = gw; it < I_IN + I_OUT + I_Q; it += NGW) {
        int r = it;
        if (r < I_IN) { p0_transpose_item(F.w_in, D, INC, F.WIN, 0, scr, r, lane); continue; } r -= I_IN;
        if (r < I_OUT) { p0_transpose_item(F.w_out, D, D, F.WOUT, 0, scr, r, lane); continue; } r -= I_OUT;
        (void)r;
    }
    const int gt = blockIdx.x * NTHR + tid, NT = G * NTHR;
    if (TABLES_IN_PHASE == 0) for (int rep_ = 0; rep_ < (PROBE_PHASE == 102 ? 2 : 1); ++rep_) prologue_tables_fwd(F, gw, NGW, lane);
    for (int i = gt; i < 16 * 16 * 128; i += NT) {
        const int hc = i >> 11, dg = (i >> 7) & 15, n = i & 127;
        const float* s = F.sub_keys + ((size_t)(hc * 128 + n)) * 128 + dg * 8;
        const f32x4 a = *(const f32x4*)s, b = *(const f32x4*)(s + 4);
        v4u o; o.x = pk2(a.x, a.y); o.y = pk2(a.z, a.w); o.z = pk2(b.x, b.y); o.w = pk2(b.z, b.w); ((v4u*)F.KEYS)[i] = o;
    }
    for (int i = gt; i < 8 * 128 * 16; i += NT) {
        const int t = (i >> 4) & 127, s0 = (i & 15) * 8;
        const float* s = F.sgu_w + (size_t)i * 8;
        const f32x4 a = *(const f32x4*)s, b = *(const f32x4*)(s + 4);
        float f[8] = {a.x, a.y, a.z, a.w, b.x, b.y, b.z, b.w};
#pragma unroll
        for (int e = 0; e < 8; ++e) f[e] = (s0 + e <= t) ? f[e] : 0.f;
        v4u o; o.x = pk2(f[0], f[1]); o.y = pk2(f[2], f[3]); o.z = pk2(f[4], f[5]); o.w = pk2(f[6], f[7]); ((v4u*)F.SGW)[i] = o;
    }
}

__device__ __forceinline__ void ph_hrows(Frame& F) {
    const int lane = lane_id(); const int gw = blockIdx.x * NWAVES + F.wave, NGW = F.G * NWAVES;
    for (int m0 = gw; m0 < M; m0 += 2 * NGW) {
        const int m1 = (m0 + NGW < M) ? m0 + NGW : m0;
        f32x4 v[2][4]; float ss[2] = {0.f, 0.f};
#pragma unroll
        for (int u = 0; u < 2; ++u) { const f32x4* xr = (const f32x4*)(F.x + (size_t)(u ? m1 : m0) * D) + lane;
#pragma unroll
            for (int j = 0; j < 4; ++j) v[u][j] = xr[64 * j]; }
#pragma unroll
        for (int u = 0; u < 2; ++u)
#pragma unroll
            for (int j = 0; j < 4; ++j) ss[u] += (v[u][j].x * v[u][j].x + v[u][j].y * v[u][j].y) + (v[u][j].z * v[u][j].z + v[u][j].w * v[u][j].w);
        const float r0 = rsqrtf(wave_sum_dpp(ss[0]) * (1.f / D) + EPS), r1 = rsqrtf(wave_sum_dpp(ss[1]) * (1.f / D) + EPS);
#pragma unroll
        for (int u = 0; u < 2; ++u) { const int m = u ? m1 : m0; const float rstd = u ? r1 : r0;
            const float* md = F.mod + (m >> 12) * 6144;
            float am = 0.f;
#pragma unroll
            for (int j = 0; j < 4; ++j) { const int c = 256 * j + 4 * lane;
                const f32x4 g = *(const f32x4*)(F.norm_g + c), sc = *(const f32x4*)(md + 1024 + c), sh = *(const f32x4*)(md + c);
                const f32x4 hv = v[u][j] * rstd * g * (sc + 1.f) + sh; v[u][j] = hv;
                am = fmaxf(am, fmaxf(fmaxf(fabsf(hv.x), fabsf(hv.y)), fmaxf(fabsf(hv.z), fabsf(hv.w)))); }
            am = wave_max_dpp(am);
            const float s8 = am > 0.f ? 127.f / am : 1.f;
            unsigned* h8 = (unsigned*)(F.HA8 + (size_t)m * D) + lane;
#pragma unroll
            for (int j = 0; j < 4; ++j) { const int q0 = (int)rintf(v[u][j].x * s8), q1 = (int)rintf(v[u][j].y * s8), q2 = (int)rintf(v[u][j].z * s8), q3 = (int)rintf(v[u][j].w * s8);
                if (u == 0 || m1 != m0) h8[64 * j] = (unsigned)((q0 & 255) | ((q1 & 255) << 8) | ((q2 & 255) << 16) | (q3 << 24)); }
            if (lane == 0 && (u == 0 || m1 != m0)) F.HAS[m] = 1.f / s8; }
    }
}

__device__ __forceinline__ void ph_x1rows(Frame& F) {
    const int lane = lane_id(); const int gw = blockIdx.x * NWAVES + F.wave, NGW = F.G * NWAVES;
    constexpr int NR = X1_NR;
    for (int m0 = gw; m0 < M; m0 += NR * NGW) {
        int mr[NR]; bool ok[NR];
#pragma unroll
        for (int u = 0; u < NR; ++u) { ok[u] = (m0 + u * NGW < M); mr[u] = ok[u] ? m0 + u * NGW : m0; }
        f32x4 xv[NR][4], yv[NR][4]; float ss[NR];
#pragma unroll
        for (int u = 0; u < NR; ++u) { const int m = mr[u]; ss[u] = 0.f;
            const f32x4* xr = (const f32x4*)(F.x + (size_t)m * D) + lane; const v2u* yr = (const v2u*)(F.Y + (size_t)m * D) + lane;
#pragma unroll
            for (int j = 0; j < 4; ++j) { xv[u][j] = xr[64 * j]; const v2u w = yr[64 * j]; yv[u][j] = (f32x4){bflo(w.x), bfhi(w.x), bflo(w.y), bfhi(w.y)}; } }
#pragma unroll
        for (int u = 0; u < NR; ++u)
#pragma unroll
            for (int j = 0; j < 4; ++j) ss[u] += (yv[u][j].x * yv[u][j].x + yv[u][j].y * yv[u][j].y) + (yv[u][j].z * yv[u][j].z + yv[u][j].w * yv[u][j].w);
        float rs[NR], s1[NR];
#pragma unroll
        for (int u = 0; u < NR; ++u) { rs[u] = rsqrtf(wave_sum_dpp(ss[u]) * (1.f / D) + EPS); s1[u] = 0.f; }
#pragma unroll
        for (int u = 0; u < NR; ++u) { const int m = mr[u]; const float* md = F.mod + (m >> 12) * 6144; const float rstd = rs[u];
            f32x4* orow = (f32x4*)(F.out + (size_t)m * D) + lane;
#pragma unroll
            for (int j = 0; j < 4; ++j) { const int c = 256 * j + 4 * lane;
                const f32x4 g1 = *(const f32x4*)(F.norm_g + 1024 + c), gt = *(const f32x4*)(md + 2048 + c);
                xv[u][j] = xv[u][j] + gt * (yv[u][j] * rstd * g1); if (ok[u]) orow[64 * j] = xv[u][j];
                s1[u] += (xv[u][j].x * xv[u][j].x + xv[u][j].y * xv[u][j].y) + (xv[u][j].z * xv[u][j].z + xv[u][j].w * xv[u][j].w); } }
        float r1v[NR];
#pragma unroll
        for (int u = 0; u < NR; ++u) r1v[u] = rsqrtf(wave_sum_dpp(s1[u]) * (1.f / D) + EPS);
#pragma unroll
        for (int u = 0; u < NR; ++u) { const int m = mr[u]; const float* md = F.mod + (m >> 12) * 6144; const float r1 = r1v[u];
#pragma unroll
            for (int j = 0; j < 4; ++j) { const int c = 256 * j + 4 * lane;
                const f32x4 g2 = *(const f32x4*)(F.norm_g + 2048 + c), sc = *(const f32x4*)(md + 4096 + c), sh = *(const f32x4*)(md + 3072 + c);
                const f32x4 hv = xv[u][j] * r1 * g2 * (sc + 1.f) + sh; xv[u][j] = hv;
                }
            float am = 0.f;
#pragma unroll
            for (int j = 0; j < 4; ++j) am = fmaxf(am, fmaxf(fmaxf(fabsf(xv[u][j].x), fabsf(xv[u][j].y)), fmaxf(fabsf(xv[u][j].z), fabsf(xv[u][j].w))));
            am = wave_max_dpp(am);
            const float s8 = am > 0.f ? 127.f / am : 1.f;
            unsigned* h8 = (unsigned*)(F.H8 + (size_t)m * D) + lane;
#pragma unroll
            for (int j = 0; j < 4; ++j) { const int q0 = (int)rintf(xv[u][j].x * s8), q1 = (int)rintf(xv[u][j].y * s8), q2 = (int)rintf(xv[u][j].z * s8), q3 = (int)rintf(xv[u][j].w * s8);
                if (ok[u]) h8[64 * j] = (unsigned)((q0 & 255) | ((q1 & 255) << 8) | ((q2 & 255) << 16) | (q3 << 24)); }
            if (lane == 0 && ok[u]) F.HS[m] = 1.f / s8; }
    }
}

namespace att {
typedef float f32x16 __attribute__((ext_vector_type(16)));
typedef short s16x4 __attribute__((ext_vector_type(4)));
constexpr int QB = 256, KVB = 64;
constexpr int NS = 4;
constexpr int BTO = 288, BTN = 416;
constexpr int L_V = 0, L_K = NS * 16384, L_WS = L_K + NS * 8192, L_BT = L_WS + 2048, L_END = L_BT + 2048;
constexpr float C2 = 0.125f * 1.4426950408889634f;
__device__ __forceinline__ int v_st(int k, int c) { const int kk = (k & ~0xC) | ((k & 4) << 1) | ((k & 8) >> 1); return ((kk >> 3) * 4 + (c >> 5)) * 512 + ((kk & 7) * 32 + (c & 31)) * 2; }
__device__ __forceinline__ int v_rd_base(int lane) { return ((lane & 3) << 3) | (((lane >> 2) & 3) << 6) | (((lane >> 4) & 1) << 5) | (((lane >> 5) & 1) << 8); }
__device__ __forceinline__ unsigned v_src(int p) { const int sub = p >> 5, q = p & 31, kk = (sub >> 2) * 8 + (q >> 2), c = (sub & 3) * 32 + (q & 3) * 8;
    const int k = (kk & ~0xC) | ((kk & 4) << 1) | ((kk & 8) >> 1); return (unsigned)(k * INC + c) * 2u; }
__device__ __forceinline__ int crow(int r, int hi) { return (r & 3) + 8 * (r >> 2) + 4 * hi; }
typedef float f32x2_t __attribute__((ext_vector_type(2))); typedef __bf16 bf16x2_t __attribute__((ext_vector_type(2)));
__device__ __forceinline__ unsigned cvtpk(float lo, float hi) { const f32x2_t v = {lo, hi}; const bf16x2_t b = __builtin_convertvector(v, bf16x2_t); return __builtin_bit_cast(unsigned, b); }

__device__ __forceinline__ void attn_unit(Frame& F, int b, int h, int qb, float lam) {
    int tid = F.wave * 64 + lane_id(); asm volatile("" : "+v"(tid));
    const int lane = tid & 63, wid = F.wave, r32 = lane & 31, hi = lane >> 5;
    LAS unsigned char* lds = F.lds;
    LAS float* wsf = (LAS float*)(lds + L_WS) + wid * 64;
    const LAS float* bt = (const LAS float*)(lds + L_BT);
    const int q0 = qb * QB, qlo = q0 + wid * 32, qpos = qlo + r32;
    const size_t rowb = (size_t)b * SEQ;
    const int NT = (q0 + QB) / KVB;
    const unsigned kdoff = (unsigned)((tid >> 3) * INC + (((tid & 7) ^ ((tid >> 3) & 7)) * 8)) * 2u;
    const unsigned vdoff0 = v_src(tid), vdoff1 = v_src(tid + 512);
    const unsigned qoff = (unsigned)(r32 * INC + hi * 8) * 2u;
#define DMA_K(t_, buf_) __builtin_amdgcn_global_load_lds((const unsigned*)(Kb + (size_t)(t_) * (KVB * INC * 2) + kdoff), (LAS unsigned*)(lds + L_K + (buf_) * 8192 + wid * 1024), 16, 0, 0)
#define DMA_V(t_, buf_) do { __builtin_amdgcn_global_load_lds((const unsigned*)(Vb + (size_t)(t_) * (KVB * INC * 2) + vdoff0), (LAS unsigned*)(lds + L_V + (buf_) * 16384 + wid * 1024), 16, 0, 0); \
        __builtin_amdgcn_global_load_lds((const unsigned*)(Vb + (size_t)(t_) * (KVB * INC * 2) + vdoff1), (LAS unsigned*)(lds + L_V + (buf_) * 16384 + 8192 + wid * 1024), 16, 0, 0); } while (0)
#define DMA_TILE(t_) do { const int sl_ = (t_) & (NS - 1); DMA_K(t_, sl_); DMA_V(t_, sl_); } while (0)
#define ABAR() do { asm volatile("s_waitcnt lgkmcnt(0)" ::: "memory"); __builtin_amdgcn_s_barrier(); asm volatile("" ::: "memory"); } while (0)
    const int vbase = (int)(uintptr_t)(lds + L_V) + v_rd_base(lane);
    const int kroff = r32 * 128, kx = (r32 & 7) << 4;
    v4u* o0st = (v4u*)(F.STASH + ((size_t)blockIdx.x * NTHR + tid) * 32);
#pragma unroll
    for (int c = 0; c < 2; ++c) {
        const char* Kb = (const char*)(F.Z + rowb * INC + 1536 + h * 128 + c * 64);
        const char* Vb = (const char*)(F.Z + rowb * INC + 2048 + h * 128);
        const char* Qb = (const char*)(F.Z + (rowb + qlo) * INC + 1024 + h * 128 + c * 64);
        bf16x8 qr[4];
#pragma unroll
        for (int d0 = 0; d0 < 4; ++d0) qr[d0] = *(const bf16x8*)(Qb + d0 * 32 + qoff);
        DMA_TILE(0); DMA_TILE(1); DMA_TILE(2);
        asm volatile("s_waitcnt vmcnt(3)" ::: "memory");
        ABAR();
        float m = -1e30f, l = 0.f;
        f32x16 o[4];
#pragma unroll
        for (int d0 = 0; d0 < 4; ++d0) o[d0] = f32x16{};
        bf16x8 pa0, pa1, pa2, pa3;
#define QK_TILE(N0, N1, su) do { N0 = f32x16{}; N1 = f32x16{}; const LAS unsigned char* kb_ = lds + L_K + (su) * 8192 + kroff; \
        _Pragma("unroll") for (int d0 = 0; d0 < 4; ++d0) { const LAS unsigned char* a_ = kb_ + ((d0 * 32 + hi * 16) ^ kx); \
            const bf16x8 b0_ = *(const LAS bf16x8*)a_, b1_ = *(const LAS bf16x8*)(a_ + 4096); \
            N0 = __builtin_amdgcn_mfma_f32_32x32x16_bf16(b0_, qr[d0], N0, 0, 0, 0); N1 = __builtin_amdgcn_mfma_f32_32x32x16_bf16(b1_, qr[d0], N1, 0, 0, 0); } } while (0)
#define FIX_TILE(N0, N1, u) do { if (qlo - (u) * KVB - 63 < 113) { const int dq_ = qpos - (u) * KVB - 4 * hi + BTO; \
        _Pragma("unroll") for (int r = 0; r < 16; ++r) { const int i0_ = dq_ - ((r & 3) + 8 * (r >> 2)), i1_ = i0_ - 32; \
            N0[r] += bt[i0_ > BTN - 1 ? BTN - 1 : i0_]; N1[r] += bt[i1_ > BTN - 1 ? BTN - 1 : (i1_ < 0 ? 0 : i1_)]; } } } while (0)
#define MAX_TILE(N0, N1, ALN, GRN) do { float pm_ = fmaxf(N0[0], N1[0]); \
        _Pragma("unroll") for (int r = 1; r < 16; ++r) pm_ = fmaxf(fmaxf(pm_, N0[r]), N1[r]); \
        { auto rr_ = __builtin_amdgcn_permlane32_swap(__float_as_uint(pm_), __float_as_uint(pm_), false, false); pm_ = fmaxf(__uint_as_float(rr_[0]), __uint_as_float(rr_[1])); } \
        pm_ *= C2; GRN = __any(pm_ > m + 8.0f); const float mn_ = GRN ? fmaxf(m, pm_) : m; ALN = GRN ? __builtin_amdgcn_exp2f(m - mn_) : 1.0f; m = mn_; } while (0)
#define PK4(P, B_, OUT) do { const unsigned a0 = cvtpk(P[B_ + 0], P[B_ + 1]), a1 = cvtpk(P[B_ + 2], P[B_ + 3]); \
        const unsigned b0 = cvtpk(P[B_ + 4], P[B_ + 5]), b1 = cvtpk(P[B_ + 6], P[B_ + 7]); \
        auto r0 = __builtin_amdgcn_permlane32_swap(a0, b0, false, false); auto r1 = __builtin_amdgcn_permlane32_swap(a1, b1, false, false); \
        v4u w = {r0[0], r1[0], r0[1], r1[1]}; OUT = __builtin_bit_cast(bf16x8, w); } while (0)
#define EXP_TILE(C0, C1, ALC) do { const float nm_ = -m; \
        _Pragma("unroll") for (int r = 0; r < 16; ++r) { C0[r] = __builtin_amdgcn_exp2f(fmaf(C0[r], C2, nm_)); C1[r] = __builtin_amdgcn_exp2f(fmaf(C1[r], C2, nm_)); } \
        float ps_ = 0.f; _Pragma("unroll") for (int r = 0; r < 16; ++r) ps_ += C0[r] + C1[r]; \
        { auto rr_ = __builtin_amdgcn_permlane32_swap(__float_as_uint(ps_), __float_as_uint(ps_), false, false); ps_ = __uint_as_float(rr_[0]) + __uint_as_float(rr_[1]); } \
        l = l * (ALC) + ps_; PK4(C0, 0, pa0); PK4(C0, 8, pa1); PK4(C1, 0, pa2); PK4(C1, 8, pa3); } while (0)
#define RESC(ALC) do { if (hi == 0) wsf[r32] = (ALC); \
        _Pragma("unroll") for (int r = 0; r < 16; ++r) { const float a_ = wsf[crow(r, hi)]; _Pragma("unroll") for (int d0 = 0; d0 < 4; ++d0) o[d0][r] *= a_; } } while (0)
#define TRRD(dst, off) asm volatile("ds_read_b64_tr_b16 %0, %1 offset:%2" : "=&v"(dst) : "v"(vb0), "i"(off) : "memory")
#define PV_RD(L, H, d0) do { constexpr int b_ = (d0) * 512; TRRD(L[0], b_); TRRD(H[0], b_ + 2048); TRRD(L[1], b_ + 4096); TRRD(H[1], b_ + 6144); TRRD(L[2], b_ + 8192); TRRD(H[2], b_ + 10240); TRRD(L[3], b_ + 12288); TRRD(H[3], b_ + 14336); } while (0)
#define PV_MM(L, H, d0) do { \
        o[d0] = __builtin_amdgcn_mfma_f32_32x32x16_bf16(pa0, (bf16x8){L[0][0], L[0][1], L[0][2], L[0][3], H[0][0], H[0][1], H[0][2], H[0][3]}, o[d0], 0, 0, 0); \
        o[d0] = __builtin_amdgcn_mfma_f32_32x32x16_bf16(pa1, (bf16x8){L[1][0], L[1][1], L[1][2], L[1][3], H[1][0], H[1][1], H[1][2], H[1][3]}, o[d0], 0, 0, 0); \
        o[d0] = __builtin_amdgcn_mfma_f32_32x32x16_bf16(pa2, (bf16x8){L[2][0], L[2][1], L[2][2], L[2][3], H[2][0], H[2][1], H[2][2], H[2][3]}, o[d0], 0, 0, 0); \
        o[d0] = __builtin_amdgcn_mfma_f32_32x32x16_bf16(pa3, (bf16x8){L[3][0], L[3][1], L[3][2], L[3][3], H[3][0], H[3][1], H[3][2], H[3][3]}, o[d0], 0, 0, 0); } while (0)
#define LGK(n) do { asm volatile("s_waitcnt lgkmcnt(" #n ")" ::: "memory"); __builtin_amdgcn_sched_barrier(0); } while (0)
#define ITER(C0, C1, ALC, GRC, N0, N1, ALN, GRN, t) do { \
        if ((t) + 3 < NT) DMA_TILE((t) + 3);                      \
        QK_TILE(N0, N1, ((t) + 1) & (NS - 1));                    \
        EXP_TILE(C0, C1, ALC); \
        _Pragma("unroll") for (int i_ = 0; i_ < 4; ++i_) { __builtin_amdgcn_sched_group_barrier(0x100, 2, 0); __builtin_amdgcn_sched_group_barrier(0x008, 1, 0); __builtin_amdgcn_sched_group_barrier(0x002, 18, 0); \
            __builtin_amdgcn_sched_group_barrier(0x008, 1, 0); __builtin_amdgcn_sched_group_barrier(0x002, 18, 0); }     \
        if (GRC) RESC(ALC); \
        if ((t) + 1 < NT) FIX_TILE(N0, N1, (t) + 1); \
        { const int vb0 = vbase + ((t) & (NS - 1)) * 16384; \
          s16x4 la[4], ha[4], lb[4], hb[4];                    \
          PV_RD(la, ha, 0); PV_RD(lb, hb, 1); LGK(8); PV_MM(la, ha, 0); \
          if ((t) + 1 < NT) MAX_TILE(N0, N1, ALN, GRN); \
          PV_RD(la, ha, 2); LGK(8); PV_MM(lb, hb, 1); PV_RD(lb, hb, 3); LGK(8); PV_MM(la, ha, 2); LGK(0); PV_MM(lb, hb, 3); } \
        if ((t) + 3 < NT) asm volatile("s_waitcnt vmcnt(3)" ::: "memory"); else asm volatile("s_waitcnt vmcnt(0)" ::: "memory");     \
        ABAR(); } while (0)
        if (wid >= 4) __builtin_amdgcn_s_setprio(1);
        f32x16 sa0, sa1, sb0, sb1; float alA = 1.f, alB = 1.f; bool grA = false, grB = false;
        QK_TILE(sa0, sa1, 0); FIX_TILE(sa0, sa1, 0); MAX_TILE(sa0, sa1, alA, grA);
        for (int t = 0; t < NT; t += 2) {
            ITER(sa0, sa1, alA, grA, sb0, sb1, alB, grB, t);
            ITER(sb0, sb1, alB, grB, sa0, sa1, alA, grA, t + 1);
        }
        __builtin_amdgcn_s_setprio(0);
#undef QK_TILE
#undef FIX_TILE
#undef MAX_TILE
#undef PK4
#undef EXP_TILE
#undef RESC
#undef TRRD
#undef PV_RD
#undef PV_MM
#undef LGK
#undef ITER
        if (hi == 0) wsf[32 + r32] = l;
        float rl[16];
#pragma unroll
        for (int r = 0; r < 16; ++r) rl[r] = __builtin_amdgcn_rcpf(wsf[32 + crow(r, hi)]);
        if (c == 0) {
#pragma unroll
            for (int d0 = 0; d0 < 4; ++d0)
#pragma unroll
                for (int j = 0; j < 2; ++j) { v4u w;
                    w.x = cvtpk(o[d0][8 * j + 0] * rl[8 * j + 0], o[d0][8 * j + 1] * rl[8 * j + 1]); w.y = cvtpk(o[d0][8 * j + 2] * rl[8 * j + 2], o[d0][8 * j + 3] * rl[8 * j + 3]);
                    w.z = cvtpk(o[d0][8 * j + 4] * rl[8 * j + 4], o[d0][8 * j + 5] * rl[8 * j + 5]); w.w = cvtpk(o[d0][8 * j + 6] * rl[8 * j + 6], o[d0][8 * j + 7] * rl[8 * j + 7]);
                    o0st[d0 * 2 + j] = w; }
        } else {
            float ss[16];
#pragma unroll
            for (int r = 0; r < 16; ++r) ss[r] = 0.f;
#pragma unroll
            for (int d0 = 0; d0 < 4; ++d0)
#pragma unroll
                for (int j = 0; j < 2; ++j) { const v4u w = o0st[d0 * 2 + j]; const unsigned ww[4] = {w.x, w.y, w.z, w.w};
#pragma unroll
                    for (int k = 0; k < 4; ++k) { const int i = 4 * j + k;
                        const float a0 = bflo(ww[k]) - lam * (o[d0][2 * i] * rl[2 * i]), a1 = bfhi(ww[k]) - lam * (o[d0][2 * i + 1] * rl[2 * i + 1]);
                        o[d0][2 * i] = a0; o[d0][2 * i + 1] = a1; ss[2 * i] += a0 * a0; ss[2 * i + 1] += a1 * a1; } }
#pragma unroll
            for (int r = 0; r < 16; ++r) {
                { DPP_SUM_ROW(ss[r]); ss[r] += __shfl_xor(ss[r], 16); }
                ss[r] = rsqrtf(ss[r] * (1.f / 128.f) + EPS) * 0.8f;
            }
            bf16* Cw = F.CAT + (rowb + qlo) * 1024 + 512 + h * 128;
#pragma unroll
            for (int d0 = 0; d0 < 4; ++d0) { const float g = F.subln_g[d0 * 32 + r32];
#pragma unroll
                for (int r = 0; r < 16; ++r) { const float v = o[d0][r] * ss[r] * g; const float vn = dpp_xor1(v);
                    if ((r32 & 1) == 0) *(unsigned*)(Cw + (size_t)crow(r, hi) * 1024 + d0 * 32 + r32) = cvtpk(v, vn); } }
        }
        __syncthreads();
    }
#undef DMA_K
#undef DMA_V
#undef DMA_TILE
#undef ABAR
}

__device__ __forceinline__ void attn_phase(Frame& F) {
    const int lane = lane_id(), tid = F.wave * 64 + lane;
    const float s01 = wave_sum(F.diff_lambda[lane] * F.diff_lambda[64 + lane]), s23 = wave_sum(F.diff_lambda[128 + lane] * F.diff_lambda[192 + lane]);
    const float lam = __expf(s01) - __expf(s23) + 0.2f;
    const int G = F.G;
    for (int it = ((G % 8 == 0) ? ((int)(blockIdx.x % 8) * (G / 8) + (int)blockIdx.x / 8) : (int)blockIdx.x); it < 256; it += G) {
        const int bh = it >> 3, x = it & 7, b = bh >> 2, h = bh & 3;
        LAS float* bt = (LAS float*)(F.lds + L_BT);
        __syncthreads();
        if (tid < BTN) { const int d = tid - BTO; int bk = d; if (d >= 16) { bk = 16 + (int)(__log2f((float)d * (1.f / 16.f)) * (16.f / 3.f)); bk = bk > 31 ? 31 : bk; }
            bt[tid] = d < 0 ? -__builtin_inff() : (F.rel_bias[bk * 4 + h] - F.rel_bias[31 * 4 + h]) * (1.4426950408889634f / C2); }
        __syncthreads();
        attn_unit(F, b, h, x, lam);
        attn_unit(F, b, h, 15 - x, lam);
    }
}
}

namespace sgu {
typedef float f32x16 __attribute__((ext_vector_type(16)));
typedef short s16x4 __attribute__((ext_vector_type(4)));
constexpr int L_T = 0, L_ST = 65536;
__device__ __forceinline__ void sgu_chunk(Frame& F, int chunk) {
    int tid = F.wave * 64 + lane_id(); asm volatile("" : "+v"(tid));
    const int lane = tid & 63, g = F.wave, r32 = lane & 31, hi = lane >> 5;
    LAS unsigned char* lds = F.lds;
    LAS float* st = (LAS float*)(lds + L_ST);
    const size_t t0 = (size_t)chunk * 128;
    for (int i = 0; i < 16; i += 2) {
        v4u raw[2];
#pragma unroll
        for (int u = 0; u < 2; ++u) raw[u] = *(const v4u*)(F.Z + (t0 + g * 16 + i + u) * INC + 512 + lane * 8);
#pragma unroll
        for (int u = 0; u < 2; ++u) { const int tl = g * 16 + i + u;
            float f[8] = {bflo(raw[u].x), bfhi(raw[u].x), bflo(raw[u].y), bfhi(raw[u].y), bflo(raw[u].z), bfhi(raw[u].z), bflo(raw[u].w), bfhi(raw[u].w)};
            float s = 0.f;
#pragma unroll
            for (int e = 0; e < 8; ++e) s += f[e];
            const float mean = wave_sum_dpp(s) * (1.f / 512.f); float q = 0.f;
#pragma unroll
            for (int e = 0; e < 8; ++e) { f[e] -= mean; q += f[e] * f[e]; }
            const float rstd = rsqrtf(wave_sum_dpp(q) * (1.f / 512.f) + EPS);
            if (lane == 0) { st[2 * tl] = mean; st[2 * tl + 1] = rstd; } }
    }
    __syncthreads();
    f32x16 acc[2][2];
    const int sr = tid >> 4, sc = (tid & 15) * 8;
    const int vb0 = (int)(uintptr_t)(lds + L_T) + (g >> 1) * 16384 + att::v_rd_base(lane);
#define SGU_STAGE(sh) do { _Pragma("unroll") for (int tile = 0; tile < 4; ++tile) { const int ch = tile * 128 + sc; \
            const f32x4 g0 = *(const f32x4*)(F.sgu_ln_g + ch), g1 = *(const f32x4*)(F.sgu_ln_g + ch + 4), b0 = *(const f32x4*)(F.sgu_ln_b + ch), b1 = *(const f32x4*)(F.sgu_ln_b + ch + 4); \
            _Pragma("unroll") for (int rr = 0; rr < 2; ++rr) { const int s = (sh) * 64 + sr + 32 * rr; \
                const v4u raw = *(const v4u*)(F.Z + (t0 + s) * INC + 512 + ch); const float mean = st[2 * s], rstd = st[2 * s + 1]; v4u o; \
                o.x = pk2((bflo(raw.x) - mean) * rstd * g0.x + b0.x, (bfhi(raw.x) - mean) * rstd * g0.y + b0.y); \
                o.y = pk2((bflo(raw.y) - mean) * rstd * g0.z + b0.z, (bfhi(raw.y) - mean) * rstd * g0.w + b0.w); \
                o.z = pk2((bflo(raw.z) - mean) * rstd * g1.x + b1.x, (bfhi(raw.z) - mean) * rstd * g1.y + b1.y); \
                o.w = pk2((bflo(raw.w) - mean) * rstd * g1.z + b1.z, (bfhi(raw.w) - mean) * rstd * g1.w + b1.w); \
                *(LAS v4u*)(lds + L_T + tile * 16384 + att::v_st(sr + 32 * rr, sc)) = o; } } } while (0)
#define TRRD(dst, off) asm volatile("ds_read_b64_tr_b16 %0, %1 offset:%2" : "=&v"(dst) : "v"(vb0), "i"(off) : "memory")
#define SGU_MMA(sh, tb0) do { _Pragma("unroll") for (int ks = 0; ks < 4; ++ks) { s16x4 l0, h0, l1, h1; \
            if ((g & 1) == 0) { TRRD(l0, 0 * 512 + ks * 4096); TRRD(h0, 0 * 512 + ks * 4096 + 2048); TRRD(l1, 1 * 512 + ks * 4096); TRRD(h1, 1 * 512 + ks * 4096 + 2048); } \
            else              { TRRD(l0, 2 * 512 + ks * 4096); TRRD(h0, 2 * 512 + ks * 4096 + 2048); TRRD(l1, 3 * 512 + ks * 4096); TRRD(h1, 3 * 512 + ks * 4096 + 2048); } \
            asm volatile("s_waitcnt lgkmcnt(0)" ::: "memory"); __builtin_amdgcn_sched_barrier(0); \
            const bf16x8 B0 = (bf16x8){l0[0], l0[1], l0[2], l0[3], h0[0], h0[1], h0[2], h0[3]}, B1 = (bf16x8){l1[0], l1[1], l1[2], l1[3], h1[0], h1[1], h1[2], h1[3]}; \
            _Pragma("unroll") for (int tl = 0; tl < 2; ++tl) { const int tb = (tb0) + tl; if ((sh) * 64 + 16 * ks > tb * 32 + 31) continue; \
                const bf16x8 A = *(const bf16x8*)(F.SGW + ((size_t)(g * 128 + tb * 32 + r32)) * 128 + (sh) * 64 + 16 * ks + 8 * hi); \
                acc[tl][0] = __builtin_amdgcn_mfma_f32_32x32x16_bf16(A, B0, acc[tl][0], 0, 0, 0); \
                acc[tl][1] = __builtin_amdgcn_mfma_f32_32x32x16_bf16(A, B1, acc[tl][1], 0, 0, 0); } } } while (0)
#define SGU_EPI(tb0) do { _Pragma("unroll") for (int tl = 0; tl < 2; ++tl) _Pragma("unroll") for (int r = 0; r < 16; ++r) { \
            const int t = ((tb0) + tl) * 32 + att::crow(r, hi); const float bs = F.sgu_b[g * 128 + t]; \
            _Pragma("unroll") for (int db = 0; db < 2; ++db) { const int ch = g * 64 + db * 32 + r32; \
                const float u = bf2f(F.Z[(t0 + t) * INC + ch]); const float v = u * (acc[tl][db][r] + bs); const float vn = dpp_xor1(v); \
                if ((r32 & 1) == 0) *(unsigned*)(F.CAT + (t0 + t) * 1024 + ch) = att::cvtpk(v, vn); } } } while (0)
#define SGU_ZERO() do { acc[0][0] = f32x16{}; acc[0][1] = f32x16{}; acc[1][0] = f32x16{}; acc[1][1] = f32x16{}; } while (0)
    SGU_STAGE(0);
    __syncthreads();
    SGU_ZERO(); SGU_MMA(0, 0); SGU_EPI(0);
    SGU_ZERO(); SGU_MMA(0, 2);
    __syncthreads();
    SGU_STAGE(1);
    __syncthreads();
    SGU_MMA(1, 2); SGU_EPI(2);
#undef SGU_STAGE
#undef TRRD
#undef SGU_MMA
#undef SGU_EPI
#undef SGU_ZERO
}
__device__ __forceinline__ void sgu_phase(Frame& F) { for (int ck = blockIdx.x; ck < M / 128; ck += F.G) { sgu_chunk(F, ck); __syncthreads(); } }
}

namespace tk {
typedef float f32x16 __attribute__((ext_vector_type(16)));
__device__ __forceinline__ float vmax(float a, float b) { float r; asm("v_max_f32 %0, %1, %2" : "=v"(r) : "v"(a), "v"(b)); return r; }
__device__ __forceinline__ float vmin(float a, float b) { float r; asm("v_min_f32 %0, %1, %2" : "=v"(r) : "v"(a), "v"(b)); return r; }
#define TK_CE(a, b) do { const float _mx = vmax(a, b), _mn = vmin(a, b); a = _mx; b = _mn; } while (0)
template <int N> __device__ __forceinline__ void sort_desc(float (&a)[N]) {
#pragma unroll
    for (int k = 2; k <= N; k <<= 1)
#pragma unroll
        for (int j = k >> 1; j > 0; j >>= 1)
#pragma unroll
            for (int i = 0; i < N; ++i) { const int l = i ^ j; if (l > i) { if ((i & k) == 0) TK_CE(a[i], a[l]); else TK_CE(a[l], a[i]); } }
}
template <int N> __device__ __forceinline__ void merge_desc(float (&a)[N]) {
#pragma unroll
    for (int j = N >> 1; j > 0; j >>= 1)
#pragma unroll
        for (int i = 0; i < N; ++i) { const int l = i ^ j; if (l > i) TK_CE(a[i], a[l]); }
}
__device__ __forceinline__ void top16_merge(float (&a)[16], const float (&b)[16]) {
#pragma unroll
    for (int i = 0; i < 16; ++i) a[i] = vmax(a[i], b[15 - i]);
    merge_desc<16>(a);
}
__device__ __forceinline__ float embed(float v, unsigned mask, unsigned code) { return __uint_as_float((__float_as_uint(v) & mask) | code); }

__device__ __forceinline__ void topk_phase(Frame& F) {
    int lane = lane_id(); asm volatile("" : "+v"(lane));
    const int r32 = lane & 31, hi = lane >> 5;
    const int gw = blockIdx.x * NWAVES + F.wave, NGW = F.G * NWAVES;
    LAS unsigned* tab = (LAS unsigned*)(F.lds + F.wave * 8192) + lane;
    const float NEG = -__builtin_inff();
    constexpr int NTASK = (M / 32) * 8; const int per = (NTASK + NGW - 1) / NGW;
    unsigned code16[16];
#pragma unroll
    for (int r = 0; r < 16; ++r) code16[r] = (unsigned)((r & 3) + 8 * (r >> 2) + 4 * hi);
    const unsigned qoff = (unsigned)(r32 * NQ + hi * 8), koff = (unsigned)((hi * 128 + r32) * 8);
#define TK_QP(task_, c_) (F.QP + (size_t)((task_) >> 3) * 32 * NQ + ((task_) & 7) * 256 + (c_) * 128)
#define TK_KP(task_, c_) (F.KEYS + (size_t)((((task_) & 7) * 2 + (c_)) * 16) * 128 * 8)
#define TK_LDQ(dst, task_, c_) do { const bf16* qp_ = TK_QP(task_, c_); _Pragma("unroll") for (int ks = 0; ks < 8; ++ks) dst[ks] = *(const bf16x8*)(qp_ + ks * 16 + qoff); } while (0)
#define TK_LDK(dst, task_, c_, nb_) do { const bf16* kp_ = TK_KP(task_, c_); _Pragma("unroll") for (int ks = 0; ks < 8; ++ks) dst[ks] = *(const bf16x8*)(kp_ + ((2 * ks) * 128 + (nb_) * 32) * 8 + koff); } while (0)
    const int task_beg = gw * per, task_end = (gw * per + per < NTASK) ? gw * per + per : NTASK;
    bf16x8 qcur[8], kcur[8];
    if (task_beg < task_end) { TK_LDQ(qcur, task_beg, 0); TK_LDK(kcur, task_beg, 0, 0); }
    for (int task = task_beg; task < task_end; ++task) {
        const int tb = task >> 3, h = task & 7;
        const size_t trow = (size_t)tb * 32 + r32;
        float sk[2][16];
        float best[16];
#pragma unroll
        for (int st = 0; st < 8; ++st) {
            const int c = st >> 2, nb = st & 3;
            bf16x8 knxt[8], qnxt[8];
            if (st < 7) TK_LDK(knxt, task, (st + 1) >> 2, (st + 1) & 3);
            if (st == 3) TK_LDQ(qnxt, task, 1);
            f32x16 acc = f32x16{};
#pragma unroll
            for (int ks = 0; ks < 8; ++ks) acc = __builtin_amdgcn_mfma_f32_32x32x16_bf16(kcur[ks], qcur[ks], acc, 0, 0, 0);
            float cur[16];
#pragma unroll
            for (int r = 0; r < 16; ++r) { cur[r] = embed(acc[r], 0xFFFFFF80u, code16[r]); if (nb) cur[r] = __uint_as_float(__float_as_uint(cur[r]) | (unsigned)(nb * 32)); }
            sort_desc<16>(cur);
            if (nb == 0) {
#pragma unroll
                for (int i = 0; i < 16; ++i) best[i] = cur[i];
            } else top16_merge(best, cur);
            if (st < 7) {
#pragma unroll
                for (int ks = 0; ks < 8; ++ks) kcur[ks] = knxt[ks];
            }
            if (st == 3) {
#pragma unroll
                for (int ks = 0; ks < 8; ++ks) qcur[ks] = qnxt[ks];
            }
            if (nb == 3) {
                float pr[16];
#pragma unroll
                for (int i = 0; i < 16; ++i) { auto rr = __builtin_amdgcn_permlane32_swap(__float_as_uint(best[i]), __float_as_uint(best[i]), false, false);
                    pr[i] = __uint_as_float(hi ? rr[0] : rr[1]); }
                top16_merge(best, pr);
#pragma unroll
                for (int i = 0; i < 16; ++i) sk[c][i] = best[i];
            }
            __builtin_amdgcn_sched_barrier(0);
        }
        { const int tn = (task + 1 < task_end) ? task + 1 : task; TK_LDQ(qcur, tn, 0); TK_LDK(kcur, tn, 0, 0); }
#pragma unroll
        for (int i = 0; i < 16; ++i) { tab[i * 64] = __float_as_uint(sk[0][i]); tab[(16 + i) * 64] = __float_as_uint(sk[1][i]); }
        float T[16], G1[16], G2[16];
#pragma unroll
        for (int j = 0; j < 16; ++j) T[j] = embed(sk[0][0] + sk[1][j], 0xFFFFFF00u, (unsigned)j);
#pragma unroll
        for (int j = 0; j < 8; ++j) { G1[j] = embed(sk[0][1] + sk[1][j], 0xFFFFFF00u, (unsigned)(16 + j)); G1[8 + j] = embed(sk[0][15 - j] + sk[1][0], 0xFFFFFF00u, (unsigned)((15 - j) << 4)); }
        merge_desc<16>(G1);
        top16_merge(T, G1);
#pragma unroll
        for (int j = 0; j < 5; ++j) G2[j] = embed(sk[0][2] + sk[1][j], 0xFFFFFF00u, (unsigned)(32 + j));
#pragma unroll
        for (int j = 0; j < 4; ++j) G2[5 + j] = embed(sk[0][3] + sk[1][j], 0xFFFFFF00u, (unsigned)(48 + j));
#pragma unroll
        for (int j = 0; j < 3; ++j) G2[9 + j] = embed(sk[0][4] + sk[1][j], 0xFFFFFF00u, (unsigned)(64 + j));
#pragma unroll
        for (int j = 0; j < 2; ++j) { G2[12 + j] = embed(sk[0][5] + sk[1][j], 0xFFFFFF00u, (unsigned)(80 + j)); G2[14 + j] = embed(sk[0][6] + sk[1][j], 0xFFFFFF00u, (unsigned)(96 + j)); }
        sort_desc<16>(G2);
        top16_merge(T, G2);
        T[15] = vmax(T[15], embed(sk[0][7] + sk[1][0], 0xFFFFFF00u, 112u)); T[14] = vmax(T[14], embed(sk[0][7] + sk[1][1], 0xFFFFFF00u, 113u));
        merge_desc<16>(T);
        const float mx = __uint_as_float(__float_as_uint(T[0]) & 0xFFFFFF00u);
        float e[16]; float den = 0.f;
#pragma unroll
        for (int k = 0; k < 16; ++k) { e[k] = __builtin_amdgcn_exp2f((__uint_as_float(__float_as_uint(T[k]) & 0xFFFFFF00u) - mx) * 1.4426950408889634f); den += e[k]; }
        const float rden = 1.f / den;
        int eo[8]; float go[8];
#pragma unroll
        for (int k = 0; k < 8; ++k) {
            const unsigned code = __float_as_uint(hi ? T[k + 8] : T[k]) & 255u;
            const unsigned a1 = tab[(code >> 4) * 64] & 127u, a2 = tab[(16 + (code & 15u)) * 64] & 127u;
            eo[k] = (int)(a1 * 128u + a2); go[k] = (hi ? e[k + 8] : e[k]) * rden;
        }
        int* ip = F.IDX + trow * PKN + h * 16 + hi * 8; float* gp = F.GATE + trow * PKN + h * 16 + hi * 8;
        *(v4u*)ip = (v4u){(unsigned)eo[0], (unsigned)eo[1], (unsigned)eo[2], (unsigned)eo[3]}; *(v4u*)(ip + 4) = (v4u){(unsigned)eo[4], (unsigned)eo[5], (unsigned)eo[6], (unsigned)eo[7]};
        *(f32x4*)gp = (f32x4){go[0], go[1], go[2], go[3]}; *(f32x4*)(gp + 4) = (f32x4){go[4], go[5], go[6], go[7]};
    }
    (void)NEG;
}
#undef TK_CE
#undef TK_QP
#undef TK_KP
#undef TK_LDQ
#undef TK_LDK
}

namespace pe {
typedef float f32x2 __attribute__((ext_vector_type(2)));
__device__ __forceinline__ f32x2 cvlo(unsigned w) { return __builtin_amdgcn_cvt_pk_f32_fp8((int)w, false); }
__device__ __forceinline__ f32x2 cvhi(unsigned w) { return __builtin_amdgcn_cvt_pk_f32_fp8((int)w, true); }
__device__ __forceinline__ float dot16(const v4u r, const f32x2 (&hf)[8]) {
    f32x2 a = cvlo(r.x) * hf[0]; f32x2 b = cvhi(r.x) * hf[1];
    a = cvlo(r.y) * hf[2] + a; b = cvhi(r.y) * hf[3] + b; a = cvlo(r.z) * hf[4] + a; b = cvhi(r.z) * hf[5] + b; a = cvlo(r.w) * hf[6] + a; b = cvhi(r.w) * hf[7] + b;
    a = a + b; return a.x + a.y;
}
#define PE_W(WREG, i) __uint_as_float(__builtin_amdgcn_readlane(__float_as_uint(WREG), (i)))
#ifndef FP6_INTERLEAVED
#define FP6_INTERLEAVED 1
#endif
typedef unsigned v6u __attribute__((ext_vector_type(6)));
typedef float v32f __attribute__((ext_vector_type(32)));
typedef float v16f __attribute__((ext_vector_type(16)));
struct Row6 { v4u q4; v2u q2; };
#ifndef PV6_G
#define PV6_G 2
#endif
#define PV6_LOAD(dst, EREG, i) do { const int ea_ = __builtin_amdgcn_readlane(EREG, 2 * (i)), eb_ = __builtin_amdgcn_readlane(EREG, 2 * (i) + 1); \
        const unsigned char* rp_ = F.VT6 + (size_t)(half ? eb_ : ea_) * 768; dst.q4 = *(const v4u*)(rp_ + l16); dst.q2 = *(const v2u*)(rp_ + 512 + l8); } while (0)
#define PV6_ACC(src, WREG, i) do { const float wa_ = PE_W(WREG, 2 * (i)), wb_ = PE_W(WREG, 2 * (i) + 1); const float w_ = half ? wb_ : wa_; const f32x2 ww_ = {w_, w_}; \
        const v6u pk_ = {src.q4.x, src.q4.y, src.q4.z, src.q4.w, src.q2.x, src.q2.y}; const v32f d_ = __builtin_amdgcn_cvt_scalef32_pk32_f32_fp6(pk_, 1.0f); \
        _Pragma("unroll") for (int k = 0; k < 16; ++k) acc[k] = (f32x2){d_[2 * k], d_[2 * k + 1]} * ww_ + acc[k]; __builtin_amdgcn_sched_barrier(0); } while (0)
#define PV6_BATCH(EREG, WREG) do { Row6 bufA[PV6_G], bufB[PV6_G];             \
        _Pragma("unroll") for (int i = 0; i < PV6_G; ++i) PV6_LOAD(bufA[i], EREG, i); \
        _Pragma("unroll") for (int gq = 0; gq < 32 / PV6_G; gq += 2) { \
            _Pragma("unroll") for (int i = 0; i < PV6_G; ++i) PV6_LOAD(bufB[i], EREG, (gq + 1) * PV6_G + i); \
            _Pragma("unroll") for (int i = 0; i < PV6_G; ++i) PV6_ACC(bufA[i], WREG, gq * PV6_G + i); \
            if (gq + 2 < 32 / PV6_G) { _Pragma("unroll") for (int i = 0; i < PV6_G; ++i) PV6_LOAD(bufA[i], EREG, (gq + 2) * PV6_G + i); } \
            _Pragma("unroll") for (int i = 0; i < PV6_G; ++i) PV6_ACC(bufB[i], WREG, (gq + 1) * PV6_G + i); } } while (0)

#define PU_IDX(dst, tt) do { const v4u* ip_ = (const v4u*)(F.IDX + (size_t)(tt) * PKN + (lane >> 3) * 16); _Pragma("unroll") for (int q_ = 0; q_ < 4; ++q_) { const v4u w_ = ip_[q_]; dst[4 * q_] = (int)w_.x; dst[4 * q_ + 1] = (int)w_.y; dst[4 * q_ + 2] = (int)w_.z; dst[4 * q_ + 3] = (int)w_.w; } } while (0)
#define PU_GATHER(dst, idx) do { _Pragma("unroll") for (int i = 0; i < 16; ++i) dst[i] = *(const v4u*)(ub + (unsigned)idx[i] * 128u + coff); } while (0)
#define PU_HS(dst, tt) do { dst[0] = *(const v4u*)(F.H8 + (size_t)(tt) * D + x * 128 + (lane & 7) * 16); } while (0)
#define PU_COMPUTE(seg, hraw, tt) do { int p[16]; \
        _Pragma("unroll") for (int i = 0; i < 16; ++i) { int a_ = __builtin_amdgcn_sdot4((int)seg[i].x, (int)hraw[0].x, 0, false); a_ = __builtin_amdgcn_sdot4((int)seg[i].y, (int)hraw[0].y, a_, false); \
            a_ = __builtin_amdgcn_sdot4((int)seg[i].z, (int)hraw[0].z, a_, false); p[i] = __builtin_amdgcn_sdot4((int)seg[i].w, (int)hraw[0].w, a_, false); }     \
          \
        _Pragma("unroll") for (int i = 0; i < 8; ++i) { const bool bt = (lane & 4) != 0; const int sd = bt ? p[i] : p[i + 8], kp = bt ? p[i + 8] : p[i]; p[i] = kp + __builtin_amdgcn_update_dpp(0, sd, 0x141, 0xF, 0xF, false); } \
        _Pragma("unroll") for (int i = 0; i < 4; ++i) { const bool bt = (lane & 2) != 0; const int sd = bt ? p[i] : p[i + 4], kp = bt ? p[i + 4] : p[i]; p[i] = kp + __builtin_amdgcn_update_dpp(0, sd, 0x4E, 0xF, 0xF, false); } \
        _Pragma("unroll") for (int i = 0; i < 2; ++i) { const bool bt = (lane & 1) != 0; const int sd = bt ? p[i] : p[i + 2], kp = bt ? p[i + 2] : p[i]; p[i] = kp + __builtin_amdgcn_update_dpp(0, sd, 0xB1, 0xF, 0xF, false); } \
        ((unsigned*)F.PART)[((size_t)x * M + (tt)) * 64 + lane] = att::cvtpk((float)p[0], (float)p[1]); } while (0)
__device__ __forceinline__ void peer_u_phase(Frame& F, const int c0, const int cn, const int w0, const int nw) {
    int lane = lane_id(); asm volatile("" : "+v"(lane));
    const int wave = F.wave;
    if (wave < w0 || wave >= w0 + nw) return;
    const unsigned coff = (unsigned)(lane & 7) * 16u;
    const int per_blk = cn / 32, per_wave = per_blk / nw;
    for (int unit = blockIdx.x; unit < 256; unit += F.G) {
        const int x = unit & 7, rk = unit >> 3;
        const unsigned char* ub = F.UT8 + (size_t)x * NEXP * 128;
        const int tbeg = c0 + rk * per_blk + (wave - w0) * per_wave, tend = tbeg + per_wave;
        int idxA[16], idxB[16]; v4u segA[16], segB[16]; v4u hA[1], hB[1];
        PU_IDX(idxA, tbeg); PU_GATHER(segA, idxA); PU_HS(hA, tbeg); PU_IDX(idxB, tbeg + 1);
        for (int t = tbeg; t < tend; t += 2) {
            PU_GATHER(segB, idxB); PU_HS(hB, t + 1);
            { const int tn = (t + 2 < tend) ? t + 2 : t; PU_IDX(idxA, tn); }
            PU_COMPUTE(segA, hA, t);
            { const int tn = (t + 2 < tend) ? t + 2 : t; PU_GATHER(segA, idxA); PU_HS(hA, tn); }
            { const int tn = (t + 3 < tend) ? t + 3 : t + 1; PU_IDX(idxB, tn); }
            PU_COMPUTE(segB, hB, t + 1);
        }
    }
}
#undef PU_IDX
#undef PU_GATHER
#undef PU_HS
#undef PU_COMPUTE

template <bool DRY> __device__ __forceinline__ void peer_phase(Frame& F, const int c0, const int cn, const int w0, const int nw) {
    int lane = lane_id(); asm volatile("" : "+v"(lane));
    if (F.wave < w0 || F.wave >= w0 + nw) return;
    const int gw = blockIdx.x * nw + (F.wave - w0), NGW = F.G * nw;
    const int half = lane >> 5; const unsigned l16 = (unsigned)(lane & 31) * 16u, l8 = (unsigned)(lane & 31) * 8u;
    for (int t = c0 + gw; t < c0 + cn; t += NGW) {
        const int b = t >> 12;
        const int e0 = F.IDX[(size_t)t * PKN + lane], e1 = F.IDX[(size_t)t * PKN + 64 + lane];
        const float g0 = F.GATE[(size_t)t * PKN + lane], g1 = F.GATE[(size_t)t * PKN + 64 + lane];
        const float su0 = F.SU[e0], su1 = F.SU[e1], sv0 = F.SV[e0], sv1 = F.SV[e1];
        float tot0 = 0.f, tot1 = 0.f;
#pragma unroll
        for (int x = 0; x < 8; ++x) { const bf16* pp = (const bf16*)F.PART + ((size_t)x * M + t) * PKN; tot0 += bf2f(pp[lane]); tot1 += bf2f(pp[64 + lane]); }
        const float hs = F.HS[t];
        const float w0 = gelu_t(tot0 * (su0 * hs)) * g0 * sv0, w1 = gelu_t(tot1 * (su1 * hs)) * g1 * sv1;
        f32x2 acc[16];
#pragma unroll
        for (int i = 0; i < 16; ++i) acc[i] = (f32x2){0.f, 0.f};
        PV6_BATCH(e0, w0);
        PV6_BATCH(e1, w1);
#pragma unroll
        for (int i = 0; i < 16; ++i) {
            auto rx = __builtin_amdgcn_permlane32_swap(__float_as_uint(acc[i].x), __float_as_uint(acc[i].x), false, false);
            auto ry = __builtin_amdgcn_permlane32_swap(__float_as_uint(acc[i].y), __float_as_uint(acc[i].y), false, false);
            acc[i] = (f32x2){__uint_as_float(rx[0]) + __uint_as_float(rx[1]), __uint_as_float(ry[0]) + __uint_as_float(ry[1])};
        }
        float y[16];
#pragma unroll
        for (int j = 0; j < 16; ++j) {
#if FP6_INTERLEAVED
            const float lo = (j & 1) ? acc[j].x : acc[j].x;
            const float hi_ = acc[j].y;
            y[j] = half ? hi_ : lo;
#else
            const float lo = (j & 1) ? acc[j >> 1].y : acc[j >> 1].x;
            const float hi_ = (j & 1) ? acc[8 + (j >> 1)].y : acc[8 + (j >> 1)].x;
            y[j] = half ? hi_ : lo;
#endif
        }
        float ss = 0.f;
#pragma unroll
        for (int j = 0; j < 16; ++j) ss += y[j] * y[j];
        const float rstd = rsqrtf(wave_sum_dpp(ss) * (1.f / D) + EPS);
        const float* md = F.mod + b * 6144 + 5120;
        const float* g3 = F.norm_g + 3072;
        int lane_e = lane; asm volatile("" : "+v"(lane_e));
        const int col0 = (lane_e & 31) * 32 + (lane_e >> 5) * 16;
        float* orow = F.out + (size_t)t * D + col0;
#pragma unroll
        for (int q4 = 0; q4 < 4; ++q4) { const int c = col0 + q4 * 4;
            const f32x4 x1 = *(const f32x4*)(orow + q4 * 4), gt = *(const f32x4*)(md + c), gg = *(const f32x4*)(g3 + c);
            const f32x4 yv = (f32x4){y[q4 * 4], y[q4 * 4 + 1], y[q4 * 4 + 2], y[q4 * 4 + 3]};
            if (!DRY) *(f32x4*)(orow + q4 * 4) = x1 + gt * (yv * rstd * gg); else if (rstd == 123.456f) *(f32x4*)(orow + q4 * 4) = yv; }
    }
}
#undef PE_W
#undef PV6_LOAD
#undef PV6_ACC
#undef PV6_BATCH

__device__ __forceinline__ void u_rows4(Frame& F, int r0, int stride, int nvalid, int lane) {
    f32x4 v[4][4];
#pragma unroll
    for (int q = 0; q < 4; ++q) { const int row = r0 + (q < nvalid ? q : 0) * stride; const f32x4* s = (const f32x4*)(F.peer_u + (size_t)row * D) + lane * 4;
#pragma unroll
        for (int i = 0; i < 4; ++i) v[q][i] = s[i]; }
#pragma unroll
    for (int q = 0; q < 4; ++q) { if (q >= nvalid) break; const int row = r0 + q * stride;
        float am = 0.f;
#pragma unroll
        for (int i = 0; i < 4; ++i) am = fmaxf(am, fmaxf(fmaxf(fabsf(v[q][i].x), fabsf(v[q][i].y)), fmaxf(fabsf(v[q][i].z), fabsf(v[q][i].w))));
        am = wave_max_dpp(am);
        const float sc = am > 0.f ? 127.f / am : 1.f;
        int w[4];
#pragma unroll
        for (int i = 0; i < 4; ++i) { const int q0 = (int)rintf(v[q][i].x * sc), q1 = (int)rintf(v[q][i].y * sc), q2 = (int)rintf(v[q][i].z * sc), q3 = (int)rintf(v[q][i].w * sc);
            w[i] = (q0 & 255) | ((q1 & 255) << 8) | ((q2 & 255) << 16) | (q3 << 24); }
        *(v4u*)(F.UT8 + (size_t)(lane >> 3) * NEXP * 128 + (size_t)row * 128 + (lane & 7) * 16) = (v4u){(unsigned)w[0], (unsigned)w[1], (unsigned)w[2], (unsigned)w[3]};
        if (lane == 0) F.SU[row] = 1.f / sc; }
}
__device__ __forceinline__ void v_pairs2(Frame& F, int p0, int stride, int nvalid, int lane) {
    const int L = lane & 31, hf = lane >> 5;
    f32x4 f[2][8];
#pragma unroll
    for (int q = 0; q < 2; ++q) { const int row = 2 * (p0 + (q < nvalid ? q : 0) * stride) + hf; const f32x4* sp = (const f32x4*)(F.peer_v + (size_t)row * D + L * 32);
#pragma unroll
        for (int i = 0; i < 8; ++i) f[q][i] = sp[i]; }
#pragma unroll
    for (int q = 0; q < 2; ++q) { if (q >= nvalid) break; const int row = 2 * (p0 + q * stride) + hf;
        float am = 0.f;
#pragma unroll
        for (int i = 0; i < 8; ++i) am = fmaxf(am, fmaxf(fmaxf(fabsf(f[q][i].x), fabsf(f[q][i].y)), fmaxf(fabsf(f[q][i].z), fabsf(f[q][i].w))));
        am = half_max_dpp(am);
        const float sc = am > 0.f ? exp2f(floorf(log2f(7.0f / am))) : 1.f;
        v16f a, b;
#pragma unroll
        for (int i = 0; i < 4; ++i) { a[4 * i] = f[q][i].x * sc; a[4 * i + 1] = f[q][i].y * sc; a[4 * i + 2] = f[q][i].z * sc; a[4 * i + 3] = f[q][i].w * sc;
            b[4 * i] = f[q][4 + i].x * sc; b[4 * i + 1] = f[q][4 + i].y * sc; b[4 * i + 2] = f[q][4 + i].z * sc; b[4 * i + 3] = f[q][4 + i].w * sc; }
        const v6u w = __builtin_amdgcn_cvt_scalef32_2xpk16_fp6_f32(a, b, 1.0f);
        unsigned char* rp = F.VT6 + (size_t)row * 768;
        *(v4u*)(rp + L * 16) = (v4u){w[0], w[1], w[2], w[3]};
        *(v2u*)(rp + 512 + L * 8) = (v2u){w[4], w[5]};
        if (L == 0) F.SV[row] = 1.f / sc; }
}
__device__ __forceinline__ void prologue_tables(Frame& F, int gw, int NGW, int lane) {
    for (int r = gw; r < NEXP; r += 4 * NGW) { const int left = (NEXP - r + NGW - 1) / NGW; u_rows4(F, r, NGW, left < 4 ? left : 4, lane); }
    for (int p = gw; p < NEXP / 2; p += 2 * NGW) { const int left = (NEXP / 2 - p + NGW - 1) / NGW; v_pairs2(F, p, NGW, left < 2 ? left : 2, lane); }
}
}

__device__ __forceinline__ void prologue_tables_fwd(Frame& F, int gw, int NGW, int lane) { pe::prologue_tables(F, gw, NGW, lane); }
struct Args { const float* in[18]; float* out; unsigned char* ws; int ph_lo, ph_hi, li, pad; };
__global__ void __launch_bounds__(NTHR, 2) fwd(Args args) {
    extern __shared__ __attribute__((aligned(16))) unsigned char lds[];
    Frame F;
    F.lds = (LAS unsigned char*)lds;
    F.MISC = (volatile LAS unsigned*)(F.lds + MISC_OFF);
    F.wave = __builtin_amdgcn_readfirstlane((int)threadIdx.x >> 6); F.G = gridDim.x;
    unsigned char* ws = args.ws;
    F.ctl = (gu32*)(ws + WS_CTL);
    F.x = args.in[0]; F.c = args.in[1]; F.w_ada = args.in[2]; F.b_ada = args.in[3]; F.norm_g = args.in[4]; F.w_in = args.in[5]; F.sgu_ln_g = args.in[6]; F.sgu_ln_b = args.in[7];
    F.sgu_w = args.in[8]; F.sgu_b = args.in[9]; F.diff_lambda = args.in[10]; F.subln_g = args.in[11]; F.rel_bias = args.in[12]; F.w_out = args.in[13]; F.w_query = args.in[14];
    F.sub_keys = args.in[15]; F.peer_u = args.in[16]; F.peer_v = args.in[17]; F.out = args.out;
    F.mod = (float*)(ws + WS_MOD); F.WIN = (bf16*)(ws + WS_WIN); F.WOUT = (bf16*)(ws + WS_WOUT); F.WQ = (bf16*)(ws + WS_WQ); F.KEYS = (bf16*)(ws + WS_KEYS); F.SGW = (bf16*)(ws + WS_SGW);
    F.UT8 = ws + WS_UT; F.H8 = ws + WS_H8; F.HS = (float*)(ws + WS_SU) + 2 * NEXP; F.HAS = (float*)(ws + WS_SU) + 2 * NEXP + M; F.WS8 = (float*)(ws + WS_SU) + 2 * NEXP + 2 * M; F.HA8 = ws + WS_H; F.W8 = ws + WS_WIN; F.WQ8 = ws + WS_WQ; F.WQS8 = (float*)(ws + WS_SU) + 2 * NEXP + 2 * M + INC; F.VT6 = ws + WS_VT; F.PART = (float*)(ws + WS_QP); F.STASH = (unsigned*)(ws + WS_H); F.SU = (float*)(ws + WS_SU); F.SV = (float*)(ws + WS_SU) + NEXP; F.H = (bf16*)(ws + WS_H); F.Y = (bf16*)(ws + WS_Y); F.Z = (bf16*)(ws + WS_Z); F.QP = (bf16*)(ws + WS_QP); F.CAT = (bf16*)(ws + WS_CAT);
    F.IDX = (int*)(ws + WS_IDX); F.GATE = (float*)(ws + WS_GATE);
    for (int u = threadIdx.x; u < (LDS_BYTES - LDSCTL_OFF) / 4; u += NTHR) ((LAS unsigned*)(F.lds + LDSCTL_OFF))[u] = 0u;
    __syncthreads();
    XcdBarrier bar = xcd_barrier_post((unsigned*)(F.ctl + CW_BAR) + args.li * XCD_BAR_WORDS, F.MISC + 8);
    const int lo = args.ph_lo, hi = args.ph_hi;
#ifndef ONLY_PHASE
#define ONLY_PHASE -1
#endif
#define IN(k) (lo <= (k) && (k) < hi && (ONLY_PHASE < 0 || ONLY_PHASE == (k)))
#define SEAM(k) do { if ((k) + 1 < hi) xcd_barrier(bar); } while (0)
    if (IN(0)) { for (int rep = 0; rep < (PROBE_PHASE == 0 ? 2 : 1); ++rep) ph_prologue(F); SEAM(0); }
    if (IN(1)) { for (int rep = 0; rep < (PROBE_PHASE == 1 ? 2 : 1); ++rep) ph_hrows(F); SEAM(1); }
    if (IN(2)) {
        pg8::Gemm g{(const pg8::bf16_t*)F.HA8, (const pg8::bf16_t*)F.W8, M, INC, D / 2}; pg8::StaticOrder S; S.init(M, INC, F.G, (int)blockIdx.x);
        pg8::EpiI8<1> E{F.Z, INC, F.HAS, F.WS8, 1024};
        for (int rep = 0; rep < (PROBE_PHASE == 2 ? 2 : 1); ++rep) pg8::gemm_phase<pg8::EpiI8<1>, pg8::StaticOrder, true, true>(F.lds, g, S, E, F.wave);
        SEAM(2);
    }
    if (IN(3)) { for (int rep = 0; rep < (PROBE_PHASE == 30 ? 2 : 1); ++rep) sgu::sgu_phase(F); for (int rep = 0; rep < (PROBE_PHASE == 3 ? 2 : 1); ++rep) att::attn_phase(F); SEAM(3); }
    if (IN(4)) {
        pg8::Gemm g{F.CAT, F.WOUT, M, D, D}; pg8::StaticOrder S; S.init(M, D, F.G, (int)blockIdx.x);
        pg8::EpiBf16<0> E{F.Y, D, nullptr, 0, 0, 1.f, 0};
        for (int rep = 0; rep < (PROBE_PHASE == 4 ? 2 : 1); ++rep) pg8::gemm_phase<pg8::EpiBf16<0>, pg8::StaticOrder, true, true>(F.lds, g, S, E, F.wave);
        SEAM(4);
    }
    if (IN(5)) { for (int rep = 0; rep < (PROBE_PHASE == 5 ? 2 : 1); ++rep) ph_x1rows(F); SEAM(5); }
    if (IN(6)) {
        pg8::Gemm g{(const pg8::bf16_t*)F.H8, (const pg8::bf16_t*)F.WQ8, M, NQ, D / 2}; pg8::StaticOrder S; S.init(M, NQ, F.G, (int)blockIdx.x);
        pg8::EpiI8<0> E{F.QP, NQ, F.HS, F.WQS8, 0};
        for (int rep = 0; rep < (PROBE_PHASE == 6 ? 2 : 1); ++rep) pg8::gemm_phase<pg8::EpiI8<0>, pg8::StaticOrder, true, true>(F.lds, g, S, E, F.wave);
        SEAM(6);
    }
    if (IN(7)) { if (TABLES_IN_PHASE == 7) prologue_tables_fwd(F, blockIdx.x * NWAVES + F.wave, F.G * NWAVES, lane_id()); for (int rep = 0; rep < (PROBE_PHASE == 7 ? 2 : 1); ++rep) tk::topk_phase(F); SEAM(7); }
    if (IN(8)) { for (int rep = 0; rep < (PROBE_PHASE == 8 ? 2 : 1); ++rep) pe::peer_u_phase(F, 0, M, 0, 8); SEAM(8); }
    if (IN(9)) { if (PROBE_PHASE == 9) pe::peer_phase<true>(F, 0, M, 0, 8); pe::peer_phase<false>(F, 0, M, 0, 8); }
#undef IN
#undef SEAM
}

extern "C" void kernel_launch(void* const* d_in, const int* in_sizes, int n_in, void* d_out, int out_size, void* d_ws, size_t ws_size, hipStream_t stream) {
    static int grid = 0;
    if (grid == 0) {
        if (n_in != 18 || in_sizes[0] != M * D || out_size != M * D || ws_size < WS_END) { fprintf(stderr, "kernel_launch: unexpected shapes (n_in %d, in0 %d, out %d, ws %zu)\n", n_in, n_in > 0 ? in_sizes[0] : -1, out_size, ws_size); grid = -1; return; }
        int dev = 0, cus = 0, per_cu = 0;
        if (hipGetDevice(&dev) != hipSuccess || hipDeviceGetAttribute(&cus, hipDeviceAttributeMultiprocessorCount, dev) != hipSuccess) { grid = -1; return; }
        if (hipFuncSetAttribute((const void*)fwd, hipFuncAttributeMaxDynamicSharedMemorySize, LDS_BYTES) != hipSuccess) { fprintf(stderr, "kernel_launch: hipFuncSetAttribute failed\n"); grid = -1; return; }
        if (hipOccupancyMaxActiveBlocksPerMultiprocessor(&per_cu, (const void*)fwd, NTHR, LDS_BYTES) != hipSuccess || per_cu < 1) fprintf(stderr, "kernel_launch: occupancy query reports %d\n", per_cu);
        (void)hipGetLastError();
        grid = cus;
    }
    if (grid < 0) return;
    if (hipMemsetAsync((char*)d_ws + WS_CTL, 0, CTL_ZERO_BYTES, stream) != hipSuccess) return;
    Args a{};
    for (int i = 0; i < 18; ++i) a.in[i] = (const float*)d_in[i];
    a.out = (float*)d_out; a.ws = (unsigned char*)d_ws;
#if MK_PER_PHASE
    for (int p = 0; p < NPHASE; ++p) { a.ph_lo = p; a.ph_hi = p + 1; a.li = p; hipLaunchKernelGGL(fwd, dim3(grid), dim3(NTHR), LDS_BYTES, stream, a); }
#else
    a.ph_lo = 0; a.ph_hi = NPHASE; a.li = 0; hipLaunchKernelGGL(fwd, dim3(grid), dim3(NTHR), LDS_BYTES, stream, a);
#endif
}
```

```cpp
#define MK_PER_PHASE 0
#include <hip/hip_runtime.h>
#include <cstdio>
#include <cstdint>
namespace pg8 {
#define PG8_LAS __attribute__((address_space(3)))
typedef unsigned short bf16_t;
typedef short bf16x8 __attribute__((ext_vector_type(8)));
typedef float f32x4 __attribute__((ext_vector_type(4)));
typedef unsigned u32x4 __attribute__((ext_vector_type(4)));
typedef int i32x4 __attribute__((ext_vector_type(4)));
constexpr int BM = 256, BK = 64, HALF = 128, HTB = HALF * BK * 2  , STAGE_BYTES = 8 * HTB, NXCD = 8, WGM = 8;

__host__ __device__ __forceinline__ int lds_byte(int r, int c) { const int st = (r >> 4) * 2 + (c >> 5), rr = r & 15, cc = c & 31, ob = rr * 64 + cc * 2; return st * 1024 + (ob ^ (((ob >> 9) & 1) << 5)); }
__host__ __device__ __forceinline__ void stage_rc(int b, int& R, int& C) { const int st = b / 1024, sb = b % 1024, swz = sb ^ (((sb >> 9) & 1) << 5); R = (st >> 1) * 16 + swz / 64; C = (st & 1) * 32 + (swz % 64) / 2; }
__host__ __device__ __forceinline__ int perm32(int rho) { const int n = rho >> 4, i = rho & 15; return 8 * (i >> 2) + 4 * n + (i & 3); }

struct Unit { int pm, pn; };
struct Gemm { const bf16_t* A; const bf16_t* Bt; int M, N, K; };

struct StaticOrder {
    int nM, nN, nwg, G, c;
    __host__ __device__ void init(int M, int N, int G_, int c_) { nM = M / BM; nN = N / BM; nwg = nM * nN; G = G_; c = c_; }
    __host__ __device__ bool next(int i, Unit& u) const {
        const long L = (long)i * G + c; if (L >= nwg) return false;
        int wgid = (int)L; { const int q = nwg / NXCD, r = nwg % NXCD, xcd = wgid % NXCD, off = wgid / NXCD; wgid = (xcd < r ? xcd * (q + 1) : r * (q + 1) + (xcd - r) * q) + off; }
        const int nig = WGM * nN, gid = wgid / nig, fm = gid * WGM, gsz = (nM - fm) < WGM ? (nM - fm) : WGM;
        u.pm = fm + ((wgid % nig) % gsz); u.pn = (wgid % nig) / gsz; return true;
    }
    __device__ __forceinline__ void a_ready(const Unit&) const {}
    __device__ __forceinline__ void done(const Unit&) const {}
};

__device__ __forceinline__ unsigned cvt_pk_bf16(float lo, float hi) { unsigned r; asm volatile("v_cvt_pk_bf16_f32 %0, %1, %2" : "=v"(r) : "v"(lo), "v"(hi)); return r; }
typedef float f32x2 __attribute__((ext_vector_type(2)));
__device__ __forceinline__ f32x2 gelu_pk(f32x2 v) {
    const f32x2 u = v * (v * v * 0.044715f + 1.0f);
    const f32x2 s = u * (-2.302208198f);
    f32x2 e; e.x = __builtin_amdgcn_exp2f(s.x); e.y = __builtin_amdgcn_exp2f(s.y);
    const f32x2 d = e + 1.0f;
    f32x2 r; r.x = __builtin_amdgcn_rcpf(d.x); r.y = __builtin_amdgcn_rcpf(d.y);
    return v * r;
}

template <int ACT  > struct EpiBf16 {
    static constexpr bool PERM = true, AFTER_DRAIN = false; typedef f32x4 acc_t;
    bf16_t* O; int ldc; const float* bias; int split_cols; size_t split_stride; float scale0; int act_cols;
    __device__ __forceinline__ void operator()(const f32x4 (&acc)[2][2][4][2], const Unit& u, int wr, int wc, int fr, int fq) const {
        const int row0 = u.pm * BM + wr * 64 + fr; int colt = u.pn * BM; bf16_t* base = O;
        float sc = 1.f; if (split_cols) { const int t = colt / split_cols; base += (size_t)t * split_stride; colt -= t * split_cols; if (t == 0) sc = scale0; }
        const int col0 = colt + wc * 32 + 8 * fq, bcol0 = u.pn * BM + wc * 32 + 8 * fq;
        f32x4 bv[2][2];
#pragma unroll
        for (int bj = 0; bj < 2; ++bj)
#pragma unroll
            for (int n = 0; n < 2; ++n) bv[bj][n] = bias ? *(const f32x4*)(bias + bcol0 + bj * HALF + 4 * n) : (f32x4){0.f, 0.f, 0.f, 0.f};
#pragma unroll
        for (int ai = 0; ai < 2; ++ai)
#pragma unroll
            for (int m = 0; m < 4; ++m) { bf16_t* rowp = base + (size_t)(row0 + ai * HALF + m * 16) * ldc + col0;
#pragma unroll
                for (int bj = 0; bj < 2; ++bj) { f32x4 v0 = acc[ai][bj][m][0] + bv[bj][0], v1 = acc[ai][bj][m][1] + bv[bj][1];
                    if (ACT == 1 && u.pn * BM < act_cols) { f32x2 a = gelu_pk((f32x2){v0[0], v0[1]}), b = gelu_pk((f32x2){v0[2], v0[3]}), c = gelu_pk((f32x2){v1[0], v1[1]}), d = gelu_pk((f32x2){v1[2], v1[3]});
                        v0 = (f32x4){a.x, a.y, b.x, b.y}; v1 = (f32x4){c.x, c.y, d.x, d.y}; }
                    v0 = v0 * sc; v1 = v1 * sc; u32x4 w; w.x = cvt_pk_bf16(v0[0], v0[1]); w.y = cvt_pk_bf16(v0[2], v0[3]); w.z = cvt_pk_bf16(v1[0], v1[1]); w.w = cvt_pk_bf16(v1[2], v1[3]);
                    *(u32x4*)(rowp + bj * HALF) = w; } }
    }
};


template <int ACT> struct EpiI8 {
    static constexpr bool PERM = true, AFTER_DRAIN = false; typedef i32x4 acc_t;
    bf16_t* O; int ldc; const float* rs; const float* cs; int act_cols;
    __device__ __forceinline__ void operator()(const i32x4 (&acc)[2][2][4][2], const Unit& u, int wr, int wc, int fr, int fq) const {
        const int row0 = u.pm * BM + wr * 64 + fr, col0 = u.pn * BM + wc * 32 + 8 * fq;
        f32x4 cv[2][2];
#pragma unroll
        for (int bj = 0; bj < 2; ++bj)
#pragma unroll
            for (int n = 0; n < 2; ++n) cv[bj][n] = *(const f32x4*)(cs + col0 + bj * HALF + 4 * n);
#pragma unroll
        for (int ai = 0; ai < 2; ++ai)
#pragma unroll
            for (int m = 0; m < 4; ++m) { const int row = row0 + ai * HALF + m * 16; const float ra = rs[row]; bf16_t* rowp = O + (size_t)row * ldc + col0;
#pragma unroll
                for (int bj = 0; bj < 2; ++bj) {
                    f32x4 v0 = __builtin_convertvector(acc[ai][bj][m][0], f32x4) * ra * cv[bj][0], v1 = __builtin_convertvector(acc[ai][bj][m][1], f32x4) * ra * cv[bj][1];
                    if (ACT == 1 && u.pn * BM < act_cols) { f32x2 a = gelu_pk((f32x2){v0[0], v0[1]}), b = gelu_pk((f32x2){v0[2], v0[3]}), c = gelu_pk((f32x2){v1[0], v1[1]}), d = gelu_pk((f32x2){v1[2], v1[3]});
                        v0 = (f32x4){a.x, a.y, b.x, b.y}; v1 = (f32x4){c.x, c.y, d.x, d.y}; }
                    u32x4 w; w.x = cvt_pk_bf16(v0[0], v0[1]); w.y = cvt_pk_bf16(v0[2], v0[3]); w.z = cvt_pk_bf16(v1[0], v1[1]); w.w = cvt_pk_bf16(v1[2], v1[3]);
                    *(u32x4*)(rowp + bj * HALF) = w; } }
    }
};

__device__ __forceinline__ f32x4 mma16(bf16x8 a, bf16x8 b, f32x4 c) { return __builtin_amdgcn_mfma_f32_16x16x32_bf16(a, b, c, 0, 0, 0); }
__device__ __forceinline__ i32x4 mma16(bf16x8 a, bf16x8 b, i32x4 c) { return __builtin_amdgcn_mfma_i32_16x16x64_i8(__builtin_bit_cast(i32x4, a), __builtin_bit_cast(i32x4, b), c, 0, 0, 0); }
template <class Epi, class Sched, bool ALIGN_EPI = false, bool SP2 = false>
__device__ __forceinline__ void gemm_phase(PG8_LAS unsigned char* lds, const Gemm g, const Sched& S, const Epi& E, const int wid  ) {
    const int lane = (int)__builtin_amdgcn_mbcnt_hi(~0u, __builtin_amdgcn_mbcnt_lo(~0u, 0u)), tid = wid * 64 + lane, wr = wid >> 2, wc = wid & 3, fr = lane & 15, fq = lane >> 4;
    const int K = g.K, nt = K / BK;
    unsigned voffA[2], voffB[2];
#pragma unroll
    for (int i = 0; i < 2; ++i) { int R, C; stage_rc(tid * 16 + i * 8192, R, C); const int Rb = Epi::PERM ? ((R & ~31) + perm32(R & 31)) : R;
        voffA[i] = (unsigned)(R * K + C) * 2u; voffB[i] = (unsigned)(Rb * K + C) * 2u; }
    const size_t kstep = (size_t)(BK * 2);
    const size_t hstep = (size_t)HALF * K * 2;
    const size_t tstep = 2 * hstep;
    const unsigned ldsw = (unsigned)wid * 1024u;
    const int aoff = lds_byte(wr * 64 + fr, fq * 8), boff = lds_byte(wc * 32 + fr, fq * 8);
#define PG8_SA(b, h) (((b) * 2 + (h)) * HTB)
#define PG8_SB(b, h) ((4 + (b) * 2 + (h)) * HTB)
#define PG8_STAGE(bufoff, gbase, voff) do { _Pragma("unroll") for (int _i = 0; _i < 2; ++_i) \
        __builtin_amdgcn_global_load_lds((const unsigned*)((const char*)(gbase) + (voff)[_i]), (PG8_LAS unsigned*)(lds + (bufoff) + ldsw + _i * 8192), 16, 0, 0); } while (0)
#define PG8_LDA(dst, b, h) do { _Pragma("unroll") for (int m = 0; m < 4; ++m) _Pragma("unroll") for (int k = 0; k < 2; ++k) dst[m][k] = *(const PG8_LAS bf16x8*)(lds + PG8_SA(b, h) + aoff + m * 2048 + k * 1024); } while (0)
#define PG8_LDB(dst, b, h) do { _Pragma("unroll") for (int n = 0; n < 2; ++n) _Pragma("unroll") for (int k = 0; k < 2; ++k) dst[n][k] = *(const PG8_LAS bf16x8*)(lds + PG8_SB(b, h) + boff + n * 2048 + k * 1024); } while (0)
#define PG8_MMA(ai, bj, At, Bt) do { __builtin_amdgcn_s_setprio(1); _Pragma("unroll") for (int m = 0; m < 4; ++m) _Pragma("unroll") for (int n = 0; n < 2; ++n) _Pragma("unroll") for (int k = 0; k < 2; ++k) \
        acc[ai][bj][m][n] = mma16(Bt[n][k], At[m][k], acc[ai][bj][m][n]); __builtin_amdgcn_s_setprio(0); } while (0)
#define PG8_WAIT_V(n) asm volatile("s_waitcnt vmcnt(" #n ")" ::: "memory")
#define PG8_WAIT_L(n) asm volatile("s_waitcnt lgkmcnt(" #n ")" ::: "memory")
#define PG8_BAR __builtin_amdgcn_s_barrier()
#define PG8_SCHED __builtin_amdgcn_sched_barrier(0)
    Unit cur, nxt; int ui = 0;
    if (!S.next(0, cur)) return;
    typedef typename Epi::acc_t acc_t;
    acc_t acc[2][2][4][2];
#pragma unroll
    for (int a = 0; a < 2; ++a)
#pragma unroll
        for (int b = 0; b < 2; ++b)
#pragma unroll
            for (int m = 0; m < 4; ++m)
#pragma unroll
                for (int n = 0; n < 2; ++n) acc[a][b][m][n] = acc_t{};
    bf16x8 At[4][2], B0[2][2], B1[2][2];
    const char* cA = (const char*)g.A + (size_t)cur.pm * tstep; const char* cB = (const char*)g.Bt + (size_t)cur.pn * tstep;
    S.a_ready(cur);
    if constexpr (SP2) {
        PG8_STAGE(PG8_SB(0, 0), cB, voffB); PG8_STAGE(PG8_SB(0, 1), cB + hstep, voffB); PG8_STAGE(PG8_SA(0, 0), cA, voffA); PG8_STAGE(PG8_SA(0, 1), cA + hstep, voffA);
        if (wr == 1) PG8_BAR;
        PG8_WAIT_V(2); PG8_BAR;
        PG8_STAGE(PG8_SB(1, 0), cB + kstep, voffB); PG8_STAGE(PG8_SA(1, 0), cA + kstep, voffA); PG8_STAGE(PG8_SB(1, 1), cB + hstep + kstep, voffB);
        PG8_WAIT_V(6); PG8_BAR;
    } else {
        PG8_STAGE(PG8_SB(0, 0), cB, voffB); PG8_STAGE(PG8_SA(0, 0), cA, voffA); PG8_STAGE(PG8_SB(0, 1), cB + hstep, voffB); PG8_STAGE(PG8_SA(0, 1), cA + hstep, voffA);
        if (wr == 1) PG8_BAR;
        PG8_WAIT_V(4); PG8_BAR;
        PG8_STAGE(PG8_SB(1, 0), cB + kstep, voffB); PG8_STAGE(PG8_SA(1, 0), cA + kstep, voffA); PG8_STAGE(PG8_SB(1, 1), cB + hstep + kstep, voffB);
        PG8_WAIT_V(6); PG8_BAR;
    }
    for (;;) {
        const bool has_next = S.next(ui + 1, nxt);
        const char* nA = has_next ? (const char*)g.A + (size_t)nxt.pm * tstep : cA; const char* nB = has_next ? (const char*)g.Bt + (size_t)nxt.pn * tstep : cB;
        for (int t = 0; t < nt; t += 2) {
            const bool last = (t == nt - 2);
            const char* a1 = cA + (size_t)(t + 1) * kstep;
            const char* a2 = last ? nA : cA + (size_t)(t + 2) * kstep; const char* b2 = last ? nB : cB + (size_t)(t + 2) * kstep;
            const char* a3 = a2 + kstep; const char* b3 = b2 + kstep;
            if (last && has_next) S.a_ready(nxt);
            if constexpr (SP2) {
            PG8_LDB(B0, 0, 0); PG8_LDB(B1, 0, 1); PG8_SCHED; PG8_LDA(At, 0, 0); PG8_STAGE(PG8_SA(1, 1), a1 + hstep, voffA);
            PG8_WAIT_V(8); PG8_WAIT_L(0); PG8_BAR; PG8_MMA(0, 0, At, B0); PG8_MMA(0, 1, At, B1); PG8_BAR; PG8_SCHED;
            PG8_LDA(At, 0, 1); PG8_STAGE(PG8_SB(0, 0), b2, voffB); PG8_STAGE(PG8_SB(0, 1), b2 + hstep, voffB); PG8_STAGE(PG8_SA(0, 0), a2, voffA);
            PG8_WAIT_V(8); PG8_WAIT_L(0); PG8_BAR; PG8_MMA(1, 0, At, B0); PG8_MMA(1, 1, At, B1); PG8_BAR; PG8_SCHED;
            PG8_LDB(B0, 1, 0); PG8_LDB(B1, 1, 1); PG8_SCHED; PG8_LDA(At, 1, 0); PG8_STAGE(PG8_SA(0, 1), a2 + hstep, voffA);
            PG8_WAIT_V(8); PG8_WAIT_L(0); PG8_BAR; PG8_MMA(0, 0, At, B0); PG8_MMA(0, 1, At, B1); PG8_BAR; PG8_SCHED;
            PG8_LDA(At, 1, 1); PG8_STAGE(PG8_SB(1, 0), b3, voffB); PG8_STAGE(PG8_SB(1, 1), b3 + hstep, voffB); PG8_STAGE(PG8_SA(1, 0), a3, voffA);
            PG8_WAIT_V(8); PG8_WAIT_L(0); PG8_BAR; PG8_MMA(1, 0, At, B0); PG8_MMA(1, 1, At, B1); PG8_BAR; PG8_SCHED;
            } else {
            PG8_LDB(B0, 0, 0); PG8_SCHED; PG8_LDA(At, 0, 0); PG8_STAGE(PG8_SA(1, 1), a1 + hstep, voffA);
            PG8_WAIT_L(8); PG8_BAR; PG8_WAIT_L(0); PG8_MMA(0, 0, At, B0); PG8_BAR; PG8_SCHED;
            PG8_LDB(B1, 0, 1); PG8_STAGE(PG8_SB(0, 0), b2, voffB);
            PG8_BAR; PG8_WAIT_L(0); PG8_MMA(0, 1, At, B1); PG8_BAR;
            PG8_LDA(At, 0, 1); PG8_STAGE(PG8_SA(0, 0), a2, voffA);
            PG8_BAR; PG8_WAIT_L(0); PG8_MMA(1, 0, At, B0); PG8_BAR; PG8_SCHED;
            PG8_STAGE(PG8_SB(0, 1), b2 + hstep, voffB);
            PG8_WAIT_V(6); PG8_BAR; PG8_MMA(1, 1, At, B1); PG8_BAR;
            PG8_LDB(B0, 1, 0); PG8_SCHED; PG8_LDA(At, 1, 0); PG8_STAGE(PG8_SA(0, 1), a2 + hstep, voffA);
            PG8_WAIT_L(8); PG8_BAR; PG8_WAIT_L(0); PG8_MMA(0, 0, At, B0); PG8_BAR; PG8_SCHED;
            PG8_LDB(B1, 1, 1); PG8_STAGE(PG8_SB(1, 0), b3, voffB);
            PG8_BAR; PG8_WAIT_L(0); PG8_MMA(0, 1, At, B1); PG8_BAR;
            PG8_LDA(At, 1, 1); PG8_STAGE(PG8_SA(1, 0), a3, voffA);
            PG8_BAR; PG8_WAIT_L(0); PG8_MMA(1, 0, At, B0); PG8_BAR; PG8_SCHED;
            PG8_STAGE(PG8_SB(1, 1), b3 + hstep, voffB);
            PG8_WAIT_V(6); PG8_BAR; PG8_MMA(1, 1, At, B1); PG8_BAR;
            }
        }
        if constexpr (ALIGN_EPI) { if (wr == 0) PG8_BAR; }
        if constexpr (!Epi::AFTER_DRAIN) { E(acc, cur, wr, wc, fr, fq); S.done(cur); }
        if (!has_next) break;
#pragma unroll
        for (int a = 0; a < 2; ++a)
#pragma unroll
            for (int b = 0; b < 2; ++b)
#pragma unroll
                for (int m = 0; m < 4; ++m)
#pragma unroll
                    for (int n = 0; n < 2; ++n) acc[a][b][m][n] = acc_t{};
        cur = nxt; cA = nA; cB = nB; ++ui;
        if constexpr (ALIGN_EPI) { if (wr == 1) PG8_BAR; }
    }
    PG8_WAIT_V(0);
    if constexpr (!ALIGN_EPI) { if (wr == 0) PG8_BAR; }
    PG8_BAR;
    if constexpr (Epi::AFTER_DRAIN) { E.fused(acc, cur, wr, wc, fr, fq, lds, wid, lane); S.done(cur); }
#undef PG8_SA
#undef PG8_SB
#undef PG8_STAGE
#undef PG8_LDA
#undef PG8_LDB
#undef PG8_MMA
#undef PG8_WAIT_V
#undef PG8_WAIT_L
#undef PG8_BAR
#undef PG8_SCHED
}
}
#ifndef MK_PER_PHASE
#define MK_PER_PHASE 0
#endif
#ifndef PROBE_PHASE
#define PROBE_PHASE -1
#endif
#ifndef X1_NR
#define X1_NR 2
#endif
#ifndef TABLES_IN_PHASE
#define TABLES_IN_PHASE 0
#endif
constexpr int NWAVES = 8, NTHR = NWAVES * 64;
constexpr int BATCH = 8, SEQ = 4096, D = 1024, M = BATCH * SEQ;
constexpr int INC = 2560;
constexpr int NEXP = 16384, PKN = 128;
constexpr int NQ = 2048;
constexpr float EPS = 1e-6f;
constexpr size_t MiB = 1u << 20;
constexpr size_t WS_CTL = 0, CTL_ZERO_BYTES = MK_PER_PHASE ? (1u << 20) : 64 * 1024;
constexpr size_t WS_MOD = 1 * MiB, WS_WIN = 2 * MiB, WS_WOUT = 7 * MiB, WS_WQ = 9 * MiB, WS_KEYS = 13 * MiB, WS_SGW = 13 * MiB + 512 * 1024;
constexpr size_t WS_SU = 14 * MiB, WS_UT = 16 * MiB, WS_VT = 48 * MiB, WS_H = 80 * MiB, WS_Y = 144 * MiB, WS_OATT = 80 * MiB, WS_Z = 208 * MiB, WS_QP = 208 * MiB;
constexpr size_t WS_H8 = 336 * MiB;
constexpr size_t WS_CAT = 368 * MiB, WS_IDX = 432 * MiB, WS_GATE = 448 * MiB, WS_END = 464 * MiB;
constexpr int CW_BAR = 4096;
constexpr int RING_BYTES = 131072, LDSCTL_OFF = RING_BYTES, MISC_OFF = LDSCTL_OFF + 320, LDS_BYTES = 147456;
constexpr int NPHASE = 10;

#define GAS __attribute__((address_space(1)))
#define LAS __attribute__((address_space(3)))
typedef unsigned short bf16;
typedef unsigned v4u __attribute__((ext_vector_type(4)));
typedef unsigned v2u __attribute__((ext_vector_type(2)));
typedef float f32x4 __attribute__((ext_vector_type(4)));
typedef short bf16x8 __attribute__((ext_vector_type(8)));
typedef GAS unsigned gu32;
typedef GAS unsigned long long gu64;
#define RLX_AGENT __ATOMIC_RELAXED, __HIP_MEMORY_SCOPE_AGENT
#define LDS_WAIT() asm volatile("s_waitcnt lgkmcnt(0)" ::: "memory")
#define VM_WAIT() asm volatile("s_waitcnt vmcnt(0)" ::: "memory")
__device__ __forceinline__ unsigned f2bf(float f) { unsigned u = __builtin_bit_cast(unsigned, f); return (u + 0x7fffu + ((u >> 16) & 1u)) >> 16; }
__device__ __forceinline__ unsigned pk2(float lo, float hi) { return f2bf(lo) | (f2bf(hi) << 16); }
__device__ __forceinline__ float bflo(unsigned w) { return __uint_as_float(w << 16); }
__device__ __forceinline__ float bfhi(unsigned w) { return __uint_as_float(w & 0xffff0000u); }
__device__ __forceinline__ float bf2f(bf16 b) { return __uint_as_float((unsigned)b << 16); }
typedef __bf16 bf16x2_t __attribute__((ext_vector_type(2)));
__device__ __forceinline__ float dot2(unsigned a, unsigned b, float acc) { return __builtin_amdgcn_fdot2_f32_bf16(__builtin_bit_cast(bf16x2_t, a), __builtin_bit_cast(bf16x2_t, b), acc, false); }
__device__ __forceinline__ float gelu_t(float v) { const float u = v * (1.f + 0.044715f * v * v); return v * __builtin_amdgcn_rcpf(1.f + __builtin_amdgcn_exp2f(-2.302208198f * u)); }
__device__ __forceinline__ int lane_id() { return (int)__builtin_amdgcn_mbcnt_hi(~0u, __builtin_amdgcn_mbcnt_lo(~0u, 0u)); }
__device__ __forceinline__ float wave_sum(float v) {
#pragma unroll
    for (int o = 1; o < 64; o <<= 1) v += __shfl_xor(v, o);
    return v;
}
#define DPP_SUM_ROW(v) do { v += __uint_as_float((unsigned)__builtin_amdgcn_update_dpp(0, (int)__float_as_uint(v), 0xB1, 0xF, 0xF, false)); \
        v += __uint_as_float((unsigned)__builtin_amdgcn_update_dpp(0, (int)__float_as_uint(v), 0x4E, 0xF, 0xF, false)); \
        v += __uint_as_float((unsigned)__builtin_amdgcn_update_dpp(0, (int)__float_as_uint(v), 0x141, 0xF, 0xF, false)); \
        v += __uint_as_float((unsigned)__builtin_amdgcn_update_dpp(0, (int)__float_as_uint(v), 0x140, 0xF, 0xF, false)); } while (0)
__device__ __forceinline__ float dpp_xor1(float v) { return __uint_as_float((unsigned)__builtin_amdgcn_update_dpp(0, (int)__float_as_uint(v), 0xB1, 0xF, 0xF, false)); }
__device__ __forceinline__ float wave_sum_dpp(float v) {
    DPP_SUM_ROW(v);
    const float r0 = __uint_as_float(__builtin_amdgcn_readlane(__float_as_uint(v), 0)), r1 = __uint_as_float(__builtin_amdgcn_readlane(__float_as_uint(v), 16));
    const float r2 = __uint_as_float(__builtin_amdgcn_readlane(__float_as_uint(v), 32)), r3 = __uint_as_float(__builtin_amdgcn_readlane(__float_as_uint(v), 48));
    return (r0 + r1) + (r2 + r3);
}
__device__ __forceinline__ float wave_max_dpp(float v) {
    v = fmaxf(v, __uint_as_float((unsigned)__builtin_amdgcn_update_dpp(0, (int)__float_as_uint(v), 0xB1, 0xF, 0xF, false)));
    v = fmaxf(v, __uint_as_float((unsigned)__builtin_amdgcn_update_dpp(0, (int)__float_as_uint(v), 0x4E, 0xF, 0xF, false)));
    v = fmaxf(v, __uint_as_float((unsigned)__builtin_amdgcn_update_dpp(0, (int)__float_as_uint(v), 0x141, 0xF, 0xF, false)));
    v = fmaxf(v, __uint_as_float((unsigned)__builtin_amdgcn_update_dpp(0, (int)__float_as_uint(v), 0x140, 0xF, 0xF, false)));
    const float r0 = __uint_as_float(__builtin_amdgcn_readlane(__float_as_uint(v), 0)), r1 = __uint_as_float(__builtin_amdgcn_readlane(__float_as_uint(v), 16));
    const float r2 = __uint_as_float(__builtin_amdgcn_readlane(__float_as_uint(v), 32)), r3 = __uint_as_float(__builtin_amdgcn_readlane(__float_as_uint(v), 48));
    return fmaxf(fmaxf(r0, r1), fmaxf(r2, r3));
}
__device__ __forceinline__ float half_max_dpp(float v) {
    v = fmaxf(v, __uint_as_float((unsigned)__builtin_amdgcn_update_dpp(0, (int)__float_as_uint(v), 0xB1, 0xF, 0xF, false)));
    v = fmaxf(v, __uint_as_float((unsigned)__builtin_amdgcn_update_dpp(0, (int)__float_as_uint(v), 0x4E, 0xF, 0xF, false)));
    v = fmaxf(v, __uint_as_float((unsigned)__builtin_amdgcn_update_dpp(0, (int)__float_as_uint(v), 0x141, 0xF, 0xF, false)));
    v = fmaxf(v, __uint_as_float((unsigned)__builtin_amdgcn_update_dpp(0, (int)__float_as_uint(v), 0x140, 0xF, 0xF, false)));
    const float r0 = __uint_as_float(__builtin_amdgcn_readlane(__float_as_uint(v), 0)), r1 = __uint_as_float(__builtin_amdgcn_readlane(__float_as_uint(v), 16));
    const float r2 = __uint_as_float(__builtin_amdgcn_readlane(__float_as_uint(v), 32)), r3 = __uint_as_float(__builtin_amdgcn_readlane(__float_as_uint(v), 48));
    return (lane_id() < 32) ? fmaxf(r0, r1) : fmaxf(r2, r3);
}
__device__ __forceinline__ float wave_max(float v) {
#pragma unroll
    for (int o = 1; o < 64; o <<= 1) v = fmaxf(v, __shfl_xor(v, o));
    return v;
}
#define XB_TMO      128
#define XB_XCNT(j)  (256  + 64 * (j))
#define XB_XSUB(j)  (1280 + 64 * (j))
#define XB_XGEN(j)  (2304 + 64 * (j))
#define XB_TOP      3328
#define XB_TOPGEN   3392
#define XCD_BAR_WORDS 3456
#define XB_SPIN_CAP (1u << 18)

__device__ __forceinline__ unsigned xb_ld(unsigned* p)              { return __hip_atomic_load(p, __ATOMIC_RELAXED, __HIP_MEMORY_SCOPE_AGENT); }
__device__ __forceinline__ unsigned xb_add(unsigned* p, unsigned v) { return __hip_atomic_fetch_add(p, v, __ATOMIC_RELAXED, __HIP_MEMORY_SCOPE_AGENT); }
__device__ __forceinline__ unsigned xb_xcc_id() { return (unsigned)__builtin_amdgcn_s_getreg((3 << 11) | 20) & 0xFu; }
#define XB_SPIN(cond, bar) do { unsigned _sp = 0; while (cond) { __builtin_amdgcn_s_sleep(1); \
    if ((++_sp & 255u) == 0u) { if (xb_ld(&(bar)[XB_TMO])) break; if (_sp > XB_SPIN_CAP) { atomicAdd(&(bar)[XB_TMO], 1u); break; } } } } while (0)

struct XcdBarrier {
    unsigned* bar; unsigned x;
    volatile LAS unsigned* st;
};

__device__ __forceinline__ XcdBarrier xcd_barrier_post(unsigned* bar, volatile LAS unsigned* st) {
    XcdBarrier b; b.bar = bar; b.x = xb_xcc_id(); b.st = st;
    if (threadIdx.x == 0) (void)xb_add(&bar[XB_XCNT(b.x)], 1u);
    return b;
}
__device__ __forceinline__ void xcd_barrier_complete(unsigned* bar, unsigned x, unsigned& nloc, unsigned& nx) {
    const unsigned G = gridDim.x * gridDim.y * gridDim.z;
    unsigned sum, cnt, mine, sp = 0u;
    for (;;) {
        sum = 0u; cnt = 0u; mine = 0u;
#pragma unroll
        for (unsigned j = 0; j < 16; ++j) { const unsigned c = xb_ld(&bar[XB_XCNT(j)]); sum += c; cnt += (c > 0u) ? 1u : 0u; mine = (j == x) ? c : mine; }
        if (sum == G) break;
        __builtin_amdgcn_s_sleep(1);
        if ((++sp & 255u) == 0u) { if (xb_ld(&bar[XB_TMO])) break; if (sp > XB_SPIN_CAP) { atomicAdd(&bar[XB_TMO], 1u); break; } }
    }
    nloc = mine > 0u ? mine : 1u; nx = cnt > 0u ? cnt : 1u;
}

__device__ __forceinline__ void xcd_barrier(const XcdBarrier& b) {
    asm volatile("s_waitcnt vmcnt(0)" ::: "memory");
    __syncthreads();
    if (threadIdx.x == 0) {
        unsigned* bar = b.bar;
        __builtin_amdgcn_s_waitcnt(0);
        unsigned nloc = b.st[0], nx = b.st[1];
        if (nloc == 0u) { xcd_barrier_complete(bar, b.x, nloc, nx); b.st[0] = nloc; b.st[1] = nx; }
        const unsigned old = xb_add(&bar[XB_XSUB(b.x)], 1u);
        const unsigned gen = old / nloc;
        if (old + 1u == (gen + 1u) * nloc) {
            __builtin_amdgcn_fence(__ATOMIC_RELEASE, "agent");
            asm volatile("s_waitcnt vmcnt(0)" ::: "memory");
            const unsigned og = xb_add(&bar[XB_TOP], 1u);
            const unsigned tg = og / nx;
            if (og + 1u == (tg + 1u) * nx) xb_add(&bar[XB_TOPGEN], 1u);
            else XB_SPIN(xb_ld(&bar[XB_TOPGEN]) == tg, bar);
            __builtin_amdgcn_fence(__ATOMIC_ACQUIRE, "agent");
            xb_add(&bar[XB_XGEN(b.x)], 1u);
            asm volatile("s_waitcnt vmcnt(0)" ::: "memory");
        } else {
            XB_SPIN(xb_ld(&bar[XB_XGEN(b.x)]) == gen, bar);
            __builtin_amdgcn_fence(__ATOMIC_ACQUIRE, "agent");
            asm volatile("s_waitcnt vmcnt(0)" ::: "memory");
        }
    }
    __syncthreads();
}
struct Frame {
    LAS unsigned char* lds;
    volatile LAS unsigned* MISC;
    gu32* ctl;
    int wave, G;
    const float *x, *c, *w_ada, *b_ada, *norm_g, *w_in, *sgu_ln_g, *sgu_ln_b, *sgu_w, *sgu_b, *diff_lambda, *subln_g, *rel_bias, *w_out, *w_query, *sub_keys, *peer_u, *peer_v;
    float* out;
    float* mod; bf16 *WIN, *WOUT, *WQ, *KEYS, *SGW, *H, *Y, *Z, *QP, *CAT; unsigned char *UT8, *VT6, *H8, *HA8, *W8, *WQ8; float *HS, *HAS, *WS8, *WQS8; float *SU, *SV, *PART; unsigned* STASH; int* IDX; float* GATE;
};

__device__ __forceinline__ void p0_transpose_item(const float* W, int K, int N, bf16* WT, int row_off, LAS float* scr, int item, int lane) {
    const int nblk = N / 32, kb = item / nblk, nb = item % nblk, k0 = 64 * kb, n0 = 32 * nb;
#pragma unroll 8
    for (int i = 0; i < 32; ++i) { const int kk = 2 * i + (lane >> 5); scr[kk * 33 + (lane & 31)] = W[(size_t)(k0 + kk) * N + n0 + (lane & 31)]; }
    LDS_WAIT(); asm volatile("" ::: "memory");
    const int c = lane & 7;
#pragma unroll
    for (int j = 0; j < 4; ++j) { const int n = (lane >> 3) + 8 * j; const LAS float* s = scr + (8 * c) * 33 + n;
        v4u o; o.x = pk2(s[0 * 33], s[1 * 33]); o.y = pk2(s[2 * 33], s[3 * 33]); o.z = pk2(s[4 * 33], s[5 * 33]); o.w = pk2(s[6 * 33], s[7 * 33]);
        *(GAS v4u*)(WT + (size_t)(row_off + n0 + n) * K + k0 + 8 * c) = o; }
    LDS_WAIT(); asm volatile("" ::: "memory");
}

__device__ __forceinline__ void prologue_tables_fwd(Frame& F, int gw, int NGW, int lane);
__device__ __forceinline__ void ph_prologue(Frame& F) {
    const int lane = lane_id(), wave = F.wave, tid = wave * 64 + lane, G = F.G;
    const int gw = blockIdx.x * NWAVES + wave, NGW = G * NWAVES;
    for (int rep_ = 0; rep_ < (PROBE_PHASE == 100 ? 2 : 1); ++rep_) {
        LAS float* sil = (LAS float*)F.lds;
        LAS float* red = sil + 8192;
        for (int i = tid; i < 8192; i += NTHR) { const float cv = F.c[i]; sil[i] = cv / (1.f + __expf(-cv)); }
        __syncthreads();
        for (int u = blockIdx.x; u < 384; u += G) {
            const int j = u * 16 + (lane & 15), kr = lane >> 4, k0 = wave * 128;
            float acc[8];
#pragma unroll
            for (int b = 0; b < 8; ++b) acc[b] = 0.f;
            const float* wp = F.w_ada + (size_t)(k0 + kr) * 6144 + j;
#pragma unroll 16
            for (int i = 0; i < 32; ++i) { const float w = wp[(size_t)i * 4 * 6144]; const int k = k0 + 4 * i + kr;
#pragma unroll
                for (int b = 0; b < 8; ++b) acc[b] += sil[b * 1024 + k] * w; }
#pragma unroll
            for (int b = 0; b < 8; ++b) { acc[b] += __shfl_xor(acc[b], 16); acc[b] += __shfl_xor(acc[b], 32); }
            if (lane < 16) {
#pragma unroll
                for (int b = 0; b < 8; ++b) red[(wave * 8 + b) * 16 + lane] = acc[b]; }
            __syncthreads();
            if (tid < 128) { const int b = tid >> 4, c = tid & 15; float s = 0.f;
#pragma unroll
                for (int w = 0; w < 8; ++w) s += red[(w * 8 + b) * 16 + c];
                F.mod[b * 6144 + u * 16 + c] = s + F.b_ada[u * 16 + c]; }
            __syncthreads();
        }
    }
    LAS float* scr = (LAS float*)(F.lds + wave * 16384);
    {
        LAS float* part = (LAS float*)(F.lds + 7 * 16384 + 8704);
        LAS float* fin = part + 256;
        const int n = lane & 31, hf = lane >> 5;
        for (int u = blockIdx.x; u < (INC + NQ) / 32; u += G) {
            const bool isq = u >= INC / 32;
            const float* Wsrc = isq ? F.w_query : F.w_in; const int Nw = isq ? NQ : INC; unsigned char* Wdst = isq ? F.WQ8 : F.W8; float* Sdst = isq ? F.WQS8 : F.WS8;
            const int n0 = (isq ? u - INC / 32 : u) * 32;
            float am = 0.f;
            { const float* wp = Wsrc + (size_t)(wave * 128 + hf) * Nw + n0 + n;
#pragma unroll 16
              for (int i = 0; i < 64; ++i) am = fmaxf(am, fabsf(wp[(size_t)(2 * i) * Nw])); }
            { auto rr = __builtin_amdgcn_permlane32_swap(__float_as_uint(am), __float_as_uint(am), false, false); am = fmaxf(__uint_as_float(rr[0]), __uint_as_float(rr[1])); }
            if (lane < 32) part[wave * 32 + lane] = am;
            __syncthreads();
            if (tid < 32) { float mx = 0.f;
#pragma unroll
                for (int w = 0; w < 8; ++w) mx = fmaxf(mx, part[w * 32 + tid]);
                fin[tid] = mx; Sdst[n0 + tid] = mx > 0.f ? mx * (1.f / 127.f) : 1.f; }
            __syncthreads();
            const float cmx = fin[n]; const float sc = cmx > 0.f ? 127.f / cmx : 1.f;
#pragma unroll 1
            for (int q = 0; q < 2; ++q) { const int k0 = (wave * 2 + q) * 64;
#pragma unroll 8
                for (int i = 0; i < 32; ++i) { const int kk = 2 * i + hf; scr[kk * 33 + n] = Wsrc[(size_t)(k0 + kk) * Nw + n0 + n]; }
                LDS_WAIT(); asm volatile("" ::: "memory");
                unsigned w8[8];
#pragma unroll
                for (int d = 0; d < 8; ++d) { const LAS float* s = scr + (32 * hf + 4 * d) * 33 + n;
                    const int q0 = (int)rintf(s[0] * sc), q1 = (int)rintf(s[33] * sc), q2 = (int)rintf(s[66] * sc), q3 = (int)rintf(s[99] * sc);
                    w8[d] = (unsigned)((q0 & 255) | ((q1 & 255) << 8) | ((q2 & 255) << 16) | (q3 << 24)); }
                unsigned char* op = Wdst + (size_t)(n0 + n) * D + k0 + 32 * hf;
                *(GAS v4u*)op = (v4u){w8[0], w8[1], w8[2], w8[3]}; *(GAS v4u*)(op + 16) = (v4u){w8[4], w8[5], w8[6], w8[7]};
                LDS_WAIT(); asm volatile("" ::: "memory"); }
            __syncthreads();
        }
    }
    constexpr int I_IN = 0, I_OUT = (D / 64) * (D / 32), I_Q = 0;
    for (int rep_ = 0; rep_ < (PROBE_PHASE == 101 ? 2 : 1); ++rep_)
    for (int it = gw; it < I_IN + I_OUT + I_Q; it += NGW) {
        int r = it;
        if (r < I_IN) { p0_transpose_item(F.w_in, D, INC, F.WIN, 0, scr, r, lane); continue; } r -= I_IN;
        if (r < I_OUT) { p0_transpose_item(F.w_out, D, D, F.WOUT, 0, scr, r, lane); continue; } r -= I_OUT;
        (void)r;
    }
    const int gt = blockIdx.x * NTHR + tid, NT = G * NTHR;
    if (TABLES_IN_PHASE == 0) for (int rep_ = 0; rep_ < (PROBE_PHASE == 102 ? 2 : 1); ++rep_) prologue_tables_fwd(F, gw, NGW, lane);
    for (int i = gt; i < 16 * 16 * 128; i += NT) {
        const int hc = i >> 11, dg = (i >> 7) & 15, n = i & 127;
        const float* s = F.sub_keys + ((size_t)(hc * 128 + n)) * 128 + dg * 8;
        const f32x4 a = *(const f32x4*)s, b = *(const f32x4*)(s + 4);
        v4u o; o.x = pk2(a.x, a.y); o.y = pk2(a.z, a.w); o.z = pk2(b.x, b.y); o.w = pk2(b.z, b.w); ((v4u*)F.KEYS)[i] = o;
    }
    for (int i = gt; i < 8 * 128 * 16; i += NT) {
        const int t = (i >> 4) & 127, s0 = (i & 15) * 8;
        const float* s = F.sgu_w + (size_t)i * 8;
        const f32x4 a = *(const f32x4*)s, b = *(const f32x4*)(s + 4);
        float f[8] = {a.x, a.y, a.z, a.w, b.x, b.y, b.z, b.w};
#pragma unroll
        for (int e = 0; e < 8; ++e) f[e] = (s0 + e <= t) ? f[e] : 0.f;
        v4u o; o.x = pk2(f[0], f[1]); o.y = pk2(f[2], f[3]); o.z = pk2(f[4], f[5]); o.w = pk2(f[6], f[7]); ((v4u*)F.SGW)[i] = o;
    }
}

__device__ __forceinline__ void ph_hrows(Frame& F) {
    const int lane = lane_id(); const int gw = blockIdx.x * NWAVES + F.wave, NGW = F.G * NWAVES;
    for (int m0 = gw; m0 < M; m0 += 2 * NGW) {
        const int m1 = (m0 + NGW < M) ? m0 + NGW : m0;
        f32x4 v[2][4]; float ss[2] = {0.f, 0.f};
#pragma unroll
        for (int u = 0; u < 2; ++u) { const f32x4* xr = (const f32x4*)(F.x + (size_t)(u ? m1 : m0) * D) + lane;
#pragma unroll
            for (int j = 0; j < 4; ++j) v[u][j] = xr[64 * j]; }
#pragma unroll
        for (int u = 0; u < 2; ++u)
#pragma unroll
            for (int j = 0; j < 4; ++j) ss[u] += (v[u][j].x * v[u][j].x + v[u][j].y * v[u][j].y) + (v[u][j].z * v[u][j].z + v[u][j].w * v[u][j].w);
        const float r0 = rsqrtf(wave_sum_dpp(ss[0]) * (1.f / D) + EPS), r1 = rsqrtf(wave_sum_dpp(ss[1]) * (1.f / D) + EPS);
#pragma unroll
        for (int u = 0; u < 2; ++u) { const int m = u ? m1 : m0; const float rstd = u ? r1 : r0;
            const float* md = F.mod + (m >> 12) * 6144;
            float am = 0.f;
#pragma unroll
            for (int j = 0; j < 4; ++j) { const int c = 256 * j + 4 * lane;
                const f32x4 g = *(const f32x4*)(F.norm_g + c), sc = *(const f32x4*)(md + 1024 + c), sh = *(const f32x4*)(md + c);
                const f32x4 hv = v[u][j] * rstd * g * (sc + 1.f) + sh; v[u][j] = hv;
                am = fmaxf(am, fmaxf(fmaxf(fabsf(hv.x), fabsf(hv.y)), fmaxf(fabsf(hv.z), fabsf(hv.w)))); }
            am = wave_max_dpp(am);
            const float s8 = am > 0.f ? 127.f / am : 1.f;
            unsigned* h8 = (unsigned*)(F.HA8 + (size_t)m * D) + lane;
#pragma unroll
            for (int j = 0; j < 4; ++j) { const int q0 = (int)rintf(v[u][j].x * s8), q1 = (int)rintf(v[u][j].y * s8), q2 = (int)rintf(v[u][j].z * s8), q3 = (int)rintf(v[u][j].w * s8);
                if (u == 0 || m1 != m0) h8[64 * j] = (unsigned)((q0 & 255) | ((q1 & 255) << 8) | ((q2 & 255) << 16) | (q3 << 24)); }
            if (lane == 0 && (u == 0 || m1 != m0)) F.HAS[m] = 1.f / s8; }
    }
}

__device__ __forceinline__ void ph_x1rows(Frame& F) {
    const int lane = lane_id(); const int gw = blockIdx.x * NWAVES + F.wave, NGW = F.G * NWAVES;
    constexpr int NR = X1_NR;
    for (int m0 = gw; m0 < M; m0 += NR * NGW) {
        int mr[NR]; bool ok[NR];
#pragma unroll
        for (int u = 0; u < NR; ++u) { ok[u] = (m0 + u * NGW < M); mr[u] = ok[u] ? m0 + u * NGW : m0; }
        f32x4 xv[NR][4], yv[NR][4]; float ss[NR];
#pragma unroll
        for (int u = 0; u < NR; ++u) { const int m = mr[u]; ss[u] = 0.f;
            const f32x4* xr = (const f32x4*)(F.x + (size_t)m * D) + lane; const v2u* yr = (const v2u*)(F.Y + (size_t)m * D) + lane;
#pragma unroll
            for (int j = 0; j < 4; ++j) { xv[u][j] = xr[64 * j]; const v2u w = yr[64 * j]; yv[u][j] = (f32x4){bflo(w.x), bfhi(w.x), bflo(w.y), bfhi(w.y)}; } }
#pragma unroll
        for (int u = 0; u < NR; ++u)
#pragma unroll
            for (int j = 0; j < 4; ++j) ss[u] += (yv[u][j].x * yv[u][j].x + yv[u][j].y * yv[u][j].y) + (yv[u][j].z * yv[u][j].z + yv[u][j].w * yv[u][j].w);
        float rs[NR], s1[NR];
#pragma unroll
        for (int u = 0; u < NR; ++u) { rs[u] = rsqrtf(wave_sum_dpp(ss[u]) * (1.f / D) + EPS); s1[u] = 0.f; }
#pragma unroll
        for (int u = 0; u < NR; ++u) { const int m = mr[u]; const float* md = F.mod + (m >> 12) * 6144; const float rstd = rs[u];
            f32x4* orow = (f32x4*)(F.out + (size_t)m * D) + lane;
#pragma unroll
            for (int j = 0; j < 4; ++j) { const int c = 256 * j + 4 * lane;
                const f32x4 g1 = *(const f32x4*)(F.norm_g + 1024 + c), gt = *(const f32x4*)(md + 2048 + c);
                xv[u][j] = xv[u][j] + gt * (yv[u][j] * rstd * g1); if (ok[u]) orow[64 * j] = xv[u][j];
                s1[u] += (xv[u][j].x * xv[u][j].x + xv[u][j].y * xv[u][j].y) + (xv[u][j].z * xv[u][j].z + xv[u][j].w * xv[u][j].w); } }
        float r1v[NR];
#pragma unroll
        for (int u = 0; u < NR; ++u) r1v[u] = rsqrtf(wave_sum_dpp(s1[u]) * (1.f / D) + EPS);
#pragma unroll
        for (int u = 0; u < NR; ++u) { const int m = mr[u]; const float* md = F.mod + (m >> 12) * 6144; const float r1 = r1v[u];
#pragma unroll
            for (int j = 0; j < 4; ++j) { const int c = 256 * j + 4 * lane;
                const f32x4 g2 = *(const f32x4*)(F.norm_g + 2048 + c), sc = *(const f32x4*)(md + 4096 + c), sh = *(const f32x4*)(md + 3072 + c);
                const f32x4 hv = xv[u][j] * r1 * g2 * (sc + 1.f) + sh; xv[u][j] = hv;
                }
            float am = 0.f;
#pragma unroll
            for (int j = 0; j < 4; ++j) am = fmaxf(am, fmaxf(fmaxf(fabsf(xv[u][j].x), fabsf(xv[u][j].y)), fmaxf(fabsf(xv[u][j].z), fabsf(xv[u][j].w))));
            am = wave_max_dpp(am);
            const float s8 = am > 0.f ? 127.f / am : 1.f;
            unsigned* h8 = (unsigned*)(F.H8 + (size_t)m * D) + lane;
#pragma unroll
            for (int j = 0; j < 4; ++j) { const int q0 = (int)rintf(xv[u][j].x * s8), q1 = (int)rintf(xv[u][j].y * s8), q2 = (int)rintf(xv[u][j].z * s8), q3 = (int)rintf(xv[u][j].w * s8);
                if (ok[u]) h8[64 * j] = (unsigned)((q0 & 255) | ((q1 & 255) << 8) | ((q2 & 255) << 16) | (q3 << 24)); }
            if (lane == 0 && ok[u]) F.HS[m] = 1.f / s8; }
    }
}

namespace att {
typedef float f32x16 __attribute__((ext_vector_type(16)));
typedef short s16x4 __attribute__((ext_vector_type(4)));
typedef short v4i16_t __attribute__((ext_vector_type(4)));
constexpr int QB = 256, KVB = 64;
constexpr int NS = 4;
constexpr int BTO = 288, BTN = 416;
constexpr int L_V = 0, L_K = NS * 16384, L_WS = L_K + NS * 8192, L_BT = L_WS + 2048, L_END = L_BT + 2048;
constexpr float C2 = 0.125f * 1.4426950408889634f;
__device__ __forceinline__ int v_st(int k, int c) { const int kk = (k & ~0xC) | ((k & 4) << 1) | ((k & 8) >> 1); return ((kk >> 3) * 4 + (c >> 5)) * 512 + ((kk & 7) * 32 + (c & 31)) * 2; }
__device__ __forceinline__ int v_rd_base(int lane) { return ((lane & 3) << 3) | (((lane >> 2) & 3) << 6) | (((lane >> 4) & 1) << 5) | (((lane >> 5) & 1) << 8); }
__device__ __forceinline__ unsigned v_src(int p) { const int sub = p >> 5, q = p & 31, kk = (sub >> 2) * 8 + (q >> 2), c = (sub & 3) * 32 + (q & 3) * 8;
    const int k = (kk & ~0xC) | ((kk & 4) << 1) | ((kk & 8) >> 1); return (unsigned)(k * INC + c) * 2u; }
__device__ __forceinline__ int crow(int r, int hi) { return (r & 3) + 8 * (r >> 2) + 4 * hi; }
typedef float f32x2_t __attribute__((ext_vector_type(2))); typedef __bf16 bf16x2_t __attribute__((ext_vector_type(2)));
__device__ __forceinline__ unsigned cvtpk(float lo, float hi) { const f32x2_t v = {lo, hi}; const bf16x2_t b = __builtin_convertvector(v, bf16x2_t); return __builtin_bit_cast(unsigned, b); }

__device__ __forceinline__ void attn_unit(Frame& F, int b, int h, int qb, float lam) {
    int tid = F.wave * 64 + lane_id(); asm volatile("" : "+v"(tid));
    const int lane = tid & 63, wid = F.wave, r32 = lane & 31, hi = lane >> 5;
    LAS unsigned char* lds = F.lds;
    LAS float* wsf = (LAS float*)(lds + L_WS) + wid * 64;
    const LAS float* bt = (const LAS float*)(lds + L_BT);
    const int q0 = qb * QB, qlo = q0 + wid * 32, qpos = qlo + r32;
    const size_t rowb = (size_t)b * SEQ;
    const int NT = (q0 + QB) / KVB;
    const unsigned kdoff = (unsigned)((tid >> 3) * INC + (((tid & 7) ^ ((tid >> 3) & 7)) * 8)) * 2u;
    const unsigned vdoff0 = v_src(tid), vdoff1 = v_src(tid + 512);
    const unsigned qoff = (unsigned)(r32 * INC + hi * 8) * 2u;
#define GLDS16(g_, lb_) do { unsigned sv_; asm volatile("s_mov_b32 %0, m0\n\ts_mov_b32 m0, %2\n\ts_nop 0\n\tglobal_load_lds_dwordx4 %1, off\n\ts_mov_b32 m0, %0" : "=&s"(sv_) : "v"(g_), "s"(lb_) : "memory"); } while (0)
#define DMA_K(t_, buf_) do { unsigned kd_ = kdoff; asm volatile("" : "+v"(kd_)); GLDS16(Kb + (size_t)(t_) * (KVB * INC * 2) + kd_, (unsigned)__builtin_amdgcn_readfirstlane((int)(uintptr_t)(lds + L_K + (buf_) * 8192 + wid * 1024))); } while (0)
#define DMA_V(t_, buf_) do { unsigned v0_ = vdoff0, v1_ = vdoff1; asm volatile("" : "+v"(v0_), "+v"(v1_)); const unsigned lb_ = (unsigned)__builtin_amdgcn_readfirstlane((int)(uintptr_t)(lds + L_V + (buf_) * 16384 + wid * 1024)); \
        GLDS16(Vb + (size_t)(t_) * (KVB * INC * 2) + v0_, lb_); GLDS16(Vb + (size_t)(t_) * (KVB * INC * 2) + v1_, lb_ + 8192u); } while (0)
#define DMA_TILE(t_) do { const int sl_ = (t_) & (NS - 1); DMA_K(t_, sl_); DMA_V(t_, sl_); } while (0)
#define ABAR() do { asm volatile("s_waitcnt lgkmcnt(0)" ::: "memory"); __builtin_amdgcn_s_barrier(); asm volatile("" ::: "memory"); } while (0)
    const int vbase = (int)(uintptr_t)(lds + L_V) + v_rd_base(lane);
    const int kroff = r32 * 128, kx = (r32 & 7) << 4;
#pragma unroll
    for (int c = 0; c < 2; ++c) {
        const char* Kb = (const char*)(F.Z + rowb * INC + 1536 + h * 128 + c * 64);
        const char* Vb = (const char*)(F.Z + rowb * INC + 2048 + h * 128);
        const char* Qb = (const char*)(F.Z + (rowb + qlo) * INC + 1024 + h * 128 + c * 64);
        bf16x8 qr[4];
#pragma unroll
        for (int d0 = 0; d0 < 4; ++d0) qr[d0] = *(const bf16x8*)(Qb + d0 * 32 + qoff);
        DMA_K(0, 0); DMA_V(0, 0); DMA_K(1, 1); DMA_K(2, 2); DMA_V(1, 1); DMA_K(3, 3); DMA_V(2, 2);
        asm volatile("s_waitcnt vmcnt(9)" ::: "memory");
        ABAR();
        float mhat, l = 0.f; bool resc = false;
        f32x16 o[4];
#pragma unroll
        for (int d0 = 0; d0 < 4; ++d0) o[d0] = f32x16{};
        f32x16 pA0, pA1, pB0, pB1; bf16x8 kf[8]; s16x4 vlo[4], vhi[4]; v4u pw0, pw1, pw2, pw3;
#define SBAR() __builtin_amdgcn_sched_barrier(0)
#define PIN(x) asm volatile("" : "+v"(x))
#define MFMA32(a_, b_, c_) __builtin_amdgcn_mfma_f32_32x32x16_bf16(a_, b_, c_, 0, 0, 0)
#define KLD2(su, d0) do { const LAS unsigned char* a_ = lds + L_K + (su) * 8192 + kroff + (((d0) * 32 + hi * 16) ^ kx); kf[2 * (d0)] = *(const LAS bf16x8*)a_; kf[2 * (d0) + 1] = *(const LAS bf16x8*)(a_ + 4096); } while (0)
#define VTR(p_) __builtin_bit_cast(s16x4, __builtin_amdgcn_ds_read_tr16_b64_v4i16((LAS v4i16_t*)(p_)))
#define VRD(i) do { const LAS unsigned char* p_ = vp_ + ((i) >> 2) * 512 + ((i) & 3) * 4096; vlo[(i) & 3] = VTR(p_); vhi[(i) & 3] = VTR(p_ + 2048); } while (0)
#define VFR(i) (bf16x8){vlo[(i) & 3][0], vlo[(i) & 3][1], vlo[(i) & 3][2], vlo[(i) & 3][3], vhi[(i) & 3][0], vhi[(i) & 3][1], vhi[(i) & 3][2], vhi[(i) & 3][3]}
#define PAF(k) __builtin_bit_cast(bf16x8, pw##k)
#define MX3(a_, b_, c_) fmaxf(fmaxf((a_), (b_)), (c_))
#define ROWMAX(P0, P1, OUT) do { float a_ = MX3(P0[0], P0[1], P1[0]), b_ = MX3(P0[2], P0[3], P1[1]); a_ = MX3(a_, P1[2], P1[3]); \
        _Pragma("unroll") for (int r = 4; r < 16; r += 4) { a_ = MX3(a_, P0[r], P0[r + 1]); b_ = MX3(b_, P0[r + 2], P0[r + 3]); a_ = MX3(a_, P1[r], P1[r + 1]); b_ = MX3(b_, P1[r + 2], P1[r + 3]); } \
        float m_ = fmaxf(a_, b_); auto rr_ = __builtin_amdgcn_permlane32_swap(__float_as_uint(m_), __float_as_uint(m_), false, false); OUT = fmaxf(__uint_as_float(rr_[0]), __uint_as_float(rr_[1])); } while (0)
#define FIX_TILE(N0, N1, u) do { if (qlo - (u) * KVB - 63 < 113) { int qp_ = qpos - 4 * hi; asm volatile("" : "+v"(qp_)); const int dq_ = qp_ - (u) * KVB + BTO;     \
        _Pragma("unroll") for (int r = 0; r < 16; ++r) { const int i0_ = dq_ - ((r & 3) + 8 * (r >> 2)), i1_ = i0_ - 32; \
            N0[r] += bt[i0_ > BTN - 1 ? BTN - 1 : i0_]; N1[r] += bt[i1_ > BTN - 1 ? BTN - 1 : (i1_ < 0 ? 0 : i1_)]; } } } while (0)
#define EX(v) __builtin_amdgcn_exp2f(fmaf((v), C2, nmh))
#define RESC() do { if (resc) { _Pragma("unroll") for (int r = 0; r < 16; ++r) { const float a_ = wsf[crow(r, hi)]; _Pragma("unroll") for (int d0 = 0; d0 < 4; ++d0) o[d0][r] *= a_; } } } while (0)
#define PKH0(P, B_, PW) do { const unsigned a0_ = cvtpk(P[B_ + 0], P[B_ + 1]), b0_ = cvtpk(P[B_ + 4], P[B_ + 5]); auto r0_ = __builtin_amdgcn_permlane32_swap(a0_, b0_, false, false); PW.x = r0_[0]; PW.z = r0_[1]; } while (0)
#define PKH1(P, B_, PW) do { const unsigned a1_ = cvtpk(P[B_ + 2], P[B_ + 3]), b1_ = cvtpk(P[B_ + 6], P[B_ + 7]); auto r1_ = __builtin_amdgcn_permlane32_swap(a1_, b1_, false, false); PW.y = r1_[0]; PW.w = r1_[1]; } while (0)
#define GAPA(MF, a0, a1, a2, a3, PK, PW) do { MF; sacc += a0; sacc += a1; sacc += a2; sacc += a3; PK; PIN(PW); PIN(sacc); SBAR(); } while (0)
#define GAPB(MF, X, i) do { MF; X[i] = EX(X[i]); X[i + 1] = EX(X[i + 1]); PIN(X); SBAR(); } while (0)
#pragma unroll
        for (int d0 = 0; d0 < 4; ++d0) KLD2(0, d0);
        pA0 = MFMA32(kf[0], qr[0], f32x16{}); pA1 = MFMA32(kf[1], qr[0], f32x16{}); pA0 = MFMA32(kf[2], qr[1], pA0); pA1 = MFMA32(kf[3], qr[1], pA1);
        pA0 = MFMA32(kf[4], qr[2], pA0); pA1 = MFMA32(kf[5], qr[2], pA1); pA0 = MFMA32(kf[6], qr[3], pA0); pA1 = MFMA32(kf[7], qr[3], pA1);
        FIX_TILE(pA0, pA1, 0);
        { float rm; ROWMAX(pA0, pA1, rm); mhat = rm * C2; const float nmh = -mhat;
#pragma unroll
          for (int r = 0; r < 16; ++r) { pA0[r] = EX(pA0[r]); pA1[r] = EX(pA1[r]); } }
        asm volatile("s_waitcnt vmcnt(5)" ::: "memory");
        ABAR();
        KLD2(1, 0); KLD2(1, 1);
#define STEP(C0, C1, P0, P1, t) do { SBAR(); \
        if ((t) + 3 < NT) DMA_K((t) + 3, ((t) + 3) & (NS - 1)); if ((t) + 2 < NT) DMA_V((t) + 2, ((t) + 2) & (NS - 1)); \
        const LAS unsigned char* vp_ = (const LAS unsigned char*)(uintptr_t)(vbase + (((t) - 1) & (NS - 1)) * 16384); \
        const int ksl_ = ((t) + 1) & (NS - 1); const bool gl_ = (t) + 1 < NT; \
        float sacc = 0.f; \
        KLD2((t) & (NS - 1), 2); SBAR(); GAPA(C0 = MFMA32(kf[0], qr[0], f32x16{}), P0[0], P0[1], P0[2], P0[3],     PKH0(P0, 0, pw0), pw0); \
        KLD2((t) & (NS - 1), 3); SBAR(); GAPA(C1 = MFMA32(kf[1], qr[0], f32x16{}), P0[4], P0[5], P0[6], P0[7],     PKH1(P0, 0, pw0), pw0); \
        VRD(0); SBAR(); GAPA(C0 = MFMA32(kf[2], qr[1], C0),       P0[8], P0[9], P0[10], P0[11],   PKH0(P0, 8, pw1), pw1); \
        VRD(1); SBAR(); GAPA(C1 = MFMA32(kf[3], qr[1], C1),       P0[12], P0[13], P0[14], P0[15], PKH1(P0, 8, pw1), pw1); \
        VRD(2); SBAR(); GAPA(C0 = MFMA32(kf[4], qr[2], C0),       P1[0], P1[1], P1[2], P1[3],     PKH0(P1, 0, pw2), pw2); \
        VRD(3); SBAR(); GAPA(C1 = MFMA32(kf[5], qr[2], C1),       P1[4], P1[5], P1[6], P1[7],     PKH1(P1, 0, pw2), pw2); \
                        GAPA(C0 = MFMA32(kf[6], qr[3], C0),       P1[8], P1[9], P1[10], P1[11],   PKH0(P1, 8, pw3), pw3); \
                        GAPA(C1 = MFMA32(kf[7], qr[3], C1),       P1[12], P1[13], P1[14], P1[15], PKH1(P1, 8, pw3), pw3); \
        l += sacc; \
        FIX_TILE(C0, C1, t); \
        { float rm_; ROWMAX(C0, C1, rm_); rm_ = fmaf(rm_, C2, -mhat); resc = false;                         \
          if (__builtin_expect(__any(rm_ > 8.0f), 0)) { const float dl_ = fmaxf(rm_, 0.f); mhat += dl_;     \
              const float f_ = __builtin_amdgcn_exp2f(-dl_); l *= f_; if (hi == 0) wsf[r32] = f_; resc = true; } } \
        const float nmh = -mhat; SBAR(); \
        GAPB(o[0] = MFMA32(PAF(0), VFR(0), o[0]), C0, 0);   VRD(4);  SBAR(); \
        GAPB(o[0] = MFMA32(PAF(1), VFR(1), o[0]), C0, 2);   VRD(5);  SBAR(); \
        GAPB(o[0] = MFMA32(PAF(2), VFR(2), o[0]), C0, 4);   VRD(6);  SBAR(); \
        GAPB(o[0] = MFMA32(PAF(3), VFR(3), o[0]), C0, 6);   VRD(7);  SBAR(); \
        GAPB(o[1] = MFMA32(PAF(0), VFR(4), o[1]), C0, 8);   VRD(8);  SBAR(); \
        GAPB(o[1] = MFMA32(PAF(1), VFR(5), o[1]), C0, 10);  VRD(9);  SBAR(); \
        GAPB(o[1] = MFMA32(PAF(2), VFR(6), o[1]), C0, 12);  VRD(10); SBAR(); \
        GAPB(o[1] = MFMA32(PAF(3), VFR(7), o[1]), C0, 14);  VRD(11); SBAR(); \
        GAPB(o[2] = MFMA32(PAF(0), VFR(8), o[2]), C1, 0);   VRD(12); SBAR(); \
        GAPB(o[2] = MFMA32(PAF(1), VFR(9), o[2]), C1, 2);   VRD(13); SBAR(); \
        GAPB(o[2] = MFMA32(PAF(2), VFR(10), o[2]), C1, 4);  VRD(14); SBAR(); \
        GAPB(o[2] = MFMA32(PAF(3), VFR(11), o[2]), C1, 6);  VRD(15); SBAR(); \
        GAPB(o[3] = MFMA32(PAF(0), VFR(12), o[3]), C1, 8);  if (gl_) { KLD2(ksl_, 0); SBAR(); } \
        GAPB(o[3] = MFMA32(PAF(1), VFR(13), o[3]), C1, 10); if (gl_) { KLD2(ksl_, 1); SBAR(); } \
        GAPB(o[3] = MFMA32(PAF(2), VFR(14), o[3]), C1, 12); \
        GAPB(o[3] = MFMA32(PAF(3), VFR(15), o[3]), C1, 14); \
        if ((t) + 3 < NT) asm volatile("s_waitcnt vmcnt(5)" ::: "memory"); else asm volatile("s_waitcnt vmcnt(0)" ::: "memory"); \
        ABAR(); RESC(); } while (0)
        if (wid >= 4) __builtin_amdgcn_s_setprio(1);
        {
            int t = 1;
            for (; t + 1 < NT; t += 2) {
                STEP(pB0, pB1, pA0, pA1, t);
                STEP(pA0, pA1, pB0, pB1, t + 1);
            }
            STEP(pB0, pB1, pA0, pA1, NT - 1);
        }
        __builtin_amdgcn_s_setprio(0);
        { float sacc = 0.f;
#pragma unroll
          for (int r = 0; r < 16; ++r) sacc += pB0[r];
#pragma unroll
          for (int r = 0; r < 16; ++r) sacc += pB1[r];
          l += sacc;
          PKH0(pB0, 0, pw0); PKH1(pB0, 0, pw0); PKH0(pB0, 8, pw1); PKH1(pB0, 8, pw1); PKH0(pB1, 0, pw2); PKH1(pB1, 0, pw2); PKH0(pB1, 8, pw3); PKH1(pB1, 8, pw3);
          const LAS unsigned char* vp_ = (const LAS unsigned char*)(uintptr_t)(vbase + ((NT - 1) & (NS - 1)) * 16384);
#pragma unroll
          for (int db = 0; db < 4; ++db) { VRD(0); VRD(1); VRD(2); VRD(3);
              o[db] = MFMA32(PAF(0), VFR(0), o[db]); o[db] = MFMA32(PAF(1), VFR(1), o[db]); o[db] = MFMA32(PAF(2), VFR(2), o[db]); o[db] = MFMA32(PAF(3), VFR(3), o[db]); vp_ += 512; } }
        { auto rr_ = __builtin_amdgcn_permlane32_swap(__float_as_uint(l), __float_as_uint(l), false, false); l = __uint_as_float(rr_[0]) + __uint_as_float(rr_[1]); }
#undef SBAR
#undef PIN
#undef MFMA32
#undef KLD2
#undef VTR
#undef VRD
#undef VFR
#undef PAF
#undef MX3
#undef ROWMAX
#undef FIX_TILE
#undef EX
#undef RESC
#undef PKH0
#undef PKH1
#undef GAPA
#undef GAPB
#undef STEP
        int lane_e = lane_id(); asm volatile("" : "+v"(lane_e));
        const int r32e = lane_e & 31, hie = lane_e >> 5;
        const unsigned o0off = (unsigned)((blockIdx.x * NTHR + wid * 64 + lane_e) * 128);
        if (hie == 0) wsf[32 + r32e] = l;
        float rl[16];
#pragma unroll
        for (int r = 0; r < 16; ++r) rl[r] = __builtin_amdgcn_rcpf(wsf[32 + crow(r, hie)]);
        if (c == 0) {
#pragma unroll
            for (int d0 = 0; d0 < 4; ++d0)
#pragma unroll
                for (int j = 0; j < 2; ++j) { v4u w;
                    w.x = cvtpk(o[d0][8 * j + 0] * rl[8 * j + 0], o[d0][8 * j + 1] * rl[8 * j + 1]); w.y = cvtpk(o[d0][8 * j + 2] * rl[8 * j + 2], o[d0][8 * j + 3] * rl[8 * j + 3]);
                    w.z = cvtpk(o[d0][8 * j + 4] * rl[8 * j + 4], o[d0][8 * j + 5] * rl[8 * j + 5]); w.w = cvtpk(o[d0][8 * j + 6] * rl[8 * j + 6], o[d0][8 * j + 7] * rl[8 * j + 7]);
                    *(v4u*)((char*)F.STASH + o0off + (d0 * 2 + j) * 16) = w; }
        } else {
            float ss[16];
#pragma unroll
            for (int r = 0; r < 16; ++r) ss[r] = 0.f;
#pragma unroll
            for (int d0 = 0; d0 < 4; ++d0)
#pragma unroll
                for (int j = 0; j < 2; ++j) { const v4u w = *(const v4u*)((const char*)F.STASH + o0off + (d0 * 2 + j) * 16); const unsigned ww[4] = {w.x, w.y, w.z, w.w};
#pragma unroll
                    for (int k = 0; k < 4; ++k) { const int i = 4 * j + k;
                        const float a0 = bflo(ww[k]) - lam * (o[d0][2 * i] * rl[2 * i]), a1 = bfhi(ww[k]) - lam * (o[d0][2 * i + 1] * rl[2 * i + 1]);
                        o[d0][2 * i] = a0; o[d0][2 * i + 1] = a1; ss[2 * i] += a0 * a0; ss[2 * i + 1] += a1 * a1; } }
#pragma unroll
            for (int r = 0; r < 16; ++r) {
                { DPP_SUM_ROW(ss[r]); ss[r] += __shfl_xor(ss[r], 16); }
                ss[r] = rsqrtf(ss[r] * (1.f / 128.f) + EPS) * 0.8f;
            }
            bf16* Cw = F.CAT + (rowb + qlo) * 1024 + 512 + h * 128;
#pragma unroll
            for (int d0 = 0; d0 < 4; ++d0) { const float g = F.subln_g[d0 * 32 + r32e];
#pragma unroll
                for (int r = 0; r < 16; ++r) { const float v = o[d0][r] * ss[r] * g; const float vn = dpp_xor1(v);
                    if ((r32e & 1) == 0) *(unsigned*)((char*)Cw + (unsigned)((crow(r, hie) * 1024 + d0 * 32 + r32e) * 2)) = cvtpk(v, vn); } }
        }
        __syncthreads();
    }
#undef DMA_K
#undef DMA_V
#undef DMA_TILE
#undef ABAR
}

__device__ __forceinline__ void attn_phase(Frame& F) {
    const int lane = lane_id(), tid = F.wave * 64 + lane;
    const float s01 = wave_sum(F.diff_lambda[lane] * F.diff_lambda[64 + lane]), s23 = wave_sum(F.diff_lambda[128 + lane] * F.diff_lambda[192 + lane]);
    const float lam = __expf(s01) - __expf(s23) + 0.2f;
    const int G = F.G;
    for (int it = ((G % 8 == 0) ? ((int)(blockIdx.x % 8) * (G / 8) + (int)blockIdx.x / 8) : (int)blockIdx.x); it < 256; it += G) {
        const int bh = it >> 3, x = it & 7, b = bh >> 2, h = bh & 3;
        LAS float* bt = (LAS float*)(F.lds + L_BT);
        __syncthreads();
        if (tid < BTN) { const int d = tid - BTO; int bk = d; if (d >= 16) { bk = 16 + (int)(__log2f((float)d * (1.f / 16.f)) * (16.f / 3.f)); bk = bk > 31 ? 31 : bk; }
            bt[tid] = d < 0 ? -__builtin_inff() : (F.rel_bias[bk * 4 + h] - F.rel_bias[31 * 4 + h]) * (1.4426950408889634f / C2); }
        __syncthreads();
        attn_unit(F, b, h, x, lam);
        attn_unit(F, b, h, 15 - x, lam);
    }
}
}

namespace sgu {
typedef float f32x16 __attribute__((ext_vector_type(16)));
typedef short s16x4 __attribute__((ext_vector_type(4)));
constexpr int L_T = 0, L_ST = 65536;
__device__ __forceinline__ void sgu_chunk(Frame& F, int chunk) {
    int tid = F.wave * 64 + lane_id(); asm volatile("" : "+v"(tid));
    const int lane = tid & 63, g = F.wave, r32 = lane & 31, hi = lane >> 5;
    LAS unsigned char* lds = F.lds;
    LAS float* st = (LAS float*)(lds + L_ST);
    const size_t t0 = (size_t)chunk * 128;
    for (int i = 0; i < 16; i += 2) {
        v4u raw[2];
#pragma unroll
        for (int u = 0; u < 2; ++u) raw[u] = *(const v4u*)(F.Z + (t0 + g * 16 + i + u) * INC + 512 + lane * 8);
#pragma unroll
        for (int u = 0; u < 2; ++u) { const int tl = g * 16 + i + u;
            float f[8] = {bflo(raw[u].x), bfhi(raw[u].x), bflo(raw[u].y), bfhi(raw[u].y), bflo(raw[u].z), bfhi(raw[u].z), bflo(raw[u].w), bfhi(raw[u].w)};
            float s = 0.f;
#pragma unroll
            for (int e = 0; e < 8; ++e) s += f[e];
            const float mean = wave_sum_dpp(s) * (1.f / 512.f); float q = 0.f;
#pragma unroll
            for (int e = 0; e < 8; ++e) { f[e] -= mean; q += f[e] * f[e]; }
            const float rstd = rsqrtf(wave_sum_dpp(q) * (1.f / 512.f) + EPS);
            if (lane == 0) { st[2 * tl] = mean; st[2 * tl + 1] = rstd; } }
    }
    __syncthreads();
    f32x16 acc[2][2];
    const int sr = tid >> 4, sc = (tid & 15) * 8;
    const int vb0 = (int)(uintptr_t)(lds + L_T) + (g >> 1) * 16384 + att::v_rd_base(lane);
#define SGU_STAGE(sh) do { _Pragma("unroll") for (int tile = 0; tile < 4; ++tile) { const int ch = tile * 128 + sc; \
            const f32x4 g0 = *(const f32x4*)(F.sgu_ln_g + ch), g1 = *(const f32x4*)(F.sgu_ln_g + ch + 4), b0 = *(const f32x4*)(F.sgu_ln_b + ch), b1 = *(const f32x4*)(F.sgu_ln_b + ch + 4); \
            _Pragma("unroll") for (int rr = 0; rr < 2; ++rr) { const int s = (sh) * 64 + sr + 32 * rr; \
                const v4u raw = *(const v4u*)(F.Z + (t0 + s) * INC + 512 + ch); const float mean = st[2 * s], rstd = st[2 * s + 1]; v4u o; \
                o.x = pk2((bflo(raw.x) - mean) * rstd * g0.x + b0.x, (bfhi(raw.x) - mean) * rstd * g0.y + b0.y); \
                o.y = pk2((bflo(raw.y) - mean) * rstd * g0.z + b0.z, (bfhi(raw.y) - mean) * rstd * g0.w + b0.w); \
                o.z = pk2((bflo(raw.z) - mean) * rstd * g1.x + b1.x, (bfhi(raw.z) - mean) * rstd * g1.y + b1.y); \
                o.w = pk2((bflo(raw.w) - mean) * rstd * g1.z + b1.z, (bfhi(raw.w) - mean) * rstd * g1.w + b1.w); \
                *(LAS v4u*)(lds + L_T + tile * 16384 + att::v_st(sr + 32 * rr, sc)) = o; } } } while (0)
#define TRRD(dst, off) asm volatile("ds_read_b64_tr_b16 %0, %1 offset:%2" : "=&v"(dst) : "v"(vb0), "i"(off) : "memory")
#define SGU_MMA(sh, tb0) do { _Pragma("unroll") for (int ks = 0; ks < 4; ++ks) { s16x4 l0, h0, l1, h1; \
            if ((g & 1) == 0) { TRRD(l0, 0 * 512 + ks * 4096); TRRD(h0, 0 * 512 + ks * 4096 + 2048); TRRD(l1, 1 * 512 + ks * 4096); TRRD(h1, 1 * 512 + ks * 4096 + 2048); } \
            else              { TRRD(l0, 2 * 512 + ks * 4096); TRRD(h0, 2 * 512 + ks * 4096 + 2048); TRRD(l1, 3 * 512 + ks * 4096); TRRD(h1, 3 * 512 + ks * 4096 + 2048); } \
            asm volatile("s_waitcnt lgkmcnt(0)" ::: "memory"); __builtin_amdgcn_sched_barrier(0); \
            const bf16x8 B0 = (bf16x8){l0[0], l0[1], l0[2], l0[3], h0[0], h0[1], h0[2], h0[3]}, B1 = (bf16x8){l1[0], l1[1], l1[2], l1[3], h1[0], h1[1], h1[2], h1[3]}; \
            _Pragma("unroll") for (int tl = 0; tl < 2; ++tl) { const int tb = (tb0) + tl; if ((sh) * 64 + 16 * ks > tb * 32 + 31) continue; \
                const bf16x8 A = *(const bf16x8*)(F.SGW + ((size_t)(g * 128 + tb * 32 + r32)) * 128 + (sh) * 64 + 16 * ks + 8 * hi); \
                acc[tl][0] = __builtin_amdgcn_mfma_f32_32x32x16_bf16(A, B0, acc[tl][0], 0, 0, 0); \
                acc[tl][1] = __builtin_amdgcn_mfma_f32_32x32x16_bf16(A, B1, acc[tl][1], 0, 0, 0); } } } while (0)
#define SGU_EPI(tb0) do { _Pragma("unroll") for (int tl = 0; tl < 2; ++tl) _Pragma("unroll") for (int r = 0; r < 16; ++r) { \
            const int t = ((tb0) + tl) * 32 + att::crow(r, hi); const float bs = F.sgu_b[g * 128 + t]; \
            _Pragma("unroll") for (int db = 0; db < 2; ++db) { const int ch = g * 64 + db * 32 + r32; \
                const float u = bf2f(F.Z[(t0 + t) * INC + ch]); const float v = u * (acc[tl][db][r] + bs); const float vn = dpp_xor1(v); \
                if ((r32 & 1) == 0) *(unsigned*)(F.CAT + (t0 + t) * 1024 + ch) = att::cvtpk(v, vn); } } } while (0)
#define SGU_ZERO() do { acc[0][0] = f32x16{}; acc[0][1] = f32x16{}; acc[1][0] = f32x16{}; acc[1][1] = f32x16{}; } while (0)
    SGU_STAGE(0);
    __syncthreads();
    SGU_ZERO(); SGU_MMA(0, 0); SGU_EPI(0);
    SGU_ZERO(); SGU_MMA(0, 2);
    __syncthreads();
    SGU_STAGE(1);
    __syncthreads();
    SGU_MMA(1, 2); SGU_EPI(2);
#undef SGU_STAGE
#undef TRRD
#undef SGU_MMA
#undef SGU_EPI
#undef SGU_ZERO
}
__device__ __forceinline__ void sgu_phase(Frame& F) { for (int ck = blockIdx.x; ck < M / 128; ck += F.G) { sgu_chunk(F, ck); __syncthreads(); } }
}

namespace tk {
typedef float f32x16 __attribute__((ext_vector_type(16)));
__device__ __forceinline__ float vmax(float a, float b) { float r; asm("v_max_f32 %0, %1, %2" : "=v"(r) : "v"(a), "v"(b)); return r; }
__device__ __forceinline__ float vmin(float a, float b) { float r; asm("v_min_f32 %0, %1, %2" : "=v"(r) : "v"(a), "v"(b)); return r; }
#define TK_CE(a, b) do { const float _mx = vmax(a, b), _mn = vmin(a, b); a = _mx; b = _mn; } while (0)
template <int N> __device__ __forceinline__ void sort_desc(float (&a)[N]) {
#pragma unroll
    for (int k = 2; k <= N; k <<= 1)
#pragma unroll
        for (int j = k >> 1; j > 0; j >>= 1)
#pragma unroll
            for (int i = 0; i < N; ++i) { const int l = i ^ j; if (l > i) { if ((i & k) == 0) TK_CE(a[i], a[l]); else TK_CE(a[l], a[i]); } }
}
template <int N> __device__ __forceinline__ void merge_desc(float (&a)[N]) {
#pragma unroll
    for (int j = N >> 1; j > 0; j >>= 1)
#pragma unroll
        for (int i = 0; i < N; ++i) { const int l = i ^ j; if (l > i) TK_CE(a[i], a[l]); }
}
__device__ __forceinline__ void top16_merge(float (&a)[16], const float (&b)[16]) {
#pragma unroll
    for (int i = 0; i < 16; ++i) a[i] = vmax(a[i], b[15 - i]);
    merge_desc<16>(a);
}
__device__ __forceinline__ float embed(float v, unsigned mask, unsigned code) { return __uint_as_float((__float_as_uint(v) & mask) | code); }

__device__ __forceinline__ void topk_phase(Frame& F) {
    int lane = lane_id(); asm volatile("" : "+v"(lane));
    const int r32 = lane & 31, hi = lane >> 5;
    const int gw = blockIdx.x * NWAVES + F.wave, NGW = F.G * NWAVES;
    LAS unsigned* tab = (LAS unsigned*)(F.lds + F.wave * 8192) + lane;
    const float NEG = -__builtin_inff();
    constexpr int NTASK = (M / 32) * 8; const int per = (NTASK + NGW - 1) / NGW;
    unsigned code16[16];
#pragma unroll
    for (int r = 0; r < 16; ++r) code16[r] = (unsigned)((r & 3) + 8 * (r >> 2) + 4 * hi);
    const unsigned qoff = (unsigned)(r32 * NQ + hi * 8), koff = (unsigned)((hi * 128 + r32) * 8);
#define TK_QP(task_, c_) (F.QP + (size_t)((task_) >> 3) * 32 * NQ + ((task_) & 7) * 256 + (c_) * 128)
#define TK_KP(task_, c_) (F.KEYS + (size_t)((((task_) & 7) * 2 + (c_)) * 16) * 128 * 8)
#define TK_LDQ(dst, task_, c_) do { const bf16* qp_ = TK_QP(task_, c_); _Pragma("unroll") for (int ks = 0; ks < 8; ++ks) dst[ks] = *(const bf16x8*)(qp_ + ks * 16 + qoff); } while (0)
#define TK_LDK(dst, task_, c_, nb_) do { const bf16* kp_ = TK_KP(task_, c_); _Pragma("unroll") for (int ks = 0; ks < 8; ++ks) dst[ks] = *(const bf16x8*)(kp_ + ((2 * ks) * 128 + (nb_) * 32) * 8 + koff); } while (0)
    const int task_beg = gw * per, task_end = (gw * per + per < NTASK) ? gw * per + per : NTASK;
    bf16x8 qcur[8], kcur[8];
    if (task_beg < task_end) { TK_LDQ(qcur, task_beg, 0); TK_LDK(kcur, task_beg, 0, 0); }
    for (int task = task_beg; task < task_end; ++task) {
        const int tb = task >> 3, h = task & 7;
        const size_t trow = (size_t)tb * 32 + r32;
        float sk[2][16];
        float best[16];
#pragma unroll
        for (int st = 0; st < 8; ++st) {
            const int c = st >> 2, nb = st & 3;
            bf16x8 knxt[8], qnxt[8];
            if (st < 7) TK_LDK(knxt, task, (st + 1) >> 2, (st + 1) & 3);
            if (st == 3) TK_LDQ(qnxt, task, 1);
            f32x16 acc = f32x16{};
#pragma unroll
            for (int ks = 0; ks < 8; ++ks) acc = __builtin_amdgcn_mfma_f32_32x32x16_bf16(kcur[ks], qcur[ks], acc, 0, 0, 0);
            float cur[16];
#pragma unroll
            for (int r = 0; r < 16; ++r) { cur[r] = embed(acc[r], 0xFFFFFF80u, code16[r]); if (nb) cur[r] = __uint_as_float(__float_as_uint(cur[r]) | (unsigned)(nb * 32)); }
            sort_desc<16>(cur);
            if (nb == 0) {
#pragma unroll
                for (int i = 0; i < 16; ++i) best[i] = cur[i];
            } else top16_merge(best, cur);
            if (st < 7) {
#pragma unroll
                for (int ks = 0; ks < 8; ++ks) kcur[ks] = knxt[ks];
            }
            if (st == 3) {
#pragma unroll
                for (int ks = 0; ks < 8; ++ks) qcur[ks] = qnxt[ks];
            }
            if (nb == 3) {
                float pr[16];
#pragma unroll
                for (int i = 0; i < 16; ++i) { auto rr = __builtin_amdgcn_permlane32_swap(__float_as_uint(best[i]), __float_as_uint(best[i]), false, false);
                    pr[i] = __uint_as_float(hi ? rr[0] : rr[1]); }
                top16_merge(best, pr);
#pragma unroll
                for (int i = 0; i < 16; ++i) sk[c][i] = best[i];
            }
            __builtin_amdgcn_sched_barrier(0);
        }
        { const int tn = (task + 1 < task_end) ? task + 1 : task; TK_LDQ(qcur, tn, 0); TK_LDK(kcur, tn, 0, 0); }
#pragma unroll
        for (int i = 0; i < 16; ++i) { tab[i * 64] = __float_as_uint(sk[0][i]); tab[(16 + i) * 64] = __float_as_uint(sk[1][i]); }
        float T[16], G1[16], G2[16];
#pragma unroll
        for (int j = 0; j < 16; ++j) T[j] = embed(sk[0][0] + sk[1][j], 0xFFFFFF00u, (unsigned)j);
#pragma unroll
        for (int j = 0; j < 8; ++j) { G1[j] = embed(sk[0][1] + sk[1][j], 0xFFFFFF00u, (unsigned)(16 + j)); G1[8 + j] = embed(sk[0][15 - j] + sk[1][0], 0xFFFFFF00u, (unsigned)((15 - j) << 4)); }
        merge_desc<16>(G1);
        top16_merge(T, G1);
#pragma unroll
        for (int j = 0; j < 5; ++j) G2[j] = embed(sk[0][2] + sk[1][j], 0xFFFFFF00u, (unsigned)(32 + j));
#pragma unroll
        for (int j = 0; j < 4; ++j) G2[5 + j] = embed(sk[0][3] + sk[1][j], 0xFFFFFF00u, (unsigned)(48 + j));
#pragma unroll
        for (int j = 0; j < 3; ++j) G2[9 + j] = embed(sk[0][4] + sk[1][j], 0xFFFFFF00u, (unsigned)(64 + j));
#pragma unroll
        for (int j = 0; j < 2; ++j) { G2[12 + j] = embed(sk[0][5] + sk[1][j], 0xFFFFFF00u, (unsigned)(80 + j)); G2[14 + j] = embed(sk[0][6] + sk[1][j], 0xFFFFFF00u, (unsigned)(96 + j)); }
        sort_desc<16>(G2);
        top16_merge(T, G2);
        T[15] = vmax(T[15], embed(sk[0][7] + sk[1][0], 0xFFFFFF00u, 112u)); T[14] = vmax(T[14], embed(sk[0][7] + sk[1][1], 0xFFFFFF00u, 113u));
        merge_desc<16>(T);
        const float mx = __uint_as_float(__float_as_uint(T[0]) & 0xFFFFFF00u);
        float e[16]; float den = 0.f;
#pragma unroll
        for (int k = 0; k < 16; ++k) { e[k] = __builtin_amdgcn_exp2f((__uint_as_float(__float_as_uint(T[k]) & 0xFFFFFF00u) - mx) * 1.4426950408889634f); den += e[k]; }
        const float rden = 1.f / den;
        int eo[8]; float go[8];
#pragma unroll
        for (int k = 0; k < 8; ++k) {
            const unsigned code = __float_as_uint(hi ? T[k + 8] : T[k]) & 255u;
            const unsigned a1 = tab[(code >> 4) * 64] & 127u, a2 = tab[(16 + (code & 15u)) * 64] & 127u;
            eo[k] = (int)(a1 * 128u + a2); go[k] = (hi ? e[k + 8] : e[k]) * rden;
        }
        int* ip = F.IDX + trow * PKN + h * 16 + hi * 8; float* gp = F.GATE + trow * PKN + h * 16 + hi * 8;
        *(v4u*)ip = (v4u){(unsigned)eo[0], (unsigned)eo[1], (unsigned)eo[2], (unsigned)eo[3]}; *(v4u*)(ip + 4) = (v4u){(unsigned)eo[4], (unsigned)eo[5], (unsigned)eo[6], (unsigned)eo[7]};
        *(f32x4*)gp = (f32x4){go[0], go[1], go[2], go[3]}; *(f32x4*)(gp + 4) = (f32x4){go[4], go[5], go[6], go[7]};
    }
    (void)NEG;
}
#undef TK_CE
#undef TK_QP
#undef TK_KP
#undef TK_LDQ
#undef TK_LDK
}

namespace pe {
typedef float f32x2 __attribute__((ext_vector_type(2)));
__device__ __forceinline__ f32x2 cvlo(unsigned w) { return __builtin_amdgcn_cvt_pk_f32_fp8((int)w, false); }
__device__ __forceinline__ f32x2 cvhi(unsigned w) { return __builtin_amdgcn_cvt_pk_f32_fp8((int)w, true); }
__device__ __forceinline__ float dot16(const v4u r, const f32x2 (&hf)[8]) {
    f32x2 a = cvlo(r.x) * hf[0]; f32x2 b = cvhi(r.x) * hf[1];
    a = cvlo(r.y) * hf[2] + a; b = cvhi(r.y) * hf[3] + b; a = cvlo(r.z) * hf[4] + a; b = cvhi(r.z) * hf[5] + b; a = cvlo(r.w) * hf[6] + a; b = cvhi(r.w) * hf[7] + b;
    a = a + b; return a.x + a.y;
}
#define PE_W(WREG, i) __uint_as_float(__builtin_amdgcn_readlane(__float_as_uint(WREG), (i)))
#ifndef FP6_INTERLEAVED
#define FP6_INTERLEAVED 1
#endif
typedef unsigned v6u __attribute__((ext_vector_type(6)));
typedef float v32f __attribute__((ext_vector_type(32)));
typedef float v16f __attribute__((ext_vector_type(16)));
struct Row6 { v4u q4; v2u q2; };
#ifndef PV6_G
#define PV6_G 2
#endif
#define PV6_LOAD(dst, EREG, i) do { const int ea_ = __builtin_amdgcn_readlane(EREG, 2 * (i)), eb_ = __builtin_amdgcn_readlane(EREG, 2 * (i) + 1); \
        const unsigned char* rp_ = F.VT6 + (size_t)(half ? eb_ : ea_) * 768; dst.q4 = *(const v4u*)(rp_ + l16); dst.q2 = *(const v2u*)(rp_ + 512 + l8); } while (0)
#define PV6_ACC(src, WREG, i) do { const float wa_ = PE_W(WREG, 2 * (i)), wb_ = PE_W(WREG, 2 * (i) + 1); const float w_ = half ? wb_ : wa_; const f32x2 ww_ = {w_, w_}; \
        const v6u pk_ = {src.q4.x, src.q4.y, src.q4.z, src.q4.w, src.q2.x, src.q2.y}; const v32f d_ = __builtin_amdgcn_cvt_scalef32_pk32_f32_fp6(pk_, 1.0f); \
        _Pragma("unroll") for (int k = 0; k < 16; ++k) acc[k] = (f32x2){d_[2 * k], d_[2 * k + 1]} * ww_ + acc[k]; __builtin_amdgcn_sched_barrier(0); } while (0)
#define PV6_BATCH(EREG, WREG) do { Row6 bufA[PV6_G], bufB[PV6_G];             \
        _Pragma("unroll") for (int i = 0; i < PV6_G; ++i) PV6_LOAD(bufA[i], EREG, i); \
        _Pragma("unroll") for (int gq = 0; gq < 32 / PV6_G; gq += 2) { \
            _Pragma("unroll") for (int i = 0; i < PV6_G; ++i) PV6_LOAD(bufB[i], EREG, (gq + 1) * PV6_G + i); \
            _Pragma("unroll") for (int i = 0; i < PV6_G; ++i) PV6_ACC(bufA[i], WREG, gq * PV6_G + i); \
            if (gq + 2 < 32 / PV6_G) { _Pragma("unroll") for (int i = 0; i < PV6_G; ++i) PV6_LOAD(bufA[i], EREG, (gq + 2) * PV6_G + i); } \
            _Pragma("unroll") for (int i = 0; i < PV6_G; ++i) PV6_ACC(bufB[i], WREG, (gq + 1) * PV6_G + i); } } while (0)

#define PU_IDX(dst, tt) do { const v4u* ip_ = (const v4u*)(F.IDX + (size_t)(tt) * PKN + (lane >> 3) * 16); _Pragma("unroll") for (int q_ = 0; q_ < 4; ++q_) { const v4u w_ = ip_[q_]; dst[4 * q_] = (int)w_.x; dst[4 * q_ + 1] = (int)w_.y; dst[4 * q_ + 2] = (int)w_.z; dst[4 * q_ + 3] = (int)w_.w; } } while (0)
#define PU_GATHER(dst, idx) do { _Pragma("unroll") for (int i = 0; i < 16; ++i) dst[i] = *(const v4u*)(ub + (unsigned)idx[i] * 128u + coff); } while (0)
#define PU_HS(dst, tt) do { dst[0] = *(const v4u*)(F.H8 + (size_t)(tt) * D + x * 128 + (lane & 7) * 16); } while (0)
#define PU_COMPUTE(seg, hraw, tt) do { int p[16]; \
        _Pragma("unroll") for (int i = 0; i < 16; ++i) { int a_ = __builtin_amdgcn_sdot4((int)seg[i].x, (int)hraw[0].x, 0, false); a_ = __builtin_amdgcn_sdot4((int)seg[i].y, (int)hraw[0].y, a_, false); \
            a_ = __builtin_amdgcn_sdot4((int)seg[i].z, (int)hraw[0].z, a_, false); p[i] = __builtin_amdgcn_sdot4((int)seg[i].w, (int)hraw[0].w, a_, false); }     \
          \
        _Pragma("unroll") for (int i = 0; i < 8; ++i) { const bool bt = (lane & 4) != 0; const int sd = bt ? p[i] : p[i + 8], kp = bt ? p[i + 8] : p[i]; p[i] = kp + __builtin_amdgcn_update_dpp(0, sd, 0x141, 0xF, 0xF, false); } \
        _Pragma("unroll") for (int i = 0; i < 4; ++i) { const bool bt = (lane & 2) != 0; const int sd = bt ? p[i] : p[i + 4], kp = bt ? p[i + 4] : p[i]; p[i] = kp + __builtin_amdgcn_update_dpp(0, sd, 0x4E, 0xF, 0xF, false); } \
        _Pragma("unroll") for (int i = 0; i < 2; ++i) { const bool bt = (lane & 1) != 0; const int sd = bt ? p[i] : p[i + 2], kp = bt ? p[i + 2] : p[i]; p[i] = kp + __builtin_amdgcn_update_dpp(0, sd, 0xB1, 0xF, 0xF, false); } \
        ((unsigned*)F.PART)[((size_t)x * M + (tt)) * 64 + lane] = att::cvtpk((float)p[0], (float)p[1]); } while (0)
__device__ __forceinline__ void peer_u_phase(Frame& F, const int c0, const int cn, const int w0, const int nw) {
    int lane = lane_id(); asm volatile("" : "+v"(lane));
    const int wave = F.wave;
    if (wave < w0 || wave >= w0 + nw) return;
    const unsigned coff = (unsigned)(lane & 7) * 16u;
    const int per_blk = cn / 32, per_wave = per_blk / nw;
    for (int unit = blockIdx.x; unit < 256; unit += F.G) {
        const int x = unit & 7, rk = unit >> 3;
        const unsigned char* ub = F.UT8 + (size_t)x * NEXP * 128;
        const int tbeg = c0 + rk * per_blk + (wave - w0) * per_wave, tend = tbeg + per_wave;
        int idxA[16], idxB[16]; v4u segA[16], segB[16]; v4u hA[1], hB[1];
        PU_IDX(idxA, tbeg); PU_GATHER(segA, idxA); PU_HS(hA, tbeg); PU_IDX(idxB, tbeg + 1);
        for (int t = tbeg; t < tend; t += 2) {
            PU_GATHER(segB, idxB); PU_HS(hB, t + 1);
            { const int tn = (t + 2 < tend) ? t + 2 : t; PU_IDX(idxA, tn); }
            PU_COMPUTE(segA, hA, t);
            { const int tn = (t + 2 < tend) ? t + 2 : t; PU_GATHER(segA, idxA); PU_HS(hA, tn); }
            { const int tn = (t + 3 < tend) ? t + 3 : t + 1; PU_IDX(idxB, tn); }
            PU_COMPUTE(segB, hB, t + 1);
        }
    }
}
#undef PU_IDX
#undef PU_GATHER
#undef PU_HS
#undef PU_COMPUTE

template <bool DRY> __device__ __forceinline__ void peer_phase(Frame& F, const int c0, const int cn, const int w0, const int nw) {
    int lane = lane_id(); asm volatile("" : "+v"(lane));
    if (F.wave < w0 || F.wave >= w0 + nw) return;
    const int gw = blockIdx.x * nw + (F.wave - w0), NGW = F.G * nw;
    const int half = lane >> 5; const unsigned l16 = (unsigned)(lane & 31) * 16u, l8 = (unsigned)(lane & 31) * 8u;
    for (int t = c0 + gw; t < c0 + cn; t += NGW) {
        const int b = t >> 12;
        const int e0 = F.IDX[(size_t)t * PKN + lane], e1 = F.IDX[(size_t)t * PKN + 64 + lane];
        const float g0 = F.GATE[(size_t)t * PKN + lane], g1 = F.GATE[(size_t)t * PKN + 64 + lane];
        const float su0 = F.SU[e0], su1 = F.SU[e1], sv0 = F.SV[e0], sv1 = F.SV[e1];
        float tot0 = 0.f, tot1 = 0.f;
#pragma unroll
        for (int x = 0; x < 8; ++x) { const bf16* pp = (const bf16*)F.PART + ((size_t)x * M + t) * PKN; tot0 += bf2f(pp[lane]); tot1 += bf2f(pp[64 + lane]); }
        const float hs = F.HS[t];
        const float w0 = gelu_t(tot0 * (su0 * hs)) * g0 * sv0, w1 = gelu_t(tot1 * (su1 * hs)) * g1 * sv1;
        f32x2 acc[16];
#pragma unroll
        for (int i = 0; i < 16; ++i) acc[i] = (f32x2){0.f, 0.f};
        PV6_BATCH(e0, w0);
        PV6_BATCH(e1, w1);
#pragma unroll
        for (int i = 0; i < 16; ++i) {
            auto rx = __builtin_amdgcn_permlane32_swap(__float_as_uint(acc[i].x), __float_as_uint(acc[i].x), false, false);
            auto ry = __builtin_amdgcn_permlane32_swap(__float_as_uint(acc[i].y), __float_as_uint(acc[i].y), false, false);
            acc[i] = (f32x2){__uint_as_float(rx[0]) + __uint_as_float(rx[1]), __uint_as_float(ry[0]) + __uint_as_float(ry[1])};
        }
        float y[16];
#pragma unroll
        for (int j = 0; j < 16; ++j) {
#if FP6_INTERLEAVED
            const float lo = (j & 1) ? acc[j].x : acc[j].x;
            const float hi_ = acc[j].y;
            y[j] = half ? hi_ : lo;
#else
            const float lo = (j & 1) ? acc[j >> 1].y : acc[j >> 1].x;
            const float hi_ = (j & 1) ? acc[8 + (j >> 1)].y : acc[8 + (j >> 1)].x;
            y[j] = half ? hi_ : lo;
#endif
        }
        float ss = 0.f;
#pragma unroll
        for (int j = 0; j < 16; ++j) ss += y[j] * y[j];
        const float rstd = rsqrtf(wave_sum_dpp(ss) * (1.f / D) + EPS);
        const float* md = F.mod + b * 6144 + 5120;
        const float* g3 = F.norm_g + 3072;
        int lane_e = lane; asm volatile("" : "+v"(lane_e));
        const int col0 = (lane_e & 31) * 32 + (lane_e >> 5) * 16;
        float* orow = F.out + (size_t)t * D + col0;
#pragma unroll
        for (int q4 = 0; q4 < 4; ++q4) { const int c = col0 + q4 * 4;
            const f32x4 x1 = *(const f32x4*)(orow + q4 * 4), gt = *(const f32x4*)(md + c), gg = *(const f32x4*)(g3 + c);
            const f32x4 yv = (f32x4){y[q4 * 4], y[q4 * 4 + 1], y[q4 * 4 + 2], y[q4 * 4 + 3]};
            if (!DRY) *(f32x4*)(orow + q4 * 4) = x1 + gt * (yv * rstd * gg); else if (rstd == 123.456f) *(f32x4*)(orow + q4 * 4) = yv; }
    }
}
#undef PE_W
#undef PV6_LOAD
#undef PV6_ACC
#undef PV6_BATCH

__device__ __forceinline__ void u_rows4(Frame& F, int r0, int stride, int nvalid, int lane) {
    f32x4 v[4][4];
#pragma unroll
    for (int q = 0; q < 4; ++q) { const int row = r0 + (q < nvalid ? q : 0) * stride; const f32x4* s = (const f32x4*)(F.peer_u + (size_t)row * D) + lane * 4;
#pragma unroll
        for (int i = 0; i < 4; ++i) v[q][i] = s[i]; }
#pragma unroll
    for (int q = 0; q < 4; ++q) { if (q >= nvalid) break; const int row = r0 + q * stride;
        float am = 0.f;
#pragma unroll
        for (int i = 0; i < 4; ++i) am = fmaxf(am, fmaxf(fmaxf(fabsf(v[q][i].x), fabsf(v[q][i].y)), fmaxf(fabsf(v[q][i].z), fabsf(v[q][i].w))));
        am = wave_max_dpp(am);
        const float sc = am > 0.f ? 127.f / am : 1.f;
        int w[4];
#pragma unroll
        for (int i = 0; i < 4; ++i) { const int q0 = (int)rintf(v[q][i].x * sc), q1 = (int)rintf(v[q][i].y * sc), q2 = (int)rintf(v[q][i].z * sc), q3 = (int)rintf(v[q][i].w * sc);
            w[i] = (q0 & 255) | ((q1 & 255) << 8) | ((q2 & 255) << 16) | (q3 << 24); }
        *(v4u*)(F.UT8 + (size_t)(lane >> 3) * NEXP * 128 + (size_t)row * 128 + (lane & 7) * 16) = (v4u){(unsigned)w[0], (unsigned)w[1], (unsigned)w[2], (unsigned)w[3]};
        if (lane == 0) F.SU[row] = 1.f / sc; }
}
__device__ __forceinline__ void v_pairs2(Frame& F, int p0, int stride, int nvalid, int lane) {
    const int L = lane & 31, hf = lane >> 5;
    f32x4 f[2][8];
#pragma unroll
    for (int q = 0; q < 2; ++q) { const int row = 2 * (p0 + (q < nvalid ? q : 0) * stride) + hf; const f32x4* sp = (const f32x4*)(F.peer_v + (size_t)row * D + L * 32);
#pragma unroll
        for (int i = 0; i < 8; ++i) f[q][i] = sp[i]; }
#pragma unroll
    for (int q = 0; q < 2; ++q) { if (q >= nvalid) break; const int row = 2 * (p0 + q * stride) + hf;
        float am = 0.f;
#pragma unroll
        for (int i = 0; i < 8; ++i) am = fmaxf(am, fmaxf(fmaxf(fabsf(f[q][i].x), fabsf(f[q][i].y)), fmaxf(fabsf(f[q][i].z), fabsf(f[q][i].w))));
        am = half_max_dpp(am);
        const float sc = am > 0.f ? exp2f(floorf(log2f(7.0f / am))) : 1.f;
        v16f a, b;
#pragma unroll
        for (int i = 0; i < 4; ++i) { a[4 * i] = f[q][i].x * sc; a[4 * i + 1] = f[q][i].y * sc; a[4 * i + 2] = f[q][i].z * sc; a[4 * i + 3] = f[q][i].w * sc;
            b[4 * i] = f[q][4 + i].x * sc; b[4 * i + 1] = f[q][4 + i].y * sc; b[4 * i + 2] = f[q][4 + i].z * sc; b[4 * i + 3] = f[q][4 + i].w * sc; }
        const v6u w = __builtin_amdgcn_cvt_scalef32_2xpk16_fp6_f32(a, b, 1.0f);
        unsigned char* rp = F.VT6 + (size_t)row * 768;
        *(v4u*)(rp + L * 16) = (v4u){w[0], w[1], w[2], w[3]};
        *(v2u*)(rp + 512 + L * 8) = (v2u){w[4], w[5]};
        if (L == 0) F.SV[row] = 1.f / sc; }
}
__device__ __forceinline__ void prologue_tables(Frame& F, int gw, int NGW, int lane) {
    for (int r = gw; r < NEXP; r += 4 * NGW) { const int left = (NEXP - r + NGW - 1) / NGW; u_rows4(F, r, NGW, left < 4 ? left : 4, lane); }
    for (int p = gw; p < NEXP / 2; p += 2 * NGW) { const int left = (NEXP / 2 - p + NGW - 1) / NGW; v_pairs2(F, p, NGW, left < 2 ? left : 2, lane); }
}
}

__device__ __forceinline__ void prologue_tables_fwd(Frame& F, int gw, int NGW, int lane) { pe::prologue_tables(F, gw, NGW, lane); }
struct Args { const float* in[18]; float* out; unsigned char* ws; int ph_lo, ph_hi, li, pad; };
__global__ void __launch_bounds__(NTHR, 2) fwd(Args args) {
    extern __shared__ __attribute__((aligned(16))) unsigned char lds[];
    Frame F;
    F.lds = (LAS unsigned char*)lds;
    F.MISC = (volatile LAS unsigned*)(F.lds + MISC_OFF);
    F.wave = __builtin_amdgcn_readfirstlane((int)threadIdx.x >> 6); F.G = gridDim.x;
    unsigned char* ws = args.ws;
    F.ctl = (gu32*)(ws + WS_CTL);
    F.x = args.in[0]; F.c = args.in[1]; F.w_ada = args.in[2]; F.b_ada = args.in[3]; F.norm_g = args.in[4]; F.w_in = args.in[5]; F.sgu_ln_g = args.in[6]; F.sgu_ln_b = args.in[7];
    F.sgu_w = args.in[8]; F.sgu_b = args.in[9]; F.diff_lambda = args.in[10]; F.subln_g = args.in[11]; F.rel_bias = args.in[12]; F.w_out = args.in[13]; F.w_query = args.in[14];
    F.sub_keys = args.in[15]; F.peer_u = args.in[16]; F.peer_v = args.in[17]; F.out = args.out;
    F.mod = (float*)(ws + WS_MOD); F.WIN = (bf16*)(ws + WS_WIN); F.WOUT = (bf16*)(ws + WS_WOUT); F.WQ = (bf16*)(ws + WS_WQ); F.KEYS = (bf16*)(ws + WS_KEYS); F.SGW = (bf16*)(ws + WS_SGW);
    F.UT8 = ws + WS_UT; F.H8 = ws + WS_H8; F.HS = (float*)(ws + WS_SU) + 2 * NEXP; F.HAS = (float*)(ws + WS_SU) + 2 * NEXP + M; F.WS8 = (float*)(ws + WS_SU) + 2 * NEXP + 2 * M; F.HA8 = ws + WS_H; F.W8 = ws + WS_WIN; F.WQ8 = ws + WS_WQ; F.WQS8 = (float*)(ws + WS_SU) + 2 * NEXP + 2 * M + INC; F.VT6 = ws + WS_VT; F.PART = (float*)(ws + WS_QP); F.STASH = (unsigned*)(ws + WS_H); F.SU = (float*)(ws + WS_SU); F.SV = (float*)(ws + WS_SU) + NEXP; F.H = (bf16*)(ws + WS_H); F.Y = (bf16*)(ws + WS_Y); F.Z = (bf16*)(ws + WS_Z); F.QP = (bf16*)(ws + WS_QP); F.CAT = (bf16*)(ws + WS_CAT);
    F.IDX = (int*)(ws + WS_IDX); F.GATE = (float*)(ws + WS_GATE);
    for (int u = threadIdx.x; u < (LDS_BYTES - LDSCTL_OFF) / 4; u += NTHR) ((LAS unsigned*)(F.lds + LDSCTL_OFF))[u] = 0u;
    __syncthreads();
    XcdBarrier bar = xcd_barrier_post((unsigned*)(F.ctl + CW_BAR) + args.li * XCD_BAR_WORDS, F.MISC + 8);
    const int lo = args.ph_lo, hi = args.ph_hi;
#ifndef ONLY_PHASE
#define ONLY_PHASE -1
#endif
#define IN(k) (lo <= (k) && (k) < hi && (ONLY_PHASE < 0 || ONLY_PHASE == (k)))
#define SEAM(k) do { if ((k) + 1 < hi) xcd_barrier(bar); } while (0)
    if (IN(0)) { for (int rep = 0; rep < (PROBE_PHASE == 0 ? 2 : 1); ++rep) ph_prologue(F); SEAM(0); }
    if (IN(1)) { for (int rep = 0; rep < (PROBE_PHASE == 1 ? 2 : 1); ++rep) ph_hrows(F); SEAM(1); }
    if (IN(2)) {
        pg8::Gemm g{(const pg8::bf16_t*)F.HA8, (const pg8::bf16_t*)F.W8, M, INC, D / 2}; pg8::StaticOrder S; S.init(M, INC, F.G, (int)blockIdx.x);
        pg8::EpiI8<1> E{F.Z, INC, F.HAS, F.WS8, 1024};
        for (int rep = 0; rep < (PROBE_PHASE == 2 ? 2 : 1); ++rep) pg8::gemm_phase<pg8::EpiI8<1>, pg8::StaticOrder, true, true>(F.lds, g, S, E, F.wave);
        SEAM(2);
    }
    if (IN(3)) { for (int rep = 0; rep < (PROBE_PHASE == 30 ? 2 : 1); ++rep) sgu::sgu_phase(F); for (int rep = 0; rep < (PROBE_PHASE == 3 ? 2 : 1); ++rep) att::attn_phase(F); SEAM(3); }
    if (IN(4)) {
        pg8::Gemm g{F.CAT, F.WOUT, M, D, D}; pg8::StaticOrder S; S.init(M, D, F.G, (int)blockIdx.x);
        pg8::EpiBf16<0> E{F.Y, D, nullptr, 0, 0, 1.f, 0};
        for (int rep = 0; rep < (PROBE_PHASE == 4 ? 2 : 1); ++rep) pg8::gemm_phase<pg8::EpiBf16<0>, pg8::StaticOrder, true, true>(F.lds, g, S, E, F.wave);
        SEAM(4);
    }
    if (IN(5)) { for (int rep = 0; rep < (PROBE_PHASE == 5 ? 2 : 1); ++rep) ph_x1rows(F); SEAM(5); }
    if (IN(6)) {
        pg8::Gemm g{(const pg8::bf16_t*)F.H8, (const pg8::bf16_t*)F.WQ8, M, NQ, D / 2}; pg8::StaticOrder S; S.init(M, NQ, F.G, (int)blockIdx.x);
        pg8::EpiI8<0> E{F.QP, NQ, F.HS, F.WQS8, 0};
        for (int rep = 0; rep < (PROBE_PHASE == 6 ? 2 : 1); ++rep) pg8::gemm_phase<pg8::EpiI8<0>, pg8::StaticOrder, true, true>(F.lds, g, S, E, F.wave);
        SEAM(6);
    }
    if (IN(7)) { if (TABLES_IN_PHASE == 7) prologue_tables_fwd(F, blockIdx.x * NWAVES + F.wave, F.G * NWAVES, lane_id()); for (int rep = 0; rep < (PROBE_PHASE == 7 ? 2 : 1); ++rep) tk::topk_phase(F); SEAM(7); }
    if (IN(8)) { for (int rep = 0; rep < (PROBE_PHASE == 8 ? 2 : 1); ++rep) pe::peer_u_phase(F, 0, M, 0, 8); SEAM(8); }
    if (IN(9)) { if (PROBE_PHASE == 9) pe::peer_phase<true>(F, 0, M, 0, 8); pe::peer_phase<false>(F, 0, M, 0, 8); }
#undef IN
#undef SEAM
}

extern "C" void kernel_launch(void* const* d_in, const int* in_sizes, int n_in, void* d_out, int out_size, void* d_ws, size_t ws_size, hipStream_t stream) {
    static int grid = 0;
    if (grid == 0) {
        if (n_in != 18 || in_sizes[0] != M * D || out_size != M * D || ws_size < WS_END) { fprintf(stderr, "kernel_launch: unexpected shapes (n_in %d, in0 %d, out %d, ws %zu)\n", n_in, n_in > 0 ? in_sizes[0] : -1, out_size, ws_size); grid = -1; return; }
        int dev = 0, cus = 0, per_cu = 0;
        if (hipGetDevice(&dev) != hipSuccess || hipDeviceGetAttribute(&cus, hipDeviceAttributeMultiprocessorCount, dev) != hipSuccess) { grid = -1; return; }
        if (hipFuncSetAttribute((const void*)fwd, hipFuncAttributeMaxDynamicSharedMemorySize, LDS_BYTES) != hipSuccess) { fprintf(stderr, "kernel_launch: hipFuncSetAttribute failed\n"); grid = -1; return; }
        if (hipOccupancyMaxActiveBlocksPerMultiprocessor(&per_cu, (const void*)fwd, NTHR, LDS_BYTES) != hipSuccess || per_cu < 1) fprintf(stderr, "kernel_launch: occupancy query reports %d\n", per_cu);
        (void)hipGetLastError();
        grid = cus;
    }
    if (grid < 0) return;
    if (hipMemsetAsync((char*)d_ws + WS_CTL, 0, CTL_ZERO_BYTES, stream) != hipSuccess) return;
    Args a{};
    for (int i = 0; i < 18; ++i) a.in[i] = (const float*)d_in[i];
    a.out = (float*)d_out; a.ws = (unsigned char*)d_ws;
#if MK_PER_PHASE
    for (int p = 0; p < NPHASE; ++p) { a.ph_lo = p; a.ph_hi = p + 1; a.li = p; hipLaunchKernelGGL(fwd, dim3(grid), dim3(NTHR), LDS_BYTES, stream, a); }
#else
    a.ph_lo = 0; a.ph_hi = NPHASE; a.li = 0; hipLaunchKernelGGL(fwd, dim3(grid), dim3(NTHR), LDS_BYTES, stream, a);
#endif
}
```

```cpp
#define MK_PER_PHASE 0
#include <hip/hip_runtime.h>
#include <cstdio>
#include <cstdint>
namespace pg8 {
#define PG8_LAS __attribute__((address_space(3)))
typedef unsigned short bf16_t;
typedef short bf16x8 __attribute__((ext_vector_type(8)));
typedef float f32x4 __attribute__((ext_vector_type(4)));
typedef unsigned u32x4 __attribute__((ext_vector_type(4)));
typedef int i32x4 __attribute__((ext_vector_type(4)));
constexpr int BM = 256, BK = 64, HALF = 128, HTB = HALF * BK * 2  , STAGE_BYTES = 8 * HTB, NXCD = 8, WGM = 8;

__host__ __device__ __forceinline__ int lds_byte(int r, int c) { const int st = (r >> 4) * 2 + (c >> 5), rr = r & 15, cc = c & 31, ob = rr * 64 + cc * 2; return st * 1024 + (ob ^ (((ob >> 9) & 1) << 5)); }
__host__ __device__ __forceinline__ void stage_rc(int b, int& R, int& C) { const int st = b / 1024, sb = b % 1024, swz = sb ^ (((sb >> 9) & 1) << 5); R = (st >> 1) * 16 + swz / 64; C = (st & 1) * 32 + (swz % 64) / 2; }
__host__ __device__ __forceinline__ int perm32(int rho) { const int n = rho >> 4, i = rho & 15; return 8 * (i >> 2) + 4 * n + (i & 3); }

struct Unit { int pm, pn; };
struct Gemm { const bf16_t* A; const bf16_t* Bt; int M, N, K; };

struct StaticOrder {
    int nM, nN, nwg, G, c;
    __host__ __device__ void init(int M, int N, int G_, int c_) { nM = M / BM; nN = N / BM; nwg = nM * nN; G = G_; c = c_; }
    __host__ __device__ bool next(int i, Unit& u) const {
        const long L = (long)i * G + c; if (L >= nwg) return false;
        int wgid = (int)L; { const int q = nwg / NXCD, r = nwg % NXCD, xcd = wgid % NXCD, off = wgid / NXCD; wgid = (xcd < r ? xcd * (q + 1) : r * (q + 1) + (xcd - r) * q) + off; }
        const int nig = WGM * nN, gid = wgid / nig, fm = gid * WGM, gsz = (nM - fm) < WGM ? (nM - fm) : WGM;
        u.pm = fm + ((wgid % nig) % gsz); u.pn = (wgid % nig) / gsz; return true;
    }
    __device__ __forceinline__ void a_ready(const Unit&) const {}
    __device__ __forceinline__ void done(const Unit&) const {}
};

__device__ __forceinline__ unsigned cvt_pk_bf16(float lo, float hi) { unsigned r; asm volatile("v_cvt_pk_bf16_f32 %0, %1, %2" : "=v"(r) : "v"(lo), "v"(hi)); return r; }
typedef float f32x2 __attribute__((ext_vector_type(2)));
__device__ __forceinline__ f32x2 gelu_pk(f32x2 v) {
    const f32x2 u = v * (v * v * 0.044715f + 1.0f);
    const f32x2 s = u * (-2.302208198f);
    f32x2 e; e.x = __builtin_amdgcn_exp2f(s.x); e.y = __builtin_amdgcn_exp2f(s.y);
    const f32x2 d = e + 1.0f;
    f32x2 r; r.x = __builtin_amdgcn_rcpf(d.x); r.y = __builtin_amdgcn_rcpf(d.y);
    return v * r;
}

template <int ACT  > struct EpiBf16 {
    static constexpr bool PERM = true, AFTER_DRAIN = false; typedef f32x4 acc_t;
    bf16_t* O; int ldc; const float* bias; int split_cols; size_t split_stride; float scale0; int act_cols;
    __device__ __forceinline__ void operator()(const f32x4 (&acc)[2][2][4][2], const Unit& u, int wr, int wc, int fr, int fq) const {
        const int row0 = u.pm * BM + wr * 64 + fr; int colt = u.pn * BM; bf16_t* base = O;
        float sc = 1.f; if (split_cols) { const int t = colt / split_cols; base += (size_t)t * split_stride; colt -= t * split_cols; if (t == 0) sc = scale0; }
        const int col0 = colt + wc * 32 + 8 * fq, bcol0 = u.pn * BM + wc * 32 + 8 * fq;
        f32x4 bv[2][2];
#pragma unroll
        for (int bj = 0; bj < 2; ++bj)
#pragma unroll
            for (int n = 0; n < 2; ++n) bv[bj][n] = bias ? *(const f32x4*)(bias + bcol0 + bj * HALF + 4 * n) : (f32x4){0.f, 0.f, 0.f, 0.f};
#pragma unroll
        for (int ai = 0; ai < 2; ++ai)
#pragma unroll
            for (int m = 0; m < 4; ++m) { bf16_t* rowp = base + (size_t)(row0 + ai * HALF + m * 16) * ldc + col0;
#pragma unroll
                for (int bj = 0; bj < 2; ++bj) { f32x4 v0 = acc[ai][bj][m][0] + bv[bj][0], v1 = acc[ai][bj][m][1] + bv[bj][1];
                    if (ACT == 1 && u.pn * BM < act_cols) { f32x2 a = gelu_pk((f32x2){v0[0], v0[1]}), b = gelu_pk((f32x2){v0[2], v0[3]}), c = gelu_pk((f32x2){v1[0], v1[1]}), d = gelu_pk((f32x2){v1[2], v1[3]});
                        v0 = (f32x4){a.x, a.y, b.x, b.y}; v1 = (f32x4){c.x, c.y, d.x, d.y}; }
                    v0 = v0 * sc; v1 = v1 * sc; u32x4 w; w.x = cvt_pk_bf16(v0[0], v0[1]); w.y = cvt_pk_bf16(v0[2], v0[3]); w.z = cvt_pk_bf16(v1[0], v1[1]); w.w = cvt_pk_bf16(v1[2], v1[3]);
                    *(u32x4*)(rowp + bj * HALF) = w; } }
    }
};


template <int ACT> struct EpiI8 {
    static constexpr bool PERM = true, AFTER_DRAIN = false; typedef i32x4 acc_t;
    bf16_t* O; int ldc; const float* rs; const float* cs; int act_cols;
    __device__ __forceinline__ void operator()(const i32x4 (&acc)[2][2][4][2], const Unit& u, int wr, int wc, int fr, int fq) const {
        const int row0 = u.pm * BM + wr * 64 + fr, col0 = u.pn * BM + wc * 32 + 8 * fq;
        f32x4 cv[2][2];
#pragma unroll
        for (int bj = 0; bj < 2; ++bj)
#pragma unroll
            for (int n = 0; n < 2; ++n) cv[bj][n] = *(const f32x4*)(cs + col0 + bj * HALF + 4 * n);
#pragma unroll
        for (int ai = 0; ai < 2; ++ai)
#pragma unroll
            for (int m = 0; m < 4; ++m) { const int row = row0 + ai * HALF + m * 16; const float ra = rs[row]; bf16_t* rowp = O + (size_t)row * ldc + col0;
#pragma unroll
                for (int bj = 0; bj < 2; ++bj) {
                    f32x4 v0 = __builtin_convertvector(acc[ai][bj][m][0], f32x4) * ra * cv[bj][0], v1 = __builtin_convertvector(acc[ai][bj][m][1], f32x4) * ra * cv[bj][1];
                    if (ACT == 1 && u.pn * BM < act_cols) { f32x2 a = gelu_pk((f32x2){v0[0], v0[1]}), b = gelu_pk((f32x2){v0[2], v0[3]}), c = gelu_pk((f32x2){v1[0], v1[1]}), d = gelu_pk((f32x2){v1[2], v1[3]});
                        v0 = (f32x4){a.x, a.y, b.x, b.y}; v1 = (f32x4){c.x, c.y, d.x, d.y}; }
                    u32x4 w; w.x = cvt_pk_bf16(v0[0], v0[1]); w.y = cvt_pk_bf16(v0[2], v0[3]); w.z = cvt_pk_bf16(v1[0], v1[1]); w.w = cvt_pk_bf16(v1[2], v1[3]);
                    *(u32x4*)(rowp + bj * HALF) = w; } }
    }
};

__device__ __forceinline__ f32x4 mma16(bf16x8 a, bf16x8 b, f32x4 c) { return __builtin_amdgcn_mfma_f32_16x16x32_bf16(a, b, c, 0, 0, 0); }
__device__ __forceinline__ i32x4 mma16(bf16x8 a, bf16x8 b, i32x4 c) { return __builtin_amdgcn_mfma_i32_16x16x64_i8(__builtin_bit_cast(i32x4, a), __builtin_bit_cast(i32x4, b), c, 0, 0, 0); }
template <class Epi, class Sched, bool ALIGN_EPI = false, bool SP2 = false>
__device__ __forceinline__ void gemm_phase(PG8_LAS unsigned char* lds, const Gemm g, const Sched& S, const Epi& E, const int wid  ) {
    const int lane = (int)__builtin_amdgcn_mbcnt_hi(~0u, __builtin_amdgcn_mbcnt_lo(~0u, 0u)), tid = wid * 64 + lane, wr = wid >> 2, wc = wid & 3, fr = lane & 15, fq = lane >> 4;
    const int K = g.K, nt = K / BK;
    unsigned voffA[2], voffB[2];
#pragma unroll
    for (int i = 0; i < 2; ++i) { int R, C; stage_rc(tid * 16 + i * 8192, R, C); const int Rb = Epi::PERM ? ((R & ~31) + perm32(R & 31)) : R;
        voffA[i] = (unsigned)(R * K + C) * 2u; voffB[i] = (unsigned)(Rb * K + C) * 2u; }
    const size_t kstep = (size_t)(BK * 2);
    const size_t hstep = (size_t)HALF * K * 2;
    const size_t tstep = 2 * hstep;
    const unsigned ldsw = (unsigned)wid * 1024u;
    const int aoff = lds_byte(wr * 64 + fr, fq * 8), boff = lds_byte(wc * 32 + fr, fq * 8);
#define PG8_SA(b, h) (((b) * 2 + (h)) * HTB)
#define PG8_SB(b, h) ((4 + (b) * 2 + (h)) * HTB)
#define PG8_STAGE(bufoff, gbase, voff) do { _Pragma("unroll") for (int _i = 0; _i < 2; ++_i) \
        __builtin_amdgcn_global_load_lds((const unsigned*)((const char*)(gbase) + (voff)[_i]), (PG8_LAS unsigned*)(lds + (bufoff) + ldsw + _i * 8192), 16, 0, 0); } while (0)
#define PG8_LDA(dst, b, h) do { _Pragma("unroll") for (int m = 0; m < 4; ++m) _Pragma("unroll") for (int k = 0; k < 2; ++k) dst[m][k] = *(const PG8_LAS bf16x8*)(lds + PG8_SA(b, h) + aoff + m * 2048 + k * 1024); } while (0)
#define PG8_LDB(dst, b, h) do { _Pragma("unroll") for (int n = 0; n < 2; ++n) _Pragma("unroll") for (int k = 0; k < 2; ++k) dst[n][k] = *(const PG8_LAS bf16x8*)(lds + PG8_SB(b, h) + boff + n * 2048 + k * 1024); } while (0)
#define PG8_MMA(ai, bj, At, Bt) do { __builtin_amdgcn_s_setprio(1); _Pragma("unroll") for (int m = 0; m < 4; ++m) _Pragma("unroll") for (int n = 0; n < 2; ++n) _Pragma("unroll") for (int k = 0; k < 2; ++k) \
        acc[ai][bj][m][n] = mma16(Bt[n][k], At[m][k], acc[ai][bj][m][n]); __builtin_amdgcn_s_setprio(0); } while (0)
#define PG8_WAIT_V(n) asm volatile("s_waitcnt vmcnt(" #n ")" ::: "memory")
#define PG8_WAIT_L(n) asm volatile("s_waitcnt lgkmcnt(" #n ")" ::: "memory")
#define PG8_BAR __builtin_amdgcn_s_barrier()
#define PG8_SCHED __builtin_amdgcn_sched_barrier(0)
    Unit cur, nxt; int ui = 0;
    if (!S.next(0, cur)) return;
    typedef typename Epi::acc_t acc_t;
    acc_t acc[2][2][4][2];
#pragma unroll
    for (int a = 0; a < 2; ++a)
#pragma unroll
        for (int b = 0; b < 2; ++b)
#pragma unroll
            for (int m = 0; m < 4; ++m)
#pragma unroll
                for (int n = 0; n < 2; ++n) acc[a][b][m][n] = acc_t{};
    bf16x8 At[4][2], B0[2][2], B1[2][2];
    const char* cA = (const char*)g.A + (size_t)cur.pm * tstep; const char* cB = (const char*)g.Bt + (size_t)cur.pn * tstep;
    S.a_ready(cur);
    if constexpr (SP2) {
        PG8_STAGE(PG8_SB(0, 0), cB, voffB); PG8_STAGE(PG8_SB(0, 1), cB + hstep, voffB); PG8_STAGE(PG8_SA(0, 0), cA, voffA); PG8_STAGE(PG8_SA(0, 1), cA + hstep, voffA);
        if (wr == 1) PG8_BAR;
        PG8_WAIT_V(2); PG8_BAR;
        PG8_STAGE(PG8_SB(1, 0), cB + kstep, voffB); PG8_STAGE(PG8_SA(1, 0), cA + kstep, voffA); PG8_STAGE(PG8_SB(1, 1), cB + hstep + kstep, voffB);
        PG8_WAIT_V(6); PG8_BAR;
    } else {
        PG8_STAGE(PG8_SB(0, 0), cB, voffB); PG8_STAGE(PG8_SA(0, 0), cA, voffA); PG8_STAGE(PG8_SB(0, 1), cB + hstep, voffB); PG8_STAGE(PG8_SA(0, 1), cA + hstep, voffA);
        if (wr == 1) PG8_BAR;
        PG8_WAIT_V(4); PG8_BAR;
        PG8_STAGE(PG8_SB(1, 0), cB + kstep, voffB); PG8_STAGE(PG8_SA(1, 0), cA + kstep, voffA); PG8_STAGE(PG8_SB(1, 1), cB + hstep + kstep, voffB);
        PG8_WAIT_V(6); PG8_BAR;
    }
    for (;;) {
        const bool has_next = S.next(ui + 1, nxt);
        const char* nA = has_next ? (const char*)g.A + (size_t)nxt.pm * tstep : cA; const char* nB = has_next ? (const char*)g.Bt + (size_t)nxt.pn * tstep : cB;
        for (int t = 0; t < nt; t += 2) {
            const bool last = (t == nt - 2);
            const char* a1 = cA + (size_t)(t + 1) * kstep;
            const char* a2 = last ? nA : cA + (size_t)(t + 2) * kstep; const char* b2 = last ? nB : cB + (size_t)(t + 2) * kstep;
            const char* a3 = a2 + kstep; const char* b3 = b2 + kstep;
            if (last && has_next) S.a_ready(nxt);
            if constexpr (SP2) {
            PG8_LDB(B0, 0, 0); PG8_LDB(B1, 0, 1); PG8_SCHED; PG8_LDA(At, 0, 0); PG8_STAGE(PG8_SA(1, 1), a1 + hstep, voffA);
            PG8_WAIT_V(8); PG8_WAIT_L(0); PG8_BAR; PG8_MMA(0, 0, At, B0); PG8_MMA(0, 1, At, B1); PG8_BAR; PG8_SCHED;
            PG8_LDA(At, 0, 1); PG8_STAGE(PG8_SB(0, 0), b2, voffB); PG8_STAGE(PG8_SB(0, 1), b2 + hstep, voffB); PG8_STAGE(PG8_SA(0, 0), a2, voffA);
            PG8_WAIT_V(8); PG8_WAIT_L(0); PG8_BAR; PG8_MMA(1, 0, At, B0); PG8_MMA(1, 1, At, B1); PG8_BAR; PG8_SCHED;
            PG8_LDB(B0, 1, 0); PG8_LDB(B1, 1, 1); PG8_SCHED; PG8_LDA(At, 1, 0); PG8_STAGE(PG8_SA(0, 1), a2 + hstep, voffA);
            PG8_WAIT_V(8); PG8_WAIT_L(0); PG8_BAR; PG8_MMA(0, 0, At, B0); PG8_MMA(0, 1, At, B1); PG8_BAR; PG8_SCHED;
            PG8_LDA(At, 1, 1); PG8_STAGE(PG8_SB(1, 0), b3, voffB); PG8_STAGE(PG8_SB(1, 1), b3 + hstep, voffB); PG8_STAGE(PG8_SA(1, 0), a3, voffA);
            PG8_WAIT_V(8); PG8_WAIT_L(0); PG8_BAR; PG8_MMA(1, 0, At, B0); PG8_MMA(1, 1, At, B1); PG8_BAR; PG8_SCHED;
            } else {
            PG8_LDB(B0, 0, 0); PG8_SCHED; PG8_LDA(At, 0, 0); PG8_STAGE(PG8_SA(1, 1), a1 + hstep, voffA);
            PG8_WAIT_L(8); PG8_BAR; PG8_WAIT_L(0); PG8_MMA(0, 0, At, B0); PG8_BAR; PG8_SCHED;
            PG8_LDB(B1, 0, 1); PG8_STAGE(PG8_SB(0, 0), b2, voffB);
            PG8_BAR; PG8_WAIT_L(0); PG8_MMA(0, 1, At, B1); PG8_BAR;
            PG8_LDA(At, 0, 1); PG8_STAGE(PG8_SA(0, 0), a2, voffA);
            PG8_BAR; PG8_WAIT_L(0); PG8_MMA(1, 0, At, B0); PG8_BAR; PG8_SCHED;
            PG8_STAGE(PG8_SB(0, 1), b2 + hstep, voffB);
            PG8_WAIT_V(6); PG8_BAR; PG8_MMA(1, 1, At, B1); PG8_BAR;
            PG8_LDB(B0, 1, 0); PG8_SCHED; PG8_LDA(At, 1, 0); PG8_STAGE(PG8_SA(0, 1), a2 + hstep, voffA);
            PG8_WAIT_L(8); PG8_BAR; PG8_WAIT_L(0); PG8_MMA(0, 0, At, B0); PG8_BAR; PG8_SCHED;
            PG8_LDB(B1, 1, 1); PG8_STAGE(PG8_SB(1, 0), b3, voffB);
            PG8_BAR; PG8_WAIT_L(0); PG8_MMA(0, 1, At, B1); PG8_BAR;
            PG8_LDA(At, 1, 1); PG8_STAGE(PG8_SA(1, 0), a3, voffA);
            PG8_BAR; PG8_WAIT_L(0); PG8_MMA(1, 0, At, B0); PG8_BAR; PG8_SCHED;
            PG8_STAGE(PG8_SB(1, 1), b3 + hstep, voffB);
            PG8_WAIT_V(6); PG8_BAR; PG8_MMA(1, 1, At, B1); PG8_BAR;
            }
        }
        if constexpr (ALIGN_EPI) { if (wr == 0) PG8_BAR; }
        if constexpr (!Epi::AFTER_DRAIN) { E(acc, cur, wr, wc, fr, fq); S.done(cur); }
        if (!has_next) break;
#pragma unroll
        for (int a = 0; a < 2; ++a)
#pragma unroll
            for (int b = 0; b < 2; ++b)
#pragma unroll
                for (int m = 0; m < 4; ++m)
#pragma unroll
                    for (int n = 0; n < 2; ++n) acc[a][b][m][n] = acc_t{};
        cur = nxt; cA = nA; cB = nB; ++ui;
        if constexpr (ALIGN_EPI) { if (wr == 1) PG8_BAR; }
    }
    PG8_WAIT_V(0);
    if constexpr (!ALIGN_EPI) { if (wr == 0) PG8_BAR; }
    PG8_BAR;
    if constexpr (Epi::AFTER_DRAIN) { E.fused(acc, cur, wr, wc, fr, fq, lds, wid, lane); S.done(cur); }
#undef PG8_SA
#undef PG8_SB
#undef PG8_STAGE
#undef PG8_LDA
#undef PG8_LDB
#undef PG8_MMA
#undef PG8_WAIT_V
#undef PG8_WAIT_L
#undef PG8_BAR
#undef PG8_SCHED
}
}
#ifndef MK_PER_PHASE
#define MK_PER_PHASE 0
#endif
#ifndef PROBE_PHASE
#define PROBE_PHASE -1
#endif
#ifndef X1_NR
#define X1_NR 2
#endif
#ifndef TABLES_IN_PHASE
#define TABLES_IN_PHASE 0
#endif
constexpr int NWAVES = 8, NTHR = NWAVES * 64;
constexpr int BATCH = 8, SEQ = 4096, D = 1024, M = BATCH * SEQ;
constexpr int INC = 2560;
constexpr int NEXP = 16384, PKN = 128;
constexpr int NQ = 2048;
constexpr float EPS = 1e-6f;
constexpr size_t MiB = 1u << 20;
constexpr size_t WS_CTL = 0, CTL_ZERO_BYTES = MK_PER_PHASE ? (1u << 20) : 64 * 1024;
constexpr size_t WS_MOD = 1 * MiB, WS_WIN = 2 * MiB, WS_WOUT = 7 * MiB, WS_WQ = 9 * MiB, WS_KEYS = 13 * MiB, WS_SGW = 13 * MiB + 512 * 1024;
constexpr size_t WS_SU = 14 * MiB, WS_UT = 16 * MiB, WS_VT = 48 * MiB, WS_H = 80 * MiB, WS_Y = 144 * MiB, WS_OATT = 80 * MiB, WS_Z = 208 * MiB, WS_QP = 208 * MiB;
constexpr size_t WS_H8 = 336 * MiB;
constexpr size_t WS_CAT = 368 * MiB, WS_IDX = 432 * MiB, WS_GATE = 448 * MiB, WS_END = 464 * MiB;
constexpr int CW_BAR = 4096;
constexpr int RING_BYTES = 131072, LDSCTL_OFF = RING_BYTES, MISC_OFF = LDSCTL_OFF + 320, LDS_BYTES = 147456;
constexpr int NPHASE = 10;

#define GAS __attribute__((address_space(1)))
#define LAS __attribute__((address_space(3)))
typedef unsigned short bf16;
typedef unsigned v4u __attribute__((ext_vector_type(4)));
typedef unsigned v2u __attribute__((ext_vector_type(2)));
typedef float f32x4 __attribute__((ext_vector_type(4)));
typedef short bf16x8 __attribute__((ext_vector_type(8)));
typedef GAS unsigned gu32;
typedef GAS unsigned long long gu64;
#define RLX_AGENT __ATOMIC_RELAXED, __HIP_MEMORY_SCOPE_AGENT
#define LDS_WAIT() asm volatile("s_waitcnt lgkmcnt(0)" ::: "memory")
#define VM_WAIT() asm volatile("s_waitcnt vmcnt(0)" ::: "memory")
__device__ __forceinline__ unsigned f2bf(float f) { unsigned u = __builtin_bit_cast(unsigned, f); return (u + 0x7fffu + ((u >> 16) & 1u)) >> 16; }
__device__ __forceinline__ unsigned pk2(float lo, float hi) { return f2bf(lo) | (f2bf(hi) << 16); }
__device__ __forceinline__ float bflo(unsigned w) { return __uint_as_float(w << 16); }
__device__ __forceinline__ float bfhi(unsigned w) { return __uint_as_float(w & 0xffff0000u); }
__device__ __forceinline__ float bf2f(bf16 b) { return __uint_as_float((unsigned)b << 16); }
typedef __bf16 bf16x2_t __attribute__((ext_vector_type(2)));
__device__ __forceinline__ float dot2(unsigned a, unsigned b, float acc) { return __builtin_amdgcn_fdot2_f32_bf16(__builtin_bit_cast(bf16x2_t, a), __builtin_bit_cast(bf16x2_t, b), acc, false); }
__device__ __forceinline__ float gelu_t(float v) { const float u = v * (1.f + 0.044715f * v * v); return v * __builtin_amdgcn_rcpf(1.f + __builtin_amdgcn_exp2f(-2.302208198f * u)); }
__device__ __forceinline__ int lane_id() { return (int)__builtin_amdgcn_mbcnt_hi(~0u, __builtin_amdgcn_mbcnt_lo(~0u, 0u)); }
__device__ __forceinline__ float wave_sum(float v) {
#pragma unroll
    for (int o = 1; o < 64; o <<= 1) v += __shfl_xor(v, o);
    return v;
}
#define DPP_SUM_ROW(v) do { v += __uint_as_float((unsigned)__builtin_amdgcn_update_dpp(0, (int)__float_as_uint(v), 0xB1, 0xF, 0xF, false)); \
        v += __uint_as_float((unsigned)__builtin_amdgcn_update_dpp(0, (int)__float_as_uint(v), 0x4E, 0xF, 0xF, false)); \
        v += __uint_as_float((unsigned)__builtin_amdgcn_update_dpp(0, (int)__float_as_uint(v), 0x141, 0xF, 0xF, false)); \
        v += __uint_as_float((unsigned)__builtin_amdgcn_update_dpp(0, (int)__float_as_uint(v), 0x140, 0xF, 0xF, false)); } while (0)
__device__ __forceinline__ float dpp_xor1(float v) { return __uint_as_float((unsigned)__builtin_amdgcn_update_dpp(0, (int)__float_as_uint(v), 0xB1, 0xF, 0xF, false)); }
__device__ __forceinline__ float wave_sum_dpp(float v) {
    DPP_SUM_ROW(v);
    const float r0 = __uint_as_float(__builtin_amdgcn_readlane(__float_as_uint(v), 0)), r1 = __uint_as_float(__builtin_amdgcn_readlane(__float_as_uint(v), 16));
    const float r2 = __uint_as_float(__builtin_amdgcn_readlane(__float_as_uint(v), 32)), r3 = __uint_as_float(__builtin_amdgcn_readlane(__float_as_uint(v), 48));
    return (r0 + r1) + (r2 + r3);
}
__device__ __forceinline__ float wave_max_dpp(float v) {
    v = fmaxf(v, __uint_as_float((unsigned)__builtin_amdgcn_update_dpp(0, (int)__float_as_uint(v), 0xB1, 0xF, 0xF, false)));
    v = fmaxf(v, __uint_as_float((unsigned)__builtin_amdgcn_update_dpp(0, (int)__float_as_uint(v), 0x4E, 0xF, 0xF, false)));
    v = fmaxf(v, __uint_as_float((unsigned)__builtin_amdgcn_update_dpp(0, (int)__float_as_uint(v), 0x141, 0xF, 0xF, false)));
    v = fmaxf(v, __uint_as_float((unsigned)__builtin_amdgcn_update_dpp(0, (int)__float_as_uint(v), 0x140, 0xF, 0xF, false)));
    const float r0 = __uint_as_float(__builtin_amdgcn_readlane(__float_as_uint(v), 0)), r1 = __uint_as_float(__builtin_amdgcn_readlane(__float_as_uint(v), 16));
    const float r2 = __uint_as_float(__builtin_amdgcn_readlane(__float_as_uint(v), 32)), r3 = __uint_as_float(__builtin_amdgcn_readlane(__float_as_uint(v), 48));
    return fmaxf(fmaxf(r0, r1), fmaxf(r2, r3));
}
__device__ __forceinline__ float half_max_dpp(float v) {
    v = fmaxf(v, __uint_as_float((unsigned)__builtin_amdgcn_update_dpp(0, (int)__float_as_uint(v), 0xB1, 0xF, 0xF, false)));
    v = fmaxf(v, __uint_as_float((unsigned)__builtin_amdgcn_update_dpp(0, (int)__float_as_uint(v), 0x4E, 0xF, 0xF, false)));
    v = fmaxf(v, __uint_as_float((unsigned)__builtin_amdgcn_update_dpp(0, (int)__float_as_uint(v), 0x141, 0xF, 0xF, false)));
    v = fmaxf(v, __uint_as_float((unsigned)__builtin_amdgcn_update_dpp(0, (int)__float_as_uint(v), 0x140, 0xF, 0xF, false)));
    const float r0 = __uint_as_float(__builtin_amdgcn_readlane(__float_as_uint(v), 0)), r1 = __uint_as_float(__builtin_amdgcn_readlane(__float_as_uint(v), 16));
    const float r2 = __uint_as_float(__builtin_amdgcn_readlane(__float_as_uint(v), 32)), r3 = __uint_as_float(__builtin_amdgcn_readlane(__float_as_uint(v), 48));
    return (lane_id() < 32) ? fmaxf(r0, r1) : fmaxf(r2, r3);
}
__device__ __forceinline__ float wave_max(float v) {
#pragma unroll
    for (int o = 1; o < 64; o <<= 1) v = fmaxf(v, __shfl_xor(v, o));
    return v;
}
#define XB_TMO      128
#define XB_XCNT(j)  (256  + 64 * (j))
#define XB_XSUB(j)  (1280 + 64 * (j))
#define XB_XGEN(j)  (2304 + 64 * (j))
#define XB_TOP      3328
#define XB_TOPGEN   3392
#define XCD_BAR_WORDS 3456
#define XB_SPIN_CAP (1u << 18)

__device__ __forceinline__ unsigned xb_ld(unsigned* p)              { return __hip_atomic_load(p, __ATOMIC_RELAXED, __HIP_MEMORY_SCOPE_AGENT); }
__device__ __forceinline__ unsigned xb_add(unsigned* p, unsigned v) { return __hip_atomic_fetch_add(p, v, __ATOMIC_RELAXED, __HIP_MEMORY_SCOPE_AGENT); }
__device__ __forceinline__ unsigned xb_xcc_id() { return (unsigned)__builtin_amdgcn_s_getreg((3 << 11) | 20) & 0xFu; }
#define XB_SPIN(cond, bar) do { unsigned _sp = 0; while (cond) { __builtin_amdgcn_s_sleep(1); \
    if ((++_sp & 255u) == 0u) { if (xb_ld(&(bar)[XB_TMO])) break; if (_sp > XB_SPIN_CAP) { atomicAdd(&(bar)[XB_TMO], 1u); break; } } } } while (0)

struct XcdBarrier {
    unsigned* bar; unsigned x;
    volatile LAS unsigned* st;
};

__device__ __forceinline__ XcdBarrier xcd_barrier_post(unsigned* bar, volatile LAS unsigned* st) {
    XcdBarrier b; b.bar = bar; b.x = xb_xcc_id(); b.st = st;
    if (threadIdx.x == 0) (void)xb_add(&bar[XB_XCNT(b.x)], 1u);
    return b;
}
__device__ __forceinline__ void xcd_barrier_complete(unsigned* bar, unsigned x, unsigned& nloc, unsigned& nx) {
    const unsigned G = gridDim.x * gridDim.y * gridDim.z;
    unsigned sum, cnt, mine, sp = 0u;
    for (;;) {
        sum = 0u; cnt = 0u; mine = 0u;
#pragma unroll
        for (unsigned j = 0; j < 16; ++j) { const unsigned c = xb_ld(&bar[XB_XCNT(j)]); sum += c; cnt += (c > 0u) ? 1u : 0u; mine = (j == x) ? c : mine; }
        if (sum == G) break;
        __builtin_amdgcn_s_sleep(1);
        if ((++sp & 255u) == 0u) { if (xb_ld(&bar[XB_TMO])) break; if (sp > XB_SPIN_CAP) { atomicAdd(&bar[XB_TMO], 1u); break; } }
    }
    nloc = mine > 0u ? mine : 1u; nx = cnt > 0u ? cnt : 1u;
}

__device__ __forceinline__ void xcd_barrier(const XcdBarrier& b) {
    asm volatile("s_waitcnt vmcnt(0)" ::: "memory");
    __syncthreads();
    if (threadIdx.x == 0) {
        unsigned* bar = b.bar;
        __builtin_amdgcn_s_waitcnt(0);
        unsigned nloc = b.st[0], nx = b.st[1];
        if (nloc == 0u) { xcd_barrier_complete(bar, b.x, nloc, nx); b.st[0] = nloc; b.st[1] = nx; }
        const unsigned old = xb_add(&bar[XB_XSUB(b.x)], 1u);
        const unsigned gen = old / nloc;
        if (old + 1u == (gen + 1u) * nloc) {
            __builtin_amdgcn_fence(__ATOMIC_RELEASE, "agent");
            asm volatile("s_waitcnt vmcnt(0)" ::: "memory");
            const unsigned og = xb_add(&bar[XB_TOP], 1u);
            const unsigned tg = og / nx;
            if (og + 1u == (tg + 1u) * nx) xb_add(&bar[XB_TOPGEN], 1u);
            else XB_SPIN(xb_ld(&bar[XB_TOPGEN]) == tg, bar);
            __builtin_amdgcn_fence(__ATOMIC_ACQUIRE, "agent");
            xb_add(&bar[XB_XGEN(b.x)], 1u);
            asm volatile("s_waitcnt vmcnt(0)" ::: "memory");
        } else {
            XB_SPIN(xb_ld(&bar[XB_XGEN(b.x)]) == gen, bar);
            __builtin_amdgcn_fence(__ATOMIC_ACQUIRE, "agent");
            asm volatile("s_waitcnt vmcnt(0)" ::: "memory");
        }
    }
    __syncthreads();
}
struct Frame {
    LAS unsigned char* lds;
    volatile LAS unsigned* MISC;
    gu32* ctl;
    int wave, G;
    const float *x, *c, *w_ada, *b_ada, *norm_g, *w_in, *sgu_ln_g, *sgu_ln_b, *sgu_w, *sgu_b, *diff_lambda, *subln_g, *rel_bias, *w_out, *w_query, *sub_keys, *peer_u, *peer_v;
    float* out;
    float* mod; bf16 *WIN, *WOUT, *WQ, *KEYS, *SGW, *H, *Y, *Z, *QP, *CAT; unsigned char *UT8, *VT6, *H8, *HA8, *W8, *WQ8; float *HS, *HAS, *WS8, *WQS8; float *SU, *SV, *PART; unsigned* STASH; int* IDX; float* GATE;
};

__device__ __forceinline__ void p0_transpose_item(const float* W, int K, int N, bf16* WT, int row_off, LAS float* scr, int item, int lane) {
    const int nblk = N / 32, kb = item / nblk, nb = item % nblk, k0 = 64 * kb, n0 = 32 * nb;
#pragma unroll 8
    for (int i = 0; i < 32; ++i) { const int kk = 2 * i + (lane >> 5); scr[kk * 33 + (lane & 31)] = W[(size_t)(k0 + kk) * N + n0 + (lane & 31)]; }
    LDS_WAIT(); asm volatile("" ::: "memory");
    const int c = lane & 7;
#pragma unroll
    for (int j = 0; j < 4; ++j) { const int n = (lane >> 3) + 8 * j; const LAS float* s = scr + (8 * c) * 33 + n;
        v4u o; o.x = pk2(s[0 * 33], s[1 * 33]); o.y = pk2(s[2 * 33], s[3 * 33]); o.z = pk2(s[4 * 33], s[5 * 33]); o.w = pk2(s[6 * 33], s[7 * 33]);
        *(GAS v4u*)(WT + (size_t)(row_off + n0 + n) * K + k0 + 8 * c) = o; }
    LDS_WAIT(); asm volatile("" ::: "memory");
}

__device__ __forceinline__ void prologue_tables_fwd(Frame& F, int gw, int NGW, int lane);
__device__ __forceinline__ void ph_prologue(Frame& F) {
    const int lane = lane_id(), wave = F.wave, tid = wave * 64 + lane, G = F.G;
    const int gw = blockIdx.x * NWAVES + wave, NGW = G * NWAVES;
    for (int rep_ = 0; rep_ < (PROBE_PHASE == 100 ? 2 : 1); ++rep_) {
        LAS float* sil = (LAS float*)F.lds;
        LAS float* red = sil + 8192;
        for (int i = tid; i < 8192; i += NTHR) { const float cv = F.c[i]; sil[i] = cv / (1.f + __expf(-cv)); }
        __syncthreads();
        for (int u = blockIdx.x; u < 384; u += G) {
            const int j = u * 16 + (lane & 15), kr = lane >> 4, k0 = wave * 128;
            float acc[8];
#pragma unroll
            for (int b = 0; b < 8; ++b) acc[b] = 0.f;
            const float* wp = F.w_ada + (size_t)(k0 + kr) * 6144 + j;
#pragma unroll 16
            for (int i = 0; i < 32; ++i) { const float w = wp[(size_t)i * 4 * 6144]; const int k = k0 + 4 * i + kr;
#pragma unroll
                for (int b = 0; b < 8; ++b) acc[b] += sil[b * 1024 + k] * w; }
#pragma unroll
            for (int b = 0; b < 8; ++b) { acc[b] += __shfl_xor(acc[b], 16); acc[b] += __shfl_xor(acc[b], 32); }
            if (lane < 16) {
#pragma unroll
                for (int b = 0; b < 8; ++b) red[(wave * 8 + b) * 16 + lane] = acc[b]; }
            __syncthreads();
            if (tid < 128) { const int b = tid >> 4, c = tid & 15; float s = 0.f;
#pragma unroll
                for (int w = 0; w < 8; ++w) s += red[(w * 8 + b) * 16 + c];
                F.mod[b * 6144 + u * 16 + c] = s + F.b_ada[u * 16 + c]; }
            __syncthreads();
        }
    }
    LAS float* scr = (LAS float*)(F.lds + wave * 16384);
    {
        LAS float* part = (LAS float*)(F.lds + 7 * 16384 + 8704);
        LAS float* fin = part + 256;
        const int n = lane & 31, hf = lane >> 5;
        for (int u = blockIdx.x; u < (INC + NQ) / 32; u += G) {
            const bool isq = u >= INC / 32;
            const float* Wsrc = isq ? F.w_query : F.w_in; const int Nw = isq ? NQ : INC; unsigned char* Wdst = isq ? F.WQ8 : F.W8; float* Sdst = isq ? F.WQS8 : F.WS8;
            const int n0 = (isq ? u - INC / 32 : u) * 32;
            float am = 0.f;
            { const float* wp = Wsrc + (size_t)(wave * 128 + hf) * Nw + n0 + n;
#pragma unroll 16
              for (int i = 0; i < 64; ++i) am = fmaxf(am, fabsf(wp[(size_t)(2 * i) * Nw])); }
            { auto rr = __builtin_amdgcn_permlane32_swap(__float_as_uint(am), __float_as_uint(am), false, false); am = fmaxf(__uint_as_float(rr[0]), __uint_as_float(rr[1])); }
            if (lane < 32) part[wave * 32 + lane] = am;
            __syncthreads();
            if (tid < 32) { float mx = 0.f;
#pragma unroll
                for (int w = 0; w < 8; ++w) mx = fmaxf(mx, part[w * 32 + tid]);
                const float qsc = (!isq && n0 >= 1024 && n0 < 1536) ? 0.125f * 1.4426950408889634f : 1.f;
                fin[tid] = mx; Sdst[n0 + tid] = (mx > 0.f ? mx * (1.f / 127.f) : 1.f) * qsc; }
            __syncthreads();
            const float cmx = fin[n]; const float sc = cmx > 0.f ? 127.f / cmx : 1.f;
#pragma unroll 1
            for (int q = 0; q < 2; ++q) { const int k0 = (wave * 2 + q) * 64;
#pragma unroll 8
                for (int i = 0; i < 32; ++i) { const int kk = 2 * i + hf; scr[kk * 33 + n] = Wsrc[(size_t)(k0 + kk) * Nw + n0 + n]; }
                LDS_WAIT(); asm volatile("" ::: "memory");
                unsigned w8[8];
#pragma unroll
                for (int d = 0; d < 8; ++d) { const LAS float* s = scr + (32 * hf + 4 * d) * 33 + n;
                    const int q0 = (int)rintf(s[0] * sc), q1 = (int)rintf(s[33] * sc), q2 = (int)rintf(s[66] * sc), q3 = (int)rintf(s[99] * sc);
                    w8[d] = (unsigned)((q0 & 255) | ((q1 & 255) << 8) | ((q2 & 255) << 16) | (q3 << 24)); }
                unsigned char* op = Wdst + (size_t)(n0 + n) * D + k0 + 32 * hf;
                *(GAS v4u*)op = (v4u){w8[0], w8[1], w8[2], w8[3]}; *(GAS v4u*)(op + 16) = (v4u){w8[4], w8[5], w8[6], w8[7]};
                LDS_WAIT(); asm volatile("" ::: "memory"); }
            __syncthreads();
        }
    }
    constexpr int I_IN = 0, I_OUT = (D / 64) * (D / 32), I_Q = 0;
    for (int rep_ = 0; rep_ < (PROBE_PHASE == 101 ? 2 : 1); ++rep_)
    for (int it = gw; it < I_IN + I_OUT + I_Q; it += NGW) {
        int r = it;
        if (r < I_IN) { p0_transpose_item(F.w_in, D, INC, F.WIN, 0, scr, r, lane); continue; } r -= I_IN;
        if (r < I_OUT) { p0_transpose_item(F.w_out, D, D, F.WOUT, 0, scr, r, lane); continue; } r -= I_OUT;
        (void)r;
    }
    const int gt = blockIdx.x * NTHR + tid, NT = G * NTHR;
    if (TABLES_IN_PHASE == 0) for (int rep_ = 0; rep_ < (PROBE_PHASE == 102 ? 2 : 1); ++rep_) prologue_tables_fwd(F, gw, NGW, lane);
    for (int i = gt; i < 16 * 16 * 128; i += NT) {
        const int hc = i >> 11, dg = (i >> 7) & 15, n = i & 127;
        const float* s = F.sub_keys + ((size_t)(hc * 128 + n)) * 128 + dg * 8;
        const f32x4 a = *(const f32x4*)s, b = *(const f32x4*)(s + 4);
        v4u o; o.x = pk2(a.x, a.y); o.y = pk2(a.z, a.w); o.z = pk2(b.x, b.y); o.w = pk2(b.z, b.w); ((v4u*)F.KEYS)[i] = o;
    }
    for (int i = gt; i < 8 * 128 * 16; i += NT) {
        const int t = (i >> 4) & 127, s0 = (i & 15) * 8;
        const float* s = F.sgu_w + (size_t)i * 8;
        const f32x4 a = *(const f32x4*)s, b = *(const f32x4*)(s + 4);
        float f[8] = {a.x, a.y, a.z, a.w, b.x, b.y, b.z, b.w};
#pragma unroll
        for (int e = 0; e < 8; ++e) f[e] = (s0 + e <= t) ? f[e] : 0.f;
        v4u o; o.x = pk2(f[0], f[1]); o.y = pk2(f[2], f[3]); o.z = pk2(f[4], f[5]); o.w = pk2(f[6], f[7]); ((v4u*)F.SGW)[i] = o;
    }
}

__device__ __forceinline__ void ph_hrows(Frame& F) {
    const int lane = lane_id(); const int gw = blockIdx.x * NWAVES + F.wave, NGW = F.G * NWAVES;
    for (int m0 = gw; m0 < M; m0 += 2 * NGW) {
        const int m1 = (m0 + NGW < M) ? m0 + NGW : m0;
        f32x4 v[2][4]; float ss[2] = {0.f, 0.f};
#pragma unroll
        for (int u = 0; u < 2; ++u) { const f32x4* xr = (const f32x4*)(F.x + (size_t)(u ? m1 : m0) * D) + lane;
#pragma unroll
            for (int j = 0; j < 4; ++j) v[u][j] = xr[64 * j]; }
#pragma unroll
        for (int u = 0; u < 2; ++u)
#pragma unroll
            for (int j = 0; j < 4; ++j) ss[u] += (v[u][j].x * v[u][j].x + v[u][j].y * v[u][j].y) + (v[u][j].z * v[u][j].z + v[u][j].w * v[u][j].w);
        const float r0 = rsqrtf(wave_sum_dpp(ss[0]) * (1.f / D) + EPS), r1 = rsqrtf(wave_sum_dpp(ss[1]) * (1.f / D) + EPS);
#pragma unroll
        for (int u = 0; u < 2; ++u) { const int m = u ? m1 : m0; const float rstd = u ? r1 : r0;
            const float* md = F.mod + (m >> 12) * 6144;
            float am = 0.f;
#pragma unroll
            for (int j = 0; j < 4; ++j) { const int c = 256 * j + 4 * lane;
                const f32x4 g = *(const f32x4*)(F.norm_g + c), sc = *(const f32x4*)(md + 1024 + c), sh = *(const f32x4*)(md + c);
                const f32x4 hv = v[u][j] * rstd * g * (sc + 1.f) + sh; v[u][j] = hv;
                am = fmaxf(am, fmaxf(fmaxf(fabsf(hv.x), fabsf(hv.y)), fmaxf(fabsf(hv.z), fabsf(hv.w)))); }
            am = wave_max_dpp(am);
            const float s8 = am > 0.f ? 127.f / am : 1.f;
            unsigned* h8 = (unsigned*)(F.HA8 + (size_t)m * D) + lane;
#pragma unroll
            for (int j = 0; j < 4; ++j) { const int q0 = (int)rintf(v[u][j].x * s8), q1 = (int)rintf(v[u][j].y * s8), q2 = (int)rintf(v[u][j].z * s8), q3 = (int)rintf(v[u][j].w * s8);
                if (u == 0 || m1 != m0) h8[64 * j] = (unsigned)((q0 & 255) | ((q1 & 255) << 8) | ((q2 & 255) << 16) | (q3 << 24)); }
            if (lane == 0 && (u == 0 || m1 != m0)) F.HAS[m] = 1.f / s8; }
    }
}

__device__ __forceinline__ void ph_x1rows(Frame& F) {
    const int lane = lane_id(); const int gw = blockIdx.x * NWAVES + F.wave, NGW = F.G * NWAVES;
    constexpr int NR = X1_NR;
    for (int m0 = gw; m0 < M; m0 += NR * NGW) {
        int mr[NR]; bool ok[NR];
#pragma unroll
        for (int u = 0; u < NR; ++u) { ok[u] = (m0 + u * NGW < M); mr[u] = ok[u] ? m0 + u * NGW : m0; }
        f32x4 xv[NR][4], yv[NR][4]; float ss[NR];
#pragma unroll
        for (int u = 0; u < NR; ++u) { const int m = mr[u]; ss[u] = 0.f;
            const f32x4* xr = (const f32x4*)(F.x + (size_t)m * D) + lane; const v2u* yr = (const v2u*)(F.Y + (size_t)m * D) + lane;
#pragma unroll
            for (int j = 0; j < 4; ++j) { xv[u][j] = xr[64 * j]; const v2u w = yr[64 * j]; yv[u][j] = (f32x4){bflo(w.x), bfhi(w.x), bflo(w.y), bfhi(w.y)}; } }
#pragma unroll
        for (int u = 0; u < NR; ++u)
#pragma unroll
            for (int j = 0; j < 4; ++j) ss[u] += (yv[u][j].x * yv[u][j].x + yv[u][j].y * yv[u][j].y) + (yv[u][j].z * yv[u][j].z + yv[u][j].w * yv[u][j].w);
        float rs[NR], s1[NR];
#pragma unroll
        for (int u = 0; u < NR; ++u) { rs[u] = rsqrtf(wave_sum_dpp(ss[u]) * (1.f / D) + EPS); s1[u] = 0.f; }
#pragma unroll
        for (int u = 0; u < NR; ++u) { const int m = mr[u]; const float* md = F.mod + (m >> 12) * 6144; const float rstd = rs[u];
            f32x4* orow = (f32x4*)(F.out + (size_t)m * D) + lane;
#pragma unroll
            for (int j = 0; j < 4; ++j) { const int c = 256 * j + 4 * lane;
                const f32x4 g1 = *(const f32x4*)(F.norm_g + 1024 + c), gt = *(const f32x4*)(md + 2048 + c);
                xv[u][j] = xv[u][j] + gt * (yv[u][j] * rstd * g1); if (ok[u]) orow[64 * j] = xv[u][j];
                s1[u] += (xv[u][j].x * xv[u][j].x + xv[u][j].y * xv[u][j].y) + (xv[u][j].z * xv[u][j].z + xv[u][j].w * xv[u][j].w); } }
        float r1v[NR];
#pragma unroll
        for (int u = 0; u < NR; ++u) r1v[u] = rsqrtf(wave_sum_dpp(s1[u]) * (1.f / D) + EPS);
#pragma unroll
        for (int u = 0; u < NR; ++u) { const int m = mr[u]; const float* md = F.mod + (m >> 12) * 6144; const float r1 = r1v[u];
#pragma unroll
            for (int j = 0; j < 4; ++j) { const int c = 256 * j + 4 * lane;
                const f32x4 g2 = *(const f32x4*)(F.norm_g + 2048 + c), sc = *(const f32x4*)(md + 4096 + c), sh = *(const f32x4*)(md + 3072 + c);
                const f32x4 hv = xv[u][j] * r1 * g2 * (sc + 1.f) + sh; xv[u][j] = hv;
                }
            float am = 0.f;
#pragma unroll
            for (int j = 0; j < 4; ++j) am = fmaxf(am, fmaxf(fmaxf(fabsf(xv[u][j].x), fabsf(xv[u][j].y)), fmaxf(fabsf(xv[u][j].z), fabsf(xv[u][j].w))));
            am = wave_max_dpp(am);
            const float s8 = am > 0.f ? 127.f / am : 1.f;
            unsigned* h8 = (unsigned*)(F.H8 + (size_t)m * D) + lane;
#pragma unroll
            for (int j = 0; j < 4; ++j) { const int q0 = (int)rintf(xv[u][j].x * s8), q1 = (int)rintf(xv[u][j].y * s8), q2 = (int)rintf(xv[u][j].z * s8), q3 = (int)rintf(xv[u][j].w * s8);
                if (ok[u]) h8[64 * j] = (unsigned)((q0 & 255) | ((q1 & 255) << 8) | ((q2 & 255) << 16) | (q3 << 24)); }
            if (lane == 0 && ok[u]) F.HS[m] = 1.f / s8; }
    }
}

namespace att {
typedef float f32x16 __attribute__((ext_vector_type(16)));
typedef short s16x4 __attribute__((ext_vector_type(4)));
typedef short v4i16_t __attribute__((ext_vector_type(4)));
constexpr int QB = 256, KVB = 64;
constexpr int NS = 4;
constexpr int BTO = 288, BTN = 416;
constexpr int L_V = 0, L_K = NS * 16384, L_WS = L_K + NS * 8192, L_BT = L_WS + 2048, L_END = L_BT + 2048;
constexpr float C2 = 0.125f * 1.4426950408889634f;
__device__ __forceinline__ int v_st(int k, int c) { const int kk = (k & ~0xC) | ((k & 4) << 1) | ((k & 8) >> 1); return ((kk >> 3) * 4 + (c >> 5)) * 512 + ((kk & 7) * 32 + (c & 31)) * 2; }
__device__ __forceinline__ int v_rd_base(int lane) { return ((lane & 3) << 3) | (((lane >> 2) & 3) << 6) | (((lane >> 4) & 1) << 5) | (((lane >> 5) & 1) << 8); }
__device__ __forceinline__ unsigned v_src(int p) { const int sub = p >> 5, q = p & 31, kk = (sub >> 2) * 8 + (q >> 2), c = (sub & 3) * 32 + (q & 3) * 8;
    const int k = kk; return (unsigned)(k * INC + c) * 2u; }
__device__ __forceinline__ int crow(int r, int hi) { return (r & 3) + 8 * (r >> 2) + 4 * hi; }
typedef float f32x2_t __attribute__((ext_vector_type(2))); typedef __bf16 bf16x2_t __attribute__((ext_vector_type(2)));
__device__ __forceinline__ unsigned cvtpk(float lo, float hi) { const f32x2_t v = {lo, hi}; const bf16x2_t b = __builtin_convertvector(v, bf16x2_t); return __builtin_bit_cast(unsigned, b); }

__device__ __forceinline__ void attn_unit(Frame& F, int b, int h, int qb, float lam) {
    int tid = F.wave * 64 + lane_id(); asm volatile("" : "+v"(tid));
    const int lane = tid & 63, wid = F.wave, r32 = lane & 31, hi = lane >> 5;
    LAS unsigned char* lds = F.lds;
    LAS float* wsf = (LAS float*)(lds + L_WS) + wid * 64;
    const LAS float* bt = (const LAS float*)(lds + L_BT);
    const int q0 = qb * QB, qlo = q0 + wid * 32, qpos = qlo + r32;
    const size_t rowb = (size_t)b * SEQ;
    const int NT = (q0 + QB) / KVB;
    const unsigned kdoff = (unsigned)((tid >> 3) * INC + (((tid & 7) ^ ((tid >> 3) & 7)) * 8)) * 2u;
    const unsigned vdoff0 = v_src(tid), vdoff1 = v_src(tid + 512);
    const unsigned qoff = (unsigned)(r32 * INC + hi * 8) * 2u;
#define GLDS16(g_, lb_) do { unsigned sv_; asm volatile("s_mov_b32 %0, m0\n\ts_mov_b32 m0, %2\n\ts_nop 0\n\tglobal_load_lds_dwordx4 %1, off\n\ts_mov_b32 m0, %0" : "=&s"(sv_) : "v"(g_), "s"(lb_) : "memory"); } while (0)
#define DMA_K(t_, buf_) do { unsigned kd_ = kdoff; asm volatile("" : "+v"(kd_)); GLDS16(Kb + (size_t)(t_) * (KVB * INC * 2) + kd_, (unsigned)__builtin_amdgcn_readfirstlane((int)(uintptr_t)(lds + L_K + (buf_) * 8192 + wid * 1024))); } while (0)
#define DMA_V(t_, buf_) do { unsigned v0_ = vdoff0, v1_ = vdoff1; asm volatile("" : "+v"(v0_), "+v"(v1_)); const unsigned lb_ = (unsigned)__builtin_amdgcn_readfirstlane((int)(uintptr_t)(lds + L_V + (buf_) * 16384 + wid * 1024)); \
        GLDS16(Vb + (size_t)(t_) * (KVB * INC * 2) + v0_, lb_); GLDS16(Vb + (size_t)(t_) * (KVB * INC * 2) + v1_, lb_ + 8192u); } while (0)
#define DMA_TILE(t_) do { const int sl_ = (t_) & (NS - 1); DMA_K(t_, sl_); DMA_V(t_, sl_); } while (0)
#define ABAR() do { asm volatile("s_waitcnt lgkmcnt(0)" ::: "memory"); __builtin_amdgcn_s_barrier(); asm volatile("" ::: "memory"); } while (0)
    const int vbase = (int)(uintptr_t)(lds + L_V) + v_rd_base(lane);
    const int kroff = r32 * 128, kx = (r32 & 7) << 4;
#pragma unroll
    for (int c = 0; c < 2; ++c) {
        const char* Kb = (const char*)(F.Z + rowb * INC + 1536 + h * 128 + c * 64);
        const char* Vb = (const char*)(F.Z + rowb * INC + 2048 + h * 128);
        const char* Qb = (const char*)(F.Z + (rowb + qlo) * INC + 1024 + h * 128 + c * 64);
        bf16x8 qr[4];
#pragma unroll
        for (int d0 = 0; d0 < 4; ++d0) qr[d0] = *(const bf16x8*)(Qb + d0 * 32 + qoff);
        DMA_K(0, 0); DMA_V(0, 0); DMA_K(1, 1); DMA_K(2, 2); DMA_V(1, 1); DMA_K(3, 3); DMA_V(2, 2);
        asm volatile("s_waitcnt vmcnt(9)" ::: "memory");
        ABAR();
        float mhat, l = 0.f; bool resc = false;
        f32x16 o[4];
#pragma unroll
        for (int d0 = 0; d0 < 4; ++d0) o[d0] = f32x16{};
        f32x16 pA0, pA1, pB0, pB1; bf16x8 kf[4]; s16x4 vlo[4], vhi[4]; v4u pw0, pw1, pw2, pw3;
        f32x16 negm; { float z_ = 0.f; asm volatile("" : "+v"(z_));
#pragma unroll
          for (int r = 0; r < 16; ++r) negm[r] = z_; }
        asm volatile("" : "+v"(negm));
#define SBAR() __builtin_amdgcn_sched_barrier(0)
#define PIN(x) asm volatile("" : "+v"(x))
#define MFMA32(a_, b_, c_) __builtin_amdgcn_mfma_f32_32x32x16_bf16(a_, b_, c_, 0, 0, 0)
#define KLD2(su, d0) do { const LAS unsigned char* a_ = lds + L_K + (su) * 8192 + kroff + (((d0) * 32 + hi * 16) ^ kx); kf[2 * ((d0) & 1)] = *(const LAS bf16x8*)a_; kf[2 * ((d0) & 1) + 1] = *(const LAS bf16x8*)(a_ + 4096); } while (0)
#define VTR(p_) __builtin_bit_cast(s16x4, __builtin_amdgcn_ds_read_tr16_b64_v4i16((LAS v4i16_t*)(p_)))
#define VRD(i) do { const LAS unsigned char* p_ = vp_ + ((i) >> 2) * 512 + ((i) & 3) * 4096; vlo[(i) & 3] = VTR(p_); vhi[(i) & 3] = VTR(p_ + 2048); } while (0)
#define VFR(i) (bf16x8){vlo[(i) & 3][0], vlo[(i) & 3][1], vlo[(i) & 3][2], vlo[(i) & 3][3], vhi[(i) & 3][0], vhi[(i) & 3][1], vhi[(i) & 3][2], vhi[(i) & 3][3]}
#define PAF(k) __builtin_bit_cast(bf16x8, pw##k)
#define MX3(a_, b_, c_) fmaxf(fmaxf((a_), (b_)), (c_))
#define ROWMAX(P0, P1, OUT) do { float a_ = MX3(P0[0], P0[1], P1[0]), b_ = MX3(P0[2], P0[3], P1[1]); a_ = MX3(a_, P1[2], P1[3]); \
        _Pragma("unroll") for (int r = 4; r < 16; r += 4) { a_ = MX3(a_, P0[r], P0[r + 1]); b_ = MX3(b_, P0[r + 2], P0[r + 3]); a_ = MX3(a_, P1[r], P1[r + 1]); b_ = MX3(b_, P1[r + 2], P1[r + 3]); } \
        float m_ = fmaxf(a_, b_); auto rr_ = __builtin_amdgcn_permlane32_swap(__float_as_uint(m_), __float_as_uint(m_), false, false); OUT = fmaxf(__uint_as_float(rr_[0]), __uint_as_float(rr_[1])); } while (0)
#define FIX_TILE(N0, N1, u) do { if (qlo - (u) * KVB - 63 < 113) { int qp_ = qpos - 4 * hi; asm volatile("" : "+v"(qp_)); const int dq_ = qp_ - (u) * KVB + BTO;     \
        _Pragma("unroll") for (int r = 0; r < 16; ++r) { const int i0_ = dq_ - ((r & 3) + 8 * (r >> 2)), i1_ = i0_ - 32; \
            N0[r] += bt[i0_ > BTN - 1 ? BTN - 1 : i0_]; N1[r] += bt[i1_ > BTN - 1 ? BTN - 1 : (i1_ < 0 ? 0 : i1_)]; } } } while (0)
#define EX(v) __builtin_amdgcn_exp2f(v)
#define RESC() do { if (resc) { _Pragma("unroll") for (int r = 0; r < 16; ++r) { const float a_ = wsf[crow(r, hi)]; _Pragma("unroll") for (int d0 = 0; d0 < 4; ++d0) o[d0][r] *= a_; } } } while (0)
#define PKH0(P, B_, PW) do { PW.x = cvtpk(P[B_ + 0], P[B_ + 1]); PW.y = cvtpk(P[B_ + 2], P[B_ + 3]); } while (0)
#define PKH1(P, B_, PW) do { PW.z = cvtpk(P[B_ + 4], P[B_ + 5]); PW.w = cvtpk(P[B_ + 6], P[B_ + 7]); } while (0)
#define GAPA(MF, a0, a1, a2, a3, PK, PW) do { MF; sacc += a0; sacc += a1; sacc += a2; sacc += a3; PK; PIN(PW); PIN(sacc); SBAR(); } while (0)
#define GAPB(MF, X, i) do { MF; X[i] = EX(X[i]); X[i + 1] = EX(X[i + 1]); PIN(X); SBAR(); } while (0)
        KLD2(0, 0); KLD2(0, 1);
        pA0 = MFMA32(kf[0], qr[0], negm); pA1 = MFMA32(kf[1], qr[0], negm); pA0 = MFMA32(kf[2], qr[1], pA0); pA1 = MFMA32(kf[3], qr[1], pA1);
        KLD2(0, 2); KLD2(0, 3);
        pA0 = MFMA32(kf[0], qr[2], pA0); pA1 = MFMA32(kf[1], qr[2], pA1); pA0 = MFMA32(kf[2], qr[3], pA0); pA1 = MFMA32(kf[3], qr[3], pA1);
        FIX_TILE(pA0, pA1, 0);
        { float rm; ROWMAX(pA0, pA1, rm); mhat = rm;
#pragma unroll
          for (int r = 0; r < 16; ++r) negm[r] = -mhat;
          asm volatile("" : "+v"(negm));
#pragma unroll
          for (int r = 0; r < 16; ++r) { pA0[r] = EX(pA0[r] - rm); pA1[r] = EX(pA1[r] - rm); } }
        asm volatile("s_waitcnt vmcnt(5)" ::: "memory");
        ABAR();
        KLD2(1, 0); KLD2(1, 1);
#define STEP(C0, C1, P0, P1, t) do { SBAR(); \
        if ((t) + 3 < NT) DMA_K((t) + 3, ((t) + 3) & (NS - 1)); if ((t) + 2 < NT) DMA_V((t) + 2, ((t) + 2) & (NS - 1)); \
        const LAS unsigned char* vp_ = (const LAS unsigned char*)(uintptr_t)(vbase + (((t) - 1) & (NS - 1)) * 16384); \
        const int ksl_ = ((t) + 1) & (NS - 1); const bool gl_ = (t) + 1 < NT; \
        float sacc = 0.f; \
                        GAPA(C0 = MFMA32(kf[0], qr[0], negm), P0[0], P0[1], P0[2], P0[3],     PKH0(P0, 0, pw0), pw0); \
                        GAPA(C1 = MFMA32(kf[1], qr[0], negm), P0[4], P0[5], P0[6], P0[7],     PKH1(P0, 0, pw0), pw0); KLD2((t) & (NS - 1), 2); SBAR();     \
                        GAPA(C0 = MFMA32(kf[2], qr[1], C0),   P0[8], P0[9], P0[10], P0[11],   PKH0(P0, 8, pw1), pw1); \
                        GAPA(C1 = MFMA32(kf[3], qr[1], C1),   P0[12], P0[13], P0[14], P0[15], PKH1(P0, 8, pw1), pw1); KLD2((t) & (NS - 1), 3); SBAR(); \
        VRD(0); SBAR(); GAPA(C0 = MFMA32(kf[0], qr[2], C0),   P1[0], P1[1], P1[2], P1[3],     PKH0(P1, 0, pw2), pw2); \
        VRD(1); SBAR(); GAPA(C1 = MFMA32(kf[1], qr[2], C1),   P1[4], P1[5], P1[6], P1[7],     PKH1(P1, 0, pw2), pw2); \
        VRD(2); SBAR(); GAPA(C0 = MFMA32(kf[2], qr[3], C0),   P1[8], P1[9], P1[10], P1[11],   PKH0(P1, 8, pw3), pw3); \
        VRD(3); SBAR(); GAPA(C1 = MFMA32(kf[3], qr[3], C1),   P1[12], P1[13], P1[14], P1[15], PKH1(P1, 8, pw3), pw3); \
        l += sacc; \
        FIX_TILE(C0, C1, t); \
        { float rm_; ROWMAX(C0, C1, rm_); resc = false;                                                    \
          if (__builtin_expect(__any(rm_ > 8.0f), 0)) { const float dl_ = fmaxf(rm_, 0.f); mhat += dl_;     \
              _Pragma("unroll") for (int r = 0; r < 16; ++r) { C0[r] -= dl_; C1[r] -= dl_; } \
              _Pragma("unroll") for (int r = 0; r < 16; ++r) negm[r] = -mhat; \
              asm volatile("" : "+v"(negm)); \
              const float f_ = __builtin_amdgcn_exp2f(-dl_); l *= f_; if (hi == 0) wsf[r32] = f_; resc = true; } } \
        SBAR(); \
        GAPB(o[0] = MFMA32(PAF(0), VFR(0), o[0]), C0, 0);   VRD(4);  SBAR(); \
        GAPB(o[0] = MFMA32(PAF(1), VFR(1), o[0]), C0, 2);   VRD(5);  SBAR(); \
        GAPB(o[0] = MFMA32(PAF(2), VFR(2), o[0]), C0, 4);   VRD(6);  SBAR(); \
        GAPB(o[0] = MFMA32(PAF(3), VFR(3), o[0]), C0, 6);   VRD(7);  SBAR(); \
        GAPB(o[1] = MFMA32(PAF(0), VFR(4), o[1]), C0, 8);   VRD(8);  SBAR(); \
        GAPB(o[1] = MFMA32(PAF(1), VFR(5), o[1]), C0, 10);  VRD(9);  SBAR(); \
        GAPB(o[1] = MFMA32(PAF(2), VFR(6), o[1]), C0, 12);  VRD(10); SBAR(); \
        GAPB(o[1] = MFMA32(PAF(3), VFR(7), o[1]), C0, 14);  VRD(11); SBAR(); \
        GAPB(o[2] = MFMA32(PAF(0), VFR(8), o[2]), C1, 0);   VRD(12); SBAR(); \
        GAPB(o[2] = MFMA32(PAF(1), VFR(9), o[2]), C1, 2);   VRD(13); SBAR(); \
        GAPB(o[2] = MFMA32(PAF(2), VFR(10), o[2]), C1, 4);  VRD(14); SBAR(); \
        GAPB(o[2] = MFMA32(PAF(3), VFR(11), o[2]), C1, 6);  VRD(15); SBAR(); \
        GAPB(o[3] = MFMA32(PAF(0), VFR(12), o[3]), C1, 8);  if (gl_) { KLD2(ksl_, 0); SBAR(); } \
        GAPB(o[3] = MFMA32(PAF(1), VFR(13), o[3]), C1, 10); if (gl_) { KLD2(ksl_, 1); SBAR(); } \
        GAPB(o[3] = MFMA32(PAF(2), VFR(14), o[3]), C1, 12); \
        GAPB(o[3] = MFMA32(PAF(3), VFR(15), o[3]), C1, 14); \
        if ((t) + 3 < NT) asm volatile("s_waitcnt vmcnt(5)" ::: "memory"); else asm volatile("s_waitcnt vmcnt(0)" ::: "memory"); \
        ABAR(); RESC(); } while (0)
        if (wid >= 4) __builtin_amdgcn_s_setprio(1);
        {
            int t = 1;
            for (; t + 1 < NT; t += 2) {
                STEP(pB0, pB1, pA0, pA1, t);
                STEP(pA0, pA1, pB0, pB1, t + 1);
            }
            STEP(pB0, pB1, pA0, pA1, NT - 1);
        }
        __builtin_amdgcn_s_setprio(0);
        { float sacc = 0.f;
#pragma unroll
          for (int r = 0; r < 16; ++r) sacc += pB0[r];
#pragma unroll
          for (int r = 0; r < 16; ++r) sacc += pB1[r];
          l += sacc;
          PKH0(pB0, 0, pw0); PKH1(pB0, 0, pw0); PKH0(pB0, 8, pw1); PKH1(pB0, 8, pw1); PKH0(pB1, 0, pw2); PKH1(pB1, 0, pw2); PKH0(pB1, 8, pw3); PKH1(pB1, 8, pw3);
          const LAS unsigned char* vp_ = (const LAS unsigned char*)(uintptr_t)(vbase + ((NT - 1) & (NS - 1)) * 16384);
#pragma unroll
          for (int db = 0; db < 4; ++db) { VRD(0); VRD(1); VRD(2); VRD(3);
              o[db] = MFMA32(PAF(0), VFR(0), o[db]); o[db] = MFMA32(PAF(1), VFR(1), o[db]); o[db] = MFMA32(PAF(2), VFR(2), o[db]); o[db] = MFMA32(PAF(3), VFR(3), o[db]); vp_ += 512; } }
        { auto rr_ = __builtin_amdgcn_permlane32_swap(__float_as_uint(l), __float_as_uint(l), false, false); l = __uint_as_float(rr_[0]) + __uint_as_float(rr_[1]); }
#undef SBAR
#undef PIN
#undef MFMA32
#undef KLD2
#undef VTR
#undef VRD
#undef VFR
#undef PAF
#undef MX3
#undef ROWMAX
#undef FIX_TILE
#undef EX
#undef RESC
#undef PKH0
#undef PKH1
#undef GAPA
#undef GAPB
#undef STEP
        int lane_e = lane_id(); asm volatile("" : "+v"(lane_e));
        const int r32e = lane_e & 31, hie = lane_e >> 5;
        const unsigned o0off = (unsigned)((blockIdx.x * NTHR + wid * 64 + lane_e) * 128);
        if (hie == 0) wsf[32 + r32e] = l;
        float rl[16];
#pragma unroll
        for (int r = 0; r < 16; ++r) rl[r] = __builtin_amdgcn_rcpf(wsf[32 + crow(r, hie)]);
        if (c == 0) {
#pragma unroll
            for (int d0 = 0; d0 < 4; ++d0)
#pragma unroll
                for (int j = 0; j < 2; ++j) { v4u w;
                    w.x = cvtpk(o[d0][8 * j + 0] * rl[8 * j + 0], o[d0][8 * j + 1] * rl[8 * j + 1]); w.y = cvtpk(o[d0][8 * j + 2] * rl[8 * j + 2], o[d0][8 * j + 3] * rl[8 * j + 3]);
                    w.z = cvtpk(o[d0][8 * j + 4] * rl[8 * j + 4], o[d0][8 * j + 5] * rl[8 * j + 5]); w.w = cvtpk(o[d0][8 * j + 6] * rl[8 * j + 6], o[d0][8 * j + 7] * rl[8 * j + 7]);
                    *(v4u*)((char*)F.STASH + o0off + (d0 * 2 + j) * 16) = w; }
        } else {
            float ss[16];
#pragma unroll
            for (int r = 0; r < 16; ++r) ss[r] = 0.f;
#pragma unroll
            for (int d0 = 0; d0 < 4; ++d0)
#pragma unroll
                for (int j = 0; j < 2; ++j) { const v4u w = *(const v4u*)((const char*)F.STASH + o0off + (d0 * 2 + j) * 16); const unsigned ww[4] = {w.x, w.y, w.z, w.w};
#pragma unroll
                    for (int k = 0; k < 4; ++k) { const int i = 4 * j + k;
                        const float a0 = bflo(ww[k]) - lam * (o[d0][2 * i] * rl[2 * i]), a1 = bfhi(ww[k]) - lam * (o[d0][2 * i + 1] * rl[2 * i + 1]);
                        o[d0][2 * i] = a0; o[d0][2 * i + 1] = a1; ss[2 * i] += a0 * a0; ss[2 * i + 1] += a1 * a1; } }
#pragma unroll
            for (int r = 0; r < 16; ++r) {
                { DPP_SUM_ROW(ss[r]); ss[r] += __shfl_xor(ss[r], 16); }
                ss[r] = rsqrtf(ss[r] * (1.f / 128.f) + EPS) * 0.8f;
            }
            bf16* Cw = F.CAT + (rowb + qlo) * 1024 + 512 + h * 128;
#pragma unroll
            for (int d0 = 0; d0 < 4; ++d0) { const float g = F.subln_g[d0 * 32 + r32e];
                unsigned off = (unsigned)((4 * hie * 1024 + d0 * 32 + r32e) * 2);
#pragma unroll
                for (int r = 0; r < 16; ++r) { const float v = o[d0][r] * ss[r] * g; const float vn = dpp_xor1(v);
                    if ((r32e & 1) == 0) *(unsigned*)((char*)Cw + off) = cvtpk(v, vn);
                    off += ((r & 3) == 3) ? 5u * 2048u : 2048u; asm volatile("" : "+v"(off)); } }
        }
        __syncthreads();
    }
#undef DMA_K
#undef DMA_V
#undef DMA_TILE
#undef ABAR
}

__device__ __forceinline__ void attn_phase(Frame& F) {
    const int lane = lane_id(), tid = F.wave * 64 + lane;
    const float s01 = wave_sum(F.diff_lambda[lane] * F.diff_lambda[64 + lane]), s23 = wave_sum(F.diff_lambda[128 + lane] * F.diff_lambda[192 + lane]);
    const float lam = __expf(s01) - __expf(s23) + 0.2f;
    const int G = F.G;
    for (int it = ((G % 8 == 0) ? ((int)(blockIdx.x % 8) * (G / 8) + (int)blockIdx.x / 8) : (int)blockIdx.x); it < 256; it += G) {
        const int bh = it >> 3, x = it & 7, b = bh >> 2, h = bh & 3;
        LAS float* bt = (LAS float*)(F.lds + L_BT);
        __syncthreads();
        if (tid < BTN) { const int d = tid - BTO; int bk = d; if (d >= 16) { bk = 16 + (int)(__log2f((float)d * (1.f / 16.f)) * (16.f / 3.f)); bk = bk > 31 ? 31 : bk; }
            bt[tid] = d < 0 ? -__builtin_inff() : (F.rel_bias[bk * 4 + h] - F.rel_bias[31 * 4 + h]) * 1.4426950408889634f; }
        __syncthreads();
        attn_unit(F, b, h, x, lam);
        attn_unit(F, b, h, 15 - x, lam);
    }
}
}

namespace sgu {
typedef float f32x16 __attribute__((ext_vector_type(16)));
typedef short s16x4 __attribute__((ext_vector_type(4)));
constexpr int L_T = 0, L_ST = 65536;
__device__ __forceinline__ void sgu_chunk(Frame& F, int chunk) {
    int tid = F.wave * 64 + lane_id(); asm volatile("" : "+v"(tid));
    const int lane = tid & 63, g = F.wave, r32 = lane & 31, hi = lane >> 5;
    LAS unsigned char* lds = F.lds;
    LAS float* st = (LAS float*)(lds + L_ST);
    const size_t t0 = (size_t)chunk * 128;
    for (int i = 0; i < 16; i += 2) {
        v4u raw[2];
#pragma unroll
        for (int u = 0; u < 2; ++u) raw[u] = *(const v4u*)(F.Z + (t0 + g * 16 + i + u) * INC + 512 + lane * 8);
#pragma unroll
        for (int u = 0; u < 2; ++u) { const int tl = g * 16 + i + u;
            float f[8] = {bflo(raw[u].x), bfhi(raw[u].x), bflo(raw[u].y), bfhi(raw[u].y), bflo(raw[u].z), bfhi(raw[u].z), bflo(raw[u].w), bfhi(raw[u].w)};
            float s = 0.f;
#pragma unroll
            for (int e = 0; e < 8; ++e) s += f[e];
            const float mean = wave_sum_dpp(s) * (1.f / 512.f); float q = 0.f;
#pragma unroll
            for (int e = 0; e < 8; ++e) { f[e] -= mean; q += f[e] * f[e]; }
            const float rstd = rsqrtf(wave_sum_dpp(q) * (1.f / 512.f) + EPS);
            if (lane == 0) { st[2 * tl] = mean; st[2 * tl + 1] = rstd; } }
    }
    __syncthreads();
    f32x16 acc[2][2];
    const int sr = tid >> 4, sc = (tid & 15) * 8;
    const int vb0 = (int)(uintptr_t)(lds + L_T) + (g >> 1) * 16384 + att::v_rd_base(lane);
#define SGU_STAGE(sh) do { _Pragma("unroll") for (int tile = 0; tile < 4; ++tile) { const int ch = tile * 128 + sc; \
            const f32x4 g0 = *(const f32x4*)(F.sgu_ln_g + ch), g1 = *(const f32x4*)(F.sgu_ln_g + ch + 4), b0 = *(const f32x4*)(F.sgu_ln_b + ch), b1 = *(const f32x4*)(F.sgu_ln_b + ch + 4); \
            _Pragma("unroll") for (int rr = 0; rr < 2; ++rr) { const int s = (sh) * 64 + sr + 32 * rr; \
                const v4u raw = *(const v4u*)(F.Z + (t0 + s) * INC + 512 + ch); const float mean = st[2 * s], rstd = st[2 * s + 1]; v4u o; \
                o.x = pk2((bflo(raw.x) - mean) * rstd * g0.x + b0.x, (bfhi(raw.x) - mean) * rstd * g0.y + b0.y); \
                o.y = pk2((bflo(raw.y) - mean) * rstd * g0.z + b0.z, (bfhi(raw.y) - mean) * rstd * g0.w + b0.w); \
                o.z = pk2((bflo(raw.z) - mean) * rstd * g1.x + b1.x, (bfhi(raw.z) - mean) * rstd * g1.y + b1.y); \
                o.w = pk2((bflo(raw.w) - mean) * rstd * g1.z + b1.z, (bfhi(raw.w) - mean) * rstd * g1.w + b1.w); \
                *(LAS v4u*)(lds + L_T + tile * 16384 + att::v_st(sr + 32 * rr, sc)) = o; } } } while (0)
#define TRRD(dst, off) asm volatile("ds_read_b64_tr_b16 %0, %1 offset:%2" : "=&v"(dst) : "v"(vb0), "i"(off) : "memory")
#define SGU_MMA(sh, tb0) do { _Pragma("unroll") for (int ks = 0; ks < 4; ++ks) { s16x4 l0, h0, l1, h1; \
            if ((g & 1) == 0) { TRRD(l0, 0 * 512 + ks * 4096); TRRD(h0, 0 * 512 + ks * 4096 + 2048); TRRD(l1, 1 * 512 + ks * 4096); TRRD(h1, 1 * 512 + ks * 4096 + 2048); } \
            else              { TRRD(l0, 2 * 512 + ks * 4096); TRRD(h0, 2 * 512 + ks * 4096 + 2048); TRRD(l1, 3 * 512 + ks * 4096); TRRD(h1, 3 * 512 + ks * 4096 + 2048); } \
            asm volatile("s_waitcnt lgkmcnt(0)" ::: "memory"); __builtin_amdgcn_sched_barrier(0); \
            const bf16x8 B0 = (bf16x8){l0[0], l0[1], l0[2], l0[3], h0[0], h0[1], h0[2], h0[3]}, B1 = (bf16x8){l1[0], l1[1], l1[2], l1[3], h1[0], h1[1], h1[2], h1[3]}; \
            _Pragma("unroll") for (int tl = 0; tl < 2; ++tl) { const int tb = (tb0) + tl; if ((sh) * 64 + 16 * ks > tb * 32 + 31) continue; \
                const bf16x8 A = *(const bf16x8*)(F.SGW + ((size_t)(g * 128 + tb * 32 + r32)) * 128 + (sh) * 64 + 16 * ks + 8 * hi); \
                acc[tl][0] = __builtin_amdgcn_mfma_f32_32x32x16_bf16(A, B0, acc[tl][0], 0, 0, 0); \
                acc[tl][1] = __builtin_amdgcn_mfma_f32_32x32x16_bf16(A, B1, acc[tl][1], 0, 0, 0); } } } while (0)
#define SGU_EPI(tb0) do { _Pragma("unroll") for (int tl = 0; tl < 2; ++tl) _Pragma("unroll") for (int r = 0; r < 16; ++r) { \
            const int t = ((tb0) + tl) * 32 + att::crow(r, hi); const float bs = F.sgu_b[g * 128 + t]; \
            _Pragma("unroll") for (int db = 0; db < 2; ++db) { const int ch = g * 64 + db * 32 + r32; \
                const float u = bf2f(F.Z[(t0 + t) * INC + ch]); const float v = u * (acc[tl][db][r] + bs); const float vn = dpp_xor1(v); \
                if ((r32 & 1) == 0) *(unsigned*)(F.CAT + (t0 + t) * 1024 + ch) = att::cvtpk(v, vn); } } } while (0)
#define SGU_ZERO() do { acc[0][0] = f32x16{}; acc[0][1] = f32x16{}; acc[1][0] = f32x16{}; acc[1][1] = f32x16{}; } while (0)
    SGU_STAGE(0);
    __syncthreads();
    SGU_ZERO(); SGU_MMA(0, 0); SGU_EPI(0);
    SGU_ZERO(); SGU_MMA(0, 2);
    __syncthreads();
    SGU_STAGE(1);
    __syncthreads();
    SGU_MMA(1, 2); SGU_EPI(2);
#undef SGU_STAGE
#undef TRRD
#undef SGU_MMA
#undef SGU_EPI
#undef SGU_ZERO
}
__device__ __forceinline__ void sgu_phase(Frame& F) { for (int ck = blockIdx.x; ck < M / 128; ck += F.G) { sgu_chunk(F, ck); __syncthreads(); } }
}

namespace tk {
typedef float f32x16 __attribute__((ext_vector_type(16)));
__device__ __forceinline__ float vmax(float a, float b) { float r; asm("v_max_f32 %0, %1, %2" : "=v"(r) : "v"(a), "v"(b)); return r; }
__device__ __forceinline__ float vmin(float a, float b) { float r; asm("v_min_f32 %0, %1, %2" : "=v"(r) : "v"(a), "v"(b)); return r; }
#define TK_CE(a, b) do { const float _mx = vmax(a, b), _mn = vmin(a, b); a = _mx; b = _mn; } while (0)
template <int N> __device__ __forceinline__ void sort_desc(float (&a)[N]) {
#pragma unroll
    for (int k = 2; k <= N; k <<= 1)
#pragma unroll
        for (int j = k >> 1; j > 0; j >>= 1)
#pragma unroll
            for (int i = 0; i < N; ++i) { const int l = i ^ j; if (l > i) { if ((i & k) == 0) TK_CE(a[i], a[l]); else TK_CE(a[l], a[i]); } }
}
template <int N> __device__ __forceinline__ void merge_desc(float (&a)[N]) {
#pragma unroll
    for (int j = N >> 1; j > 0; j >>= 1)
#pragma unroll
        for (int i = 0; i < N; ++i) { const int l = i ^ j; if (l > i) TK_CE(a[i], a[l]); }
}
__device__ __forceinline__ void top16_merge(float (&a)[16], const float (&b)[16]) {
#pragma unroll
    for (int i = 0; i < 16; ++i) a[i] = vmax(a[i], b[15 - i]);
    merge_desc<16>(a);
}
__device__ __forceinline__ float embed(float v, unsigned mask, unsigned code) { return __uint_as_float((__float_as_uint(v) & mask) | code); }

__device__ __forceinline__ void topk_phase(Frame& F) {
    int lane = lane_id(); asm volatile("" : "+v"(lane));
    const int r32 = lane & 31, hi = lane >> 5;
    const int gw = blockIdx.x * NWAVES + F.wave, NGW = F.G * NWAVES;
    LAS unsigned* tab = (LAS unsigned*)(F.lds + F.wave * 8192) + lane;
    const float NEG = -__builtin_inff();
    constexpr int NTASK = (M / 32) * 8; const int per = (NTASK + NGW - 1) / NGW;
    unsigned code16[16];
#pragma unroll
    for (int r = 0; r < 16; ++r) code16[r] = (unsigned)((r & 3) + 8 * (r >> 2) + 4 * hi);
    const unsigned qoff = (unsigned)(r32 * NQ + hi * 8), koff = (unsigned)((hi * 128 + r32) * 8);
#define TK_QP(task_, c_) (F.QP + (size_t)((task_) >> 3) * 32 * NQ + ((task_) & 7) * 256 + (c_) * 128)
#define TK_KP(task_, c_) (F.KEYS + (size_t)((((task_) & 7) * 2 + (c_)) * 16) * 128 * 8)
#define TK_LDQ(dst, task_, c_) do { const bf16* qp_ = TK_QP(task_, c_); _Pragma("unroll") for (int ks = 0; ks < 8; ++ks) dst[ks] = *(const bf16x8*)(qp_ + ks * 16 + qoff); } while (0)
#define TK_LDK(dst, task_, c_, nb_) do { const bf16* kp_ = TK_KP(task_, c_); _Pragma("unroll") for (int ks = 0; ks < 8; ++ks) dst[ks] = *(const bf16x8*)(kp_ + ((2 * ks) * 128 + (nb_) * 32) * 8 + koff); } while (0)
    const int task_beg = gw * per, task_end = (gw * per + per < NTASK) ? gw * per + per : NTASK;
    bf16x8 qcur[8], kcur[8];
    if (task_beg < task_end) { TK_LDQ(qcur, task_beg, 0); TK_LDK(kcur, task_beg, 0, 0); }
    for (int task = task_beg; task < task_end; ++task) {
        const int tb = task >> 3, h = task & 7;
        const size_t trow = (size_t)tb * 32 + r32;
        float sk[2][16];
        float best[16];
#pragma unroll
        for (int st = 0; st < 8; ++st) {
            const int c = st >> 2, nb = st & 3;
            bf16x8 knxt[8], qnxt[8];
            if (st < 7) TK_LDK(knxt, task, (st + 1) >> 2, (st + 1) & 3);
            if (st == 3) TK_LDQ(qnxt, task, 1);
            f32x16 acc = f32x16{};
#pragma unroll
            for (int ks = 0; ks < 8; ++ks) acc = __builtin_amdgcn_mfma_f32_32x32x16_bf16(kcur[ks], qcur[ks], acc, 0, 0, 0);
            float cur[16];
#pragma unroll
            for (int r = 0; r < 16; ++r) { cur[r] = embed(acc[r], 0xFFFFFF80u, code16[r]); if (nb) cur[r] = __uint_as_float(__float_as_uint(cur[r]) | (unsigned)(nb * 32)); }
            sort_desc<16>(cur);
            if (nb == 0) {
#pragma unroll
                for (int i = 0; i < 16; ++i) best[i] = cur[i];
            } else top16_merge(best, cur);
            if (st < 7) {
#pragma unroll
                for (int ks = 0; ks < 8; ++ks) kcur[ks] = knxt[ks];
            }
            if (st == 3) {
#pragma unroll
                for (int ks = 0; ks < 8; ++ks) qcur[ks] = qnxt[ks];
            }
            if (nb == 3) {
                float pr[16];
#pragma unroll
                for (int i = 0; i < 16; ++i) { auto rr = __builtin_amdgcn_permlane32_swap(__float_as_uint(best[i]), __float_as_uint(best[i]), false, false);
                    pr[i] = __uint_as_float(hi ? rr[0] : rr[1]); }
                top16_merge(best, pr);
#pragma unroll
                for (int i = 0; i < 16; ++i) sk[c][i] = best[i];
            }
            __builtin_amdgcn_sched_barrier(0);
        }
        { const int tn = (task + 1 < task_end) ? task + 1 : task; TK_LDQ(qcur, tn, 0); TK_LDK(kcur, tn, 0, 0); }
#pragma unroll
        for (int i = 0; i < 16; ++i) { tab[i * 64] = __float_as_uint(sk[0][i]); tab[(16 + i) * 64] = __float_as_uint(sk[1][i]); }
        float T[16], G1[16], G2[16];
#pragma unroll
        for (int j = 0; j < 16; ++j) T[j] = embed(sk[0][0] + sk[1][j], 0xFFFFFF00u, (unsigned)j);
#pragma unroll
        for (int j = 0; j < 8; ++j) { G1[j] = embed(sk[0][1] + sk[1][j], 0xFFFFFF00u, (unsigned)(16 + j)); G1[8 + j] = embed(sk[0][15 - j] + sk[1][0], 0xFFFFFF00u, (unsigned)((15 - j) << 4)); }
        merge_desc<16>(G1);
        top16_merge(T, G1);
#pragma unroll
        for (int j = 0; j < 5; ++j) G2[j] = embed(sk[0][2] + sk[1][j], 0xFFFFFF00u, (unsigned)(32 + j));
#pragma unroll
        for (int j = 0; j < 4; ++j) G2[5 + j] = embed(sk[0][3] + sk[1][j], 0xFFFFFF00u, (unsigned)(48 + j));
#pragma unroll
        for (int j = 0; j < 3; ++j) G2[9 + j] = embed(sk[0][4] + sk[1][j], 0xFFFFFF00u, (unsigned)(64 + j));
#pragma unroll
        for (int j = 0; j < 2; ++j) { G2[12 + j] = embed(sk[0][5] + sk[1][j], 0xFFFFFF00u, (unsigned)(80 + j)); G2[14 + j] = embed(sk[0][6] + sk[1][j], 0xFFFFFF00u, (unsigned)(96 + j)); }
        sort_desc<16>(G2);
        top16_merge(T, G2);
        T[15] = vmax(T[15], embed(sk[0][7] + sk[1][0], 0xFFFFFF00u, 112u)); T[14] = vmax(T[14], embed(sk[0][7] + sk[1][1], 0xFFFFFF00u, 113u));
        merge_desc<16>(T);
        const float mx = __uint_as_float(__float_as_uint(T[0]) & 0xFFFFFF00u);
        float e[16]; float den = 0.f;
#pragma unroll
        for (int k = 0; k < 16; ++k) { e[k] = __builtin_amdgcn_exp2f((__uint_as_float(__float_as_uint(T[k]) & 0xFFFFFF00u) - mx) * 1.4426950408889634f); den += e[k]; }
        const float rden = 1.f / den;
        int eo[8]; float go[8];
#pragma unroll
        for (int k = 0; k < 8; ++k) {
            const unsigned code = __float_as_uint(hi ? T[k + 8] : T[k]) & 255u;
            const unsigned a1 = tab[(code >> 4) * 64] & 127u, a2 = tab[(16 + (code & 15u)) * 64] & 127u;
            eo[k] = (int)(a1 * 128u + a2); go[k] = (hi ? e[k + 8] : e[k]) * rden;
        }
        int* ip = F.IDX + trow * PKN + h * 16 + hi * 8; float* gp = F.GATE + trow * PKN + h * 16 + hi * 8;
        *(v4u*)ip = (v4u){(unsigned)eo[0], (unsigned)eo[1], (unsigned)eo[2], (unsigned)eo[3]}; *(v4u*)(ip + 4) = (v4u){(unsigned)eo[4], (unsigned)eo[5], (unsigned)eo[6], (unsigned)eo[7]};
        *(f32x4*)gp = (f32x4){go[0], go[1], go[2], go[3]}; *(f32x4*)(gp + 4) = (f32x4){go[4], go[5], go[6], go[7]};
    }
    (void)NEG;
}
#undef TK_CE
#undef TK_QP
#undef TK_KP
#undef TK_LDQ
#undef TK_LDK
}

namespace pe {
typedef float f32x2 __attribute__((ext_vector_type(2)));
__device__ __forceinline__ f32x2 cvlo(unsigned w) { return __builtin_amdgcn_cvt_pk_f32_fp8((int)w, false); }
__device__ __forceinline__ f32x2 cvhi(unsigned w) { return __builtin_amdgcn_cvt_pk_f32_fp8((int)w, true); }
__device__ __forceinline__ float dot16(const v4u r, const f32x2 (&hf)[8]) {
    f32x2 a = cvlo(r.x) * hf[0]; f32x2 b = cvhi(r.x) * hf[1];
    a = cvlo(r.y) * hf[2] + a; b = cvhi(r.y) * hf[3] + b; a = cvlo(r.z) * hf[4] + a; b = cvhi(r.z) * hf[5] + b; a = cvlo(r.w) * hf[6] + a; b = cvhi(r.w) * hf[7] + b;
    a = a + b; return a.x + a.y;
}
#define PE_W(WREG, i) __uint_as_float(__builtin_amdgcn_readlane(__float_as_uint(WREG), (i)))
#ifndef FP6_INTERLEAVED
#define FP6_INTERLEAVED 1
#endif
typedef unsigned v6u __attribute__((ext_vector_type(6)));
typedef float v32f __attribute__((ext_vector_type(32)));
typedef float v16f __attribute__((ext_vector_type(16)));
struct Row6 { v4u q4; v2u q2; };
#ifndef PV6_G
#define PV6_G 2
#endif
#define PV6_LOAD(dst, EREG, i) do { const int ea_ = __builtin_amdgcn_readlane(EREG, 2 * (i)), eb_ = __builtin_amdgcn_readlane(EREG, 2 * (i) + 1); \
        const unsigned char* rp_ = F.VT6 + (size_t)(half ? eb_ : ea_) * 768; dst.q4 = *(const v4u*)(rp_ + l16); dst.q2 = *(const v2u*)(rp_ + 512 + l8); } while (0)
#define PV6_ACC(src, WREG, i) do { const float wa_ = PE_W(WREG, 2 * (i)), wb_ = PE_W(WREG, 2 * (i) + 1); const float w_ = half ? wb_ : wa_; const f32x2 ww_ = {w_, w_}; \
        const v6u pk_ = {src.q4.x, src.q4.y, src.q4.z, src.q4.w, src.q2.x, src.q2.y}; const v32f d_ = __builtin_amdgcn_cvt_scalef32_pk32_f32_fp6(pk_, 1.0f); \
        _Pragma("unroll") for (int k = 0; k < 16; ++k) acc[k] = (f32x2){d_[2 * k], d_[2 * k + 1]} * ww_ + acc[k]; __builtin_amdgcn_sched_barrier(0); } while (0)
#define PV6_BATCH(EREG, WREG) do { Row6 bufA[PV6_G], bufB[PV6_G];             \
        _Pragma("unroll") for (int i = 0; i < PV6_G; ++i) PV6_LOAD(bufA[i], EREG, i); \
        _Pragma("unroll") for (int gq = 0; gq < 32 / PV6_G; gq += 2) { \
            _Pragma("unroll") for (int i = 0; i < PV6_G; ++i) PV6_LOAD(bufB[i], EREG, (gq + 1) * PV6_G + i); \
            _Pragma("unroll") for (int i = 0; i < PV6_G; ++i) PV6_ACC(bufA[i], WREG, gq * PV6_G + i); \
            if (gq + 2 < 32 / PV6_G) { _Pragma("unroll") for (int i = 0; i < PV6_G; ++i) PV6_LOAD(bufA[i], EREG, (gq + 2) * PV6_G + i); } \
            _Pragma("unroll") for (int i = 0; i < PV6_G; ++i) PV6_ACC(bufB[i], WREG, (gq + 1) * PV6_G + i); } } while (0)

#define PU_IDX(dst, tt) do { const v4u* ip_ = (const v4u*)(F.IDX + (size_t)(tt) * PKN + (lane >> 3) * 16); _Pragma("unroll") for (int q_ = 0; q_ < 4; ++q_) { const v4u w_ = ip_[q_]; dst[4 * q_] = (int)w_.x; dst[4 * q_ + 1] = (int)w_.y; dst[4 * q_ + 2] = (int)w_.z; dst[4 * q_ + 3] = (int)w_.w; } } while (0)
#define PU_GATHER(dst, idx) do { _Pragma("unroll") for (int i = 0; i < 16; ++i) dst[i] = *(const v4u*)(ub + (unsigned)idx[i] * 128u + coff); } while (0)
#define PU_HS(dst, tt) do { dst[0] = *(const v4u*)(F.H8 + (size_t)(tt) * D + x * 128 + (lane & 7) * 16); } while (0)
#define PU_COMPUTE(seg, hraw, tt) do { int p[16]; \
        _Pragma("unroll") for (int i = 0; i < 16; ++i) { int a_ = __builtin_amdgcn_sdot4((int)seg[i].x, (int)hraw[0].x, 0, false); a_ = __builtin_amdgcn_sdot4((int)seg[i].y, (int)hraw[0].y, a_, false); \
            a_ = __builtin_amdgcn_sdot4((int)seg[i].z, (int)hraw[0].z, a_, false); p[i] = __builtin_amdgcn_sdot4((int)seg[i].w, (int)hraw[0].w, a_, false); }     \
          \
        _Pragma("unroll") for (int i = 0; i < 8; ++i) { const bool bt = (lane & 4) != 0; const int sd = bt ? p[i] : p[i + 8], kp = bt ? p[i + 8] : p[i]; p[i] = kp + __builtin_amdgcn_update_dpp(0, sd, 0x141, 0xF, 0xF, false); } \
        _Pragma("unroll") for (int i = 0; i < 4; ++i) { const bool bt = (lane & 2) != 0; const int sd = bt ? p[i] : p[i + 4], kp = bt ? p[i + 4] : p[i]; p[i] = kp + __builtin_amdgcn_update_dpp(0, sd, 0x4E, 0xF, 0xF, false); } \
        _Pragma("unroll") for (int i = 0; i < 2; ++i) { const bool bt = (lane & 1) != 0; const int sd = bt ? p[i] : p[i + 2], kp = bt ? p[i + 2] : p[i]; p[i] = kp + __builtin_amdgcn_update_dpp(0, sd, 0xB1, 0xF, 0xF, false); } \
        ((unsigned*)F.PART)[((size_t)x * M + (tt)) * 64 + lane] = att::cvtpk((float)p[0], (float)p[1]); } while (0)
__device__ __forceinline__ void peer_u_phase(Frame& F, const int c0, const int cn, const int w0, const int nw) {
    int lane = lane_id(); asm volatile("" : "+v"(lane));
    const int wave = F.wave;
    if (wave < w0 || wave >= w0 + nw) return;
    const unsigned coff = (unsigned)(lane & 7) * 16u;
    const int per_blk = cn / 32, per_wave = per_blk / nw;
    for (int unit = blockIdx.x; unit < 256; unit += F.G) {
        const int x = unit & 7, rk = unit >> 3;
        const unsigned char* ub = F.UT8 + (size_t)x * NEXP * 128;
        const int tbeg = c0 + rk * per_blk + (wave - w0) * per_wave, tend = tbeg + per_wave;
        int idxA[16], idxB[16]; v4u segA[16], segB[16]; v4u hA[1], hB[1];
        PU_IDX(idxA, tbeg); PU_GATHER(segA, idxA); PU_HS(hA, tbeg); PU_IDX(idxB, tbeg + 1);
        for (int t = tbeg; t < tend; t += 2) {
            PU_GATHER(segB, idxB); PU_HS(hB, t + 1);
            { const int tn = (t + 2 < tend) ? t + 2 : t; PU_IDX(idxA, tn); }
            PU_COMPUTE(segA, hA, t);
            { const int tn = (t + 2 < tend) ? t + 2 : t; PU_GATHER(segA, idxA); PU_HS(hA, tn); }
            { const int tn = (t + 3 < tend) ? t + 3 : t + 1; PU_IDX(idxB, tn); }
            PU_COMPUTE(segB, hB, t + 1);
        }
    }
}
#undef PU_IDX
#undef PU_GATHER
#undef PU_HS
#undef PU_COMPUTE

template <bool DRY> __device__ __forceinline__ void peer_phase(Frame& F, const int c0, const int cn, const int w0, const int nw) {
    int lane = lane_id(); asm volatile("" : "+v"(lane));
    if (F.wave < w0 || F.wave >= w0 + nw) return;
    const int gw = blockIdx.x * nw + (F.wave - w0), NGW = F.G * nw;
    const int half = lane >> 5; const unsigned l16 = (unsigned)(lane & 31) * 16u, l8 = (unsigned)(lane & 31) * 8u;
    for (int t = c0 + gw; t < c0 + cn; t += NGW) {
        const int b = t >> 12;
        const int e0 = F.IDX[(size_t)t * PKN + lane], e1 = F.IDX[(size_t)t * PKN + 64 + lane];
        const float g0 = F.GATE[(size_t)t * PKN + lane], g1 = F.GATE[(size_t)t * PKN + 64 + lane];
        const float su0 = F.SU[e0], su1 = F.SU[e1], sv0 = F.SV[e0], sv1 = F.SV[e1];
        float tot0 = 0.f, tot1 = 0.f;
#pragma unroll
        for (int x = 0; x < 8; ++x) { const bf16* pp = (const bf16*)F.PART + ((size_t)x * M + t) * PKN; tot0 += bf2f(pp[lane]); tot1 += bf2f(pp[64 + lane]); }
        const float hs = F.HS[t];
        const float w0 = gelu_t(tot0 * (su0 * hs)) * g0 * sv0, w1 = gelu_t(tot1 * (su1 * hs)) * g1 * sv1;
        f32x2 acc[16];
#pragma unroll
        for (int i = 0; i < 16; ++i) acc[i] = (f32x2){0.f, 0.f};
        PV6_BATCH(e0, w0);
        PV6_BATCH(e1, w1);
#pragma unroll
        for (int i = 0; i < 16; ++i) {
            auto rx = __builtin_amdgcn_permlane32_swap(__float_as_uint(acc[i].x), __float_as_uint(acc[i].x), false, false);
            auto ry = __builtin_amdgcn_permlane32_swap(__float_as_uint(acc[i].y), __float_as_uint(acc[i].y), false, false);
            acc[i] = (f32x2){__uint_as_float(rx[0]) + __uint_as_float(rx[1]), __uint_as_float(ry[0]) + __uint_as_float(ry[1])};
        }
        float y[16];
#pragma unroll
        for (int j = 0; j < 16; ++j) {
#if FP6_INTERLEAVED
            const float lo = (j & 1) ? acc[j].x : acc[j].x;
            const float hi_ = acc[j].y;
            y[j] = half ? hi_ : lo;
#else
            const float lo = (j & 1) ? acc[j >> 1].y : acc[j >> 1].x;
            const float hi_ = (j & 1) ? acc[8 + (j >> 1)].y : acc[8 + (j >> 1)].x;
            y[j] = half ? hi_ : lo;
#endif
        }
        float ss = 0.f;
#pragma unroll
        for (int j = 0; j < 16; ++j) ss += y[j] * y[j];
        const float rstd = rsqrtf(wave_sum_dpp(ss) * (1.f / D) + EPS);
        const float* md = F.mod + b * 6144 + 5120;
        const float* g3 = F.norm_g + 3072;
        int lane_e = lane; asm volatile("" : "+v"(lane_e));
        const int col0 = (lane_e & 31) * 32 + (lane_e >> 5) * 16;
        float* orow = F.out + (size_t)t * D + col0;
#pragma unroll
        for (int q4 = 0; q4 < 4; ++q4) { const int c = col0 + q4 * 4;
            const f32x4 x1 = *(const f32x4*)(orow + q4 * 4), gt = *(const f32x4*)(md + c), gg = *(const f32x4*)(g3 + c);
            const f32x4 yv = (f32x4){y[q4 * 4], y[q4 * 4 + 1], y[q4 * 4 + 2], y[q4 * 4 + 3]};
            if (!DRY) *(f32x4*)(orow + q4 * 4) = x1 + gt * (yv * rstd * gg); else if (rstd == 123.456f) *(f32x4*)(orow + q4 * 4) = yv; }
    }
}
#undef PE_W
#undef PV6_LOAD
#undef PV6_ACC
#undef PV6_BATCH

__device__ __forceinline__ void u_rows4(Frame& F, int r0, int stride, int nvalid, int lane) {
    f32x4 v[4][4];
#pragma unroll
    for (int q = 0; q < 4; ++q) { const int row = r0 + (q < nvalid ? q : 0) * stride; const f32x4* s = (const f32x4*)(F.peer_u + (size_t)row * D) + lane * 4;
#pragma unroll
        for (int i = 0; i < 4; ++i) v[q][i] = s[i]; }
#pragma unroll
    for (int q = 0; q < 4; ++q) { if (q >= nvalid) break; const int row = r0 + q * stride;
        float am = 0.f;
#pragma unroll
        for (int i = 0; i < 4; ++i) am = fmaxf(am, fmaxf(fmaxf(fabsf(v[q][i].x), fabsf(v[q][i].y)), fmaxf(fabsf(v[q][i].z), fabsf(v[q][i].w))));
        am = wave_max_dpp(am);
        const float sc = am > 0.f ? 127.f / am : 1.f;
        int w[4];
#pragma unroll
        for (int i = 0; i < 4; ++i) { const int q0 = (int)rintf(v[q][i].x * sc), q1 = (int)rintf(v[q][i].y * sc), q2 = (int)rintf(v[q][i].z * sc), q3 = (int)rintf(v[q][i].w * sc);
            w[i] = (q0 & 255) | ((q1 & 255) << 8) | ((q2 & 255) << 16) | (q3 << 24); }
        *(v4u*)(F.UT8 + (size_t)(lane >> 3) * NEXP * 128 + (size_t)row * 128 + (lane & 7) * 16) = (v4u){(unsigned)w[0], (unsigned)w[1], (unsigned)w[2], (unsigned)w[3]};
        if (lane == 0) F.SU[row] = 1.f / sc; }
}
__device__ __forceinline__ void v_pairs2(Frame& F, int p0, int stride, int nvalid, int lane) {
    const int L = lane & 31, hf = lane >> 5;
    f32x4 f[2][8];
#pragma unroll
    for (int q = 0; q < 2; ++q) { const int row = 2 * (p0 + (q < nvalid ? q : 0) * stride) + hf; const f32x4* sp = (const f32x4*)(F.peer_v + (size_t)row * D + L * 32);
#pragma unroll
        for (int i = 0; i < 8; ++i) f[q][i] = sp[i]; }
#pragma unroll
    for (int q = 0; q < 2; ++q) { if (q >= nvalid) break; const int row = 2 * (p0 + q * stride) + hf;
        float am = 0.f;
#pragma unroll
        for (int i = 0; i < 8; ++i) am = fmaxf(am, fmaxf(fmaxf(fabsf(f[q][i].x), fabsf(f[q][i].y)), fmaxf(fabsf(f[q][i].z), fabsf(f[q][i].w))));
        am = half_max_dpp(am);
        const float sc = am > 0.f ? exp2f(floorf(log2f(7.0f / am))) : 1.f;
        v16f a, b;
#pragma unroll
        for (int i = 0; i < 4; ++i) { a[4 * i] = f[q][i].x * sc; a[4 * i + 1] = f[q][i].y * sc; a[4 * i + 2] = f[q][i].z * sc; a[4 * i + 3] = f[q][i].w * sc;
            b[4 * i] = f[q][4 + i].x * sc; b[4 * i + 1] = f[q][4 + i].y * sc; b[4 * i + 2] = f[q][4 + i].z * sc; b[4 * i + 3] = f[q][4 + i].w * sc; }
        const v6u w = __builtin_amdgcn_cvt_scalef32_2xpk16_fp6_f32(a, b, 1.0f);
        unsigned char* rp = F.VT6 + (size_t)row * 768;
        *(v4u*)(rp + L * 16) = (v4u){w[0], w[1], w[2], w[3]};
        *(v2u*)(rp + 512 + L * 8) = (v2u){w[4], w[5]};
        if (L == 0) F.SV[row] = 1.f / sc; }
}
__device__ __forceinline__ void prologue_tables(Frame& F, int gw, int NGW, int lane) {
    for (int r = gw; r < NEXP; r += 4 * NGW) { const int left = (NEXP - r + NGW - 1) / NGW; u_rows4(F, r, NGW, left < 4 ? left : 4, lane); }
    for (int p = gw; p < NEXP / 2; p += 2 * NGW) { const int left = (NEXP / 2 - p + NGW - 1) / NGW; v_pairs2(F, p, NGW, left < 2 ? left : 2, lane); }
}
}

__device__ __forceinline__ void prologue_tables_fwd(Frame& F, int gw, int NGW, int lane) { pe::prologue_tables(F, gw, NGW, lane); }
struct Args { const float* in[18]; float* out; unsigned char* ws; int ph_lo, ph_hi, li, pad; };
__global__ void __launch_bounds__(NTHR, 2) fwd(Args args) {
    extern __shared__ __attribute__((aligned(16))) unsigned char lds[];
    Frame F;
    F.lds = (LAS unsigned char*)lds;
    F.MISC = (volatile LAS unsigned*)(F.lds + MISC_OFF);
    F.wave = __builtin_amdgcn_readfirstlane((int)threadIdx.x >> 6); F.G = gridDim.x;
    unsigned char* ws = args.ws;
    F.ctl = (gu32*)(ws + WS_CTL);
    F.x = args.in[0]; F.c = args.in[1]; F.w_ada = args.in[2]; F.b_ada = args.in[3]; F.norm_g = args.in[4]; F.w_in = args.in[5]; F.sgu_ln_g = args.in[6]; F.sgu_ln_b = args.in[7];
    F.sgu_w = args.in[8]; F.sgu_b = args.in[9]; F.diff_lambda = args.in[10]; F.subln_g = args.in[11]; F.rel_bias = args.in[12]; F.w_out = args.in[13]; F.w_query = args.in[14];
    F.sub_keys = args.in[15]; F.peer_u = args.in[16]; F.peer_v = args.in[17]; F.out = args.out;
    F.mod = (float*)(ws + WS_MOD); F.WIN = (bf16*)(ws + WS_WIN); F.WOUT = (bf16*)(ws + WS_WOUT); F.WQ = (bf16*)(ws + WS_WQ); F.KEYS = (bf16*)(ws + WS_KEYS); F.SGW = (bf16*)(ws + WS_SGW);
    F.UT8 = ws + WS_UT; F.H8 = ws + WS_H8; F.HS = (float*)(ws + WS_SU) + 2 * NEXP; F.HAS = (float*)(ws + WS_SU) + 2 * NEXP + M; F.WS8 = (float*)(ws + WS_SU) + 2 * NEXP + 2 * M; F.HA8 = ws + WS_H; F.W8 = ws + WS_WIN; F.WQ8 = ws + WS_WQ; F.WQS8 = (float*)(ws + WS_SU) + 2 * NEXP + 2 * M + INC; F.VT6 = ws + WS_VT; F.PART = (float*)(ws + WS_QP); F.STASH = (unsigned*)(ws + WS_H); F.SU = (float*)(ws + WS_SU); F.SV = (float*)(ws + WS_SU) + NEXP; F.H = (bf16*)(ws + WS_H); F.Y = (bf16*)(ws + WS_Y); F.Z = (bf16*)(ws + WS_Z); F.QP = (bf16*)(ws + WS_QP); F.CAT = (bf16*)(ws + WS_CAT);
    F.IDX = (int*)(ws + WS_IDX); F.GATE = (float*)(ws + WS_GATE);
    for (int u = threadIdx.x; u < (LDS_BYTES - LDSCTL_OFF) / 4; u += NTHR) ((LAS unsigned*)(F.lds + LDSCTL_OFF))[u] = 0u;
    __syncthreads();
    XcdBarrier bar = xcd_barrier_post((unsigned*)(F.ctl + CW_BAR) + args.li * XCD_BAR_WORDS, F.MISC + 8);
    const int lo = args.ph_lo, hi = args.ph_hi;
#ifndef ONLY_PHASE
#define ONLY_PHASE -1
#endif
#define IN(k) (lo <= (k) && (k) < hi && (ONLY_PHASE < 0 || ONLY_PHASE == (k)))
#define SEAM(k) do { if ((k) + 1 < hi) xcd_barrier(bar); } while (0)
    if (IN(0)) { for (int rep = 0; rep < (PROBE_PHASE == 0 ? 2 : 1); ++rep) ph_prologue(F); SEAM(0); }
    if (IN(1)) { for (int rep = 0; rep < (PROBE_PHASE == 1 ? 2 : 1); ++rep) ph_hrows(F); SEAM(1); }
    if (IN(2)) {
        pg8::Gemm g{(const pg8::bf16_t*)F.HA8, (const pg8::bf16_t*)F.W8, M, INC, D / 2}; pg8::StaticOrder S; S.init(M, INC, F.G, (int)blockIdx.x);
        pg8::EpiI8<1> E{F.Z, INC, F.HAS, F.WS8, 1024};
        for (int rep = 0; rep < (PROBE_PHASE == 2 ? 2 : 1); ++rep) pg8::gemm_phase<pg8::EpiI8<1>, pg8::StaticOrder, true, true>(F.lds, g, S, E, F.wave);
        SEAM(2);
    }
    if (IN(3)) { for (int rep = 0; rep < (PROBE_PHASE == 30 ? 2 : 1); ++rep) sgu::sgu_phase(F); for (int rep = 0; rep < (PROBE_PHASE == 3 ? 2 : 1); ++rep) att::attn_phase(F); SEAM(3); }
    if (IN(4)) {
        pg8::Gemm g{F.CAT, F.WOUT, M, D, D}; pg8::StaticOrder S; S.init(M, D, F.G, (int)blockIdx.x);
        pg8::EpiBf16<0> E{F.Y, D, nullptr, 0, 0, 1.f, 0};
        for (int rep = 0; rep < (PROBE_PHASE == 4 ? 2 : 1); ++rep) pg8::gemm_phase<pg8::EpiBf16<0>, pg8::StaticOrder, true, true>(F.lds, g, S, E, F.wave);
        SEAM(4);
    }
    if (IN(5)) { for (int rep = 0; rep < (PROBE_PHASE == 5 ? 2 : 1); ++rep) ph_x1rows(F); SEAM(5); }
    if (IN(6)) {
        pg8::Gemm g{(const pg8::bf16_t*)F.H8, (const pg8::bf16_t*)F.WQ8, M, NQ, D / 2}; pg8::StaticOrder S; S.init(M, NQ, F.G, (int)blockIdx.x);
        pg8::EpiI8<0> E{F.QP, NQ, F.HS, F.WQS8, 0};
        for (int rep = 0; rep < (PROBE_PHASE == 6 ? 2 : 1); ++rep) pg8::gemm_phase<pg8::EpiI8<0>, pg8::StaticOrder, true, true>(F.lds, g, S, E, F.wave);
        SEAM(6);
    }
    if (IN(7)) { if (TABLES_IN_PHASE == 7) prologue_tables_fwd(F, blockIdx.x * NWAVES + F.wave, F.G * NWAVES, lane_id()); for (int rep = 0; rep < (PROBE_PHASE == 7 ? 2 : 1); ++rep) tk::topk_phase(F); SEAM(7); }
    if (IN(8)) { for (int rep = 0; rep < (PROBE_PHASE == 8 ? 2 : 1); ++rep) pe::peer_u_phase(F, 0, M, 0, 8); SEAM(8); }
    if (IN(9)) { if (PROBE_PHASE == 9) pe::peer_phase<true>(F, 0, M, 0, 8); pe::peer_phase<false>(F, 0, M, 0, 8); }
#undef IN
#undef SEAM
}

extern "C" void kernel_launch(void* const* d_in, const int* in_sizes, int n_in, void* d_out, int out_size, void* d_ws, size_t ws_size, hipStream_t stream) {
    static int grid = 0;
    if (grid == 0) {
        if (n_in != 18 || in_sizes[0] != M * D || out_size != M * D || ws_size < WS_END) { fprintf(stderr, "kernel_launch: unexpected shapes (n_in %d, in0 %d, out %d, ws %zu)\n", n_in, n_in > 0 ? in_sizes[0] : -1, out_size, ws_size); grid = -1; return; }
        int dev = 0, cus = 0, per_cu = 0;
        if (hipGetDevice(&dev) != hipSuccess || hipDeviceGetAttribute(&cus, hipDeviceAttributeMultiprocessorCount, dev) != hipSuccess) { grid = -1; return; }
        if (hipFuncSetAttribute((const void*)fwd, hipFuncAttributeMaxDynamicSharedMemorySize, LDS_BYTES) != hipSuccess) { fprintf(stderr, "kernel_launch: hipFuncSetAttribute failed\n"); grid = -1; return; }
        if (hipOccupancyMaxActiveBlocksPerMultiprocessor(&per_cu, (const void*)fwd, NTHR, LDS_BYTES) != hipSuccess || per_cu < 1) fprintf(stderr, "kernel_launch: occupancy query reports %d\n", per_cu);
        (void)hipGetLastError();
        grid = cus;
    }
    if (grid < 0) return;
    if (hipMemsetAsync((char*)d_ws + WS_CTL, 0, CTL_ZERO_BYTES, stream) != hipSuccess) return;
    Args a{};
    for (int i = 0; i < 18; ++i) a.in[i] = (const float*)d_in[i];
    a.out = (float*)d_out; a.ws = (unsigned char*)d_ws;
#if MK_PER_PHASE
    for (int p = 0; p < NPHASE; ++p) { a.ph_lo = p; a.ph_hi = p + 1; a.li = p; hipLaunchKernelGGL(fwd, dim3(grid), dim3(NTHR), LDS_BYTES, stream, a); }
#else
    a.ph_lo = 0; a.ph_hi = NPHASE; a.li = 0; hipLaunchKernelGGL(fwd, dim3(grid), dim3(NTHR), LDS_BYTES, stream, a);
#endif
}
```

```cpp
#define MK_PER_PHASE 0
#include <hip/hip_runtime.h>
#include <cstdio>
#include <cstdint>
namespace pg8 {
#define PG8_LAS __attribute__((address_space(3)))
typedef unsigned short bf16_t;
typedef short bf16x8 __attribute__((ext_vector_type(8)));
typedef float f32x4 __attribute__((ext_vector_type(4)));
typedef unsigned u32x4 __attribute__((ext_vector_type(4)));
typedef int i32x4 __attribute__((ext_vector_type(4)));
constexpr int BM = 256, BK = 64, HALF = 128, HTB = HALF * BK * 2  , STAGE_BYTES = 8 * HTB, NXCD = 8, WGM = 8;

__host__ __device__ __forceinline__ int lds_byte(int r, int c) { const int st = (r >> 4) * 2 + (c >> 5), rr = r & 15, cc = c & 31, ob = rr * 64 + cc * 2; return st * 1024 + (ob ^ (((ob >> 9) & 1) << 5)); }
__host__ __device__ __forceinline__ void stage_rc(int b, int& R, int& C) { const int st = b / 1024, sb = b % 1024, swz = sb ^ (((sb >> 9) & 1) << 5); R = (st >> 1) * 16 + swz / 64; C = (st & 1) * 32 + (swz % 64) / 2; }
__host__ __device__ __forceinline__ int perm32(int rho) { const int n = rho >> 4, i = rho & 15; return 8 * (i >> 2) + 4 * n + (i & 3); }

struct Unit { int pm, pn; };
struct Gemm { const bf16_t* A; const bf16_t* Bt; int M, N, K; };

struct StaticOrder {
    int nM, nN, nwg, G, c;
    __host__ __device__ void init(int M, int N, int G_, int c_) { nM = M / BM; nN = N / BM; nwg = nM * nN; G = G_; c = c_; }
    __host__ __device__ bool next(int i, Unit& u) const {
        const long L = (long)i * G + c; if (L >= nwg) return false;
        int wgid = (int)L; { const int q = nwg / NXCD, r = nwg % NXCD, xcd = wgid % NXCD, off = wgid / NXCD; wgid = (xcd < r ? xcd * (q + 1) : r * (q + 1) + (xcd - r) * q) + off; }
        const int nig = WGM * nN, gid = wgid / nig, fm = gid * WGM, gsz = (nM - fm) < WGM ? (nM - fm) : WGM;
        u.pm = fm + ((wgid % nig) % gsz); u.pn = (wgid % nig) / gsz; return true;
    }
    __device__ __forceinline__ void a_ready(const Unit&) const {}
    __device__ __forceinline__ void done(const Unit&) const {}
};

__device__ __forceinline__ unsigned cvt_pk_bf16(float lo, float hi) { unsigned r; asm volatile("v_cvt_pk_bf16_f32 %0, %1, %2" : "=v"(r) : "v"(lo), "v"(hi)); return r; }
typedef float f32x2 __attribute__((ext_vector_type(2)));
__device__ __forceinline__ f32x2 gelu_pk(f32x2 v) {
    const f32x2 u = v * (v * v * 0.044715f + 1.0f);
    const f32x2 s = u * (-2.302208198f);
    f32x2 e; e.x = __builtin_amdgcn_exp2f(s.x); e.y = __builtin_amdgcn_exp2f(s.y);
    const f32x2 d = e + 1.0f;
    f32x2 r; r.x = __builtin_amdgcn_rcpf(d.x); r.y = __builtin_amdgcn_rcpf(d.y);
    return v * r;
}

template <int ACT  > struct EpiBf16 {
    static constexpr bool PERM = true, AFTER_DRAIN = false; typedef f32x4 acc_t;
    bf16_t* O; int ldc; const float* bias; int split_cols; size_t split_stride; float scale0; int act_cols;
    __device__ __forceinline__ void operator()(const f32x4 (&acc)[2][2][4][2], const Unit& u, int wr, int wc, int fr, int fq) const {
        const int row0 = u.pm * BM + wr * 64 + fr; int colt = u.pn * BM; bf16_t* base = O;
        float sc = 1.f; if (split_cols) { const int t = colt / split_cols; base += (size_t)t * split_stride; colt -= t * split_cols; if (t == 0) sc = scale0; }
        const int col0 = colt + wc * 32 + 8 * fq, bcol0 = u.pn * BM + wc * 32 + 8 * fq;
        f32x4 bv[2][2];
#pragma unroll
        for (int bj = 0; bj < 2; ++bj)
#pragma unroll
            for (int n = 0; n < 2; ++n) bv[bj][n] = bias ? *(const f32x4*)(bias + bcol0 + bj * HALF + 4 * n) : (f32x4){0.f, 0.f, 0.f, 0.f};
#pragma unroll
        for (int ai = 0; ai < 2; ++ai)
#pragma unroll
            for (int m = 0; m < 4; ++m) { bf16_t* rowp = base + (size_t)(row0 + ai * HALF + m * 16) * ldc + col0;
#pragma unroll
                for (int bj = 0; bj < 2; ++bj) { f32x4 v0 = acc[ai][bj][m][0] + bv[bj][0], v1 = acc[ai][bj][m][1] + bv[bj][1];
                    if (ACT == 1 && u.pn * BM < act_cols) { f32x2 a = gelu_pk((f32x2){v0[0], v0[1]}), b = gelu_pk((f32x2){v0[2], v0[3]}), c = gelu_pk((f32x2){v1[0], v1[1]}), d = gelu_pk((f32x2){v1[2], v1[3]});
                        v0 = (f32x4){a.x, a.y, b.x, b.y}; v1 = (f32x4){c.x, c.y, d.x, d.y}; }
                    v0 = v0 * sc; v1 = v1 * sc; u32x4 w; w.x = cvt_pk_bf16(v0[0], v0[1]); w.y = cvt_pk_bf16(v0[2], v0[3]); w.z = cvt_pk_bf16(v1[0], v1[1]); w.w = cvt_pk_bf16(v1[2], v1[3]);
                    *(u32x4*)(rowp + bj * HALF) = w; } }
    }
};


template <int ACT> struct EpiI8 {
    static constexpr bool PERM = true, AFTER_DRAIN = false; typedef i32x4 acc_t;
    bf16_t* O; int ldc; const float* rs; const float* cs; int act_cols;
    __device__ __forceinline__ void operator()(const i32x4 (&acc)[2][2][4][2], const Unit& u, int wr, int wc, int fr, int fq) const {
        const int row0 = u.pm * BM + wr * 64 + fr, col0 = u.pn * BM + wc * 32 + 8 * fq;
        f32x4 cv[2][2];
#pragma unroll
        for (int bj = 0; bj < 2; ++bj)
#pragma unroll
            for (int n = 0; n < 2; ++n) cv[bj][n] = *(const f32x4*)(cs + col0 + bj * HALF + 4 * n);
#pragma unroll
        for (int ai = 0; ai < 2; ++ai)
#pragma unroll
            for (int m = 0; m < 4; ++m) { const int row = row0 + ai * HALF + m * 16; const float ra = rs[row]; bf16_t* rowp = O + (size_t)row * ldc + col0;
#pragma unroll
                for (int bj = 0; bj < 2; ++bj) {
                    f32x4 v0 = __builtin_convertvector(acc[ai][bj][m][0], f32x4) * ra * cv[bj][0], v1 = __builtin_convertvector(acc[ai][bj][m][1], f32x4) * ra * cv[bj][1];
                    if (ACT == 1 && u.pn * BM < act_cols) { f32x2 a = gelu_pk((f32x2){v0[0], v0[1]}), b = gelu_pk((f32x2){v0[2], v0[3]}), c = gelu_pk((f32x2){v1[0], v1[1]}), d = gelu_pk((f32x2){v1[2], v1[3]});
                        v0 = (f32x4){a.x, a.y, b.x, b.y}; v1 = (f32x4){c.x, c.y, d.x, d.y}; }
                    u32x4 w; w.x = cvt_pk_bf16(v0[0], v0[1]); w.y = cvt_pk_bf16(v0[2], v0[3]); w.z = cvt_pk_bf16(v1[0], v1[1]); w.w = cvt_pk_bf16(v1[2], v1[3]);
                    *(u32x4*)(rowp + bj * HALF) = w; } }
    }
};

__device__ __forceinline__ f32x4 mma16(bf16x8 a, bf16x8 b, f32x4 c) { return __builtin_amdgcn_mfma_f32_16x16x32_bf16(a, b, c, 0, 0, 0); }
__device__ __forceinline__ i32x4 mma16(bf16x8 a, bf16x8 b, i32x4 c) { return __builtin_amdgcn_mfma_i32_16x16x64_i8(__builtin_bit_cast(i32x4, a), __builtin_bit_cast(i32x4, b), c, 0, 0, 0); }
template <class Epi, class Sched, bool ALIGN_EPI = false, bool SP2 = false>
__device__ __forceinline__ void gemm_phase(PG8_LAS unsigned char* lds, const Gemm g, const Sched& S, const Epi& E, const int wid  ) {
    const int lane = (int)__builtin_amdgcn_mbcnt_hi(~0u, __builtin_amdgcn_mbcnt_lo(~0u, 0u)), tid = wid * 64 + lane, wr = wid >> 2, wc = wid & 3, fr = lane & 15, fq = lane >> 4;
    const int K = g.K, nt = K / BK;
    unsigned voffA[2], voffB[2];
#pragma unroll
    for (int i = 0; i < 2; ++i) { int R, C; stage_rc(tid * 16 + i * 8192, R, C); const int Rb = Epi::PERM ? ((R & ~31) + perm32(R & 31)) : R;
        voffA[i] = (unsigned)(R * K + C) * 2u; voffB[i] = (unsigned)(Rb * K + C) * 2u; }
    const size_t kstep = (size_t)(BK * 2);
    const size_t hstep = (size_t)HALF * K * 2;
    const size_t tstep = 2 * hstep;
    const unsigned ldsw = (unsigned)wid * 1024u;
    const int aoff = lds_byte(wr * 64 + fr, fq * 8), boff = lds_byte(wc * 32 + fr, fq * 8);
#define PG8_SA(b, h) (((b) * 2 + (h)) * HTB)
#define PG8_SB(b, h) ((4 + (b) * 2 + (h)) * HTB)
#define PG8_STAGE(bufoff, gbase, voff) do { _Pragma("unroll") for (int _i = 0; _i < 2; ++_i) \
        __builtin_amdgcn_global_load_lds((const unsigned*)((const char*)(gbase) + (voff)[_i]), (PG8_LAS unsigned*)(lds + (bufoff) + ldsw + _i * 8192), 16, 0, 0); } while (0)
#define PG8_LDA(dst, b, h) do { _Pragma("unroll") for (int m = 0; m < 4; ++m) _Pragma("unroll") for (int k = 0; k < 2; ++k) dst[m][k] = *(const PG8_LAS bf16x8*)(lds + PG8_SA(b, h) + aoff + m * 2048 + k * 1024); } while (0)
#define PG8_LDB(dst, b, h) do { _Pragma("unroll") for (int n = 0; n < 2; ++n) _Pragma("unroll") for (int k = 0; k < 2; ++k) dst[n][k] = *(const PG8_LAS bf16x8*)(lds + PG8_SB(b, h) + boff + n * 2048 + k * 1024); } while (0)
#define PG8_MMA(ai, bj, At, Bt) do { __builtin_amdgcn_s_setprio(1); _Pragma("unroll") for (int m = 0; m < 4; ++m) _Pragma("unroll") for (int n = 0; n < 2; ++n) _Pragma("unroll") for (int k = 0; k < 2; ++k) \
        acc[ai][bj][m][n] = mma16(Bt[n][k], At[m][k], acc[ai][bj][m][n]); __builtin_amdgcn_s_setprio(0); } while (0)
#define PG8_WAIT_V(n) asm volatile("s_waitcnt vmcnt(" #n ")" ::: "memory")
#define PG8_WAIT_L(n) asm volatile("s_waitcnt lgkmcnt(" #n ")" ::: "memory")
#define PG8_BAR __builtin_amdgcn_s_barrier()
#define PG8_SCHED __builtin_amdgcn_sched_barrier(0)
    Unit cur, nxt; int ui = 0;
    if (!S.next(0, cur)) return;
    typedef typename Epi::acc_t acc_t;
    acc_t acc[2][2][4][2];
#pragma unroll
    for (int a = 0; a < 2; ++a)
#pragma unroll
        for (int b = 0; b < 2; ++b)
#pragma unroll
            for (int m = 0; m < 4; ++m)
#pragma unroll
                for (int n = 0; n < 2; ++n) acc[a][b][m][n] = acc_t{};
    bf16x8 At[4][2], B0[2][2], B1[2][2];
    const char* cA = (const char*)g.A + (size_t)cur.pm * tstep; const char* cB = (const char*)g.Bt + (size_t)cur.pn * tstep;
    S.a_ready(cur);
    if constexpr (SP2) {
        PG8_STAGE(PG8_SB(0, 0), cB, voffB); PG8_STAGE(PG8_SB(0, 1), cB + hstep, voffB); PG8_STAGE(PG8_SA(0, 0), cA, voffA); PG8_STAGE(PG8_SA(0, 1), cA + hstep, voffA);
        if (wr == 1) PG8_BAR;
        PG8_WAIT_V(2); PG8_BAR;
        PG8_STAGE(PG8_SB(1, 0), cB + kstep, voffB); PG8_STAGE(PG8_SA(1, 0), cA + kstep, voffA); PG8_STAGE(PG8_SB(1, 1), cB + hstep + kstep, voffB);
        PG8_WAIT_V(6); PG8_BAR;
    } else {
        PG8_STAGE(PG8_SB(0, 0), cB, voffB); PG8_STAGE(PG8_SA(0, 0), cA, voffA); PG8_STAGE(PG8_SB(0, 1), cB + hstep, voffB); PG8_STAGE(PG8_SA(0, 1), cA + hstep, voffA);
        if (wr == 1) PG8_BAR;
        PG8_WAIT_V(4); PG8_BAR;
        PG8_STAGE(PG8_SB(1, 0), cB + kstep, voffB); PG8_STAGE(PG8_SA(1, 0), cA + kstep, voffA); PG8_STAGE(PG8_SB(1, 1), cB + hstep + kstep, voffB);
        PG8_WAIT_V(6); PG8_BAR;
    }
    for (;;) {
        const bool has_next = S.next(ui + 1, nxt);
        const char* nA = has_next ? (const char*)g.A + (size_t)nxt.pm * tstep : cA; const char* nB = has_next ? (const char*)g.Bt + (size_t)nxt.pn * tstep : cB;
        for (int t = 0; t < nt; t += 2) {
            const bool last = (t == nt - 2);
            const char* a1 = cA + (size_t)(t + 1) * kstep;
            const char* a2 = last ? nA : cA + (size_t)(t + 2) * kstep; const char* b2 = last ? nB : cB + (size_t)(t + 2) * kstep;
            const char* a3 = a2 + kstep; const char* b3 = b2 + kstep;
            if (last && has_next) S.a_ready(nxt);
            if constexpr (SP2) {
            PG8_LDB(B0, 0, 0); PG8_LDB(B1, 0, 1); PG8_SCHED; PG8_LDA(At, 0, 0); PG8_STAGE(PG8_SA(1, 1), a1 + hstep, voffA);
            PG8_WAIT_V(8); PG8_WAIT_L(0); PG8_BAR; PG8_MMA(0, 0, At, B0); PG8_MMA(0, 1, At, B1); PG8_BAR; PG8_SCHED;
            PG8_LDA(At, 0, 1); PG8_STAGE(PG8_SB(0, 0), b2, voffB); PG8_STAGE(PG8_SB(0, 1), b2 + hstep, voffB); PG8_STAGE(PG8_SA(0, 0), a2, voffA);
            PG8_WAIT_V(8); PG8_WAIT_L(0); PG8_BAR; PG8_MMA(1, 0, At, B0); PG8_MMA(1, 1, At, B1); PG8_BAR; PG8_SCHED;
            PG8_LDB(B0, 1, 0); PG8_LDB(B1, 1, 1); PG8_SCHED; PG8_LDA(At, 1, 0); PG8_STAGE(PG8_SA(0, 1), a2 + hstep, voffA);
            PG8_WAIT_V(8); PG8_WAIT_L(0); PG8_BAR; PG8_MMA(0, 0, At, B0); PG8_MMA(0, 1, At, B1); PG8_BAR; PG8_SCHED;
            PG8_LDA(At, 1, 1); PG8_STAGE(PG8_SB(1, 0), b3, voffB); PG8_STAGE(PG8_SB(1, 1), b3 + hstep, voffB); PG8_STAGE(PG8_SA(1, 0), a3, voffA);
            PG8_WAIT_V(8); PG8_WAIT_L(0); PG8_BAR; PG8_MMA(1, 0, At, B0); PG8_MMA(1, 1, At, B1); PG8_BAR; PG8_SCHED;
            } else {
            PG8_LDB(B0, 0, 0); PG8_SCHED; PG8_LDA(At, 0, 0); PG8_STAGE(PG8_SA(1, 1), a1 + hstep, voffA);
            PG8_WAIT_L(8); PG8_BAR; PG8_WAIT_L(0); PG8_MMA(0, 0, At, B0); PG8_BAR; PG8_SCHED;
            PG8_LDB(B1, 0, 1); PG8_STAGE(PG8_SB(0, 0), b2, voffB);
            PG8_BAR; PG8_WAIT_L(0); PG8_MMA(0, 1, At, B1); PG8_BAR;
            PG8_LDA(At, 0, 1); PG8_STAGE(PG8_SA(0, 0), a2, voffA);
            PG8_BAR; PG8_WAIT_L(0); PG8_MMA(1, 0, At, B0); PG8_BAR; PG8_SCHED;
            PG8_STAGE(PG8_SB(0, 1), b2 + hstep, voffB);
            PG8_WAIT_V(6); PG8_BAR; PG8_MMA(1, 1, At, B1); PG8_BAR;
            PG8_LDB(B0, 1, 0); PG8_SCHED; PG8_LDA(At, 1, 0); PG8_STAGE(PG8_SA(0, 1), a2 + hstep, voffA);
            PG8_WAIT_L(8); PG8_BAR; PG8_WAIT_L(0); PG8_MMA(0, 0, At, B0); PG8_BAR; PG8_SCHED;
            PG8_LDB(B1, 1, 1); PG8_STAGE(PG8_SB(1, 0), b3, voffB);
            PG8_BAR; PG8_WAIT_L(0); PG8_MMA(0, 1, At, B1); PG8_BAR;
            PG8_LDA(At, 1, 1); PG8_STAGE(PG8_SA(1, 0), a3, voffA);
            PG8_BAR; PG8_WAIT_L(0); PG8_MMA(1, 0, At, B0); PG8_BAR; PG8_SCHED;
            PG8_STAGE(PG8_SB(1, 1), b3 + hstep, voffB);
            PG8_WAIT_V(6); PG8_BAR; PG8_MMA(1, 1, At, B1); PG8_BAR;
            }
        }
        if constexpr (ALIGN_EPI) { if (wr == 0) PG8_BAR; }
        if constexpr (!Epi::AFTER_DRAIN) { E(acc, cur, wr, wc, fr, fq); S.done(cur); }
        if (!has_next) break;
#pragma unroll
        for (int a = 0; a < 2; ++a)
#pragma unroll
            for (int b = 0; b < 2; ++b)
#pragma unroll
                for (int m = 0; m < 4; ++m)
#pragma unroll
                    for (int n = 0; n < 2; ++n) acc[a][b][m][n] = acc_t{};
        cur = nxt; cA = nA; cB = nB; ++ui;
        if constexpr (ALIGN_EPI) { if (wr == 1) PG8_BAR; }
    }
    PG8_WAIT_V(0);
    if constexpr (!ALIGN_EPI) { if (wr == 0) PG8_BAR; }
    PG8_BAR;
    if constexpr (Epi::AFTER_DRAIN) { E.fused(acc, cur, wr, wc, fr, fq, lds, wid, lane); S.done(cur); }
#undef PG8_SA
#undef PG8_SB
#undef PG8_STAGE
#undef PG8_LDA
#undef PG8_LDB
#undef PG8_MMA
#undef PG8_WAIT_V
#undef PG8_WAIT_L
#undef PG8_BAR
#undef PG8_SCHED
}
}
#ifndef MK_PER_PHASE
#define MK_PER_PHASE 0
#endif
#ifndef PROBE_PHASE
#define PROBE_PHASE -1
#endif
#ifndef X1_NR
#define X1_NR 2
#endif
#ifndef TABLES_IN_PHASE
#define TABLES_IN_PHASE 0
#endif
constexpr int NWAVES = 8, NTHR = NWAVES * 64;
constexpr int BATCH = 8, SEQ = 4096, D = 1024, M = BATCH * SEQ;
constexpr int INC = 2560;
constexpr int NEXP = 16384, PKN = 128;
constexpr int NQ = 2048;
constexpr float EPS = 1e-6f;
constexpr size_t MiB = 1u << 20;
constexpr size_t WS_CTL = 0, CTL_ZERO_BYTES = MK_PER_PHASE ? (1u << 20) : 64 * 1024;
constexpr size_t WS_MOD = 1 * MiB, WS_WIN = 2 * MiB, WS_WOUT = 7 * MiB, WS_WQ = 9 * MiB, WS_KEYS = 13 * MiB, WS_SGW = 13 * MiB + 512 * 1024;
constexpr size_t WS_SU = 14 * MiB, WS_UT = 16 * MiB, WS_VT = 48 * MiB, WS_H = 80 * MiB, WS_Y = 144 * MiB, WS_OATT = 80 * MiB, WS_Z = 208 * MiB, WS_QP = 208 * MiB;
constexpr size_t WS_H8 = 336 * MiB;
constexpr size_t WS_CAT = 368 * MiB, WS_IDX = 432 * MiB, WS_GATE = 448 * MiB, WS_END = 464 * MiB;
constexpr int CW_BAR = 4096;
constexpr int RING_BYTES = 131072, LDSCTL_OFF = RING_BYTES, MISC_OFF = LDSCTL_OFF + 320, LDS_BYTES = 147456;
constexpr int NPHASE = 10;

#define GAS __attribute__((address_space(1)))
#define LAS __attribute__((address_space(3)))
typedef unsigned short bf16;
typedef unsigned v4u __attribute__((ext_vector_type(4)));
typedef unsigned v2u __attribute__((ext_vector_type(2)));
typedef float f32x4 __attribute__((ext_vector_type(4)));
typedef short bf16x8 __attribute__((ext_vector_type(8)));
typedef GAS unsigned gu32;
typedef GAS unsigned long long gu64;
#define RLX_AGENT __ATOMIC_RELAXED, __HIP_MEMORY_SCOPE_AGENT
#define LDS_WAIT() asm volatile("s_waitcnt lgkmcnt(0)" ::: "memory")
#define VM_WAIT() asm volatile("s_waitcnt vmcnt(0)" ::: "memory")
__device__ __forceinline__ unsigned f2bf(float f) { unsigned u = __builtin_bit_cast(unsigned, f); return (u + 0x7fffu + ((u >> 16) & 1u)) >> 16; }
__device__ __forceinline__ unsigned pk2(float lo, float hi) { return f2bf(lo) | (f2bf(hi) << 16); }
__device__ __forceinline__ float bflo(unsigned w) { return __uint_as_float(w << 16); }
__device__ __forceinline__ float bfhi(unsigned w) { return __uint_as_float(w & 0xffff0000u); }
__device__ __forceinline__ float bf2f(bf16 b) { return __uint_as_float((unsigned)b << 16); }
typedef __bf16 bf16x2_t __attribute__((ext_vector_type(2)));
__device__ __forceinline__ float dot2(unsigned a, unsigned b, float acc) { return __builtin_amdgcn_fdot2_f32_bf16(__builtin_bit_cast(bf16x2_t, a), __builtin_bit_cast(bf16x2_t, b), acc, false); }
__device__ __forceinline__ float gelu_t(float v) { const float u = v * (1.f + 0.044715f * v * v); return v * __builtin_amdgcn_rcpf(1.f + __builtin_amdgcn_exp2f(-2.302208198f * u)); }
__device__ __forceinline__ int lane_id() { return (int)__builtin_amdgcn_mbcnt_hi(~0u, __builtin_amdgcn_mbcnt_lo(~0u, 0u)); }
__device__ __forceinline__ float wave_sum(float v) {
#pragma unroll
    for (int o = 1; o < 64; o <<= 1) v += __shfl_xor(v, o);
    return v;
}
#define DPP_SUM_ROW(v) do { v += __uint_as_float((unsigned)__builtin_amdgcn_update_dpp(0, (int)__float_as_uint(v), 0xB1, 0xF, 0xF, false)); \
        v += __uint_as_float((unsigned)__builtin_amdgcn_update_dpp(0, (int)__float_as_uint(v), 0x4E, 0xF, 0xF, false)); \
        v += __uint_as_float((unsigned)__builtin_amdgcn_update_dpp(0, (int)__float_as_uint(v), 0x141, 0xF, 0xF, false)); \
        v += __uint_as_float((unsigned)__builtin_amdgcn_update_dpp(0, (int)__float_as_uint(v), 0x140, 0xF, 0xF, false)); } while (0)
__device__ __forceinline__ float dpp_xor1(float v) { return __uint_as_float((unsigned)__builtin_amdgcn_update_dpp(0, (int)__float_as_uint(v), 0xB1, 0xF, 0xF, false)); }
__device__ __forceinline__ float wave_sum_dpp(float v) {
    DPP_SUM_ROW(v);
    const float r0 = __uint_as_float(__builtin_amdgcn_readlane(__float_as_uint(v), 0)), r1 = __uint_as_float(__builtin_amdgcn_readlane(__float_as_uint(v), 16));
    const float r2 = __uint_as_float(__builtin_amdgcn_readlane(__float_as_uint(v), 32)), r3 = __uint_as_float(__builtin_amdgcn_readlane(__float_as_uint(v), 48));
    return (r0 + r1) + (r2 + r3);
}
__device__ __forceinline__ float wave_max_dpp(float v) {
    v = fmaxf(v, __uint_as_float((unsigned)__builtin_amdgcn_update_dpp(0, (int)__float_as_uint(v), 0xB1, 0xF, 0xF, false)));
    v = fmaxf(v, __uint_as_float((unsigned)__builtin_amdgcn_update_dpp(0, (int)__float_as_uint(v), 0x4E, 0xF, 0xF, false)));
    v = fmaxf(v, __uint_as_float((unsigned)__builtin_amdgcn_update_dpp(0, (int)__float_as_uint(v), 0x141, 0xF, 0xF, false)));
    v = fmaxf(v, __uint_as_float((unsigned)__builtin_amdgcn_update_dpp(0, (int)__float_as_uint(v), 0x140, 0xF, 0xF, false)));
    const float r0 = __uint_as_float(__builtin_amdgcn_readlane(__float_as_uint(v), 0)), r1 = __uint_as_float(__builtin_amdgcn_readlane(__float_as_uint(v), 16));
    const float r2 = __uint_as_float(__builtin_amdgcn_readlane(__float_as_uint(v), 32)), r3 = __uint_as_float(__builtin_amdgcn_readlane(__float_as_uint(v), 48));
    return fmaxf(fmaxf(r0, r1), fmaxf(r2, r3));
}
__device__ __forceinline__ float half_max_dpp(float v) {
    v = fmaxf(v, __uint_as_float((unsigned)__builtin_amdgcn_update_dpp(0, (int)__float_as_uint(v), 0xB1, 0xF, 0xF, false)));
    v = fmaxf(v, __uint_as_float((unsigned)__builtin_amdgcn_update_dpp(0, (int)__float_as_uint(v), 0x4E, 0xF, 0xF, false)));
    v = fmaxf(v, __uint_as_float((unsigned)__builtin_amdgcn_update_dpp(0, (int)__float_as_uint(v), 0x141, 0xF, 0xF, false)));
    v = fmaxf(v, __uint_as_float((unsigned)__builtin_amdgcn_update_dpp(0, (int)__float_as_uint(v), 0x140, 0xF, 0xF, false)));
    const float r0 = __uint_as_float(__builtin_amdgcn_readlane(__float_as_uint(v), 0)), r1 = __uint_as_float(__builtin_amdgcn_readlane(__float_as_uint(v), 16));
    const float r2 = __uint_as_float(__builtin_amdgcn_readlane(__float_as_uint(v), 32)), r3 = __uint_as_float(__builtin_amdgcn_readlane(__float_as_uint(v), 48));
    return (lane_id() < 32) ? fmaxf(r0, r1) : fmaxf(r2, r3);
}
__device__ __forceinline__ float wave_max(float v) {
#pragma unroll
    for (int o = 1; o < 64; o <<= 1) v = fmaxf(v, __shfl_xor(v, o));
    return v;
}
#define XB_TMO      128
#define XB_XCNT(j)  (256  + 64 * (j))
#define XB_XSUB(j)  (1280 + 64 * (j))
#define XB_XGEN(j)  (2304 + 64 * (j))
#define XB_TOP      3328
#define XB_TOPGEN   3392
#define XCD_BAR_WORDS 3456
#define XB_SPIN_CAP (1u << 18)

__device__ __forceinline__ unsigned xb_ld(unsigned* p)              { return __hip_atomic_load(p, __ATOMIC_RELAXED, __HIP_MEMORY_SCOPE_AGENT); }
__device__ __forceinline__ unsigned xb_add(unsigned* p, unsigned v) { return __hip_atomic_fetch_add(p, v, __ATOMIC_RELAXED, __HIP_MEMORY_SCOPE_AGENT); }
__device__ __forceinline__ unsigned xb_xcc_id() { return (unsigned)__builtin_amdgcn_s_getreg((3 << 11) | 20) & 0xFu; }
#define XB_SPIN(cond, bar) do { unsigned _sp = 0; while (cond) { __builtin_amdgcn_s_sleep(1); \
    if ((++_sp & 255u) == 0u) { if (xb_ld(&(bar)[XB_TMO])) break; if (_sp > XB_SPIN_CAP) { atomicAdd(&(bar)[XB_TMO], 1u); break; } } } } while (0)

struct XcdBarrier {
    unsigned* bar; unsigned x;
    volatile LAS unsigned* st;
};

__device__ __forceinline__ XcdBarrier xcd_barrier_post(unsigned* bar, volatile LAS unsigned* st) {
    XcdBarrier b; b.bar = bar; b.x = xb_xcc_id(); b.st = st;
    if (threadIdx.x == 0) (void)xb_add(&bar[XB_XCNT(b.x)], 1u);
    return b;
}
__device__ __forceinline__ void xcd_barrier_complete(unsigned* bar, unsigned x, unsigned& nloc, unsigned& nx) {
    const unsigned G = gridDim.x * gridDim.y * gridDim.z;
    unsigned sum, cnt, mine, sp = 0u;
    for (;;) {
        sum = 0u; cnt = 0u; mine = 0u;
#pragma unroll
        for (unsigned j = 0; j < 16; ++j) { const unsigned c = xb_ld(&bar[XB_XCNT(j)]); sum += c; cnt += (c > 0u) ? 1u : 0u; mine = (j == x) ? c : mine; }
        if (sum == G) break;
        __builtin_amdgcn_s_sleep(1);
        if ((++sp & 255u) == 0u) { if (xb_ld(&bar[XB_TMO])) break; if (sp > XB_SPIN_CAP) { atomicAdd(&bar[XB_TMO], 1u); break; } }
    }
    nloc = mine > 0u ? mine : 1u; nx = cnt > 0u ? cnt : 1u;
}

__device__ __forceinline__ void xcd_barrier(const XcdBarrier& b) {
    asm volatile("s_waitcnt vmcnt(0)" ::: "memory");
    __syncthreads();
    if (threadIdx.x == 0) {
        unsigned* bar = b.bar;
        __builtin_amdgcn_s_waitcnt(0);
        unsigned nloc = b.st[0], nx = b.st[1];
        if (nloc == 0u) { xcd_barrier_complete(bar, b.x, nloc, nx); b.st[0] = nloc; b.st[1] = nx; }
        const unsigned old = xb_add(&bar[XB_XSUB(b.x)], 1u);
        const unsigned gen = old / nloc;
        if (old + 1u == (gen + 1u) * nloc) {
            __builtin_amdgcn_fence(__ATOMIC_RELEASE, "agent");
            asm volatile("s_waitcnt vmcnt(0)" ::: "memory");
            const unsigned og = xb_add(&bar[XB_TOP], 1u);
            const unsigned tg = og / nx;
            if (og + 1u == (tg + 1u) * nx) xb_add(&bar[XB_TOPGEN], 1u);
            else XB_SPIN(xb_ld(&bar[XB_TOPGEN]) == tg, bar);
            __builtin_amdgcn_fence(__ATOMIC_ACQUIRE, "agent");
            xb_add(&bar[XB_XGEN(b.x)], 1u);
            asm volatile("s_waitcnt vmcnt(0)" ::: "memory");
        } else {
            XB_SPIN(xb_ld(&bar[XB_XGEN(b.x)]) == gen, bar);
            __builtin_amdgcn_fence(__ATOMIC_ACQUIRE, "agent");
            asm volatile("s_waitcnt vmcnt(0)" ::: "memory");
        }
    }
    __syncthreads();
}
struct Frame {
    LAS unsigned char* lds;
    volatile LAS unsigned* MISC;
    gu32* ctl;
    int wave, G;
    const float *x, *c, *w_ada, *b_ada, *norm_g, *w_in, *sgu_ln_g, *sgu_ln_b, *sgu_w, *sgu_b, *diff_lambda, *subln_g, *rel_bias, *w_out, *w_query, *sub_keys, *peer_u, *peer_v;
    float* out;
    float* mod; bf16 *WIN, *WOUT, *WQ, *KEYS, *SGW, *H, *Y, *Z, *QP, *CAT; unsigned char *UT8, *VT6, *H8, *HA8, *W8, *WQ8; float *HS, *HAS, *WS8, *WQS8; float *SU, *SV, *PART; unsigned* STASH; int* IDX; float* GATE;
};

__device__ __forceinline__ void p0_transpose_item(const float* W, int K, int N, bf16* WT, int row_off, LAS float* scr, int item, int lane) {
    const int nblk = N / 32, kb = item / nblk, nb = item % nblk, k0 = 64 * kb, n0 = 32 * nb;
#pragma unroll 8
    for (int i = 0; i < 32; ++i) { const int kk = 2 * i + (lane >> 5); scr[kk * 33 + (lane & 31)] = W[(size_t)(k0 + kk) * N + n0 + (lane & 31)]; }
    LDS_WAIT(); asm volatile("" ::: "memory");
    const int c = lane & 7;
#pragma unroll
    for (int j = 0; j < 4; ++j) { const int n = (lane >> 3) + 8 * j; const LAS float* s = scr + (8 * c) * 33 + n;
        v4u o; o.x = pk2(s[0 * 33], s[1 * 33]); o.y = pk2(s[2 * 33], s[3 * 33]); o.z = pk2(s[4 * 33], s[5 * 33]); o.w = pk2(s[6 * 33], s[7 * 33]);
        *(GAS v4u*)(WT + (size_t)(row_off + n0 + n) * K + k0 + 8 * c) = o; }
    LDS_WAIT(); asm volatile("" ::: "memory");
}

__device__ __forceinline__ void prologue_tables_fwd(Frame& F, int gw, int NGW, int lane);
__device__ __forceinline__ void ph_prologue(Frame& F) {
    const int lane = lane_id(), wave = F.wave, tid = wave * 64 + lane, G = F.G;
    const int gw = blockIdx.x * NWAVES + wave, NGW = G * NWAVES;
    for (int rep_ = 0; rep_ < (PROBE_PHASE == 100 ? 2 : 1); ++rep_) {
        LAS float* sil = (LAS float*)F.lds;
        LAS float* red = sil + 8192;
        for (int i = tid; i < 8192; i += NTHR) { const float cv = F.c[i]; sil[i] = cv / (1.f + __expf(-cv)); }
        __syncthreads();
        for (int u = blockIdx.x; u < 384; u += G) {
            const int j = u * 16 + (lane & 15), kr = lane >> 4, k0 = wave * 128;
            float acc[8];
#pragma unroll
            for (int b = 0; b < 8; ++b) acc[b] = 0.f;
            const float* wp = F.w_ada + (size_t)(k0 + kr) * 6144 + j;
#pragma unroll 16
            for (int i = 0; i < 32; ++i) { const float w = wp[(size_t)i * 4 * 6144]; const int k = k0 + 4 * i + kr;
#pragma unroll
                for (int b = 0; b < 8; ++b) acc[b] += sil[b * 1024 + k] * w; }
#pragma unroll
            for (int b = 0; b < 8; ++b) { acc[b] += __shfl_xor(acc[b], 16); acc[b] += __shfl_xor(acc[b], 32); }
            if (lane < 16) {
#pragma unroll
                for (int b = 0; b < 8; ++b) red[(wave * 8 + b) * 16 + lane] = acc[b]; }
            __syncthreads();
            if (tid < 128) { const int b = tid >> 4, c = tid & 15; float s = 0.f;
#pragma unroll
                for (int w = 0; w < 8; ++w) s += red[(w * 8 + b) * 16 + c];
                F.mod[b * 6144 + u * 16 + c] = s + F.b_ada[u * 16 + c]; }
            __syncthreads();
        }
    }
    LAS float* scr = (LAS float*)(F.lds + wave * 16384);
    {
        LAS float* part = (LAS float*)(F.lds + 7 * 16384 + 8704);
        LAS float* fin = part + 256;
        const int n = lane & 31, hf = lane >> 5;
        for (int u = blockIdx.x; u < (INC + NQ) / 32; u += G) {
            const bool isq = u >= INC / 32;
            const float* Wsrc = isq ? F.w_query : F.w_in; const int Nw = isq ? NQ : INC; unsigned char* Wdst = isq ? F.WQ8 : F.W8; float* Sdst = isq ? F.WQS8 : F.WS8;
            const int n0 = (isq ? u - INC / 32 : u) * 32;
            float am = 0.f;
            { const float* wp = Wsrc + (size_t)(wave * 128 + hf) * Nw + n0 + n;
#pragma unroll 16
              for (int i = 0; i < 64; ++i) am = fmaxf(am, fabsf(wp[(size_t)(2 * i) * Nw])); }
            { auto rr = __builtin_amdgcn_permlane32_swap(__float_as_uint(am), __float_as_uint(am), false, false); am = fmaxf(__uint_as_float(rr[0]), __uint_as_float(rr[1])); }
            if (lane < 32) part[wave * 32 + lane] = am;
            __syncthreads();
            if (tid < 32) { float mx = 0.f;
#pragma unroll
                for (int w = 0; w < 8; ++w) mx = fmaxf(mx, part[w * 32 + tid]);
                const float qsc = (!isq && n0 >= 1024 && n0 < 1536) ? 0.125f * 1.4426950408889634f : 1.f;
                fin[tid] = mx; Sdst[n0 + tid] = (mx > 0.f ? mx * (1.f / 127.f) : 1.f) * qsc; }
            __syncthreads();
            const float cmx = fin[n]; const float sc = cmx > 0.f ? 127.f / cmx : 1.f;
#pragma unroll 1
            for (int q = 0; q < 2; ++q) { const int k0 = (wave * 2 + q) * 64;
#pragma unroll 8
                for (int i = 0; i < 32; ++i) { const int kk = 2 * i + hf; scr[kk * 33 + n] = Wsrc[(size_t)(k0 + kk) * Nw + n0 + n]; }
                LDS_WAIT(); asm volatile("" ::: "memory");
                unsigned w8[8];
#pragma unroll
                for (int d = 0; d < 8; ++d) { const LAS float* s = scr + (32 * hf + 4 * d) * 33 + n;
                    const int q0 = (int)rintf(s[0] * sc), q1 = (int)rintf(s[33] * sc), q2 = (int)rintf(s[66] * sc), q3 = (int)rintf(s[99] * sc);
                    w8[d] = (unsigned)((q0 & 255) | ((q1 & 255) << 8) | ((q2 & 255) << 16) | (q3 << 24)); }
                unsigned char* op = Wdst + (size_t)(n0 + n) * D + k0 + 32 * hf;
                *(GAS v4u*)op = (v4u){w8[0], w8[1], w8[2], w8[3]}; *(GAS v4u*)(op + 16) = (v4u){w8[4], w8[5], w8[6], w8[7]};
                LDS_WAIT(); asm volatile("" ::: "memory"); }
            __syncthreads();
        }
    }
    constexpr int I_IN = 0, I_OUT = (D / 64) * (D / 32), I_Q = 0;
    for (int rep_ = 0; rep_ < (PROBE_PHASE == 101 ? 2 : 1); ++rep_)
    for (int it = gw; it < I_IN + I_OUT + I_Q; it += NGW) {
        int r = it;
        if (r < I_IN) { p0_transpose_item(F.w_in, D, INC, F.WIN, 0, scr, r, lane); continue; } r -= I_IN;
        if (r < I_OUT) { p0_transpose_item(F.w_out, D, D, F.WOUT, 0, scr, r, lane); continue; } r -= I_OUT;
        (void)r;
    }
    const int gt = blockIdx.x * NTHR + tid, NT = G * NTHR;
    if (TABLES_IN_PHASE == 0) for (int rep_ = 0; rep_ < (PROBE_PHASE == 102 ? 2 : 1); ++rep_) prologue_tables_fwd(F, gw, NGW, lane);
    for (int i = gt; i < 16 * 16 * 128; i += NT) {
        const int hc = i >> 11, dg = (i >> 7) & 15, n = i & 127;
        const float* s = F.sub_keys + ((size_t)(hc * 128 + n)) * 128 + dg * 8;
        const f32x4 a = *(const f32x4*)s, b = *(const f32x4*)(s + 4);
        v4u o; o.x = pk2(a.x, a.y); o.y = pk2(a.z, a.w); o.z = pk2(b.x, b.y); o.w = pk2(b.z, b.w); ((v4u*)F.KEYS)[i] = o;
    }
    for (int i = gt; i < 8 * 128 * 16; i += NT) {
        const int t = (i >> 4) & 127, s0 = (i & 15) * 8;
        const float* s = F.sgu_w + (size_t)i * 8;
        const f32x4 a = *(const f32x4*)s, b = *(const f32x4*)(s + 4);
        float f[8] = {a.x, a.y, a.z, a.w, b.x, b.y, b.z, b.w};
#pragma unroll
        for (int e = 0; e < 8; ++e) f[e] = (s0 + e <= t) ? f[e] : 0.f;
        v4u o; o.x = pk2(f[0], f[1]); o.y = pk2(f[2], f[3]); o.z = pk2(f[4], f[5]); o.w = pk2(f[6], f[7]); ((v4u*)F.SGW)[i] = o;
    }
}

__device__ __forceinline__ void ph_hrows(Frame& F) {
    const int lane = lane_id(); const int gw = blockIdx.x * NWAVES + F.wave, NGW = F.G * NWAVES;
    const int rpw = (M + NGW - 1) / NGW, rbeg = gw * rpw, rend = (rbeg + rpw < M) ? rbeg + rpw : M;
    if (rbeg >= rend) return;
    f32x4 s1[4], sh1[4]; int cb = -1;
    f32x4 v[4], vn[4];
#define HR_LOAD(dst, m_) do { const f32x4* xr = (const f32x4*)(F.x + (size_t)(m_) * D) + lane; _Pragma("unroll") for (int j = 0; j < 4; ++j) dst[j] = xr[64 * j]; } while (0)
    HR_LOAD(v, rbeg);
    for (int m = rbeg; m < rend; ++m) {
        if ((m >> 12) != cb) { cb = m >> 12; const float* md = F.mod + cb * 6144;
#pragma unroll
            for (int j = 0; j < 4; ++j) { const int c = 256 * j + 4 * lane;
                const f32x4 g = *(const f32x4*)(F.norm_g + c), sc = *(const f32x4*)(md + 1024 + c);
                s1[j] = g * (sc + 1.f); sh1[j] = *(const f32x4*)(md + c); } }
        { const int mn = (m + 1 < rend) ? m + 1 : m; HR_LOAD(vn, mn); }
        float ss = 0.f;
#pragma unroll
        for (int j = 0; j < 4; ++j) ss += (v[j].x * v[j].x + v[j].y * v[j].y) + (v[j].z * v[j].z + v[j].w * v[j].w);
        const float rstd = rsqrtf(wave_sum_dpp(ss) * (1.f / D) + EPS);
        float am = 0.f;
#pragma unroll
        for (int j = 0; j < 4; ++j) { const f32x4 hv = (v[j] * rstd) * s1[j] + sh1[j]; v[j] = hv;
            am = fmaxf(am, fmaxf(fmaxf(fabsf(hv.x), fabsf(hv.y)), fmaxf(fabsf(hv.z), fabsf(hv.w)))); }
        am = wave_max_dpp(am);
        const float s8 = am > 0.f ? 127.f / am : 1.f;
        unsigned* h8 = (unsigned*)(F.HA8 + (size_t)m * D) + lane;
#pragma unroll
        for (int j = 0; j < 4; ++j) { const int q0 = (int)rintf(v[j].x * s8), q1 = (int)rintf(v[j].y * s8), q2 = (int)rintf(v[j].z * s8), q3 = (int)rintf(v[j].w * s8);
            h8[64 * j] = (unsigned)((q0 & 255) | ((q1 & 255) << 8) | ((q2 & 255) << 16) | (q3 << 24)); }
        if (lane == 0) F.HAS[m] = 1.f / s8;
#pragma unroll
        for (int j = 0; j < 4; ++j) v[j] = vn[j];
    }
#undef HR_LOAD
}

__device__ __forceinline__ void ph_x1rows(Frame& F) {
    const int lane = lane_id(); const int gw = blockIdx.x * NWAVES + F.wave, NGW = F.G * NWAVES;
    const int rpw = (M + NGW - 1) / NGW, rbeg = gw * rpw, rend = (rbeg + rpw < M) ? rbeg + rpw : M;
    if (rbeg >= rend) return;
    f32x4 gg1[4], s2[4], sh2[4]; int cb = -1;
    f32x4 xv[4], xn[4]; v2u yw[4], yn[4];
#define XR_LOAD(dx, dy, m_) do { const f32x4* xr = (const f32x4*)(F.x + (size_t)(m_) * D) + lane; const v2u* yr = (const v2u*)(F.Y + (size_t)(m_) * D) + lane; \
        _Pragma("unroll") for (int j = 0; j < 4; ++j) { dx[j] = xr[64 * j]; dy[j] = yr[64 * j]; } } while (0)
    XR_LOAD(xv, yw, rbeg);
    for (int m = rbeg; m < rend; ++m) {
        if ((m >> 12) != cb) { cb = m >> 12; const float* md = F.mod + cb * 6144;
#pragma unroll
            for (int j = 0; j < 4; ++j) { const int c = 256 * j + 4 * lane;
                const f32x4 g1 = *(const f32x4*)(F.norm_g + 1024 + c), gt = *(const f32x4*)(md + 2048 + c);
                const f32x4 g2 = *(const f32x4*)(F.norm_g + 2048 + c), sc = *(const f32x4*)(md + 4096 + c);
                gg1[j] = gt * g1; s2[j] = g2 * (sc + 1.f); sh2[j] = *(const f32x4*)(md + 3072 + c); } }
        { const int mn = (m + 1 < rend) ? m + 1 : m; XR_LOAD(xn, yn, mn); }
        f32x4 yv[4]; float ss = 0.f;
#pragma unroll
        for (int j = 0; j < 4; ++j) { const v2u w = yw[j]; yv[j] = (f32x4){bflo(w.x), bfhi(w.x), bflo(w.y), bfhi(w.y)};
            ss += (yv[j].x * yv[j].x + yv[j].y * yv[j].y) + (yv[j].z * yv[j].z + yv[j].w * yv[j].w); }
        const float rstd = rsqrtf(wave_sum_dpp(ss) * (1.f / D) + EPS);
        f32x4* orow = (f32x4*)(F.out + (size_t)m * D) + lane; float s1 = 0.f;
#pragma unroll
        for (int j = 0; j < 4; ++j) { xv[j] = xv[j] + (yv[j] * rstd) * gg1[j]; orow[64 * j] = xv[j];
            s1 += (xv[j].x * xv[j].x + xv[j].y * xv[j].y) + (xv[j].z * xv[j].z + xv[j].w * xv[j].w); }
        const float r1 = rsqrtf(wave_sum_dpp(s1) * (1.f / D) + EPS);
        float am = 0.f;
#pragma unroll
        for (int j = 0; j < 4; ++j) { const f32x4 hv = (xv[j] * r1) * s2[j] + sh2[j]; xv[j] = hv;
            am = fmaxf(am, fmaxf(fmaxf(fabsf(hv.x), fabsf(hv.y)), fmaxf(fabsf(hv.z), fabsf(hv.w)))); }
        am = wave_max_dpp(am);
        const float s8 = am > 0.f ? 127.f / am : 1.f;
        unsigned* h8 = (unsigned*)(F.H8 + (size_t)m * D) + lane;
#pragma unroll
        for (int j = 0; j < 4; ++j) { const int q0 = (int)rintf(xv[j].x * s8), q1 = (int)rintf(xv[j].y * s8), q2 = (int)rintf(xv[j].z * s8), q3 = (int)rintf(xv[j].w * s8);
            h8[64 * j] = (unsigned)((q0 & 255) | ((q1 & 255) << 8) | ((q2 & 255) << 16) | (q3 << 24)); }
        if (lane == 0) F.HS[m] = 1.f / s8;
#pragma unroll
        for (int j = 0; j < 4; ++j) { xv[j] = xn[j]; yw[j] = yn[j]; }
    }
#undef XR_LOAD
}

namespace att {
typedef float f32x16 __attribute__((ext_vector_type(16)));
typedef short s16x4 __attribute__((ext_vector_type(4)));
typedef short v4i16_t __attribute__((ext_vector_type(4)));
constexpr int QB = 256, KVB = 64;
constexpr int NS = 4;
constexpr int BTO = 288, BTN = 416;
constexpr int L_V = 0, L_K = NS * 16384, L_WS = L_K + NS * 8192, L_BT = L_WS + 2048, L_END = L_BT + 2048;
constexpr float C2 = 0.125f * 1.4426950408889634f;
__device__ __forceinline__ int v_st(int k, int c) { const int kk = (k & ~0xC) | ((k & 4) << 1) | ((k & 8) >> 1); return ((kk >> 3) * 4 + (c >> 5)) * 512 + ((kk & 7) * 32 + (c & 31)) * 2; }
__device__ __forceinline__ int v_rd_base(int lane) { return ((lane & 3) << 3) | (((lane >> 2) & 3) << 6) | (((lane >> 4) & 1) << 5) | (((lane >> 5) & 1) << 8); }
__device__ __forceinline__ unsigned v_src(int p) { const int sub = p >> 5, q = p & 31, kk = (sub >> 2) * 8 + (q >> 2), c = (sub & 3) * 32 + (q & 3) * 8;
    const int k = kk; return (unsigned)(k * INC + c) * 2u; }
__device__ __forceinline__ int crow(int r, int hi) { return (r & 3) + 8 * (r >> 2) + 4 * hi; }
typedef float f32x2_t __attribute__((ext_vector_type(2))); typedef __bf16 bf16x2_t __attribute__((ext_vector_type(2)));
__device__ __forceinline__ unsigned cvtpk(float lo, float hi) { const f32x2_t v = {lo, hi}; const bf16x2_t b = __builtin_convertvector(v, bf16x2_t); return __builtin_bit_cast(unsigned, b); }

__device__ __forceinline__ void attn_unit(Frame& F, int b, int h, int qb, float lam) {
    int tid = F.wave * 64 + lane_id(); asm volatile("" : "+v"(tid));
    const int lane = tid & 63, wid = F.wave, r32 = lane & 31, hi = lane >> 5;
    LAS unsigned char* lds = F.lds;
    LAS float* wsf = (LAS float*)(lds + L_WS) + wid * 64;
    const LAS float* bt = (const LAS float*)(lds + L_BT);
    const int q0 = qb * QB, qlo = q0 + wid * 32, qpos = qlo + r32;
    const size_t rowb = (size_t)b * SEQ;
    const int NT = (q0 + QB) / KVB;
    const unsigned kdoff = (unsigned)((tid >> 3) * INC + (((tid & 7) ^ ((tid >> 3) & 7)) * 8)) * 2u;
    const unsigned vdoff0 = v_src(tid), vdoff1 = v_src(tid + 512);
    const unsigned qoff = (unsigned)(r32 * INC + hi * 8) * 2u;
#define GLDS16(g_, lb_) do { unsigned sv_; asm volatile("s_mov_b32 %0, m0\n\ts_mov_b32 m0, %2\n\ts_nop 0\n\tglobal_load_lds_dwordx4 %1, off\n\ts_mov_b32 m0, %0" : "=&s"(sv_) : "v"(g_), "s"(lb_) : "memory"); } while (0)
#define DMA_K(t_, buf_) do { unsigned kd_ = kdoff; asm volatile("" : "+v"(kd_)); GLDS16(Kb + (size_t)(t_) * (KVB * INC * 2) + kd_, (unsigned)__builtin_amdgcn_readfirstlane((int)(uintptr_t)(lds + L_K + (buf_) * 8192 + wid * 1024))); } while (0)
#define DMA_V(t_, buf_) do { unsigned v0_ = vdoff0, v1_ = vdoff1; asm volatile("" : "+v"(v0_), "+v"(v1_)); const unsigned lb_ = (unsigned)__builtin_amdgcn_readfirstlane((int)(uintptr_t)(lds + L_V + (buf_) * 16384 + wid * 1024)); \
        GLDS16(Vb + (size_t)(t_) * (KVB * INC * 2) + v0_, lb_); GLDS16(Vb + (size_t)(t_) * (KVB * INC * 2) + v1_, lb_ + 8192u); } while (0)
#define DMA_TILE(t_) do { const int sl_ = (t_) & (NS - 1); DMA_K(t_, sl_); DMA_V(t_, sl_); } while (0)
#define ABAR() do { asm volatile("s_waitcnt lgkmcnt(0)" ::: "memory"); __builtin_amdgcn_s_barrier(); asm volatile("" ::: "memory"); } while (0)
    const int vbase = (int)(uintptr_t)(lds + L_V) + v_rd_base(lane);
    const int kroff = r32 * 128, kx = (r32 & 7) << 4;
#pragma unroll
    for (int c = 0; c < 2; ++c) {
        const char* Kb = (const char*)(F.Z + rowb * INC + 1536 + h * 128 + c * 64);
        const char* Vb = (const char*)(F.Z + rowb * INC + 2048 + h * 128);
        const char* Qb = (const char*)(F.Z + (rowb + qlo) * INC + 1024 + h * 128 + c * 64);
        bf16x8 qr[4];
#pragma unroll
        for (int d0 = 0; d0 < 4; ++d0) qr[d0] = *(const bf16x8*)(Qb + d0 * 32 + qoff);
        DMA_K(0, 0); DMA_V(0, 0); DMA_K(1, 1); DMA_K(2, 2); DMA_V(1, 1); DMA_K(3, 3); DMA_V(2, 2);
        asm volatile("s_waitcnt vmcnt(9)" ::: "memory");
        ABAR();
        float mhat, l = 0.f; bool resc = false;
        f32x16 o[4];
#pragma unroll
        for (int d0 = 0; d0 < 4; ++d0) o[d0] = f32x16{};
        f32x16 pA0, pA1, pB0, pB1; bf16x8 kf[4]; s16x4 vlo[4], vhi[4]; v4u pw0, pw1, pw2, pw3;
        f32x16 negm; { float z_ = 0.f; asm volatile("" : "+v"(z_));
#pragma unroll
          for (int r = 0; r < 16; ++r) negm[r] = z_; }
        asm volatile("" : "+v"(negm));
#define SBAR() __builtin_amdgcn_sched_barrier(0)
#define PIN(x) asm volatile("" : "+v"(x))
#define MFMA32(a_, b_, c_) __builtin_amdgcn_mfma_f32_32x32x16_bf16(a_, b_, c_, 0, 0, 0)
#define KLD2(su, d0) do { const LAS unsigned char* a_ = lds + L_K + (su) * 8192 + kroff + (((d0) * 32 + hi * 16) ^ kx); kf[2 * ((d0) & 1)] = *(const LAS bf16x8*)a_; kf[2 * ((d0) & 1) + 1] = *(const LAS bf16x8*)(a_ + 4096); } while (0)
#define VTR(p_) __builtin_bit_cast(s16x4, __builtin_amdgcn_ds_read_tr16_b64_v4i16((LAS v4i16_t*)(p_)))
#define VRD(i) do { const LAS unsigned char* p_ = vp_ + ((i) >> 2) * 512 + ((i) & 3) * 4096; vlo[(i) & 3] = VTR(p_); vhi[(i) & 3] = VTR(p_ + 2048); } while (0)
#define VFR(i) (bf16x8){vlo[(i) & 3][0], vlo[(i) & 3][1], vlo[(i) & 3][2], vlo[(i) & 3][3], vhi[(i) & 3][0], vhi[(i) & 3][1], vhi[(i) & 3][2], vhi[(i) & 3][3]}
#define PAF(k) __builtin_bit_cast(bf16x8, pw##k)
#define MX3(a_, b_, c_) fmaxf(fmaxf((a_), (b_)), (c_))
#define ROWMAX(P0, P1, OUT) do { float a_ = MX3(P0[0], P0[1], P1[0]), b_ = MX3(P0[2], P0[3], P1[1]); a_ = MX3(a_, P1[2], P1[3]); \
        _Pragma("unroll") for (int r = 4; r < 16; r += 4) { a_ = MX3(a_, P0[r], P0[r + 1]); b_ = MX3(b_, P0[r + 2], P0[r + 3]); a_ = MX3(a_, P1[r], P1[r + 1]); b_ = MX3(b_, P1[r + 2], P1[r + 3]); } \
        float m_ = fmaxf(a_, b_); auto rr_ = __builtin_amdgcn_permlane32_swap(__float_as_uint(m_), __float_as_uint(m_), false, false); OUT = fmaxf(__uint_as_float(rr_[0]), __uint_as_float(rr_[1])); } while (0)
#define FIX_TILE(N0, N1, u) do { if (qlo - (u) * KVB - 63 < 113) { int qp_ = qpos - 4 * hi; asm volatile("" : "+v"(qp_)); const int dq_ = qp_ - (u) * KVB + BTO;     \
        _Pragma("unroll") for (int r = 0; r < 16; ++r) { const int i0_ = dq_ - ((r & 3) + 8 * (r >> 2)), i1_ = i0_ - 32; \
            N0[r] += bt[i0_ > BTN - 1 ? BTN - 1 : i0_]; N1[r] += bt[i1_ > BTN - 1 ? BTN - 1 : (i1_ < 0 ? 0 : i1_)]; } } } while (0)
#define EX(v) __builtin_amdgcn_exp2f(v)
#define RESC() do { if (resc) { _Pragma("unroll") for (int r = 0; r < 16; ++r) { const float a_ = wsf[crow(r, hi)]; _Pragma("unroll") for (int d0 = 0; d0 < 4; ++d0) o[d0][r] *= a_; } } } while (0)
#define PKH0(P, B_, PW) do { PW.x = cvtpk(P[B_ + 0], P[B_ + 1]); PW.y = cvtpk(P[B_ + 2], P[B_ + 3]); } while (0)
#define PKH1(P, B_, PW) do { PW.z = cvtpk(P[B_ + 4], P[B_ + 5]); PW.w = cvtpk(P[B_ + 6], P[B_ + 7]); } while (0)
#define GAPA(MF, a0, a1, a2, a3, PK, PW) do { MF; sacc += a0; sacc += a1; sacc += a2; sacc += a3; PK; PIN(PW); PIN(sacc); SBAR(); } while (0)
#define GAPB(MF, X, i) do { MF; X[i] = EX(X[i]); X[i + 1] = EX(X[i + 1]); PIN(X); SBAR(); } while (0)
        KLD2(0, 0); KLD2(0, 1);
        pA0 = MFMA32(kf[0], qr[0], negm); pA1 = MFMA32(kf[1], qr[0], negm); pA0 = MFMA32(kf[2], qr[1], pA0); pA1 = MFMA32(kf[3], qr[1], pA1);
        KLD2(0, 2); KLD2(0, 3);
        pA0 = MFMA32(kf[0], qr[2], pA0); pA1 = MFMA32(kf[1], qr[2], pA1); pA0 = MFMA32(kf[2], qr[3], pA0); pA1 = MFMA32(kf[3], qr[3], pA1);
        FIX_TILE(pA0, pA1, 0);
        { float rm; ROWMAX(pA0, pA1, rm); mhat = rm;
#pragma unroll
          for (int r = 0; r < 16; ++r) negm[r] = -mhat;
          asm volatile("" : "+v"(negm));
#pragma unroll
          for (int r = 0; r < 16; ++r) { pA0[r] = EX(pA0[r] - rm); pA1[r] = EX(pA1[r] - rm); } }
        asm volatile("s_waitcnt vmcnt(5)" ::: "memory");
        ABAR();
        KLD2(1, 0); KLD2(1, 1);
#define STEP(C0, C1, P0, P1, t) do { SBAR(); \
        if ((t) + 3 < NT) DMA_K((t) + 3, ((t) + 3) & (NS - 1)); if ((t) + 2 < NT) DMA_V((t) + 2, ((t) + 2) & (NS - 1)); \
        const LAS unsigned char* vp_ = (const LAS unsigned char*)(uintptr_t)(vbase + (((t) - 1) & (NS - 1)) * 16384); \
        const int ksl_ = ((t) + 1) & (NS - 1); const bool gl_ = (t) + 1 < NT; \
        float sacc = 0.f; \
                        GAPA(C0 = MFMA32(kf[0], qr[0], negm), P0[0], P0[1], P0[2], P0[3],     PKH0(P0, 0, pw0), pw0); \
                        GAPA(C1 = MFMA32(kf[1], qr[0], negm), P0[4], P0[5], P0[6], P0[7],     PKH1(P0, 0, pw0), pw0); KLD2((t) & (NS - 1), 2); SBAR();     \
                        GAPA(C0 = MFMA32(kf[2], qr[1], C0),   P0[8], P0[9], P0[10], P0[11],   PKH0(P0, 8, pw1), pw1); \
                        GAPA(C1 = MFMA32(kf[3], qr[1], C1),   P0[12], P0[13], P0[14], P0[15], PKH1(P0, 8, pw1), pw1); KLD2((t) & (NS - 1), 3); SBAR(); \
        VRD(0); SBAR(); GAPA(C0 = MFMA32(kf[0], qr[2], C0),   P1[0], P1[1], P1[2], P1[3],     PKH0(P1, 0, pw2), pw2); \
        VRD(1); SBAR(); GAPA(C1 = MFMA32(kf[1], qr[2], C1),   P1[4], P1[5], P1[6], P1[7],     PKH1(P1, 0, pw2), pw2); \
        VRD(2); SBAR(); GAPA(C0 = MFMA32(kf[2], qr[3], C0),   P1[8], P1[9], P1[10], P1[11],   PKH0(P1, 8, pw3), pw3); \
        VRD(3); SBAR(); GAPA(C1 = MFMA32(kf[3], qr[3], C1),   P1[12], P1[13], P1[14], P1[15], PKH1(P1, 8, pw3), pw3); \
        l += sacc; \
        FIX_TILE(C0, C1, t); \
        { float rm_; ROWMAX(C0, C1, rm_); resc = false;                                                    \
          if (__builtin_expect(__any(rm_ > 8.0f), 0)) { const float dl_ = fmaxf(rm_, 0.f); mhat += dl_;     \
              _Pragma("unroll") for (int r = 0; r < 16; ++r) { C0[r] -= dl_; C1[r] -= dl_; } \
              _Pragma("unroll") for (int r = 0; r < 16; ++r) negm[r] = -mhat; \
              asm volatile("" : "+v"(negm)); \
              const float f_ = __builtin_amdgcn_exp2f(-dl_); l *= f_; if (hi == 0) wsf[r32] = f_; resc = true; } } \
        SBAR(); \
        GAPB(o[0] = MFMA32(PAF(0), VFR(0), o[0]), C0, 0);   VRD(4);  SBAR(); \
        GAPB(o[0] = MFMA32(PAF(1), VFR(1), o[0]), C0, 2);   VRD(5);  SBAR(); \
        GAPB(o[0] = MFMA32(PAF(2), VFR(2), o[0]), C0, 4);   VRD(6);  SBAR(); \
        GAPB(o[0] = MFMA32(PAF(3), VFR(3), o[0]), C0, 6);   VRD(7);  SBAR(); \
        GAPB(o[1] = MFMA32(PAF(0), VFR(4), o[1]), C0, 8);   VRD(8);  SBAR(); \
        GAPB(o[1] = MFMA32(PAF(1), VFR(5), o[1]), C0, 10);  VRD(9);  SBAR(); \
        GAPB(o[1] = MFMA32(PAF(2), VFR(6), o[1]), C0, 12);  VRD(10); SBAR(); \
        GAPB(o[1] = MFMA32(PAF(3), VFR(7), o[1]), C0, 14);  VRD(11); SBAR(); \
        GAPB(o[2] = MFMA32(PAF(0), VFR(8), o[2]), C1, 0);   VRD(12); SBAR(); \
        GAPB(o[2] = MFMA32(PAF(1), VFR(9), o[2]), C1, 2);   VRD(13); SBAR(); \
        GAPB(o[2] = MFMA32(PAF(2), VFR(10), o[2]), C1, 4);  VRD(14); SBAR(); \
        GAPB(o[2] = MFMA32(PAF(3), VFR(11), o[2]), C1, 6);  VRD(15); SBAR(); \
        GAPB(o[3] = MFMA32(PAF(0), VFR(12), o[3]), C1, 8);  if (gl_) { KLD2(ksl_, 0); SBAR(); } \
        GAPB(o[3] = MFMA32(PAF(1), VFR(13), o[3]), C1, 10); if (gl_) { KLD2(ksl_, 1); SBAR(); } \
        GAPB(o[3] = MFMA32(PAF(2), VFR(14), o[3]), C1, 12); \
        GAPB(o[3] = MFMA32(PAF(3), VFR(15), o[3]), C1, 14); \
        if ((t) + 3 < NT) asm volatile("s_waitcnt vmcnt(5)" ::: "memory"); else asm volatile("s_waitcnt vmcnt(0)" ::: "memory"); \
        ABAR(); RESC(); } while (0)
        if (wid >= 4) __builtin_amdgcn_s_setprio(1);
        {
            int t = 1;
            for (; t + 1 < NT; t += 2) {
                STEP(pB0, pB1, pA0, pA1, t);
                STEP(pA0, pA1, pB0, pB1, t + 1);
            }
            STEP(pB0, pB1, pA0, pA1, NT - 1);
        }
        __builtin_amdgcn_s_setprio(0);
        { float sacc = 0.f;
#pragma unroll
          for (int r = 0; r < 16; ++r) sacc += pB0[r];
#pragma unroll
          for (int r = 0; r < 16; ++r) sacc += pB1[r];
          l += sacc;
          PKH0(pB0, 0, pw0); PKH1(pB0, 0, pw0); PKH0(pB0, 8, pw1); PKH1(pB0, 8, pw1); PKH0(pB1, 0, pw2); PKH1(pB1, 0, pw2); PKH0(pB1, 8, pw3); PKH1(pB1, 8, pw3);
          const LAS unsigned char* vp_ = (const LAS unsigned char*)(uintptr_t)(vbase + ((NT - 1) & (NS - 1)) * 16384);
#pragma unroll
          for (int db = 0; db < 4; ++db) { VRD(0); VRD(1); VRD(2); VRD(3);
              o[db] = MFMA32(PAF(0), VFR(0), o[db]); o[db] = MFMA32(PAF(1), VFR(1), o[db]); o[db] = MFMA32(PAF(2), VFR(2), o[db]); o[db] = MFMA32(PAF(3), VFR(3), o[db]); vp_ += 512; } }
        { auto rr_ = __builtin_amdgcn_permlane32_swap(__float_as_uint(l), __float_as_uint(l), false, false); l = __uint_as_float(rr_[0]) + __uint_as_float(rr_[1]); }
#undef SBAR
#undef PIN
#undef MFMA32
#undef KLD2
#undef VTR
#undef VRD
#undef VFR
#undef PAF
#undef MX3
#undef ROWMAX
#undef FIX_TILE
#undef EX
#undef RESC
#undef PKH0
#undef PKH1
#undef GAPA
#undef GAPB
#undef STEP
        int lane_e = lane_id(); asm volatile("" : "+v"(lane_e));
        const int r32e = lane_e & 31, hie = lane_e >> 5;
        const unsigned o0off = (unsigned)((blockIdx.x * NTHR + wid * 64 + lane_e) * 128);
        if (hie == 0) wsf[32 + r32e] = l;
        float rl[16];
#pragma unroll
        for (int r = 0; r < 16; ++r) rl[r] = __builtin_amdgcn_rcpf(wsf[32 + crow(r, hie)]);
        if (c == 0) {
#pragma unroll
            for (int d0 = 0; d0 < 4; ++d0)
#pragma unroll
                for (int j = 0; j < 2; ++j) { v4u w;
                    w.x = cvtpk(o[d0][8 * j + 0] * rl[8 * j + 0], o[d0][8 * j + 1] * rl[8 * j + 1]); w.y = cvtpk(o[d0][8 * j + 2] * rl[8 * j + 2], o[d0][8 * j + 3] * rl[8 * j + 3]);
                    w.z = cvtpk(o[d0][8 * j + 4] * rl[8 * j + 4], o[d0][8 * j + 5] * rl[8 * j + 5]); w.w = cvtpk(o[d0][8 * j + 6] * rl[8 * j + 6], o[d0][8 * j + 7] * rl[8 * j + 7]);
                    *(v4u*)((char*)F.STASH + o0off + (d0 * 2 + j) * 16) = w; }
        } else {
            float ss[16];
#pragma unroll
            for (int r = 0; r < 16; ++r) ss[r] = 0.f;
#pragma unroll
            for (int d0 = 0; d0 < 4; ++d0)
#pragma unroll
                for (int j = 0; j < 2; ++j) { const v4u w = *(const v4u*)((const char*)F.STASH + o0off + (d0 * 2 + j) * 16); const unsigned ww[4] = {w.x, w.y, w.z, w.w};
#pragma unroll
                    for (int k = 0; k < 4; ++k) { const int i = 4 * j + k;
                        const float a0 = bflo(ww[k]) - lam * (o[d0][2 * i] * rl[2 * i]), a1 = bfhi(ww[k]) - lam * (o[d0][2 * i + 1] * rl[2 * i + 1]);
                        o[d0][2 * i] = a0; o[d0][2 * i + 1] = a1; ss[2 * i] += a0 * a0; ss[2 * i + 1] += a1 * a1; } }
#pragma unroll
            for (int r = 0; r < 16; ++r) {
                { DPP_SUM_ROW(ss[r]); ss[r] += __shfl_xor(ss[r], 16); }
                ss[r] = rsqrtf(ss[r] * (1.f / 128.f) + EPS) * 0.8f;
            }
            bf16* Cw = F.CAT + (rowb + qlo) * 1024 + 512 + h * 128;
#pragma unroll
            for (int d0 = 0; d0 < 4; ++d0) { const float g = F.subln_g[d0 * 32 + r32e];
                unsigned off = (unsigned)((4 * hie * 1024 + d0 * 32 + r32e) * 2);
#pragma unroll
                for (int r = 0; r < 16; ++r) { const float v = o[d0][r] * ss[r] * g; const float vn = dpp_xor1(v);
                    if ((r32e & 1) == 0) *(unsigned*)((char*)Cw + off) = cvtpk(v, vn);
                    off += ((r & 3) == 3) ? 5u * 2048u : 2048u; asm volatile("" : "+v"(off)); } }
        }
        __syncthreads();
    }
#undef DMA_K
#undef DMA_V
#undef DMA_TILE
#undef ABAR
}

__device__ __forceinline__ void attn_phase(Frame& F) {
    const int lane = lane_id(), tid = F.wave * 64 + lane;
    const float s01 = wave_sum(F.diff_lambda[lane] * F.diff_lambda[64 + lane]), s23 = wave_sum(F.diff_lambda[128 + lane] * F.diff_lambda[192 + lane]);
    const float lam = __expf(s01) - __expf(s23) + 0.2f;
    const int G = F.G;
    for (int it = ((G % 8 == 0) ? ((int)(blockIdx.x % 8) * (G / 8) + (int)blockIdx.x / 8) : (int)blockIdx.x); it < 256; it += G) {
        const int bh = it >> 3, x = it & 7, b = bh >> 2, h = bh & 3;
        LAS float* bt = (LAS float*)(F.lds + L_BT);
        __syncthreads();
        if (tid < BTN) { const int d = tid - BTO; int bk = d; if (d >= 16) { bk = 16 + (int)(__log2f((float)d * (1.f / 16.f)) * (16.f / 3.f)); bk = bk > 31 ? 31 : bk; }
            bt[tid] = d < 0 ? -__builtin_inff() : (F.rel_bias[bk * 4 + h] - F.rel_bias[31 * 4 + h]) * 1.4426950408889634f; }
        __syncthreads();
        attn_unit(F, b, h, x, lam);
        attn_unit(F, b, h, 15 - x, lam);
    }
}
}

namespace sgu {
typedef float f32x16 __attribute__((ext_vector_type(16)));
typedef short s16x4 __attribute__((ext_vector_type(4)));
constexpr int L_T = 0, L_ST = 65536;
__device__ __forceinline__ void sgu_chunk(Frame& F, int chunk) {
    int tid = F.wave * 64 + lane_id(); asm volatile("" : "+v"(tid));
    const int lane = tid & 63, g = F.wave, r32 = lane & 31, hi = lane >> 5;
    LAS unsigned char* lds = F.lds;
    LAS float* st = (LAS float*)(lds + L_ST);
    const size_t t0 = (size_t)chunk * 128;
    for (int i = 0; i < 16; i += 2) {
        v4u raw[2];
#pragma unroll
        for (int u = 0; u < 2; ++u) raw[u] = *(const v4u*)(F.Z + (t0 + g * 16 + i + u) * INC + 512 + lane * 8);
#pragma unroll
        for (int u = 0; u < 2; ++u) { const int tl = g * 16 + i + u;
            float f[8] = {bflo(raw[u].x), bfhi(raw[u].x), bflo(raw[u].y), bfhi(raw[u].y), bflo(raw[u].z), bfhi(raw[u].z), bflo(raw[u].w), bfhi(raw[u].w)};
            float s = 0.f;
#pragma unroll
            for (int e = 0; e < 8; ++e) s += f[e];
            const float mean = wave_sum_dpp(s) * (1.f / 512.f); float q = 0.f;
#pragma unroll
            for (int e = 0; e < 8; ++e) { f[e] -= mean; q += f[e] * f[e]; }
            const float rstd = rsqrtf(wave_sum_dpp(q) * (1.f / 512.f) + EPS);
            if (lane == 0) { st[2 * tl] = mean; st[2 * tl + 1] = rstd; } }
    }
    __syncthreads();
    f32x16 acc[2][2];
    const int sr = tid >> 4, sc = (tid & 15) * 8;
    const int vb0 = (int)(uintptr_t)(lds + L_T) + (g >> 1) * 16384 + att::v_rd_base(lane);
#define SGU_STAGE(sh) do { _Pragma("unroll") for (int tile = 0; tile < 4; ++tile) { const int ch = tile * 128 + sc; \
            const f32x4 g0 = *(const f32x4*)(F.sgu_ln_g + ch), g1 = *(const f32x4*)(F.sgu_ln_g + ch + 4), b0 = *(const f32x4*)(F.sgu_ln_b + ch), b1 = *(const f32x4*)(F.sgu_ln_b + ch + 4); \
            _Pragma("unroll") for (int rr = 0; rr < 2; ++rr) { const int s = (sh) * 64 + sr + 32 * rr; \
                const v4u raw = *(const v4u*)(F.Z + (t0 + s) * INC + 512 + ch); const float mean = st[2 * s], rstd = st[2 * s + 1]; v4u o; \
                o.x = pk2((bflo(raw.x) - mean) * rstd * g0.x + b0.x, (bfhi(raw.x) - mean) * rstd * g0.y + b0.y); \
                o.y = pk2((bflo(raw.y) - mean) * rstd * g0.z + b0.z, (bfhi(raw.y) - mean) * rstd * g0.w + b0.w); \
                o.z = pk2((bflo(raw.z) - mean) * rstd * g1.x + b1.x, (bfhi(raw.z) - mean) * rstd * g1.y + b1.y); \
                o.w = pk2((bflo(raw.w) - mean) * rstd * g1.z + b1.z, (bfhi(raw.w) - mean) * rstd * g1.w + b1.w); \
                *(LAS v4u*)(lds + L_T + tile * 16384 + att::v_st(sr + 32 * rr, sc)) = o; } } } while (0)
#define TRRD(dst, off) asm volatile("ds_read_b64_tr_b16 %0, %1 offset:%2" : "=&v"(dst) : "v"(vb0), "i"(off) : "memory")
#define SGU_MMA(sh, tb0) do { _Pragma("unroll") for (int ks = 0; ks < 4; ++ks) { s16x4 l0, h0, l1, h1; \
            if ((g & 1) == 0) { TRRD(l0, 0 * 512 + ks * 4096); TRRD(h0, 0 * 512 + ks * 4096 + 2048); TRRD(l1, 1 * 512 + ks * 4096); TRRD(h1, 1 * 512 + ks * 4096 + 2048); } \
            else              { TRRD(l0, 2 * 512 + ks * 4096); TRRD(h0, 2 * 512 + ks * 4096 + 2048); TRRD(l1, 3 * 512 + ks * 4096); TRRD(h1, 3 * 512 + ks * 4096 + 2048); } \
            asm volatile("s_waitcnt lgkmcnt(0)" ::: "memory"); __builtin_amdgcn_sched_barrier(0); \
            const bf16x8 B0 = (bf16x8){l0[0], l0[1], l0[2], l0[3], h0[0], h0[1], h0[2], h0[3]}, B1 = (bf16x8){l1[0], l1[1], l1[2], l1[3], h1[0], h1[1], h1[2], h1[3]}; \
            _Pragma("unroll") for (int tl = 0; tl < 2; ++tl) { const int tb = (tb0) + tl; if ((sh) * 64 + 16 * ks > tb * 32 + 31) continue; \
                const bf16x8 A = *(const bf16x8*)(F.SGW + ((size_t)(g * 128 + tb * 32 + r32)) * 128 + (sh) * 64 + 16 * ks + 8 * hi); \
                acc[tl][0] = __builtin_amdgcn_mfma_f32_32x32x16_bf16(A, B0, acc[tl][0], 0, 0, 0); \
                acc[tl][1] = __builtin_amdgcn_mfma_f32_32x32x16_bf16(A, B1, acc[tl][1], 0, 0, 0); } } } while (0)
#define SGU_EPI(tb0) do { _Pragma("unroll") for (int tl = 0; tl < 2; ++tl) _Pragma("unroll") for (int r = 0; r < 16; ++r) { \
            const int t = ((tb0) + tl) * 32 + att::crow(r, hi); const float bs = F.sgu_b[g * 128 + t]; \
            _Pragma("unroll") for (int db = 0; db < 2; ++db) { const int ch = g * 64 + db * 32 + r32; \
                const float u = bf2f(F.Z[(t0 + t) * INC + ch]); const float v = u * (acc[tl][db][r] + bs); const float vn = dpp_xor1(v); \
                if ((r32 & 1) == 0) *(unsigned*)(F.CAT + (t0 + t) * 1024 + ch) = att::cvtpk(v, vn); } } } while (0)
#define SGU_ZERO() do { acc[0][0] = f32x16{}; acc[0][1] = f32x16{}; acc[1][0] = f32x16{}; acc[1][1] = f32x16{}; } while (0)
    SGU_STAGE(0);
    __syncthreads();
    SGU_ZERO(); SGU_MMA(0, 0); SGU_EPI(0);
    SGU_ZERO(); SGU_MMA(0, 2);
    __syncthreads();
    SGU_STAGE(1);
    __syncthreads();
    SGU_MMA(1, 2); SGU_EPI(2);
#undef SGU_STAGE
#undef TRRD
#undef SGU_MMA
#undef SGU_EPI
#undef SGU_ZERO
}
__device__ __forceinline__ void sgu_phase(Frame& F) { for (int ck = blockIdx.x; ck < M / 128; ck += F.G) { sgu_chunk(F, ck); __syncthreads(); } }
}

namespace tk {
typedef float f32x16 __attribute__((ext_vector_type(16)));
__device__ __forceinline__ float vmax(float a, float b) { float r; asm("v_max_f32 %0, %1, %2" : "=v"(r) : "v"(a), "v"(b)); return r; }
__device__ __forceinline__ float vmin(float a, float b) { float r; asm("v_min_f32 %0, %1, %2" : "=v"(r) : "v"(a), "v"(b)); return r; }
#define TK_CE(a, b) do { const float _mx = vmax(a, b), _mn = vmin(a, b); a = _mx; b = _mn; } while (0)
template <int N> __device__ __forceinline__ void sort_desc(float (&a)[N]) {
#pragma unroll
    for (int k = 2; k <= N; k <<= 1)
#pragma unroll
        for (int j = k >> 1; j > 0; j >>= 1)
#pragma unroll
            for (int i = 0; i < N; ++i) { const int l = i ^ j; if (l > i) { if ((i & k) == 0) TK_CE(a[i], a[l]); else TK_CE(a[l], a[i]); } }
}
template <int N> __device__ __forceinline__ void merge_desc(float (&a)[N]) {
#pragma unroll
    for (int j = N >> 1; j > 0; j >>= 1)
#pragma unroll
        for (int i = 0; i < N; ++i) { const int l = i ^ j; if (l > i) TK_CE(a[i], a[l]); }
}
__device__ __forceinline__ void top16_merge(float (&a)[16], const float (&b)[16]) {
#pragma unroll
    for (int i = 0; i < 16; ++i) a[i] = vmax(a[i], b[15 - i]);
    merge_desc<16>(a);
}
__device__ __forceinline__ float embed(float v, unsigned mask, unsigned code) { return __uint_as_float((__float_as_uint(v) & mask) | code); }

__device__ __forceinline__ void topk_phase(Frame& F) {
    int lane = lane_id(); asm volatile("" : "+v"(lane));
    const int r32 = lane & 31, hi = lane >> 5;
    const int gw = blockIdx.x * NWAVES + F.wave, NGW = F.G * NWAVES;
    LAS unsigned* tab = (LAS unsigned*)(F.lds + F.wave * 8192) + lane;
    const float NEG = -__builtin_inff();
    constexpr int NTASK = (M / 32) * 8; const int per = (NTASK + NGW - 1) / NGW;
    unsigned code16[16];
#pragma unroll
    for (int r = 0; r < 16; ++r) code16[r] = (unsigned)((r & 3) + 8 * (r >> 2) + 4 * hi);
    const unsigned qoff = (unsigned)(r32 * NQ + hi * 8), koff = (unsigned)((hi * 128 + r32) * 8);
#define TK_QP(task_, c_) (F.QP + (size_t)((task_) >> 3) * 32 * NQ + ((task_) & 7) * 256 + (c_) * 128)
#define TK_KP(task_, c_) (F.KEYS + (size_t)((((task_) & 7) * 2 + (c_)) * 16) * 128 * 8)
#define TK_LDQ(dst, task_, c_) do { const bf16* qp_ = TK_QP(task_, c_); _Pragma("unroll") for (int ks = 0; ks < 8; ++ks) dst[ks] = *(const bf16x8*)(qp_ + ks * 16 + qoff); } while (0)
#define TK_LDK(dst, task_, c_, nb_) do { const bf16* kp_ = TK_KP(task_, c_); _Pragma("unroll") for (int ks = 0; ks < 8; ++ks) dst[ks] = *(const bf16x8*)(kp_ + ((2 * ks) * 128 + (nb_) * 32) * 8 + koff); } while (0)
    const int task_beg = gw * per, task_end = (gw * per + per < NTASK) ? gw * per + per : NTASK;
    bf16x8 qcur[8], kcur[8];
    if (task_beg < task_end) { TK_LDQ(qcur, task_beg, 0); TK_LDK(kcur, task_beg, 0, 0); }
    for (int task = task_beg; task < task_end; ++task) {
        const int tb = task >> 3, h = task & 7;
        const size_t trow = (size_t)tb * 32 + r32;
        float sk[2][16];
        float best[16];
#pragma unroll
        for (int st = 0; st < 8; ++st) {
            const int c = st >> 2, nb = st & 3;
            bf16x8 knxt[8], qnxt[8];
            if (st < 7) TK_LDK(knxt, task, (st + 1) >> 2, (st + 1) & 3);
            if (st == 3) TK_LDQ(qnxt, task, 1);
            f32x16 acc = f32x16{};
#pragma unroll
            for (int ks = 0; ks < 8; ++ks) acc = __builtin_amdgcn_mfma_f32_32x32x16_bf16(kcur[ks], qcur[ks], acc, 0, 0, 0);
            float cur[16];
#pragma unroll
            for (int r = 0; r < 16; ++r) { cur[r] = embed(acc[r], 0xFFFFFF80u, code16[r]); if (nb) cur[r] = __uint_as_float(__float_as_uint(cur[r]) | (unsigned)(nb * 32)); }
            sort_desc<16>(cur);
            if (nb == 0) {
#pragma unroll
                for (int i = 0; i < 16; ++i) best[i] = cur[i];
            } else top16_merge(best, cur);
            if (st < 7) {
#pragma unroll
                for (int ks = 0; ks < 8; ++ks) kcur[ks] = knxt[ks];
            }
            if (st == 3) {
#pragma unroll
                for (int ks = 0; ks < 8; ++ks) qcur[ks] = qnxt[ks];
            }
            if (nb == 3) {
                float pr[16];
#pragma unroll
                for (int i = 0; i < 16; ++i) { auto rr = __builtin_amdgcn_permlane32_swap(__float_as_uint(best[i]), __float_as_uint(best[i]), false, false);
                    pr[i] = __uint_as_float(hi ? rr[0] : rr[1]); }
                top16_merge(best, pr);
#pragma unroll
                for (int i = 0; i < 16; ++i) sk[c][i] = best[i];
            }
            __builtin_amdgcn_sched_barrier(0);
        }
        { const int tn = (task + 1 < task_end) ? task + 1 : task; TK_LDQ(qcur, tn, 0); TK_LDK(kcur, tn, 0, 0); }
#pragma unroll
        for (int i = 0; i < 16; ++i) { tab[i * 64] = __float_as_uint(sk[0][i]); tab[(16 + i) * 64] = __float_as_uint(sk[1][i]); }
        float T[16], G1[16], G2[16];
#pragma unroll
        for (int j = 0; j < 16; ++j) T[j] = embed(sk[0][0] + sk[1][j], 0xFFFFFF00u, (unsigned)j);
#pragma unroll
        for (int j = 0; j < 8; ++j) { G1[j] = embed(sk[0][1] + sk[1][j], 0xFFFFFF00u, (unsigned)(16 + j)); G1[8 + j] = embed(sk[0][15 - j] + sk[1][0], 0xFFFFFF00u, (unsigned)((15 - j) << 4)); }
        merge_desc<16>(G1);
        top16_merge(T, G1);
#pragma unroll
        for (int j = 0; j < 5; ++j) G2[j] = embed(sk[0][2] + sk[1][j], 0xFFFFFF00u, (unsigned)(32 + j));
#pragma unroll
        for (int j = 0; j < 4; ++j) G2[5 + j] = embed(sk[0][3] + sk[1][j], 0xFFFFFF00u, (unsigned)(48 + j));
#pragma unroll
        for (int j = 0; j < 3; ++j) G2[9 + j] = embed(sk[0][4] + sk[1][j], 0xFFFFFF00u, (unsigned)(64 + j));
#pragma unroll
        for (int j = 0; j < 2; ++j) { G2[12 + j] = embed(sk[0][5] + sk[1][j], 0xFFFFFF00u, (unsigned)(80 + j)); G2[14 + j] = embed(sk[0][6] + sk[1][j], 0xFFFFFF00u, (unsigned)(96 + j)); }
        sort_desc<16>(G2);
        top16_merge(T, G2);
        T[15] = vmax(T[15], embed(sk[0][7] + sk[1][0], 0xFFFFFF00u, 112u)); T[14] = vmax(T[14], embed(sk[0][7] + sk[1][1], 0xFFFFFF00u, 113u));
        merge_desc<16>(T);
        const float mx = __uint_as_float(__float_as_uint(T[0]) & 0xFFFFFF00u);
        float e[16]; float den = 0.f;
#pragma unroll
        for (int k = 0; k < 16; ++k) { e[k] = __builtin_amdgcn_exp2f((__uint_as_float(__float_as_uint(T[k]) & 0xFFFFFF00u) - mx) * 1.4426950408889634f); den += e[k]; }
        const float rden = 1.f / den;
        int eo[8]; float go[8];
#pragma unroll
        for (int k = 0; k < 8; ++k) {
            const unsigned code = __float_as_uint(hi ? T[k + 8] : T[k]) & 255u;
            const unsigned a1 = tab[(code >> 4) * 64] & 127u, a2 = tab[(16 + (code & 15u)) * 64] & 127u;
            eo[k] = (int)(a1 * 128u + a2); go[k] = (hi ? e[k + 8] : e[k]) * rden;
        }
        int* ip = F.IDX + trow * PKN + h * 16 + hi * 8; float* gp = F.GATE + trow * PKN + h * 16 + hi * 8;
        *(v4u*)ip = (v4u){(unsigned)eo[0], (unsigned)eo[1], (unsigned)eo[2], (unsigned)eo[3]}; *(v4u*)(ip + 4) = (v4u){(unsigned)eo[4], (unsigned)eo[5], (unsigned)eo[6], (unsigned)eo[7]};
        *(f32x4*)gp = (f32x4){go[0], go[1], go[2], go[3]}; *(f32x4*)(gp + 4) = (f32x4){go[4], go[5], go[6], go[7]};
    }
    (void)NEG;
}
#undef TK_CE
#undef TK_QP
#undef TK_KP
#undef TK_LDQ
#undef TK_LDK
}

namespace pe {
typedef float f32x2 __attribute__((ext_vector_type(2)));
__device__ __forceinline__ f32x2 cvlo(unsigned w) { return __builtin_amdgcn_cvt_pk_f32_fp8((int)w, false); }
__device__ __forceinline__ f32x2 cvhi(unsigned w) { return __builtin_amdgcn_cvt_pk_f32_fp8((int)w, true); }
__device__ __forceinline__ float dot16(const v4u r, const f32x2 (&hf)[8]) {
    f32x2 a = cvlo(r.x) * hf[0]; f32x2 b = cvhi(r.x) * hf[1];
    a = cvlo(r.y) * hf[2] + a; b = cvhi(r.y) * hf[3] + b; a = cvlo(r.z) * hf[4] + a; b = cvhi(r.z) * hf[5] + b; a = cvlo(r.w) * hf[6] + a; b = cvhi(r.w) * hf[7] + b;
    a = a + b; return a.x + a.y;
}
#define PE_W(WREG, i) __uint_as_float(__builtin_amdgcn_readlane(__float_as_uint(WREG), (i)))
#ifndef FP6_INTERLEAVED
#define FP6_INTERLEAVED 1
#endif
typedef unsigned v6u __attribute__((ext_vector_type(6)));
typedef float v32f __attribute__((ext_vector_type(32)));
typedef float v16f __attribute__((ext_vector_type(16)));
struct Row6 { v4u q4; v2u q2; };
#ifndef PV6_G
#define PV6_G 2
#endif
#define PV6_LOAD(dst, EREG, i) do { const int ea_ = __builtin_amdgcn_readlane(EREG, 2 * (i)), eb_ = __builtin_amdgcn_readlane(EREG, 2 * (i) + 1); \
        const unsigned char* rp_ = F.VT6 + (size_t)(half ? eb_ : ea_) * 768; dst.q4 = *(const v4u*)(rp_ + l16); dst.q2 = *(const v2u*)(rp_ + 512 + l8); } while (0)
#define PV6_ACC(src, WREG, i) do { const float wa_ = PE_W(WREG, 2 * (i)), wb_ = PE_W(WREG, 2 * (i) + 1); const float w_ = half ? wb_ : wa_; const f32x2 ww_ = {w_, w_}; \
        const v6u pk_ = {src.q4.x, src.q4.y, src.q4.z, src.q4.w, src.q2.x, src.q2.y}; const v32f d_ = __builtin_amdgcn_cvt_scalef32_pk32_f32_fp6(pk_, 1.0f); \
        _Pragma("unroll") for (int k = 0; k < 16; ++k) acc[k] = (f32x2){d_[2 * k], d_[2 * k + 1]} * ww_ + acc[k]; __builtin_amdgcn_sched_barrier(0); } while (0)
#define PV6_BATCH(EREG, WREG) do { Row6 bufA[PV6_G], bufB[PV6_G];             \
        _Pragma("unroll") for (int i = 0; i < PV6_G; ++i) PV6_LOAD(bufA[i], EREG, i); \
        _Pragma("unroll") for (int gq = 0; gq < 32 / PV6_G; gq += 2) { \
            _Pragma("unroll") for (int i = 0; i < PV6_G; ++i) PV6_LOAD(bufB[i], EREG, (gq + 1) * PV6_G + i); \
            _Pragma("unroll") for (int i = 0; i < PV6_G; ++i) PV6_ACC(bufA[i], WREG, gq * PV6_G + i); \
            if (gq + 2 < 32 / PV6_G) { _Pragma("unroll") for (int i = 0; i < PV6_G; ++i) PV6_LOAD(bufA[i], EREG, (gq + 2) * PV6_G + i); } \
            _Pragma("unroll") for (int i = 0; i < PV6_G; ++i) PV6_ACC(bufB[i], WREG, (gq + 1) * PV6_G + i); } } while (0)

#define PU_IDX(dst, tt) do { const v4u* ip_ = (const v4u*)(F.IDX + (size_t)(tt) * PKN + (lane >> 3) * 16); _Pragma("unroll") for (int q_ = 0; q_ < 4; ++q_) { const v4u w_ = ip_[q_]; dst[4 * q_] = (int)w_.x; dst[4 * q_ + 1] = (int)w_.y; dst[4 * q_ + 2] = (int)w_.z; dst[4 * q_ + 3] = (int)w_.w; } } while (0)
#define PU_GATHER(dst, idx) do { _Pragma("unroll") for (int i = 0; i < 16; ++i) dst[i] = *(const v4u*)(ub + (unsigned)idx[i] * 128u + coff); } while (0)
#define PU_HS(dst, tt) do { dst[0] = *(const v4u*)(F.H8 + (size_t)(tt) * D + x * 128 + (lane & 7) * 16); } while (0)
#define PU_COMPUTE(seg, hraw, tt) do { int p[16]; \
        _Pragma("unroll") for (int i = 0; i < 16; ++i) { int a_ = __builtin_amdgcn_sdot4((int)seg[i].x, (int)hraw[0].x, 0, false); a_ = __builtin_amdgcn_sdot4((int)seg[i].y, (int)hraw[0].y, a_, false); \
            a_ = __builtin_amdgcn_sdot4((int)seg[i].z, (int)hraw[0].z, a_, false); p[i] = __builtin_amdgcn_sdot4((int)seg[i].w, (int)hraw[0].w, a_, false); }     \
          \
        _Pragma("unroll") for (int i = 0; i < 8; ++i) { const bool bt = (lane & 4) != 0; const int sd = bt ? p[i] : p[i + 8], kp = bt ? p[i + 8] : p[i]; p[i] = kp + __builtin_amdgcn_update_dpp(0, sd, 0x141, 0xF, 0xF, false); } \
        _Pragma("unroll") for (int i = 0; i < 4; ++i) { const bool bt = (lane & 2) != 0; const int sd = bt ? p[i] : p[i + 4], kp = bt ? p[i + 4] : p[i]; p[i] = kp + __builtin_amdgcn_update_dpp(0, sd, 0x4E, 0xF, 0xF, false); } \
        _Pragma("unroll") for (int i = 0; i < 2; ++i) { const bool bt = (lane & 1) != 0; const int sd = bt ? p[i] : p[i + 2], kp = bt ? p[i + 2] : p[i]; p[i] = kp + __builtin_amdgcn_update_dpp(0, sd, 0xB1, 0xF, 0xF, false); } \
        ((unsigned*)F.PART)[((size_t)x * M + (tt)) * 64 + lane] = att::cvtpk((float)p[0], (float)p[1]); } while (0)
__device__ __forceinline__ void peer_u_phase(Frame& F, const int c0, const int cn, const int w0, const int nw) {
    int lane = lane_id(); asm volatile("" : "+v"(lane));
    const int wave = F.wave;
    if (wave < w0 || wave >= w0 + nw) return;
    const unsigned coff = (unsigned)(lane & 7) * 16u;
    const int per_blk = cn / 32, per_wave = per_blk / nw;
    for (int unit = blockIdx.x; unit < 256; unit += F.G) {
        const int x = unit & 7, rk = unit >> 3;
        const unsigned char* ub = F.UT8 + (size_t)x * NEXP * 128;
        const int tbeg = c0 + rk * per_blk + (wave - w0) * per_wave, tend = tbeg + per_wave;
        int idxA[16], idxB[16]; v4u segA[16], segB[16]; v4u hA[1], hB[1];
        PU_IDX(idxA, tbeg); PU_GATHER(segA, idxA); PU_HS(hA, tbeg); PU_IDX(idxB, tbeg + 1);
        for (int t = tbeg; t < tend; t += 2) {
            PU_GATHER(segB, idxB); PU_HS(hB, t + 1);
            { const int tn = (t + 2 < tend) ? t + 2 : t; PU_IDX(idxA, tn); }
            PU_COMPUTE(segA, hA, t);
            { const int tn = (t + 2 < tend) ? t + 2 : t; PU_GATHER(segA, idxA); PU_HS(hA, tn); }
            { const int tn = (t + 3 < tend) ? t + 3 : t + 1; PU_IDX(idxB, tn); }
            PU_COMPUTE(segB, hB, t + 1);
        }
    }
}
#undef PU_IDX
#undef PU_GATHER
#undef PU_HS
#undef PU_COMPUTE

template <bool DRY> __device__ __forceinline__ void peer_phase(Frame& F, const int c0, const int cn, const int w0, const int nw) {
    int lane = lane_id(); asm volatile("" : "+v"(lane));
    if (F.wave < w0 || F.wave >= w0 + nw) return;
    const int gw = blockIdx.x * nw + (F.wave - w0), NGW = F.G * nw;
    const int half = lane >> 5; const unsigned l16 = (unsigned)(lane & 31) * 16u, l8 = (unsigned)(lane & 31) * 8u;
    for (int t = c0 + gw; t < c0 + cn; t += NGW) {
        const int b = t >> 12;
        const int e0 = F.IDX[(size_t)t * PKN + lane], e1 = F.IDX[(size_t)t * PKN + 64 + lane];
        const float g0 = F.GATE[(size_t)t * PKN + lane], g1 = F.GATE[(size_t)t * PKN + 64 + lane];
        const float su0 = F.SU[e0], su1 = F.SU[e1], sv0 = F.SV[e0], sv1 = F.SV[e1];
        float tot0 = 0.f, tot1 = 0.f;
#pragma unroll
        for (int x = 0; x < 8; ++x) { const bf16* pp = (const bf16*)F.PART + ((size_t)x * M + t) * PKN; tot0 += bf2f(pp[lane]); tot1 += bf2f(pp[64 + lane]); }
        const float hs = F.HS[t];
        const float w0 = gelu_t(tot0 * (su0 * hs)) * g0 * sv0, w1 = gelu_t(tot1 * (su1 * hs)) * g1 * sv1;
        f32x2 acc[16];
#pragma unroll
        for (int i = 0; i < 16; ++i) acc[i] = (f32x2){0.f, 0.f};
        PV6_BATCH(e0, w0);
        PV6_BATCH(e1, w1);
#pragma unroll
        for (int i = 0; i < 16; ++i) {
            auto rx = __builtin_amdgcn_permlane32_swap(__float_as_uint(acc[i].x), __float_as_uint(acc[i].x), false, false);
            auto ry = __builtin_amdgcn_permlane32_swap(__float_as_uint(acc[i].y), __float_as_uint(acc[i].y), false, false);
            acc[i] = (f32x2){__uint_as_float(rx[0]) + __uint_as_float(rx[1]), __uint_as_float(ry[0]) + __uint_as_float(ry[1])};
        }
        float y[16];
#pragma unroll
        for (int j = 0; j < 16; ++j) {
#if FP6_INTERLEAVED
            const float lo = (j & 1) ? acc[j].x : acc[j].x;
            const float hi_ = acc[j].y;
            y[j] = half ? hi_ : lo;
#else
            const float lo = (j & 1) ? acc[j >> 1].y : acc[j >> 1].x;
            const float hi_ = (j & 1) ? acc[8 + (j >> 1)].y : acc[8 + (j >> 1)].x;
            y[j] = half ? hi_ : lo;
#endif
        }
        float ss = 0.f;
#pragma unroll
        for (int j = 0; j < 16; ++j) ss += y[j] * y[j];
        const float rstd = rsqrtf(wave_sum_dpp(ss) * (1.f / D) + EPS);
        const float* md = F.mod + b * 6144 + 5120;
        const float* g3 = F.norm_g + 3072;
        int lane_e = lane; asm volatile("" : "+v"(lane_e));
        const int col0 = (lane_e & 31) * 32 + (lane_e >> 5) * 16;
        float* orow = F.out + (size_t)t * D + col0;
#pragma unroll
        for (int q4 = 0; q4 < 4; ++q4) { const int c = col0 + q4 * 4;
            const f32x4 x1 = *(const f32x4*)(orow + q4 * 4), gt = *(const f32x4*)(md + c), gg = *(const f32x4*)(g3 + c);
            const f32x4 yv = (f32x4){y[q4 * 4], y[q4 * 4 + 1], y[q4 * 4 + 2], y[q4 * 4 + 3]};
            if (!DRY) *(f32x4*)(orow + q4 * 4) = x1 + gt * (yv * rstd * gg); else if (rstd == 123.456f) *(f32x4*)(orow + q4 * 4) = yv; }
    }
}
#undef PE_W
#undef PV6_LOAD
#undef PV6_ACC
#undef PV6_BATCH

__device__ __forceinline__ void u_rows4(Frame& F, int r0, int stride, int nvalid, int lane) {
    f32x4 v[4][4];
#pragma unroll
    for (int q = 0; q < 4; ++q) { const int row = r0 + (q < nvalid ? q : 0) * stride; const f32x4* s = (const f32x4*)(F.peer_u + (size_t)row * D) + lane * 4;
#pragma unroll
        for (int i = 0; i < 4; ++i) v[q][i] = s[i]; }
#pragma unroll
    for (int q = 0; q < 4; ++q) { if (q >= nvalid) break; const int row = r0 + q * stride;
        float am = 0.f;
#pragma unroll
        for (int i = 0; i < 4; ++i) am = fmaxf(am, fmaxf(fmaxf(fabsf(v[q][i].x), fabsf(v[q][i].y)), fmaxf(fabsf(v[q][i].z), fabsf(v[q][i].w))));
        am = wave_max_dpp(am);
        const float sc = am > 0.f ? 127.f / am : 1.f;
        int w[4];
#pragma unroll
        for (int i = 0; i < 4; ++i) { const int q0 = (int)rintf(v[q][i].x * sc), q1 = (int)rintf(v[q][i].y * sc), q2 = (int)rintf(v[q][i].z * sc), q3 = (int)rintf(v[q][i].w * sc);
            w[i] = (q0 & 255) | ((q1 & 255) << 8) | ((q2 & 255) << 16) | (q3 << 24); }
        *(v4u*)(F.UT8 + (size_t)(lane >> 3) * NEXP * 128 + (size_t)row * 128 + (lane & 7) * 16) = (v4u){(unsigned)w[0], (unsigned)w[1], (unsigned)w[2], (unsigned)w[3]};
        if (lane == 0) F.SU[row] = 1.f / sc; }
}
__device__ __forceinline__ void v_pairs2(Frame& F, int p0, int stride, int nvalid, int lane) {
    const int L = lane & 31, hf = lane >> 5;
    f32x4 f[2][8];
#pragma unroll
    for (int q = 0; q < 2; ++q) { const int row = 2 * (p0 + (q < nvalid ? q : 0) * stride) + hf; const f32x4* sp = (const f32x4*)(F.peer_v + (size_t)row * D + L * 32);
#pragma unroll
        for (int i = 0; i < 8; ++i) f[q][i] = sp[i]; }
#pragma unroll
    for (int q = 0; q < 2; ++q) { if (q >= nvalid) break; const int row = 2 * (p0 + q * stride) + hf;
        float am = 0.f;
#pragma unroll
        for (int i = 0; i < 8; ++i) am = fmaxf(am, fmaxf(fmaxf(fabsf(f[q][i].x), fabsf(f[q][i].y)), fmaxf(fabsf(f[q][i].z), fabsf(f[q][i].w))));
        am = half_max_dpp(am);
        const float sc = am > 0.f ? exp2f(floorf(log2f(7.0f / am))) : 1.f;
        v16f a, b;
#pragma unroll
        for (int i = 0; i < 4; ++i) { a[4 * i] = f[q][i].x * sc; a[4 * i + 1] = f[q][i].y * sc; a[4 * i + 2] = f[q][i].z * sc; a[4 * i + 3] = f[q][i].w * sc;
            b[4 * i] = f[q][4 + i].x * sc; b[4 * i + 1] = f[q][4 + i].y * sc; b[4 * i + 2] = f[q][4 + i].z * sc; b[4 * i + 3] = f[q][4 + i].w * sc; }
        const v6u w = __builtin_amdgcn_cvt_scalef32_2xpk16_fp6_f32(a, b, 1.0f);
        unsigned char* rp = F.VT6 + (size_t)row * 768;
        *(v4u*)(rp + L * 16) = (v4u){w[0], w[1], w[2], w[3]};
        *(v2u*)(rp + 512 + L * 8) = (v2u){w[4], w[5]};
        if (L == 0) F.SV[row] = 1.f / sc; }
}
__device__ __forceinline__ void prologue_tables(Frame& F, int gw, int NGW, int lane) {
    for (int r = gw; r < NEXP; r += 4 * NGW) { const int left = (NEXP - r + NGW - 1) / NGW; u_rows4(F, r, NGW, left < 4 ? left : 4, lane); }
    for (int p = gw; p < NEXP / 2; p += 2 * NGW) { const int left = (NEXP / 2 - p + NGW - 1) / NGW; v_pairs2(F, p, NGW, left < 2 ? left : 2, lane); }
}
}

__device__ __forceinline__ void prologue_tables_fwd(Frame& F, int gw, int NGW, int lane) { pe::prologue_tables(F, gw, NGW, lane); }
struct Args { const float* in[18]; float* out; unsigned char* ws; int ph_lo, ph_hi, li, pad; };
__global__ void __launch_bounds__(NTHR, 2) fwd(Args args) {
    extern __shared__ __attribute__((aligned(16))) unsigned char lds[];
    Frame F;
    F.lds = (LAS unsigned char*)lds;
    F.MISC = (volatile LAS unsigned*)(F.lds + MISC_OFF);
    F.wave = __builtin_amdgcn_readfirstlane((int)threadIdx.x >> 6); F.G = gridDim.x;
    unsigned char* ws = args.ws;
    F.ctl = (gu32*)(ws + WS_CTL);
    F.x = args.in[0]; F.c = args.in[1]; F.w_ada = args.in[2]; F.b_ada = args.in[3]; F.norm_g = args.in[4]; F.w_in = args.in[5]; F.sgu_ln_g = args.in[6]; F.sgu_ln_b = args.in[7];
    F.sgu_w = args.in[8]; F.sgu_b = args.in[9]; F.diff_lambda = args.in[10]; F.subln_g = args.in[11]; F.rel_bias = args.in[12]; F.w_out = args.in[13]; F.w_query = args.in[14];
    F.sub_keys = args.in[15]; F.peer_u = args.in[16]; F.peer_v = args.in[17]; F.out = args.out;
    F.mod = (float*)(ws + WS_MOD); F.WIN = (bf16*)(ws + WS_WIN); F.WOUT = (bf16*)(ws + WS_WOUT); F.WQ = (bf16*)(ws + WS_WQ); F.KEYS = (bf16*)(ws + WS_KEYS); F.SGW = (bf16*)(ws + WS_SGW);
    F.UT8 = ws + WS_UT; F.H8 = ws + WS_H8; F.HS = (float*)(ws + WS_SU) + 2 * NEXP; F.HAS = (float*)(ws + WS_SU) + 2 * NEXP + M; F.WS8 = (float*)(ws + WS_SU) + 2 * NEXP + 2 * M; F.HA8 = ws + WS_H; F.W8 = ws + WS_WIN; F.WQ8 = ws + WS_WQ; F.WQS8 = (float*)(ws + WS_SU) + 2 * NEXP + 2 * M + INC; F.VT6 = ws + WS_VT; F.PART = (float*)(ws + WS_QP); F.STASH = (unsigned*)(ws + WS_H); F.SU = (float*)(ws + WS_SU); F.SV = (float*)(ws + WS_SU) + NEXP; F.H = (bf16*)(ws + WS_H); F.Y = (bf16*)(ws + WS_Y); F.Z = (bf16*)(ws + WS_Z); F.QP = (bf16*)(ws + WS_QP); F.CAT = (bf16*)(ws + WS_CAT);
    F.IDX = (int*)(ws + WS_IDX); F.GATE = (float*)(ws + WS_GATE);
    for (int u = threadIdx.x; u < (LDS_BYTES - LDSCTL_OFF) / 4; u += NTHR) ((LAS unsigned*)(F.lds + LDSCTL_OFF))[u] = 0u;
    __syncthreads();
    XcdBarrier bar = xcd_barrier_post((unsigned*)(F.ctl + CW_BAR) + args.li * XCD_BAR_WORDS, F.MISC + 8);
    const int lo = args.ph_lo, hi = args.ph_hi;
#ifndef ONLY_PHASE
#define ONLY_PHASE -1
#endif
#define IN(k) (lo <= (k) && (k) < hi && (ONLY_PHASE < 0 || ONLY_PHASE == (k)))
#define SEAM(k) do { if ((k) + 1 < hi) xcd_barrier(bar); } while (0)
    if (IN(0)) { for (int rep = 0; rep < (PROBE_PHASE == 0 ? 2 : 1); ++rep) ph_prologue(F); SEAM(0); }
    if (IN(1)) { for (int rep = 0; rep < (PROBE_PHASE == 1 ? 2 : 1); ++rep) ph_hrows(F); SEAM(1); }
    if (IN(2)) {
        pg8::Gemm g{(const pg8::bf16_t*)F.HA8, (const pg8::bf16_t*)F.W8, M, INC, D / 2}; pg8::StaticOrder S; S.init(M, INC, F.G, (int)blockIdx.x);
        pg8::EpiI8<1> E{F.Z, INC, F.HAS, F.WS8, 1024};
        for (int rep = 0; rep < (PROBE_PHASE == 2 ? 2 : 1); ++rep) pg8::gemm_phase<pg8::EpiI8<1>, pg8::StaticOrder, true, true>(F.lds, g, S, E, F.wave);
        SEAM(2);
    }
    if (IN(3)) { for (int rep = 0; rep < (PROBE_PHASE == 30 ? 2 : 1); ++rep) sgu::sgu_phase(F); for (int rep = 0; rep < (PROBE_PHASE == 3 ? 2 : 1); ++rep) att::attn_phase(F); SEAM(3); }
    if (IN(4)) {
        pg8::Gemm g{F.CAT, F.WOUT, M, D, D}; pg8::StaticOrder S; S.init(M, D, F.G, (int)blockIdx.x);
        pg8::EpiBf16<0> E{F.Y, D, nullptr, 0, 0, 1.f, 0};
        for (int rep = 0; rep < (PROBE_PHASE == 4 ? 2 : 1); ++rep) pg8::gemm_phase<pg8::EpiBf16<0>, pg8::StaticOrder, true, true>(F.lds, g, S, E, F.wave);
        SEAM(4);
    }
    if (IN(5)) { for (int rep = 0; rep < (PROBE_PHASE == 5 ? 2 : 1); ++rep) ph_x1rows(F); SEAM(5); }
    if (IN(6)) {
        pg8::Gemm g{(const pg8::bf16_t*)F.H8, (const pg8::bf16_t*)F.WQ8, M, NQ, D / 2}; pg8::StaticOrder S; S.init(M, NQ, F.G, (int)blockIdx.x);
        pg8::EpiI8<0> E{F.QP, NQ, F.HS, F.WQS8, 0};
        for (int rep = 0; rep < (PROBE_PHASE == 6 ? 2 : 1); ++rep) pg8::gemm_phase<pg8::EpiI8<0>, pg8::StaticOrder, true, true>(F.lds, g, S, E, F.wave);
        SEAM(6);
    }
    if (IN(7)) { if (TABLES_IN_PHASE == 7) prologue_tables_fwd(F, blockIdx.x * NWAVES + F.wave, F.G * NWAVES, lane_id()); for (int rep = 0; rep < (PROBE_PHASE == 7 ? 2 : 1); ++rep) tk::topk_phase(F); SEAM(7); }
    if (IN(8)) { for (int rep = 0; rep < (PROBE_PHASE == 8 ? 2 : 1); ++rep) pe::peer_u_phase(F, 0, M, 0, 8); SEAM(8); }
    if (IN(9)) { if (PROBE_PHASE == 9) pe::peer_phase<true>(F, 0, M, 0, 8); pe::peer_phase<false>(F, 0, M, 0, 8); }
#undef IN
#undef SEAM
}

extern "C" void kernel_launch(void* const* d_in, const int* in_sizes, int n_in, void* d_out, int out_size, void* d_ws, size_t ws_size, hipStream_t stream) {
    static int grid = 0;
    if (grid == 0) {
        if (n_in != 18 || in_sizes[0] != M * D || out_size != M * D || ws_size < WS_END) { fprintf(stderr, "kernel_launch: unexpected shapes (n_in %d, in0 %d, out %d, ws %zu)\n", n_in, n_in > 0 ? in_sizes[0] : -1, out_size, ws_size); grid = -1; return; }
        int dev = 0, cus = 0, per_cu = 0;
        if (hipGetDevice(&dev) != hipSuccess || hipDeviceGetAttribute(&cus, hipDeviceAttributeMultiprocessorCount, dev) != hipSuccess) { grid = -1; return; }
        if (hipFuncSetAttribute((const void*)fwd, hipFuncAttributeMaxDynamicSharedMemorySize, LDS_BYTES) != hipSuccess) { fprintf(stderr, "kernel_launch: hipFuncSetAttribute failed\n"); grid = -1; return; }
        if (hipOccupancyMaxActiveBlocksPerMultiprocessor(&per_cu, (const void*)fwd, NTHR, LDS_BYTES) != hipSuccess || per_cu < 1) fprintf(stderr, "kernel_launch: occupancy query reports %d\n", per_cu);
        (void)hipGetLastError();
        grid = cus;
    }
    if (grid < 0) return;
    if (hipMemsetAsync((char*)d_ws + WS_CTL, 0, CTL_ZERO_BYTES, stream) != hipSuccess) return;
    Args a{};
    for (int i = 0; i < 18; ++i) a.in[i] = (const float*)d_in[i];
    a.out = (float*)d_out; a.ws = (unsigned char*)d_ws;
#if MK_PER_PHASE
    for (int p = 0; p < NPHASE; ++p) { a.ph_lo = p; a.ph_hi = p + 1; a.li = p; hipLaunchKernelGGL(fwd, dim3(grid), dim3(NTHR), LDS_BYTES, stream, a); }
#else
    a.ph_lo = 0; a.ph_hi = NPHASE; a.li = 0; hipLaunchKernelGGL(fwd, dim3(grid), dim3(NTHR), LDS_BYTES, stream, a);
#endif
}
```

```cpp
#define MK_PER_PHASE 0
#include <hip/hip_runtime.h>
#include <cstdio>
#include <cstdint>
namespace pg8 {
#define PG8_LAS __attribute__((address_space(3)))
typedef unsigned short bf16_t;
typedef short bf16x8 __attribute__((ext_vector_type(8)));
typedef float f32x4 __attribute__((ext_vector_type(4)));
typedef unsigned u32x4 __attribute__((ext_vector_type(4)));
typedef int i32x4 __attribute__((ext_vector_type(4)));
constexpr int BM = 256, BK = 64, HALF = 128, HTB = HALF * BK * 2  , STAGE_BYTES = 8 * HTB, NXCD = 8, WGM = 8;

__host__ __device__ __forceinline__ int lds_byte(int r, int c) { const int st = (r >> 4) * 2 + (c >> 5), rr = r & 15, cc = c & 31, ob = rr * 64 + cc * 2; return st * 1024 + (ob ^ (((ob >> 9) & 1) << 5)); }
__host__ __device__ __forceinline__ void stage_rc(int b, int& R, int& C) { const int st = b / 1024, sb = b % 1024, swz = sb ^ (((sb >> 9) & 1) << 5); R = (st >> 1) * 16 + swz / 64; C = (st & 1) * 32 + (swz % 64) / 2; }
__host__ __device__ __forceinline__ int perm32(int rho) { const int n = rho >> 4, i = rho & 15; return 8 * (i >> 2) + 4 * n + (i & 3); }

struct Unit { int pm, pn; };
struct Gemm { const bf16_t* A; const bf16_t* Bt; int M, N, K; };

struct StaticOrder {
    int nM, nN, nwg, G, c;
    __host__ __device__ void init(int M, int N, int G_, int c_) { nM = M / BM; nN = N / BM; nwg = nM * nN; G = G_; c = c_; }
    __host__ __device__ bool next(int i, Unit& u) const {
        const long L = (long)i * G + c; if (L >= nwg) return false;
        int wgid = (int)L; { const int q = nwg / NXCD, r = nwg % NXCD, xcd = wgid % NXCD, off = wgid / NXCD; wgid = (xcd < r ? xcd * (q + 1) : r * (q + 1) + (xcd - r) * q) + off; }
        const int nig = WGM * nN, gid = wgid / nig, fm = gid * WGM, gsz = (nM - fm) < WGM ? (nM - fm) : WGM;
        u.pm = fm + ((wgid % nig) % gsz); u.pn = (wgid % nig) / gsz; return true;
    }
    __device__ __forceinline__ void a_ready(const Unit&) const {}
    __device__ __forceinline__ void done(const Unit&) const {}
};

__device__ __forceinline__ unsigned cvt_pk_bf16(float lo, float hi) { unsigned r; asm volatile("v_cvt_pk_bf16_f32 %0, %1, %2" : "=v"(r) : "v"(lo), "v"(hi)); return r; }
typedef float f32x2 __attribute__((ext_vector_type(2)));
__device__ __forceinline__ f32x2 gelu_pk(f32x2 v) {
    const f32x2 u = v * (v * v * 0.044715f + 1.0f);
    const f32x2 s = u * (-2.302208198f);
    f32x2 e; e.x = __builtin_amdgcn_exp2f(s.x); e.y = __builtin_amdgcn_exp2f(s.y);
    const f32x2 d = e + 1.0f;
    f32x2 r; r.x = __builtin_amdgcn_rcpf(d.x); r.y = __builtin_amdgcn_rcpf(d.y);
    return v * r;
}

template <int ACT  > struct EpiBf16 {
    static constexpr bool PERM = true, AFTER_DRAIN = false; typedef f32x4 acc_t;
    bf16_t* O; int ldc; const float* bias; int split_cols; size_t split_stride; float scale0; int act_cols;
    __device__ __forceinline__ void operator()(const f32x4 (&acc)[2][2][4][2], const Unit& u, int wr, int wc, int fr, int fq) const {
        const int row0 = u.pm * BM + wr * 64 + fr; int colt = u.pn * BM; bf16_t* base = O;
        float sc = 1.f; if (split_cols) { const int t = colt / split_cols; base += (size_t)t * split_stride; colt -= t * split_cols; if (t == 0) sc = scale0; }
        const int col0 = colt + wc * 32 + 8 * fq, bcol0 = u.pn * BM + wc * 32 + 8 * fq;
        f32x4 bv[2][2];
#pragma unroll
        for (int bj = 0; bj < 2; ++bj)
#pragma unroll
            for (int n = 0; n < 2; ++n) bv[bj][n] = bias ? *(const f32x4*)(bias + bcol0 + bj * HALF + 4 * n) : (f32x4){0.f, 0.f, 0.f, 0.f};
#pragma unroll
        for (int ai = 0; ai < 2; ++ai)
#pragma unroll
            for (int m = 0; m < 4; ++m) { bf16_t* rowp = base + (size_t)(row0 + ai * HALF + m * 16) * ldc + col0;
#pragma unroll
                for (int bj = 0; bj < 2; ++bj) { f32x4 v0 = acc[ai][bj][m][0] + bv[bj][0], v1 = acc[ai][bj][m][1] + bv[bj][1];
                    if (ACT == 1 && u.pn * BM < act_cols) { f32x2 a = gelu_pk((f32x2){v0[0], v0[1]}), b = gelu_pk((f32x2){v0[2], v0[3]}), c = gelu_pk((f32x2){v1[0], v1[1]}), d = gelu_pk((f32x2){v1[2], v1[3]});
                        v0 = (f32x4){a.x, a.y, b.x, b.y}; v1 = (f32x4){c.x, c.y, d.x, d.y}; }
                    v0 = v0 * sc; v1 = v1 * sc; u32x4 w; w.x = cvt_pk_bf16(v0[0], v0[1]); w.y = cvt_pk_bf16(v0[2], v0[3]); w.z = cvt_pk_bf16(v1[0], v1[1]); w.w = cvt_pk_bf16(v1[2], v1[3]);
                    *(u32x4*)(rowp + bj * HALF) = w; } }
    }
};


template <int ACT> struct EpiI8 {
    static constexpr bool PERM = true, AFTER_DRAIN = false; typedef i32x4 acc_t;
    bf16_t* O; int ldc; const float* rs; const float* cs; int act_cols;
    __device__ __forceinline__ void operator()(const i32x4 (&acc)[2][2][4][2], const Unit& u, int wr, int wc, int fr, int fq) const {
        const int row0 = u.pm * BM + wr * 64 + fr, col0 = u.pn * BM + wc * 32 + 8 * fq;
        f32x4 cv[2][2];
#pragma unroll
        for (int bj = 0; bj < 2; ++bj)
#pragma unroll
            for (int n = 0; n < 2; ++n) cv[bj][n] = *(const f32x4*)(cs + col0 + bj * HALF + 4 * n);
#pragma unroll
        for (int ai = 0; ai < 2; ++ai)
#pragma unroll
            for (int m = 0; m < 4; ++m) { const int row = row0 + ai * HALF + m * 16; const float ra = rs[row]; bf16_t* rowp = O + (size_t)row * ldc + col0;
#pragma unroll
                for (int bj = 0; bj < 2; ++bj) {
                    f32x4 v0 = __builtin_convertvector(acc[ai][bj][m][0], f32x4) * ra * cv[bj][0], v1 = __builtin_convertvector(acc[ai][bj][m][1], f32x4) * ra * cv[bj][1];
                    if (ACT == 1 && u.pn * BM < act_cols) { f32x2 a = gelu_pk((f32x2){v0[0], v0[1]}), b = gelu_pk((f32x2){v0[2], v0[3]}), c = gelu_pk((f32x2){v1[0], v1[1]}), d = gelu_pk((f32x2){v1[2], v1[3]});
                        v0 = (f32x4){a.x, a.y, b.x, b.y}; v1 = (f32x4){c.x, c.y, d.x, d.y}; }
                    u32x4 w; w.x = cvt_pk_bf16(v0[0], v0[1]); w.y = cvt_pk_bf16(v0[2], v0[3]); w.z = cvt_pk_bf16(v1[0], v1[1]); w.w = cvt_pk_bf16(v1[2], v1[3]);
                    *(u32x4*)(rowp + bj * HALF) = w; } }
    }
};

__device__ __forceinline__ f32x4 mma16(bf16x8 a, bf16x8 b, f32x4 c) { return __builtin_amdgcn_mfma_f32_16x16x32_bf16(a, b, c, 0, 0, 0); }
__device__ __forceinline__ i32x4 mma16(bf16x8 a, bf16x8 b, i32x4 c) { return __builtin_amdgcn_mfma_i32_16x16x64_i8(__builtin_bit_cast(i32x4, a), __builtin_bit_cast(i32x4, b), c, 0, 0, 0); }
template <class Epi, class Sched, bool ALIGN_EPI = false, bool SP2 = false>
__device__ __forceinline__ void gemm_phase(PG8_LAS unsigned char* lds, const Gemm g, const Sched& S, const Epi& E, const int wid  ) {
    const int lane = (int)__builtin_amdgcn_mbcnt_hi(~0u, __builtin_amdgcn_mbcnt_lo(~0u, 0u)), tid = wid * 64 + lane, wr = wid >> 2, wc = wid & 3, fr = lane & 15, fq = lane >> 4;
    const int K = g.K, nt = K / BK;
    unsigned voffA[2], voffB[2];
#pragma unroll
    for (int i = 0; i < 2; ++i) { int R, C; stage_rc(tid * 16 + i * 8192, R, C); const int Rb = Epi::PERM ? ((R & ~31) + perm32(R & 31)) : R;
        voffA[i] = (unsigned)(R * K + C) * 2u; voffB[i] = (unsigned)(Rb * K + C) * 2u; }
    const size_t kstep = (size_t)(BK * 2);
    const size_t hstep = (size_t)HALF * K * 2;
    const size_t tstep = 2 * hstep;
    const unsigned ldsw = (unsigned)wid * 1024u;
    const int aoff = lds_byte(wr * 64 + fr, fq * 8), boff = lds_byte(wc * 32 + fr, fq * 8);
#define PG8_SA(b, h) (((b) * 2 + (h)) * HTB)
#define PG8_SB(b, h) ((4 + (b) * 2 + (h)) * HTB)
#define PG8_STAGE(bufoff, gbase, voff) do { _Pragma("unroll") for (int _i = 0; _i < 2; ++_i) \
        __builtin_amdgcn_global_load_lds((const unsigned*)((const char*)(gbase) + (voff)[_i]), (PG8_LAS unsigned*)(lds + (bufoff) + ldsw + _i * 8192), 16, 0, 0); } while (0)
#define PG8_LDA(dst, b, h) do { _Pragma("unroll") for (int m = 0; m < 4; ++m) _Pragma("unroll") for (int k = 0; k < 2; ++k) dst[m][k] = *(const PG8_LAS bf16x8*)(lds + PG8_SA(b, h) + aoff + m * 2048 + k * 1024); } while (0)
#define PG8_LDB(dst, b, h) do { _Pragma("unroll") for (int n = 0; n < 2; ++n) _Pragma("unroll") for (int k = 0; k < 2; ++k) dst[n][k] = *(const PG8_LAS bf16x8*)(lds + PG8_SB(b, h) + boff + n * 2048 + k * 1024); } while (0)
#define PG8_MMA(ai, bj, At, Bt) do { __builtin_amdgcn_s_setprio(1); _Pragma("unroll") for (int m = 0; m < 4; ++m) _Pragma("unroll") for (int n = 0; n < 2; ++n) _Pragma("unroll") for (int k = 0; k < 2; ++k) \
        acc[ai][bj][m][n] = mma16(Bt[n][k], At[m][k], acc[ai][bj][m][n]); __builtin_amdgcn_s_setprio(0); } while (0)
#define PG8_WAIT_V(n) asm volatile("s_waitcnt vmcnt(" #n ")" ::: "memory")
#define PG8_WAIT_L(n) asm volatile("s_waitcnt lgkmcnt(" #n ")" ::: "memory")
#define PG8_BAR __builtin_amdgcn_s_barrier()
#define PG8_SCHED __builtin_amdgcn_sched_barrier(0)
    Unit cur, nxt; int ui = 0;
    if (!S.next(0, cur)) return;
    typedef typename Epi::acc_t acc_t;
    acc_t acc[2][2][4][2];
#pragma unroll
    for (int a = 0; a < 2; ++a)
#pragma unroll
        for (int b = 0; b < 2; ++b)
#pragma unroll
            for (int m = 0; m < 4; ++m)
#pragma unroll
                for (int n = 0; n < 2; ++n) acc[a][b][m][n] = acc_t{};
    bf16x8 At[4][2], B0[2][2], B1[2][2];
    const char* cA = (const char*)g.A + (size_t)cur.pm * tstep; const char* cB = (const char*)g.Bt + (size_t)cur.pn * tstep;
    S.a_ready(cur);
    if constexpr (SP2) {
        PG8_STAGE(PG8_SB(0, 0), cB, voffB); PG8_STAGE(PG8_SB(0, 1), cB + hstep, voffB); PG8_STAGE(PG8_SA(0, 0), cA, voffA); PG8_STAGE(PG8_SA(0, 1), cA + hstep, voffA);
        if (wr == 1) PG8_BAR;
        PG8_WAIT_V(2); PG8_BAR;
        PG8_STAGE(PG8_SB(1, 0), cB + kstep, voffB); PG8_STAGE(PG8_SA(1, 0), cA + kstep, voffA); PG8_STAGE(PG8_SB(1, 1), cB + hstep + kstep, voffB);
        PG8_WAIT_V(6); PG8_BAR;
    } else {
        PG8_STAGE(PG8_SB(0, 0), cB, voffB); PG8_STAGE(PG8_SA(0, 0), cA, voffA); PG8_STAGE(PG8_SB(0, 1), cB + hstep, voffB); PG8_STAGE(PG8_SA(0, 1), cA + hstep, voffA);
        if (wr == 1) PG8_BAR;
        PG8_WAIT_V(4); PG8_BAR;
        PG8_STAGE(PG8_SB(1, 0), cB + kstep, voffB); PG8_STAGE(PG8_SA(1, 0), cA + kstep, voffA); PG8_STAGE(PG8_SB(1, 1), cB + hstep + kstep, voffB);
        PG8_WAIT_V(6); PG8_BAR;
    }
    for (;;) {
        const bool has_next = S.next(ui + 1, nxt);
        const char* nA = has_next ? (const char*)g.A + (size_t)nxt.pm * tstep : cA; const char* nB = has_next ? (const char*)g.Bt + (size_t)nxt.pn * tstep : cB;
        for (int t = 0; t < nt; t += 2) {
            const bool last = (t == nt - 2);
            const char* a1 = cA + (size_t)(t + 1) * kstep;
            const char* a2 = last ? nA : cA + (size_t)(t + 2) * kstep; const char* b2 = last ? nB : cB + (size_t)(t + 2) * kstep;
            const char* a3 = a2 + kstep; const char* b3 = b2 + kstep;
            if (last && has_next) S.a_ready(nxt);
            if constexpr (SP2) {
            PG8_LDB(B0, 0, 0); PG8_LDB(B1, 0, 1); PG8_SCHED; PG8_LDA(At, 0, 0); PG8_STAGE(PG8_SA(1, 1), a1 + hstep, voffA);
            PG8_WAIT_V(8); PG8_WAIT_L(0); PG8_BAR; PG8_MMA(0, 0, At, B0); PG8_MMA(0, 1, At, B1); PG8_BAR; PG8_SCHED;
            PG8_LDA(At, 0, 1); PG8_STAGE(PG8_SB(0, 0), b2, voffB); PG8_STAGE(PG8_SB(0, 1), b2 + hstep, voffB); PG8_STAGE(PG8_SA(0, 0), a2, voffA);
            PG8_WAIT_V(8); PG8_WAIT_L(0); PG8_BAR; PG8_MMA(1, 0, At, B0); PG8_MMA(1, 1, At, B1); PG8_BAR; PG8_SCHED;
            PG8_LDB(B0, 1, 0); PG8_LDB(B1, 1, 1); PG8_SCHED; PG8_LDA(At, 1, 0); PG8_STAGE(PG8_SA(0, 1), a2 + hstep, voffA);
            PG8_WAIT_V(8); PG8_WAIT_L(0); PG8_BAR; PG8_MMA(0, 0, At, B0); PG8_MMA(0, 1, At, B1); PG8_BAR; PG8_SCHED;
            PG8_LDA(At, 1, 1); PG8_STAGE(PG8_SB(1, 0), b3, voffB); PG8_STAGE(PG8_SB(1, 1), b3 + hstep, voffB); PG8_STAGE(PG8_SA(1, 0), a3, voffA);
            PG8_WAIT_V(8); PG8_WAIT_L(0); PG8_BAR; PG8_MMA(1, 0, At, B0); PG8_MMA(1, 1, At, B1); PG8_BAR; PG8_SCHED;
            } else {
            PG8_LDB(B0, 0, 0); PG8_SCHED; PG8_LDA(At, 0, 0); PG8_STAGE(PG8_SA(1, 1), a1 + hstep, voffA);
            PG8_WAIT_L(8); PG8_BAR; PG8_WAIT_L(0); PG8_MMA(0, 0, At, B0); PG8_BAR; PG8_SCHED;
            PG8_LDB(B1, 0, 1); PG8_STAGE(PG8_SB(0, 0), b2, voffB);
            PG8_BAR; PG8_WAIT_L(0); PG8_MMA(0, 1, At, B1); PG8_BAR;
            PG8_LDA(At, 0, 1); PG8_STAGE(PG8_SA(0, 0), a2, voffA);
            PG8_BAR; PG8_WAIT_L(0); PG8_MMA(1, 0, At, B0); PG8_BAR; PG8_SCHED;
            PG8_STAGE(PG8_SB(0, 1), b2 + hstep, voffB);
            PG8_WAIT_V(6); PG8_BAR; PG8_MMA(1, 1, At, B1); PG8_BAR;
            PG8_LDB(B0, 1, 0); PG8_SCHED; PG8_LDA(At, 1, 0); PG8_STAGE(PG8_SA(0, 1), a2 + hstep, voffA);
            PG8_WAIT_L(8); PG8_BAR; PG8_WAIT_L(0); PG8_MMA(0, 0, At, B0); PG8_BAR; PG8_SCHED;
            PG8_LDB(B1, 1, 1); PG8_STAGE(PG8_SB(1, 0), b3, voffB);
            PG8_BAR; PG8_WAIT_L(0); PG8_MMA(0, 1, At, B1); PG8_BAR;
            PG8_LDA(At, 1, 1); PG8_STAGE(PG8_SA(1, 0), a3, voffA);
            PG8_BAR; PG8_WAIT_L(0); PG8_MMA(1, 0, At, B0); PG8_BAR; PG8_SCHED;
            PG8_STAGE(PG8_SB(1, 1), b3 + hstep, voffB);
            PG8_WAIT_V(6); PG8_BAR; PG8_MMA(1, 1, At, B1); PG8_BAR;
            }
        }
        if constexpr (ALIGN_EPI) { if (wr == 0) PG8_BAR; }
        if constexpr (!Epi::AFTER_DRAIN) { E(acc, cur, wr, wc, fr, fq); S.done(cur); }
        if (!has_next) break;
#pragma unroll
        for (int a = 0; a < 2; ++a)
#pragma unroll
            for (int b = 0; b < 2; ++b)
#pragma unroll
                for (int m = 0; m < 4; ++m)
#pragma unroll
                    for (int n = 0; n < 2; ++n) acc[a][b][m][n] = acc_t{};
        cur = nxt; cA = nA; cB = nB; ++ui;
        if constexpr (ALIGN_EPI) { if (wr == 1) PG8_BAR; }
    }
    PG8_WAIT_V(0);
    if constexpr (!ALIGN_EPI) { if (wr == 0) PG8_BAR; }
    PG8_BAR;
    if constexpr (Epi::AFTER_DRAIN) { E.fused(acc, cur, wr, wc, fr, fq, lds, wid, lane); S.done(cur); }
#undef PG8_SA
#undef PG8_SB
#undef PG8_STAGE
#undef PG8_LDA
#undef PG8_LDB
#undef PG8_MMA
#undef PG8_WAIT_V
#undef PG8_WAIT_L
#undef PG8_BAR
#undef PG8_SCHED
}
}
#ifndef MK_PER_PHASE
#define MK_PER_PHASE 0
#endif
#ifndef PROBE_PHASE
#define PROBE_PHASE -1
#endif
#ifndef X1_NR
#define X1_NR 2
#endif
#ifndef TABLES_IN_PHASE
#define TABLES_IN_PHASE 0
#endif
constexpr int NWAVES = 8, NTHR = NWAVES * 64;
constexpr int BATCH = 8, SEQ = 4096, D = 1024, M = BATCH * SEQ;
constexpr int INC = 2560;
constexpr int NEXP = 16384, PKN = 128;
constexpr int NQ = 2048;
constexpr float EPS = 1e-6f;
constexpr size_t MiB = 1u << 20;
constexpr size_t WS_CTL = 0, CTL_ZERO_BYTES = MK_PER_PHASE ? (1u << 20) : 64 * 1024;
constexpr size_t WS_MOD = 1 * MiB, WS_WIN = 2 * MiB, WS_WOUT = 7 * MiB, WS_WQ = 9 * MiB, WS_KEYS = 13 * MiB, WS_SGW = 13 * MiB + 512 * 1024;
constexpr size_t WS_SU = 14 * MiB, WS_UT = 16 * MiB, WS_VT = 48 * MiB, WS_H = 80 * MiB, WS_Y = 144 * MiB, WS_OATT = 80 * MiB, WS_Z = 208 * MiB, WS_QP = 208 * MiB;
constexpr size_t WS_H8 = 336 * MiB;
constexpr size_t WS_CAT = 368 * MiB, WS_IDX = 432 * MiB, WS_GATE = 448 * MiB, WS_END = 464 * MiB;
constexpr int CW_BAR = 4096;
constexpr int RING_BYTES = 131072, LDSCTL_OFF = RING_BYTES, MISC_OFF = LDSCTL_OFF + 320, LDS_BYTES = 147456;
constexpr int NPHASE = 10;

#define GAS __attribute__((address_space(1)))
#define LAS __attribute__((address_space(3)))
typedef unsigned short bf16;
typedef unsigned v4u __attribute__((ext_vector_type(4)));
typedef unsigned v2u __attribute__((ext_vector_type(2)));
typedef float f32x4 __attribute__((ext_vector_type(4)));
typedef short bf16x8 __attribute__((ext_vector_type(8)));
typedef GAS unsigned gu32;
typedef GAS unsigned long long gu64;
#define RLX_AGENT __ATOMIC_RELAXED, __HIP_MEMORY_SCOPE_AGENT
#define LDS_WAIT() asm volatile("s_waitcnt lgkmcnt(0)" ::: "memory")
#define VM_WAIT() asm volatile("s_waitcnt vmcnt(0)" ::: "memory")
__device__ __forceinline__ unsigned f2bf(float f) { unsigned u = __builtin_bit_cast(unsigned, f); return (u + 0x7fffu + ((u >> 16) & 1u)) >> 16; }
__device__ __forceinline__ unsigned pk2(float lo, float hi) { return f2bf(lo) | (f2bf(hi) << 16); }
__device__ __forceinline__ float bflo(unsigned w) { return __uint_as_float(w << 16); }
__device__ __forceinline__ float bfhi(unsigned w) { return __uint_as_float(w & 0xffff0000u); }
__device__ __forceinline__ float bf2f(bf16 b) { return __uint_as_float((unsigned)b << 16); }
typedef __bf16 bf16x2_t __attribute__((ext_vector_type(2)));
__device__ __forceinline__ float dot2(unsigned a, unsigned b, float acc) { return __builtin_amdgcn_fdot2_f32_bf16(__builtin_bit_cast(bf16x2_t, a), __builtin_bit_cast(bf16x2_t, b), acc, false); }
__device__ __forceinline__ float gelu_t(float v) { const float u = v * (1.f + 0.044715f * v * v); return v * __builtin_amdgcn_rcpf(1.f + __builtin_amdgcn_exp2f(-2.302208198f * u)); }
__device__ __forceinline__ int lane_id() { return (int)__builtin_amdgcn_mbcnt_hi(~0u, __builtin_amdgcn_mbcnt_lo(~0u, 0u)); }
__device__ __forceinline__ float wave_sum(float v) {
#pragma unroll
    for (int o = 1; o < 64; o <<= 1) v += __shfl_xor(v, o);
    return v;
}
#define DPP_SUM_ROW(v) do { v += __uint_as_float((unsigned)__builtin_amdgcn_update_dpp(0, (int)__float_as_uint(v), 0xB1, 0xF, 0xF, false)); \
        v += __uint_as_float((unsigned)__builtin_amdgcn_update_dpp(0, (int)__float_as_uint(v), 0x4E, 0xF, 0xF, false)); \
        v += __uint_as_float((unsigned)__builtin_amdgcn_update_dpp(0, (int)__float_as_uint(v), 0x141, 0xF, 0xF, false)); \
        v += __uint_as_float((unsigned)__builtin_amdgcn_update_dpp(0, (int)__float_as_uint(v), 0x140, 0xF, 0xF, false)); } while (0)
__device__ __forceinline__ float dpp_xor1(float v) { return __uint_as_float((unsigned)__builtin_amdgcn_update_dpp(0, (int)__float_as_uint(v), 0xB1, 0xF, 0xF, false)); }
__device__ __forceinline__ float wave_sum_dpp(float v) {
    DPP_SUM_ROW(v);
    const float r0 = __uint_as_float(__builtin_amdgcn_readlane(__float_as_uint(v), 0)), r1 = __uint_as_float(__builtin_amdgcn_readlane(__float_as_uint(v), 16));
    const float r2 = __uint_as_float(__builtin_amdgcn_readlane(__float_as_uint(v), 32)), r3 = __uint_as_float(__builtin_amdgcn_readlane(__float_as_uint(v), 48));
    return (r0 + r1) + (r2 + r3);
}
__device__ __forceinline__ float wave_max_dpp(float v) {
    v = fmaxf(v, __uint_as_float((unsigned)__builtin_amdgcn_update_dpp(0, (int)__float_as_uint(v), 0xB1, 0xF, 0xF, false)));
    v = fmaxf(v, __uint_as_float((unsigned)__builtin_amdgcn_update_dpp(0, (int)__float_as_uint(v), 0x4E, 0xF, 0xF, false)));
    v = fmaxf(v, __uint_as_float((unsigned)__builtin_amdgcn_update_dpp(0, (int)__float_as_uint(v), 0x141, 0xF, 0xF, false)));
    v = fmaxf(v, __uint_as_float((unsigned)__builtin_amdgcn_update_dpp(0, (int)__float_as_uint(v), 0x140, 0xF, 0xF, false)));
    const float r0 = __uint_as_float(__builtin_amdgcn_readlane(__float_as_uint(v), 0)), r1 = __uint_as_float(__builtin_amdgcn_readlane(__float_as_uint(v), 16));
    const float r2 = __uint_as_float(__builtin_amdgcn_readlane(__float_as_uint(v), 32)), r3 = __uint_as_float(__builtin_amdgcn_readlane(__float_as_uint(v), 48));
    return fmaxf(fmaxf(r0, r1), fmaxf(r2, r3));
}
__device__ __forceinline__ float half_max_dpp(float v) {
    v = fmaxf(v, __uint_as_float((unsigned)__builtin_amdgcn_update_dpp(0, (int)__float_as_uint(v), 0xB1, 0xF, 0xF, false)));
    v = fmaxf(v, __uint_as_float((unsigned)__builtin_amdgcn_update_dpp(0, (int)__float_as_uint(v), 0x4E, 0xF, 0xF, false)));
    v = fmaxf(v, __uint_as_float((unsigned)__builtin_amdgcn_update_dpp(0, (int)__float_as_uint(v), 0x141, 0xF, 0xF, false)));
    v = fmaxf(v, __uint_as_float((unsigned)__builtin_amdgcn_update_dpp(0, (int)__float_as_uint(v), 0x140, 0xF, 0xF, false)));
    const float r0 = __uint_as_float(__builtin_amdgcn_readlane(__float_as_uint(v), 0)), r1 = __uint_as_float(__builtin_amdgcn_readlane(__float_as_uint(v), 16));
    const float r2 = __uint_as_float(__builtin_amdgcn_readlane(__float_as_uint(v), 32)), r3 = __uint_as_float(__builtin_amdgcn_readlane(__float_as_uint(v), 48));
    return (lane_id() < 32) ? fmaxf(r0, r1) : fmaxf(r2, r3);
}
__device__ __forceinline__ float wave_max(float v) {
#pragma unroll
    for (int o = 1; o < 64; o <<= 1) v = fmaxf(v, __shfl_xor(v, o));
    return v;
}
#define XB_TMO      128
#define XB_XCNT(j)  (256  + 64 * (j))
#define XB_XSUB(j)  (1280 + 64 * (j))
#define XB_XGEN(j)  (2304 + 64 * (j))
#define XB_TOP      3328
#define XB_TOPGEN   3392
#define XCD_BAR_WORDS 3456
#define XB_SPIN_CAP (1u << 18)

__device__ __forceinline__ unsigned xb_ld(unsigned* p)              { return __hip_atomic_load(p, __ATOMIC_RELAXED, __HIP_MEMORY_SCOPE_AGENT); }
__device__ __forceinline__ unsigned xb_add(unsigned* p, unsigned v) { return __hip_atomic_fetch_add(p, v, __ATOMIC_RELAXED, __HIP_MEMORY_SCOPE_AGENT); }
__device__ __forceinline__ unsigned xb_xcc_id() { return (unsigned)__builtin_amdgcn_s_getreg((3 << 11) | 20) & 0xFu; }
#define XB_SPIN(cond, bar) do { unsigned _sp = 0; while (cond) { __builtin_amdgcn_s_sleep(1); \
    if ((++_sp & 255u) == 0u) { if (xb_ld(&(bar)[XB_TMO])) break; if (_sp > XB_SPIN_CAP) { atomicAdd(&(bar)[XB_TMO], 1u); break; } } } } while (0)

struct XcdBarrier {
    unsigned* bar; unsigned x;
    volatile LAS unsigned* st;
};

__device__ __forceinline__ XcdBarrier xcd_barrier_post(unsigned* bar, volatile LAS unsigned* st) {
    XcdBarrier b; b.bar = bar; b.x = xb_xcc_id(); b.st = st;
    if (threadIdx.x == 0) (void)xb_add(&bar[XB_XCNT(b.x)], 1u);
    return b;
}
__device__ __forceinline__ void xcd_barrier_complete(unsigned* bar, unsigned x, unsigned& nloc, unsigned& nx) {
    const unsigned G = gridDim.x * gridDim.y * gridDim.z;
    unsigned sum, cnt, mine, sp = 0u;
    for (;;) {
        sum = 0u; cnt = 0u; mine = 0u;
#pragma unroll
        for (unsigned j = 0; j < 16; ++j) { const unsigned c = xb_ld(&bar[XB_XCNT(j)]); sum += c; cnt += (c > 0u) ? 1u : 0u; mine = (j == x) ? c : mine; }
        if (sum == G) break;
        __builtin_amdgcn_s_sleep(1);
        if ((++sp & 255u) == 0u) { if (xb_ld(&bar[XB_TMO])) break; if (sp > XB_SPIN_CAP) { atomicAdd(&bar[XB_TMO], 1u); break; } }
    }
    nloc = mine > 0u ? mine : 1u; nx = cnt > 0u ? cnt : 1u;
}

__device__ __forceinline__ void xcd_barrier(const XcdBarrier& b) {
    asm volatile("s_waitcnt vmcnt(0)" ::: "memory");
    __syncthreads();
    if (threadIdx.x == 0) {
        unsigned* bar = b.bar;
        __builtin_amdgcn_s_waitcnt(0);
        unsigned nloc = b.st[0], nx = b.st[1];
        if (nloc == 0u) { xcd_barrier_complete(bar, b.x, nloc, nx); b.st[0] = nloc; b.st[1] = nx; }
        const unsigned old = xb_add(&bar[XB_XSUB(b.x)], 1u);
        const unsigned gen = old / nloc;
        if (old + 1u == (gen + 1u) * nloc) {
            __builtin_amdgcn_fence(__ATOMIC_RELEASE, "agent");
            asm volatile("s_waitcnt vmcnt(0)" ::: "memory");
            const unsigned og = xb_add(&bar[XB_TOP], 1u);
            const unsigned tg = og / nx;
            if (og + 1u == (tg + 1u) * nx) xb_add(&bar[XB_TOPGEN], 1u);
            else XB_SPIN(xb_ld(&bar[XB_TOPGEN]) == tg, bar);
            __builtin_amdgcn_fence(__ATOMIC_ACQUIRE, "agent");
            xb_add(&bar[XB_XGEN(b.x)], 1u);
            asm volatile("s_waitcnt vmcnt(0)" ::: "memory");
        } else {
            XB_SPIN(xb_ld(&bar[XB_XGEN(b.x)]) == gen, bar);
            __builtin_amdgcn_fence(__ATOMIC_ACQUIRE, "agent");
            asm volatile("s_waitcnt vmcnt(0)" ::: "memory");
        }
    }
    __syncthreads();
}
struct Frame {
    LAS unsigned char* lds;
    volatile LAS unsigned* MISC;
    gu32* ctl;
    int wave, G;
    const float *x, *c, *w_ada, *b_ada, *norm_g, *w_in, *sgu_ln_g, *sgu_ln_b, *sgu_w, *sgu_b, *diff_lambda, *subln_g, *rel_bias, *w_out, *w_query, *sub_keys, *peer_u, *peer_v;
    float* out;
    float* mod; bf16 *WIN, *WOUT, *WQ, *KEYS, *SGW, *H, *Y, *Z, *QP, *CAT; unsigned char *UT8, *VT6, *H8, *HA8, *W8, *WQ8; float *HS, *HAS, *WS8, *WQS8; float *SU, *SV, *PART; unsigned* STASH; int* IDX; float* GATE; bf16* X1B;
};

__device__ __forceinline__ void p0_transpose_item(const float* W, int K, int N, bf16* WT, int row_off, LAS float* scr, int item, int lane) {
    const int nblk = N / 32, kb = item / nblk, nb = item % nblk, k0 = 64 * kb, n0 = 32 * nb;
#pragma unroll 8
    for (int i = 0; i < 32; ++i) { const int kk = 2 * i + (lane >> 5); scr[kk * 33 + (lane & 31)] = W[(size_t)(k0 + kk) * N + n0 + (lane & 31)]; }
    LDS_WAIT(); asm volatile("" ::: "memory");
    const int c = lane & 7;
#pragma unroll
    for (int j = 0; j < 4; ++j) { const int n = (lane >> 3) + 8 * j; const LAS float* s = scr + (8 * c) * 33 + n;
        v4u o; o.x = pk2(s[0 * 33], s[1 * 33]); o.y = pk2(s[2 * 33], s[3 * 33]); o.z = pk2(s[4 * 33], s[5 * 33]); o.w = pk2(s[6 * 33], s[7 * 33]);
        *(GAS v4u*)(WT + (size_t)(row_off + n0 + n) * K + k0 + 8 * c) = o; }
    LDS_WAIT(); asm volatile("" ::: "memory");
}

__device__ __forceinline__ void prologue_tables_fwd(Frame& F, int gw, int NGW, int lane);
__device__ __forceinline__ void ph_prologue(Frame& F) {
    const int lane = lane_id(), wave = F.wave, tid = wave * 64 + lane, G = F.G;
    const int gw = blockIdx.x * NWAVES + wave, NGW = G * NWAVES;
    for (int rep_ = 0; rep_ < (PROBE_PHASE == 100 ? 2 : 1); ++rep_) {
        LAS float* sil = (LAS float*)F.lds;
        LAS float* red = sil + 8192;
        for (int i = tid; i < 8192; i += NTHR) { const float cv = F.c[i]; sil[i] = cv / (1.f + __expf(-cv)); }
        __syncthreads();
        for (int u = blockIdx.x; u < 384; u += G) {
            const int j = u * 16 + (lane & 15), kr = lane >> 4, k0 = wave * 128;
            float acc[8];
#pragma unroll
            for (int b = 0; b < 8; ++b) acc[b] = 0.f;
            const float* wp = F.w_ada + (size_t)(k0 + kr) * 6144 + j;
#pragma unroll 16
            for (int i = 0; i < 32; ++i) { const float w = wp[(size_t)i * 4 * 6144]; const int k = k0 + 4 * i + kr;
#pragma unroll
                for (int b = 0; b < 8; ++b) acc[b] += sil[b * 1024 + k] * w; }
#pragma unroll
            for (int b = 0; b < 8; ++b) { acc[b] += __shfl_xor(acc[b], 16); acc[b] += __shfl_xor(acc[b], 32); }
            if (lane < 16) {
#pragma unroll
                for (int b = 0; b < 8; ++b) red[(wave * 8 + b) * 16 + lane] = acc[b]; }
            __syncthreads();
            if (tid < 128) { const int b = tid >> 4, c = tid & 15; float s = 0.f;
#pragma unroll
                for (int w = 0; w < 8; ++w) s += red[(w * 8 + b) * 16 + c];
                F.mod[b * 6144 + u * 16 + c] = s + F.b_ada[u * 16 + c]; }
            __syncthreads();
        }
    }
    LAS float* scr = (LAS float*)(F.lds + wave * 16384);
    {
        LAS float* part = (LAS float*)(F.lds + 7 * 16384 + 8704);
        LAS float* fin = part + 256;
        const int n = lane & 31, hf = lane >> 5;
        for (int u = blockIdx.x; u < (INC + NQ) / 32; u += G) {
            const bool isq = u >= INC / 32;
            const float* Wsrc = isq ? F.w_query : F.w_in; const int Nw = isq ? NQ : INC; unsigned char* Wdst = isq ? F.WQ8 : F.W8; float* Sdst = isq ? F.WQS8 : F.WS8;
            const int n0 = (isq ? u - INC / 32 : u) * 32;
            float am = 0.f;
            { const float* wp = Wsrc + (size_t)(wave * 128 + hf) * Nw + n0 + n;
#pragma unroll 16
              for (int i = 0; i < 64; ++i) am = fmaxf(am, fabsf(wp[(size_t)(2 * i) * Nw])); }
            { auto rr = __builtin_amdgcn_permlane32_swap(__float_as_uint(am), __float_as_uint(am), false, false); am = fmaxf(__uint_as_float(rr[0]), __uint_as_float(rr[1])); }
            if (lane < 32) part[wave * 32 + lane] = am;
            __syncthreads();
            if (tid < 32) { float mx = 0.f;
#pragma unroll
                for (int w = 0; w < 8; ++w) mx = fmaxf(mx, part[w * 32 + tid]);
                const float qsc = (!isq && n0 >= 1024 && n0 < 1536) ? 0.125f * 1.4426950408889634f : 1.f;
                fin[tid] = mx; Sdst[n0 + tid] = (mx > 0.f ? mx * (1.f / 127.f) : 1.f) * qsc; }
            __syncthreads();
            const float cmx = fin[n]; const float sc = cmx > 0.f ? 127.f / cmx : 1.f;
#pragma unroll 1
            for (int q = 0; q < 2; ++q) { const int k0 = (wave * 2 + q) * 64;
#pragma unroll 8
                for (int i = 0; i < 32; ++i) { const int kk = 2 * i + hf; scr[kk * 33 + n] = Wsrc[(size_t)(k0 + kk) * Nw + n0 + n]; }
                LDS_WAIT(); asm volatile("" ::: "memory");
                unsigned w8[8];
#pragma unroll
                for (int d = 0; d < 8; ++d) { const LAS float* s = scr + (32 * hf + 4 * d) * 33 + n;
                    const int q0 = (int)rintf(s[0] * sc), q1 = (int)rintf(s[33] * sc), q2 = (int)rintf(s[66] * sc), q3 = (int)rintf(s[99] * sc);
                    w8[d] = (unsigned)((q0 & 255) | ((q1 & 255) << 8) | ((q2 & 255) << 16) | (q3 << 24)); }
                unsigned char* op = Wdst + (size_t)(n0 + n) * D + k0 + 32 * hf;
                *(GAS v4u*)op = (v4u){w8[0], w8[1], w8[2], w8[3]}; *(GAS v4u*)(op + 16) = (v4u){w8[4], w8[5], w8[6], w8[7]};
                LDS_WAIT(); asm volatile("" ::: "memory"); }
            __syncthreads();
        }
    }
    constexpr int I_IN = 0, I_OUT = (D / 64) * (D / 32), I_Q = 0;
    for (int rep_ = 0; rep_ < (PROBE_PHASE == 101 ? 2 : 1); ++rep_)
    for (int it = gw; it < I_IN + I_OUT + I_Q; it += NGW) {
        int r = it;
        if (r < I_IN) { p0_transpose_item(F.w_in, D, INC, F.WIN, 0, scr, r, lane); continue; } r -= I_IN;
        if (r < I_OUT) { p0_transpose_item(F.w_out, D, D, F.WOUT, 0, scr, r, lane); continue; } r -= I_OUT;
        (void)r;
    }
    const int gt = blockIdx.x * NTHR + tid, NT = G * NTHR;
    if (TABLES_IN_PHASE == 0) for (int rep_ = 0; rep_ < (PROBE_PHASE == 102 ? 2 : 1); ++rep_) prologue_tables_fwd(F, gw, NGW, lane);
    for (int i = gt; i < 16 * 16 * 128; i += NT) {
        const int hc = i >> 11, dg = (i >> 7) & 15, n = i & 127;
        const float* s = F.sub_keys + ((size_t)(hc * 128 + n)) * 128 + dg * 8;
        const f32x4 a = *(const f32x4*)s, b = *(const f32x4*)(s + 4);
        v4u o; o.x = pk2(a.x, a.y); o.y = pk2(a.z, a.w); o.z = pk2(b.x, b.y); o.w = pk2(b.z, b.w); ((v4u*)F.KEYS)[i] = o;
    }
    for (int i = gt; i < 8 * 128 * 16; i += NT) {
        const int t = (i >> 4) & 127, s0 = (i & 15) * 8;
        const float* s = F.sgu_w + (size_t)i * 8;
        const f32x4 a = *(const f32x4*)s, b = *(const f32x4*)(s + 4);
        float f[8] = {a.x, a.y, a.z, a.w, b.x, b.y, b.z, b.w};
#pragma unroll
        for (int e = 0; e < 8; ++e) f[e] = (s0 + e <= t) ? f[e] : 0.f;
        v4u o; o.x = pk2(f[0], f[1]); o.y = pk2(f[2], f[3]); o.z = pk2(f[4], f[5]); o.w = pk2(f[6], f[7]); ((v4u*)F.SGW)[i] = o;
    }
}

__device__ __forceinline__ void ph_hrows(Frame& F) {
    const int lane = lane_id(); const int gw = blockIdx.x * NWAVES + F.wave, NGW = F.G * NWAVES;
    const int rpw = (M + NGW - 1) / NGW, rbeg = gw * rpw, rend = (rbeg + rpw < M) ? rbeg + rpw : M;
    if (rbeg >= rend) return;
    f32x4 s1[4], sh1[4]; int cb = -1;
    f32x4 v[4], vn[4];
#define HR_LOAD(dst, m_) do { const f32x4* xr = (const f32x4*)(F.x + (size_t)(m_) * D) + lane; _Pragma("unroll") for (int j = 0; j < 4; ++j) dst[j] = xr[64 * j]; } while (0)
    HR_LOAD(v, rbeg);
    for (int m = rbeg; m < rend; ++m) {
        if ((m >> 12) != cb) { cb = m >> 12; const float* md = F.mod + cb * 6144;
#pragma unroll
            for (int j = 0; j < 4; ++j) { const int c = 256 * j + 4 * lane;
                const f32x4 g = *(const f32x4*)(F.norm_g + c), sc = *(const f32x4*)(md + 1024 + c);
                s1[j] = g * (sc + 1.f); sh1[j] = *(const f32x4*)(md + c); } }
        { const int mn = (m + 1 < rend) ? m + 1 : m; HR_LOAD(vn, mn); }
        float ss = 0.f;
#pragma unroll
        for (int j = 0; j < 4; ++j) ss += (v[j].x * v[j].x + v[j].y * v[j].y) + (v[j].z * v[j].z + v[j].w * v[j].w);
        const float rstd = rsqrtf(wave_sum_dpp(ss) * (1.f / D) + EPS);
        float am = 0.f;
#pragma unroll
        for (int j = 0; j < 4; ++j) { const f32x4 hv = (v[j] * rstd) * s1[j] + sh1[j]; v[j] = hv;
            am = fmaxf(am, fmaxf(fmaxf(fabsf(hv.x), fabsf(hv.y)), fmaxf(fabsf(hv.z), fabsf(hv.w)))); }
        am = wave_max_dpp(am);
        const float s8 = am > 0.f ? 127.f / am : 1.f;
        unsigned* h8 = (unsigned*)(F.HA8 + (size_t)m * D) + lane;
#pragma unroll
        for (int j = 0; j < 4; ++j) { const int q0 = (int)rintf(v[j].x * s8), q1 = (int)rintf(v[j].y * s8), q2 = (int)rintf(v[j].z * s8), q3 = (int)rintf(v[j].w * s8);
            h8[64 * j] = (unsigned)((q0 & 255) | ((q1 & 255) << 8) | ((q2 & 255) << 16) | (q3 << 24)); }
        if (lane == 0) F.HAS[m] = 1.f / s8;
#pragma unroll
        for (int j = 0; j < 4; ++j) v[j] = vn[j];
    }
#undef HR_LOAD
}

__device__ __forceinline__ void ph_x1rows(Frame& F) {
    const int lane = lane_id(); const int gw = blockIdx.x * NWAVES + F.wave, NGW = F.G * NWAVES;
    const int rpw = (M + NGW - 1) / NGW, rbeg = gw * rpw, rend = (rbeg + rpw < M) ? rbeg + rpw : M;
    if (rbeg >= rend) return;
    f32x4 gg1[4], s2[4], sh2[4]; int cb = -1;
    f32x4 xv[4], xn[4]; v2u yw[4], yn[4];
#define XR_LOAD(dx, dy, m_) do { const f32x4* xr = (const f32x4*)(F.x + (size_t)(m_) * D) + lane; const v2u* yr = (const v2u*)(F.Y + (size_t)(m_) * D) + lane; \
        _Pragma("unroll") for (int j = 0; j < 4; ++j) { dx[j] = xr[64 * j]; dy[j] = yr[64 * j]; } } while (0)
    XR_LOAD(xv, yw, rbeg);
    for (int m = rbeg; m < rend; ++m) {
        if ((m >> 12) != cb) { cb = m >> 12; const float* md = F.mod + cb * 6144;
#pragma unroll
            for (int j = 0; j < 4; ++j) { const int c = 256 * j + 4 * lane;
                const f32x4 g1 = *(const f32x4*)(F.norm_g + 1024 + c), gt = *(const f32x4*)(md + 2048 + c);
                const f32x4 g2 = *(const f32x4*)(F.norm_g + 2048 + c), sc = *(const f32x4*)(md + 4096 + c);
                gg1[j] = gt * g1; s2[j] = g2 * (sc + 1.f); sh2[j] = *(const f32x4*)(md + 3072 + c); } }
        { const int mn = (m + 1 < rend) ? m + 1 : m; XR_LOAD(xn, yn, mn); }
        f32x4 yv[4]; float ss = 0.f;
#pragma unroll
        for (int j = 0; j < 4; ++j) { const v2u w = yw[j]; yv[j] = (f32x4){bflo(w.x), bfhi(w.x), bflo(w.y), bfhi(w.y)};
            ss += (yv[j].x * yv[j].x + yv[j].y * yv[j].y) + (yv[j].z * yv[j].z + yv[j].w * yv[j].w); }
        const float rstd = rsqrtf(wave_sum_dpp(ss) * (1.f / D) + EPS);
        v2u* orow = (v2u*)(F.X1B + (size_t)m * D) + lane; float s1 = 0.f;
#pragma unroll
        for (int j = 0; j < 4; ++j) { xv[j] = xv[j] + (yv[j] * rstd) * gg1[j]; orow[64 * j] = (v2u){pk2(xv[j].x, xv[j].y), pk2(xv[j].z, xv[j].w)};
            s1 += (xv[j].x * xv[j].x + xv[j].y * xv[j].y) + (xv[j].z * xv[j].z + xv[j].w * xv[j].w); }
        const float r1 = rsqrtf(wave_sum_dpp(s1) * (1.f / D) + EPS);
        float am = 0.f;
#pragma unroll
        for (int j = 0; j < 4; ++j) { const f32x4 hv = (xv[j] * r1) * s2[j] + sh2[j]; xv[j] = hv;
            am = fmaxf(am, fmaxf(fmaxf(fabsf(hv.x), fabsf(hv.y)), fmaxf(fabsf(hv.z), fabsf(hv.w)))); }
        am = wave_max_dpp(am);
        const float s8 = am > 0.f ? 127.f / am : 1.f;
        unsigned* h8 = (unsigned*)(F.H8 + (size_t)m * D) + lane;
#pragma unroll
        for (int j = 0; j < 4; ++j) { const int q0 = (int)rintf(xv[j].x * s8), q1 = (int)rintf(xv[j].y * s8), q2 = (int)rintf(xv[j].z * s8), q3 = (int)rintf(xv[j].w * s8);
            h8[64 * j] = (unsigned)((q0 & 255) | ((q1 & 255) << 8) | ((q2 & 255) << 16) | (q3 << 24)); }
        if (lane == 0) F.HS[m] = 1.f / s8;
#pragma unroll
        for (int j = 0; j < 4; ++j) { xv[j] = xn[j]; yw[j] = yn[j]; }
    }
#undef XR_LOAD
}

namespace att {
typedef float f32x16 __attribute__((ext_vector_type(16)));
typedef short s16x4 __attribute__((ext_vector_type(4)));
typedef short v4i16_t __attribute__((ext_vector_type(4)));
constexpr int QB = 256, KVB = 64;
constexpr int NS = 4;
constexpr int BTO = 288, BTN = 416;
constexpr int L_V = 0, L_K = NS * 16384, L_WS = L_K + NS * 8192, L_BT = L_WS + 2048, L_END = L_BT + 2048;
constexpr float C2 = 0.125f * 1.4426950408889634f;
__device__ __forceinline__ int v_st(int k, int c) { const int kk = (k & ~0xC) | ((k & 4) << 1) | ((k & 8) >> 1); return ((kk >> 3) * 4 + (c >> 5)) * 512 + ((kk & 7) * 32 + (c & 31)) * 2; }
__device__ __forceinline__ int v_rd_base(int lane) { return ((lane & 3) << 3) | (((lane >> 2) & 3) << 6) | (((lane >> 4) & 1) << 5) | (((lane >> 5) & 1) << 8); }
__device__ __forceinline__ unsigned v_src(int p) { const int sub = p >> 5, q = p & 31, kk = (sub >> 2) * 8 + (q >> 2), c = (sub & 3) * 32 + (q & 3) * 8;
    const int k = kk; return (unsigned)(k * INC + c) * 2u; }
__device__ __forceinline__ int crow(int r, int hi) { return (r & 3) + 8 * (r >> 2) + 4 * hi; }
typedef float f32x2_t __attribute__((ext_vector_type(2))); typedef __bf16 bf16x2_t __attribute__((ext_vector_type(2)));
__device__ __forceinline__ unsigned cvtpk(float lo, float hi) { const f32x2_t v = {lo, hi}; const bf16x2_t b = __builtin_convertvector(v, bf16x2_t); return __builtin_bit_cast(unsigned, b); }

__device__ __forceinline__ void attn_unit(Frame& F, int b, int h, int qb, float lam) {
    int tid = F.wave * 64 + lane_id(); asm volatile("" : "+v"(tid));
    const int lane = tid & 63, wid = F.wave, r32 = lane & 31, hi = lane >> 5;
    LAS unsigned char* lds = F.lds;
    LAS float* wsf = (LAS float*)(lds + L_WS) + wid * 64;
    const LAS float* bt = (const LAS float*)(lds + L_BT);
    const int q0 = qb * QB, qlo = q0 + wid * 32, qpos = qlo + r32;
    const size_t rowb = (size_t)b * SEQ;
    const int NT = (q0 + QB) / KVB;
    const unsigned kdoff = (unsigned)((tid >> 3) * INC + (((tid & 7) ^ ((tid >> 3) & 7)) * 8)) * 2u;
    const unsigned vdoff0 = v_src(tid), vdoff1 = v_src(tid + 512);
    const unsigned qoff = (unsigned)(r32 * INC + hi * 8) * 2u;
#define GLDS16(g_, lb_) do { unsigned sv_; asm volatile("s_mov_b32 %0, m0\n\ts_mov_b32 m0, %2\n\ts_nop 0\n\tglobal_load_lds_dwordx4 %1, off\n\ts_mov_b32 m0, %0" : "=&s"(sv_) : "v"(g_), "s"(lb_) : "memory"); } while (0)
#define DMA_K(t_, buf_) do { unsigned kd_ = kdoff; asm volatile("" : "+v"(kd_)); GLDS16(Kb + (size_t)(t_) * (KVB * INC * 2) + kd_, (unsigned)__builtin_amdgcn_readfirstlane((int)(uintptr_t)(lds + L_K + (buf_) * 8192 + wid * 1024))); } while (0)
#define DMA_V(t_, buf_) do { unsigned v0_ = vdoff0, v1_ = vdoff1; asm volatile("" : "+v"(v0_), "+v"(v1_)); const unsigned lb_ = (unsigned)__builtin_amdgcn_readfirstlane((int)(uintptr_t)(lds + L_V + (buf_) * 16384 + wid * 1024)); \
        GLDS16(Vb + (size_t)(t_) * (KVB * INC * 2) + v0_, lb_); GLDS16(Vb + (size_t)(t_) * (KVB * INC * 2) + v1_, lb_ + 8192u); } while (0)
#define DMA_TILE(t_) do { const int sl_ = (t_) & (NS - 1); DMA_K(t_, sl_); DMA_V(t_, sl_); } while (0)
#define ABAR() do { asm volatile("s_waitcnt lgkmcnt(0)" ::: "memory"); __builtin_amdgcn_s_barrier(); asm volatile("" ::: "memory"); } while (0)
    const int vbase = (int)(uintptr_t)(lds + L_V) + v_rd_base(lane);
    const int kroff = r32 * 128, kx = (r32 & 7) << 4;
#pragma unroll
    for (int c = 0; c < 2; ++c) {
        const char* Kb = (const char*)(F.Z + rowb * INC + 1536 + h * 128 + c * 64);
        const char* Vb = (const char*)(F.Z + rowb * INC + 2048 + h * 128);
        const char* Qb = (const char*)(F.Z + (rowb + qlo) * INC + 1024 + h * 128 + c * 64);
        bf16x8 qr[4];
#pragma unroll
        for (int d0 = 0; d0 < 4; ++d0) qr[d0] = *(const bf16x8*)(Qb + d0 * 32 + qoff);
        DMA_K(0, 0); DMA_V(0, 0); DMA_K(1, 1); DMA_K(2, 2); DMA_V(1, 1); DMA_K(3, 3); DMA_V(2, 2);
        asm volatile("s_waitcnt vmcnt(9)" ::: "memory");
        ABAR();
        float mhat, l = 0.f; bool resc = false;
        f32x16 o[4];
#pragma unroll
        for (int d0 = 0; d0 < 4; ++d0) o[d0] = f32x16{};
        f32x16 pA0, pA1, pB0, pB1; bf16x8 kf[4]; s16x4 vlo[4], vhi[4]; v4u pw0, pw1, pw2, pw3;
        f32x16 negm; { float z_ = 0.f; asm volatile("" : "+v"(z_));
#pragma unroll
          for (int r = 0; r < 16; ++r) negm[r] = z_; }
        asm volatile("" : "+v"(negm));
#define SBAR() __builtin_amdgcn_sched_barrier(0)
#define PIN(x) asm volatile("" : "+v"(x))
#define MFMA32(a_, b_, c_) __builtin_amdgcn_mfma_f32_32x32x16_bf16(a_, b_, c_, 0, 0, 0)
#define KLD2(su, d0) do { const LAS unsigned char* a_ = lds + L_K + (su) * 8192 + kroff + (((d0) * 32 + hi * 16) ^ kx); kf[2 * ((d0) & 1)] = *(const LAS bf16x8*)a_; kf[2 * ((d0) & 1) + 1] = *(const LAS bf16x8*)(a_ + 4096); } while (0)
#define VTR(p_) __builtin_bit_cast(s16x4, __builtin_amdgcn_ds_read_tr16_b64_v4i16((LAS v4i16_t*)(p_)))
#define VRD(i) do { const LAS unsigned char* p_ = vp_ + ((i) >> 2) * 512 + ((i) & 3) * 4096; vlo[(i) & 3] = VTR(p_); vhi[(i) & 3] = VTR(p_ + 2048); } while (0)
#define VFR(i) (bf16x8){vlo[(i) & 3][0], vlo[(i) & 3][1], vlo[(i) & 3][2], vlo[(i) & 3][3], vhi[(i) & 3][0], vhi[(i) & 3][1], vhi[(i) & 3][2], vhi[(i) & 3][3]}
#define PAF(k) __builtin_bit_cast(bf16x8, pw##k)
#define MX3(a_, b_, c_) fmaxf(fmaxf((a_), (b_)), (c_))
#define ROWMAX(P0, P1, OUT) do { float a_ = MX3(P0[0], P0[1], P1[0]), b_ = MX3(P0[2], P0[3], P1[1]); a_ = MX3(a_, P1[2], P1[3]); \
        _Pragma("unroll") for (int r = 4; r < 16; r += 4) { a_ = MX3(a_, P0[r], P0[r + 1]); b_ = MX3(b_, P0[r + 2], P0[r + 3]); a_ = MX3(a_, P1[r], P1[r + 1]); b_ = MX3(b_, P1[r + 2], P1[r + 3]); } \
        float m_ = fmaxf(a_, b_); auto rr_ = __builtin_amdgcn_permlane32_swap(__float_as_uint(m_), __float_as_uint(m_), false, false); OUT = fmaxf(__uint_as_float(rr_[0]), __uint_as_float(rr_[1])); } while (0)
#define FIX_TILE(N0, N1, u) do { if (qlo - (u) * KVB - 63 < 113) { int qp_ = qpos - 4 * hi; asm volatile("" : "+v"(qp_)); const int dq_ = qp_ - (u) * KVB + BTO;     \
        _Pragma("unroll") for (int r = 0; r < 16; ++r) { const int i0_ = dq_ - ((r & 3) + 8 * (r >> 2)), i1_ = i0_ - 32; \
            N0[r] += bt[i0_ > BTN - 1 ? BTN - 1 : i0_]; N1[r] += bt[i1_ > BTN - 1 ? BTN - 1 : (i1_ < 0 ? 0 : i1_)]; } } } while (0)
#define EX(v) __builtin_amdgcn_exp2f(v)
#define RESC() do { if (resc) { _Pragma("unroll") for (int r = 0; r < 16; ++r) { const float a_ = wsf[crow(r, hi)]; _Pragma("unroll") for (int d0 = 0; d0 < 4; ++d0) o[d0][r] *= a_; } } } while (0)
#define PKH0(P, B_, PW) do { PW.x = cvtpk(P[B_ + 0], P[B_ + 1]); PW.y = cvtpk(P[B_ + 2], P[B_ + 3]); } while (0)
#define PKH1(P, B_, PW) do { PW.z = cvtpk(P[B_ + 4], P[B_ + 5]); PW.w = cvtpk(P[B_ + 6], P[B_ + 7]); } while (0)
#define GAPA(MF, a0, a1, a2, a3, PK, PW) do { MF; sacc += a0; sacc += a1; sacc += a2; sacc += a3; PK; PIN(PW); PIN(sacc); SBAR(); } while (0)
#define GAPB(MF, X, i) do { MF; X[i] = EX(X[i]); X[i + 1] = EX(X[i + 1]); PIN(X); SBAR(); } while (0)
        KLD2(0, 0); KLD2(0, 1);
        pA0 = MFMA32(kf[0], qr[0], negm); pA1 = MFMA32(kf[1], qr[0], negm); pA0 = MFMA32(kf[2], qr[1], pA0); pA1 = MFMA32(kf[3], qr[1], pA1);
        KLD2(0, 2); KLD2(0, 3);
        pA0 = MFMA32(kf[0], qr[2], pA0); pA1 = MFMA32(kf[1], qr[2], pA1); pA0 = MFMA32(kf[2], qr[3], pA0); pA1 = MFMA32(kf[3], qr[3], pA1);
        FIX_TILE(pA0, pA1, 0);
        { float rm; ROWMAX(pA0, pA1, rm); mhat = rm;
#pragma unroll
          for (int r = 0; r < 16; ++r) negm[r] = -mhat;
          asm volatile("" : "+v"(negm));
#pragma unroll
          for (int r = 0; r < 16; ++r) { pA0[r] = EX(pA0[r] - rm); pA1[r] = EX(pA1[r] - rm); } }
        asm volatile("s_waitcnt vmcnt(5)" ::: "memory");
        ABAR();
        KLD2(1, 0); KLD2(1, 1);
#define STEP(C0, C1, P0, P1, t) do { SBAR(); \
        if ((t) + 3 < NT) DMA_K((t) + 3, ((t) + 3) & (NS - 1)); if ((t) + 2 < NT) DMA_V((t) + 2, ((t) + 2) & (NS - 1)); \
        const LAS unsigned char* vp_ = (const LAS unsigned char*)(uintptr_t)(vbase + (((t) - 1) & (NS - 1)) * 16384); \
        const int ksl_ = ((t) + 1) & (NS - 1); const bool gl_ = (t) + 1 < NT; \
        float sacc = 0.f; \
                        GAPA(C0 = MFMA32(kf[0], qr[0], negm), P0[0], P0[1], P0[2], P0[3],     PKH0(P0, 0, pw0), pw0); \
                        GAPA(C1 = MFMA32(kf[1], qr[0], negm), P0[4], P0[5], P0[6], P0[7],     PKH1(P0, 0, pw0), pw0); KLD2((t) & (NS - 1), 2); SBAR();     \
                        GAPA(C0 = MFMA32(kf[2], qr[1], C0),   P0[8], P0[9], P0[10], P0[11],   PKH0(P0, 8, pw1), pw1); \
                        GAPA(C1 = MFMA32(kf[3], qr[1], C1),   P0[12], P0[13], P0[14], P0[15], PKH1(P0, 8, pw1), pw1); KLD2((t) & (NS - 1), 3); SBAR(); \
        VRD(0); SBAR(); GAPA(C0 = MFMA32(kf[0], qr[2], C0),   P1[0], P1[1], P1[2], P1[3],     PKH0(P1, 0, pw2), pw2); \
        VRD(1); SBAR(); GAPA(C1 = MFMA32(kf[1], qr[2], C1),   P1[4], P1[5], P1[6], P1[7],     PKH1(P1, 0, pw2), pw2); \
        VRD(2); SBAR(); GAPA(C0 = MFMA32(kf[2], qr[3], C0),   P1[8], P1[9], P1[10], P1[11],   PKH0(P1, 8, pw3), pw3); \
        VRD(3); SBAR(); GAPA(C1 = MFMA32(kf[3], qr[3], C1),   P1[12], P1[13], P1[14], P1[15], PKH1(P1, 8, pw3), pw3); \
        l += sacc; \
        FIX_TILE(C0, C1, t); \
        { float rm_; ROWMAX(C0, C1, rm_); resc = false;                                                    \
          if (__builtin_expect(__any(rm_ > 8.0f), 0)) { const float dl_ = fmaxf(rm_, 0.f); mhat += dl_;     \
              _Pragma("unroll") for (int r = 0; r < 16; ++r) { C0[r] -= dl_; C1[r] -= dl_; } \
              _Pragma("unroll") for (int r = 0; r < 16; ++r) negm[r] = -mhat; \
              asm volatile("" : "+v"(negm)); \
              const float f_ = __builtin_amdgcn_exp2f(-dl_); l *= f_; if (hi == 0) wsf[r32] = f_; resc = true; } } \
        SBAR(); \
        GAPB(o[0] = MFMA32(PAF(0), VFR(0), o[0]), C0, 0);   VRD(4);  SBAR(); \
        GAPB(o[0] = MFMA32(PAF(1), VFR(1), o[0]), C0, 2);   VRD(5);  SBAR(); \
        GAPB(o[0] = MFMA32(PAF(2), VFR(2), o[0]), C0, 4);   VRD(6);  SBAR(); \
        GAPB(o[0] = MFMA32(PAF(3), VFR(3), o[0]), C0, 6);   VRD(7);  SBAR(); \
        GAPB(o[1] = MFMA32(PAF(0), VFR(4), o[1]), C0, 8);   VRD(8);  SBAR(); \
        GAPB(o[1] = MFMA32(PAF(1), VFR(5), o[1]), C0, 10);  VRD(9);  SBAR(); \
        GAPB(o[1] = MFMA32(PAF(2), VFR(6), o[1]), C0, 12);  VRD(10); SBAR(); \
        GAPB(o[1] = MFMA32(PAF(3), VFR(7), o[1]), C0, 14);  VRD(11); SBAR(); \
        GAPB(o[2] = MFMA32(PAF(0), VFR(8), o[2]), C1, 0);   VRD(12); SBAR(); \
        GAPB(o[2] = MFMA32(PAF(1), VFR(9), o[2]), C1, 2);   VRD(13); SBAR(); \
        GAPB(o[2] = MFMA32(PAF(2), VFR(10), o[2]), C1, 4);  VRD(14); SBAR(); \
        GAPB(o[2] = MFMA32(PAF(3), VFR(11), o[2]), C1, 6);  VRD(15); SBAR(); \
        GAPB(o[3] = MFMA32(PAF(0), VFR(12), o[3]), C1, 8);  if (gl_) { KLD2(ksl_, 0); SBAR(); } \
        GAPB(o[3] = MFMA32(PAF(1), VFR(13), o[3]), C1, 10); if (gl_) { KLD2(ksl_, 1); SBAR(); } \
        GAPB(o[3] = MFMA32(PAF(2), VFR(14), o[3]), C1, 12); \
        GAPB(o[3] = MFMA32(PAF(3), VFR(15), o[3]), C1, 14); \
        if ((t) + 3 < NT) asm volatile("s_waitcnt vmcnt(5)" ::: "memory"); else asm volatile("s_waitcnt vmcnt(0)" ::: "memory"); \
        ABAR(); RESC(); } while (0)
        if (wid >= 4) __builtin_amdgcn_s_setprio(1);
        {
            int t = 1;
            for (; t + 1 < NT; t += 2) {
                STEP(pB0, pB1, pA0, pA1, t);
                STEP(pA0, pA1, pB0, pB1, t + 1);
            }
            STEP(pB0, pB1, pA0, pA1, NT - 1);
        }
        __builtin_amdgcn_s_setprio(0);
        { float sacc = 0.f;
#pragma unroll
          for (int r = 0; r < 16; ++r) sacc += pB0[r];
#pragma unroll
          for (int r = 0; r < 16; ++r) sacc += pB1[r];
          l += sacc;
          PKH0(pB0, 0, pw0); PKH1(pB0, 0, pw0); PKH0(pB0, 8, pw1); PKH1(pB0, 8, pw1); PKH0(pB1, 0, pw2); PKH1(pB1, 0, pw2); PKH0(pB1, 8, pw3); PKH1(pB1, 8, pw3);
          const LAS unsigned char* vp_ = (const LAS unsigned char*)(uintptr_t)(vbase + ((NT - 1) & (NS - 1)) * 16384);
#pragma unroll
          for (int db = 0; db < 4; ++db) { VRD(0); VRD(1); VRD(2); VRD(3);
              o[db] = MFMA32(PAF(0), VFR(0), o[db]); o[db] = MFMA32(PAF(1), VFR(1), o[db]); o[db] = MFMA32(PAF(2), VFR(2), o[db]); o[db] = MFMA32(PAF(3), VFR(3), o[db]); vp_ += 512; } }
        { auto rr_ = __builtin_amdgcn_permlane32_swap(__float_as_uint(l), __float_as_uint(l), false, false); l = __uint_as_float(rr_[0]) + __uint_as_float(rr_[1]); }
#undef SBAR
#undef PIN
#undef MFMA32
#undef KLD2
#undef VTR
#undef VRD
#undef VFR
#undef PAF
#undef MX3
#undef ROWMAX
#undef FIX_TILE
#undef EX
#undef RESC
#undef PKH0
#undef PKH1
#undef GAPA
#undef GAPB
#undef STEP
        int lane_e = lane_id(); asm volatile("" : "+v"(lane_e));
        const int r32e = lane_e & 31, hie = lane_e >> 5;
        const unsigned o0off = (unsigned)((blockIdx.x * NTHR + wid * 64 + lane_e) * 128);
        if (hie == 0) wsf[32 + r32e] = l;
        float rl[16];
#pragma unroll
        for (int r = 0; r < 16; ++r) rl[r] = __builtin_amdgcn_rcpf(wsf[32 + crow(r, hie)]);
        if (c == 0) {
#pragma unroll
            for (int d0 = 0; d0 < 4; ++d0)
#pragma unroll
                for (int j = 0; j < 2; ++j) { v4u w;
                    w.x = cvtpk(o[d0][8 * j + 0] * rl[8 * j + 0], o[d0][8 * j + 1] * rl[8 * j + 1]); w.y = cvtpk(o[d0][8 * j + 2] * rl[8 * j + 2], o[d0][8 * j + 3] * rl[8 * j + 3]);
                    w.z = cvtpk(o[d0][8 * j + 4] * rl[8 * j + 4], o[d0][8 * j + 5] * rl[8 * j + 5]); w.w = cvtpk(o[d0][8 * j + 6] * rl[8 * j + 6], o[d0][8 * j + 7] * rl[8 * j + 7]);
                    *(v4u*)((char*)F.STASH + o0off + (d0 * 2 + j) * 16) = w; }
        } else {
            float ss[16];
#pragma unroll
            for (int r = 0; r < 16; ++r) ss[r] = 0.f;
#pragma unroll
            for (int d0 = 0; d0 < 4; ++d0)
#pragma unroll
                for (int j = 0; j < 2; ++j) { const v4u w = *(const v4u*)((const char*)F.STASH + o0off + (d0 * 2 + j) * 16); const unsigned ww[4] = {w.x, w.y, w.z, w.w};
#pragma unroll
                    for (int k = 0; k < 4; ++k) { const int i = 4 * j + k;
                        const float a0 = bflo(ww[k]) - lam * (o[d0][2 * i] * rl[2 * i]), a1 = bfhi(ww[k]) - lam * (o[d0][2 * i + 1] * rl[2 * i + 1]);
                        o[d0][2 * i] = a0; o[d0][2 * i + 1] = a1; ss[2 * i] += a0 * a0; ss[2 * i + 1] += a1 * a1; } }
#pragma unroll
            for (int r = 0; r < 16; ++r) {
                { DPP_SUM_ROW(ss[r]); ss[r] += __shfl_xor(ss[r], 16); }
                ss[r] = rsqrtf(ss[r] * (1.f / 128.f) + EPS) * 0.8f;
            }
            bf16* Cw = F.CAT + (rowb + qlo) * 1024 + 512 + h * 128;
#pragma unroll
            for (int d0 = 0; d0 < 4; ++d0) { const float g = F.subln_g[d0 * 32 + r32e];
                unsigned off = (unsigned)((4 * hie * 1024 + d0 * 32 + r32e) * 2);
#pragma unroll
                for (int r = 0; r < 16; ++r) { const float v = o[d0][r] * ss[r] * g; const float vn = dpp_xor1(v);
                    if ((r32e & 1) == 0) *(unsigned*)((char*)Cw + off) = cvtpk(v, vn);
                    off += ((r & 3) == 3) ? 5u * 2048u : 2048u; asm volatile("" : "+v"(off)); } }
        }
        __syncthreads();
    }
#undef DMA_K
#undef DMA_V
#undef DMA_TILE
#undef ABAR
}

__device__ __forceinline__ void attn_phase(Frame& F) {
    const int lane = lane_id(), tid = F.wave * 64 + lane;
    const float s01 = wave_sum(F.diff_lambda[lane] * F.diff_lambda[64 + lane]), s23 = wave_sum(F.diff_lambda[128 + lane] * F.diff_lambda[192 + lane]);
    const float lam = __expf(s01) - __expf(s23) + 0.2f;
    const int G = F.G;
    for (int it = ((G % 8 == 0) ? ((int)(blockIdx.x % 8) * (G / 8) + (int)blockIdx.x / 8) : (int)blockIdx.x); it < 256; it += G) {
        const int bh = it >> 3, x = it & 7, b = bh >> 2, h = bh & 3;
        LAS float* bt = (LAS float*)(F.lds + L_BT);
        __syncthreads();
        if (tid < BTN) { const int d = tid - BTO; int bk = d; if (d >= 16) { bk = 16 + (int)(__log2f((float)d * (1.f / 16.f)) * (16.f / 3.f)); bk = bk > 31 ? 31 : bk; }
            bt[tid] = d < 0 ? -__builtin_inff() : (F.rel_bias[bk * 4 + h] - F.rel_bias[31 * 4 + h]) * 1.4426950408889634f; }
        __syncthreads();
        attn_unit(F, b, h, x, lam);
        attn_unit(F, b, h, 15 - x, lam);
    }
}
}

namespace sgu {
typedef float f32x16 __attribute__((ext_vector_type(16)));
typedef short s16x4 __attribute__((ext_vector_type(4)));
constexpr int L_T = 0, L_ST = 65536;
__device__ __forceinline__ void sgu_chunk(Frame& F, int chunk) {
    int tid = F.wave * 64 + lane_id(); asm volatile("" : "+v"(tid));
    const int lane = tid & 63, g = F.wave, r32 = lane & 31, hi = lane >> 5;
    LAS unsigned char* lds = F.lds;
    LAS float* st = (LAS float*)(lds + L_ST);
    const size_t t0 = (size_t)chunk * 128;
    for (int i = 0; i < 16; i += 2) {
        v4u raw[2];
#pragma unroll
        for (int u = 0; u < 2; ++u) raw[u] = *(const v4u*)(F.Z + (t0 + g * 16 + i + u) * INC + 512 + lane * 8);
#pragma unroll
        for (int u = 0; u < 2; ++u) { const int tl = g * 16 + i + u;
            float f[8] = {bflo(raw[u].x), bfhi(raw[u].x), bflo(raw[u].y), bfhi(raw[u].y), bflo(raw[u].z), bfhi(raw[u].z), bflo(raw[u].w), bfhi(raw[u].w)};
            float s = 0.f;
#pragma unroll
            for (int e = 0; e < 8; ++e) s += f[e];
            const float mean = wave_sum_dpp(s) * (1.f / 512.f); float q = 0.f;
#pragma unroll
            for (int e = 0; e < 8; ++e) { f[e] -= mean; q += f[e] * f[e]; }
            const float rstd = rsqrtf(wave_sum_dpp(q) * (1.f / 512.f) + EPS);
            if (lane == 0) { st[2 * tl] = mean; st[2 * tl + 1] = rstd; } }
    }
    __syncthreads();
    f32x16 acc[2][2];
    const int sr = tid >> 4, sc = (tid & 15) * 8;
    const int vb0 = (int)(uintptr_t)(lds + L_T) + (g >> 1) * 16384 + att::v_rd_base(lane);
#define SGU_STAGE(sh) do { _Pragma("unroll") for (int tile = 0; tile < 4; ++tile) { const int ch = tile * 128 + sc; \
            const f32x4 g0 = *(const f32x4*)(F.sgu_ln_g + ch), g1 = *(const f32x4*)(F.sgu_ln_g + ch + 4), b0 = *(const f32x4*)(F.sgu_ln_b + ch), b1 = *(const f32x4*)(F.sgu_ln_b + ch + 4); \
            _Pragma("unroll") for (int rr = 0; rr < 2; ++rr) { const int s = (sh) * 64 + sr + 32 * rr; \
                const v4u raw = *(const v4u*)(F.Z + (t0 + s) * INC + 512 + ch); const float mean = st[2 * s], rstd = st[2 * s + 1]; v4u o; \
                o.x = pk2((bflo(raw.x) - mean) * rstd * g0.x + b0.x, (bfhi(raw.x) - mean) * rstd * g0.y + b0.y); \
                o.y = pk2((bflo(raw.y) - mean) * rstd * g0.z + b0.z, (bfhi(raw.y) - mean) * rstd * g0.w + b0.w); \
                o.z = pk2((bflo(raw.z) - mean) * rstd * g1.x + b1.x, (bfhi(raw.z) - mean) * rstd * g1.y + b1.y); \
                o.w = pk2((bflo(raw.w) - mean) * rstd * g1.z + b1.z, (bfhi(raw.w) - mean) * rstd * g1.w + b1.w); \
                *(LAS v4u*)(lds + L_T + tile * 16384 + att::v_st(sr + 32 * rr, sc)) = o; } } } while (0)
#define TRRD(dst, off) asm volatile("ds_read_b64_tr_b16 %0, %1 offset:%2" : "=&v"(dst) : "v"(vb0), "i"(off) : "memory")
#define SGU_MMA(sh, tb0) do { _Pragma("unroll") for (int ks = 0; ks < 4; ++ks) { s16x4 l0, h0, l1, h1; \
            if ((g & 1) == 0) { TRRD(l0, 0 * 512 + ks * 4096); TRRD(h0, 0 * 512 + ks * 4096 + 2048); TRRD(l1, 1 * 512 + ks * 4096); TRRD(h1, 1 * 512 + ks * 4096 + 2048); } \
            else              { TRRD(l0, 2 * 512 + ks * 4096); TRRD(h0, 2 * 512 + ks * 4096 + 2048); TRRD(l1, 3 * 512 + ks * 4096); TRRD(h1, 3 * 512 + ks * 4096 + 2048); } \
            asm volatile("s_waitcnt lgkmcnt(0)" ::: "memory"); __builtin_amdgcn_sched_barrier(0); \
            const bf16x8 B0 = (bf16x8){l0[0], l0[1], l0[2], l0[3], h0[0], h0[1], h0[2], h0[3]}, B1 = (bf16x8){l1[0], l1[1], l1[2], l1[3], h1[0], h1[1], h1[2], h1[3]}; \
            _Pragma("unroll") for (int tl = 0; tl < 2; ++tl) { const int tb = (tb0) + tl; if ((sh) * 64 + 16 * ks > tb * 32 + 31) continue; \
                const bf16x8 A = *(const bf16x8*)(F.SGW + ((size_t)(g * 128 + tb * 32 + r32)) * 128 + (sh) * 64 + 16 * ks + 8 * hi); \
                acc[tl][0] = __builtin_amdgcn_mfma_f32_32x32x16_bf16(A, B0, acc[tl][0], 0, 0, 0); \
                acc[tl][1] = __builtin_amdgcn_mfma_f32_32x32x16_bf16(A, B1, acc[tl][1], 0, 0, 0); } } } while (0)
#define SGU_EPI(tb0) do { _Pragma("unroll") for (int tl = 0; tl < 2; ++tl) _Pragma("unroll") for (int r = 0; r < 16; ++r) { \
            const int t = ((tb0) + tl) * 32 + att::crow(r, hi); const float bs = F.sgu_b[g * 128 + t]; \
            _Pragma("unroll") for (int db = 0; db < 2; ++db) { const int ch = g * 64 + db * 32 + r32; \
                const float u = bf2f(F.Z[(t0 + t) * INC + ch]); const float v = u * (acc[tl][db][r] + bs); const float vn = dpp_xor1(v); \
                if ((r32 & 1) == 0) *(unsigned*)(F.CAT + (t0 + t) * 1024 + ch) = att::cvtpk(v, vn); } } } while (0)
#define SGU_ZERO() do { acc[0][0] = f32x16{}; acc[0][1] = f32x16{}; acc[1][0] = f32x16{}; acc[1][1] = f32x16{}; } while (0)
    SGU_STAGE(0);
    __syncthreads();
    SGU_ZERO(); SGU_MMA(0, 0); SGU_EPI(0);
    SGU_ZERO(); SGU_MMA(0, 2);
    __syncthreads();
    SGU_STAGE(1);
    __syncthreads();
    SGU_MMA(1, 2); SGU_EPI(2);
#undef SGU_STAGE
#undef TRRD
#undef SGU_MMA
#undef SGU_EPI
#undef SGU_ZERO
}
__device__ __forceinline__ void sgu_phase(Frame& F) { for (int ck = blockIdx.x; ck < M / 128; ck += F.G) { sgu_chunk(F, ck); __syncthreads(); } }
}

namespace tk {
typedef float f32x16 __attribute__((ext_vector_type(16)));
__device__ __forceinline__ float vmax(float a, float b) { float r; asm("v_max_f32 %0, %1, %2" : "=v"(r) : "v"(a), "v"(b)); return r; }
__device__ __forceinline__ float vmin(float a, float b) { float r; asm("v_min_f32 %0, %1, %2" : "=v"(r) : "v"(a), "v"(b)); return r; }
#define TK_CE(a, b) do { const float _mx = vmax(a, b), _mn = vmin(a, b); a = _mx; b = _mn; } while (0)
template <int N> __device__ __forceinline__ void sort_desc(float (&a)[N]) {
#pragma unroll
    for (int k = 2; k <= N; k <<= 1)
#pragma unroll
        for (int j = k >> 1; j > 0; j >>= 1)
#pragma unroll
            for (int i = 0; i < N; ++i) { const int l = i ^ j; if (l > i) { if ((i & k) == 0) TK_CE(a[i], a[l]); else TK_CE(a[l], a[i]); } }
}
template <int N> __device__ __forceinline__ void merge_desc(float (&a)[N]) {
#pragma unroll
    for (int j = N >> 1; j > 0; j >>= 1)
#pragma unroll
        for (int i = 0; i < N; ++i) { const int l = i ^ j; if (l > i) TK_CE(a[i], a[l]); }
}
__device__ __forceinline__ void top16_merge(float (&a)[16], const float (&b)[16]) {
#pragma unroll
    for (int i = 0; i < 16; ++i) a[i] = vmax(a[i], b[15 - i]);
    merge_desc<16>(a);
}
__device__ __forceinline__ float embed(float v, unsigned mask, unsigned code) { return __uint_as_float((__float_as_uint(v) & mask) | code); }

__device__ __forceinline__ void topk_phase(Frame& F) {
    int lane = lane_id(); asm volatile("" : "+v"(lane));
    const int r32 = lane & 31, hi = lane >> 5;
    const int gw = blockIdx.x * NWAVES + F.wave, NGW = F.G * NWAVES;
    LAS unsigned* tab = (LAS unsigned*)(F.lds + F.wave * 8192) + lane;
    const float NEG = -__builtin_inff();
    constexpr int NTASK = (M / 32) * 8; const int per = (NTASK + NGW - 1) / NGW;
    unsigned code16[16];
#pragma unroll
    for (int r = 0; r < 16; ++r) code16[r] = (unsigned)((r & 3) + 8 * (r >> 2) + 4 * hi);
    const unsigned qoff = (unsigned)(r32 * NQ + hi * 8), koff = (unsigned)((hi * 128 + r32) * 8);
#define TK_QP(task_, c_) (F.QP + (size_t)((task_) >> 3) * 32 * NQ + ((task_) & 7) * 256 + (c_) * 128)
#define TK_KP(task_, c_) (F.KEYS + (size_t)((((task_) & 7) * 2 + (c_)) * 16) * 128 * 8)
#define TK_LDQ(dst, task_, c_) do { const bf16* qp_ = TK_QP(task_, c_); _Pragma("unroll") for (int ks = 0; ks < 8; ++ks) dst[ks] = *(const bf16x8*)(qp_ + ks * 16 + qoff); } while (0)
#define TK_LDK(dst, task_, c_, nb_) do { const bf16* kp_ = TK_KP(task_, c_); _Pragma("unroll") for (int ks = 0; ks < 8; ++ks) dst[ks] = *(const bf16x8*)(kp_ + ((2 * ks) * 128 + (nb_) * 32) * 8 + koff); } while (0)
    const int task_beg = gw * per, task_end = (gw * per + per < NTASK) ? gw * per + per : NTASK;
    bf16x8 qcur[8], kcur[8];
    if (task_beg < task_end) { TK_LDQ(qcur, task_beg, 0); TK_LDK(kcur, task_beg, 0, 0); }
    for (int task = task_beg; task < task_end; ++task) {
        const int tb = task >> 3, h = task & 7;
        const size_t trow = (size_t)tb * 32 + r32;
        float sk[2][16];
        float best[16];
#pragma unroll
        for (int st = 0; st < 8; ++st) {
            const int c = st >> 2, nb = st & 3;
            bf16x8 knxt[8], qnxt[8];
            if (st < 7) TK_LDK(knxt, task, (st + 1) >> 2, (st + 1) & 3);
            if (st == 3) TK_LDQ(qnxt, task, 1);
            f32x16 acc = f32x16{};
#pragma unroll
            for (int ks = 0; ks < 8; ++ks) acc = __builtin_amdgcn_mfma_f32_32x32x16_bf16(kcur[ks], qcur[ks], acc, 0, 0, 0);
            float cur[16];
#pragma unroll
            for (int r = 0; r < 16; ++r) { cur[r] = embed(acc[r], 0xFFFFFF80u, code16[r]); if (nb) cur[r] = __uint_as_float(__float_as_uint(cur[r]) | (unsigned)(nb * 32)); }
            sort_desc<16>(cur);
            if (nb == 0) {
#pragma unroll
                for (int i = 0; i < 16; ++i) best[i] = cur[i];
            } else top16_merge(best, cur);
            if (st < 7) {
#pragma unroll
                for (int ks = 0; ks < 8; ++ks) kcur[ks] = knxt[ks];
            }
            if (st == 3) {
#pragma unroll
                for (int ks = 0; ks < 8; ++ks) qcur[ks] = qnxt[ks];
            }
            if (nb == 3) {
                float pr[16];
#pragma unroll
                for (int i = 0; i < 16; ++i) { auto rr = __builtin_amdgcn_permlane32_swap(__float_as_uint(best[i]), __float_as_uint(best[i]), false, false);
                    pr[i] = __uint_as_float(hi ? rr[0] : rr[1]); }
                top16_merge(best, pr);
#pragma unroll
                for (int i = 0; i < 16; ++i) sk[c][i] = best[i];
            }
            __builtin_amdgcn_sched_barrier(0);
        }
        { const int tn = (task + 1 < task_end) ? task + 1 : task; TK_LDQ(qcur, tn, 0); TK_LDK(kcur, tn, 0, 0); }
#pragma unroll
        for (int i = 0; i < 16; ++i) { tab[i * 64] = __float_as_uint(sk[0][i]); tab[(16 + i) * 64] = __float_as_uint(sk[1][i]); }
        float T[16], G1[16], G2[16];
#pragma unroll
        for (int j = 0; j < 16; ++j) T[j] = embed(sk[0][0] + sk[1][j], 0xFFFFFF00u, (unsigned)j);
#pragma unroll
        for (int j = 0; j < 8; ++j) { G1[j] = embed(sk[0][1] + sk[1][j], 0xFFFFFF00u, (unsigned)(16 + j)); G1[8 + j] = embed(sk[0][15 - j] + sk[1][0], 0xFFFFFF00u, (unsigned)((15 - j) << 4)); }
        merge_desc<16>(G1);
        top16_merge(T, G1);
#pragma unroll
        for (int j = 0; j < 5; ++j) G2[j] = embed(sk[0][2] + sk[1][j], 0xFFFFFF00u, (unsigned)(32 + j));
#pragma unroll
        for (int j = 0; j < 4; ++j) G2[5 + j] = embed(sk[0][3] + sk[1][j], 0xFFFFFF00u, (unsigned)(48 + j));
#pragma unroll
        for (int j = 0; j < 3; ++j) G2[9 + j] = embed(sk[0][4] + sk[1][j], 0xFFFFFF00u, (unsigned)(64 + j));
#pragma unroll
        for (int j = 0; j < 2; ++j) { G2[12 + j] = embed(sk[0][5] + sk[1][j], 0xFFFFFF00u, (unsigned)(80 + j)); G2[14 + j] = embed(sk[0][6] + sk[1][j], 0xFFFFFF00u, (unsigned)(96 + j)); }
        sort_desc<16>(G2);
        top16_merge(T, G2);
        T[15] = vmax(T[15], embed(sk[0][7] + sk[1][0], 0xFFFFFF00u, 112u)); T[14] = vmax(T[14], embed(sk[0][7] + sk[1][1], 0xFFFFFF00u, 113u));
        merge_desc<16>(T);
        const float mx = __uint_as_float(__float_as_uint(T[0]) & 0xFFFFFF00u);
        float e[16]; float den = 0.f;
#pragma unroll
        for (int k = 0; k < 16; ++k) { e[k] = __builtin_amdgcn_exp2f((__uint_as_float(__float_as_uint(T[k]) & 0xFFFFFF00u) - mx) * 1.4426950408889634f); den += e[k]; }
        const float rden = 1.f / den;
        int eo[8]; float go[8];
#pragma unroll
        for (int k = 0; k < 8; ++k) {
            const unsigned code = __float_as_uint(hi ? T[k + 8] : T[k]) & 255u;
            const unsigned a1 = tab[(code >> 4) * 64] & 127u, a2 = tab[(16 + (code & 15u)) * 64] & 127u;
            eo[k] = (int)(a1 * 128u + a2); go[k] = (hi ? e[k + 8] : e[k]) * rden;
        }
        int* ip = F.IDX + trow * PKN + h * 16 + hi * 8; float* gp = F.GATE + trow * PKN + h * 16 + hi * 8;
        *(v4u*)ip = (v4u){(unsigned)eo[0], (unsigned)eo[1], (unsigned)eo[2], (unsigned)eo[3]}; *(v4u*)(ip + 4) = (v4u){(unsigned)eo[4], (unsigned)eo[5], (unsigned)eo[6], (unsigned)eo[7]};
        *(f32x4*)gp = (f32x4){go[0], go[1], go[2], go[3]}; *(f32x4*)(gp + 4) = (f32x4){go[4], go[5], go[6], go[7]};
    }
    (void)NEG;
}
#undef TK_CE
#undef TK_QP
#undef TK_KP
#undef TK_LDQ
#undef TK_LDK
}

namespace pe {
typedef float f32x2 __attribute__((ext_vector_type(2)));
__device__ __forceinline__ f32x2 cvlo(unsigned w) { return __builtin_amdgcn_cvt_pk_f32_fp8((int)w, false); }
__device__ __forceinline__ f32x2 cvhi(unsigned w) { return __builtin_amdgcn_cvt_pk_f32_fp8((int)w, true); }
__device__ __forceinline__ float dot16(const v4u r, const f32x2 (&hf)[8]) {
    f32x2 a = cvlo(r.x) * hf[0]; f32x2 b = cvhi(r.x) * hf[1];
    a = cvlo(r.y) * hf[2] + a; b = cvhi(r.y) * hf[3] + b; a = cvlo(r.z) * hf[4] + a; b = cvhi(r.z) * hf[5] + b; a = cvlo(r.w) * hf[6] + a; b = cvhi(r.w) * hf[7] + b;
    a = a + b; return a.x + a.y;
}
#define PE_W(WREG, i) __uint_as_float(__builtin_amdgcn_readlane(__float_as_uint(WREG), (i)))
#ifndef FP6_INTERLEAVED
#define FP6_INTERLEAVED 1
#endif
typedef unsigned v6u __attribute__((ext_vector_type(6)));
typedef float v32f __attribute__((ext_vector_type(32)));
typedef float v16f __attribute__((ext_vector_type(16)));
struct Row6 { v4u q4; v2u q2; };
#ifndef PV6_G
#define PV6_G 2
#endif
#define PV6_LOAD(dst, EREG, i) do { const int ea_ = __builtin_amdgcn_readlane(EREG, 2 * (i)), eb_ = __builtin_amdgcn_readlane(EREG, 2 * (i) + 1); \
        const unsigned char* rp_ = F.VT6 + (size_t)(half ? eb_ : ea_) * 768; dst.q4 = *(const v4u*)(rp_ + l16); dst.q2 = *(const v2u*)(rp_ + 512 + l8); } while (0)
#define PV6_ACC(src, WREG, i) do { const float wa_ = PE_W(WREG, 2 * (i)), wb_ = PE_W(WREG, 2 * (i) + 1); const float w_ = half ? wb_ : wa_; const f32x2 ww_ = {w_, w_}; \
        const v6u pk_ = {src.q4.x, src.q4.y, src.q4.z, src.q4.w, src.q2.x, src.q2.y}; const v32f d_ = __builtin_amdgcn_cvt_scalef32_pk32_f32_fp6(pk_, 1.0f); \
        _Pragma("unroll") for (int k = 0; k < 16; ++k) acc[k] = (f32x2){d_[2 * k], d_[2 * k + 1]} * ww_ + acc[k]; __builtin_amdgcn_sched_barrier(0); } while (0)
#define PV6_BATCH(EREG, WREG) do { Row6 bufA[PV6_G], bufB[PV6_G];             \
        _Pragma("unroll") for (int i = 0; i < PV6_G; ++i) PV6_LOAD(bufA[i], EREG, i); \
        _Pragma("unroll") for (int gq = 0; gq < 32 / PV6_G; gq += 2) { \
            _Pragma("unroll") for (int i = 0; i < PV6_G; ++i) PV6_LOAD(bufB[i], EREG, (gq + 1) * PV6_G + i); \
            _Pragma("unroll") for (int i = 0; i < PV6_G; ++i) PV6_ACC(bufA[i], WREG, gq * PV6_G + i); \
            if (gq + 2 < 32 / PV6_G) { _Pragma("unroll") for (int i = 0; i < PV6_G; ++i) PV6_LOAD(bufA[i], EREG, (gq + 2) * PV6_G + i); } \
            _Pragma("unroll") for (int i = 0; i < PV6_G; ++i) PV6_ACC(bufB[i], WREG, (gq + 1) * PV6_G + i); } } while (0)

#define PU_IDX(dst, tt) do { const v4u* ip_ = (const v4u*)(F.IDX + (size_t)(tt) * PKN + (lane >> 3) * 16); _Pragma("unroll") for (int q_ = 0; q_ < 4; ++q_) { const v4u w_ = ip_[q_]; dst[4 * q_] = (int)w_.x; dst[4 * q_ + 1] = (int)w_.y; dst[4 * q_ + 2] = (int)w_.z; dst[4 * q_ + 3] = (int)w_.w; } } while (0)
#define PU_GATHER(dst, idx) do { _Pragma("unroll") for (int i = 0; i < 16; ++i) dst[i] = *(const v4u*)(ub + (unsigned)idx[i] * 128u + coff); } while (0)
#define PU_HS(dst, tt) do { dst[0] = *(const v4u*)(F.H8 + (size_t)(tt) * D + x * 128 + (lane & 7) * 16); } while (0)
#define PU_COMPUTE(seg, hraw, tt) do { int p[16]; \
        _Pragma("unroll") for (int i = 0; i < 16; ++i) { int a_ = __builtin_amdgcn_sdot4((int)seg[i].x, (int)hraw[0].x, 0, false); a_ = __builtin_amdgcn_sdot4((int)seg[i].y, (int)hraw[0].y, a_, false); \
            a_ = __builtin_amdgcn_sdot4((int)seg[i].z, (int)hraw[0].z, a_, false); p[i] = __builtin_amdgcn_sdot4((int)seg[i].w, (int)hraw[0].w, a_, false); }     \
          \
        _Pragma("unroll") for (int i = 0; i < 8; ++i) { const bool bt = (lane & 4) != 0; const int sd = bt ? p[i] : p[i + 8], kp = bt ? p[i + 8] : p[i]; p[i] = kp + __builtin_amdgcn_update_dpp(0, sd, 0x141, 0xF, 0xF, false); } \
        _Pragma("unroll") for (int i = 0; i < 4; ++i) { const bool bt = (lane & 2) != 0; const int sd = bt ? p[i] : p[i + 4], kp = bt ? p[i + 4] : p[i]; p[i] = kp + __builtin_amdgcn_update_dpp(0, sd, 0x4E, 0xF, 0xF, false); } \
        _Pragma("unroll") for (int i = 0; i < 2; ++i) { const bool bt = (lane & 1) != 0; const int sd = bt ? p[i] : p[i + 2], kp = bt ? p[i + 2] : p[i]; p[i] = kp + __builtin_amdgcn_update_dpp(0, sd, 0xB1, 0xF, 0xF, false); } \
        ((unsigned*)F.PART)[((size_t)x * M + (tt)) * 64 + lane] = att::cvtpk((float)p[0], (float)p[1]); } while (0)
__device__ __forceinline__ void peer_u_phase(Frame& F, const int c0, const int cn, const int w0, const int nw) {
    int lane = lane_id(); asm volatile("" : "+v"(lane));
    const int wave = F.wave;
    if (wave < w0 || wave >= w0 + nw) return;
    const unsigned coff = (unsigned)(lane & 7) * 16u;
    const int per_blk = cn / 32, per_wave = per_blk / nw;
    for (int unit = blockIdx.x; unit < 256; unit += F.G) {
        const int x = unit & 7, rk = unit >> 3;
        const unsigned char* ub = F.UT8 + (size_t)x * NEXP * 128;
        const int tbeg = c0 + rk * per_blk + (wave - w0) * per_wave, tend = tbeg + per_wave;
        int idxA[16], idxB[16]; v4u segA[16], segB[16]; v4u hA[1], hB[1];
        PU_IDX(idxA, tbeg); PU_GATHER(segA, idxA); PU_HS(hA, tbeg); PU_IDX(idxB, tbeg + 1);
        for (int t = tbeg; t < tend; t += 2) {
            PU_GATHER(segB, idxB); PU_HS(hB, t + 1);
            { const int tn = (t + 2 < tend) ? t + 2 : t; PU_IDX(idxA, tn); }
            PU_COMPUTE(segA, hA, t);
            { const int tn = (t + 2 < tend) ? t + 2 : t; PU_GATHER(segA, idxA); PU_HS(hA, tn); }
            { const int tn = (t + 3 < tend) ? t + 3 : t + 1; PU_IDX(idxB, tn); }
            PU_COMPUTE(segB, hB, t + 1);
        }
    }
}
#undef PU_IDX
#undef PU_GATHER
#undef PU_HS
#undef PU_COMPUTE

template <bool DRY> __device__ __forceinline__ void peer_phase(Frame& F, const int c0, const int cn, const int w0, const int nw) {
    int lane = lane_id(); asm volatile("" : "+v"(lane));
    if (F.wave < w0 || F.wave >= w0 + nw) return;
    const int gw = blockIdx.x * nw + (F.wave - w0), NGW = F.G * nw;
    const int half = lane >> 5; const unsigned l16 = (unsigned)(lane & 31) * 16u, l8 = (unsigned)(lane & 31) * 8u;
    for (int t = c0 + gw; t < c0 + cn; t += NGW) {
        const int b = t >> 12;
        const int e0 = F.IDX[(size_t)t * PKN + lane], e1 = F.IDX[(size_t)t * PKN + 64 + lane];
        const float g0 = F.GATE[(size_t)t * PKN + lane], g1 = F.GATE[(size_t)t * PKN + 64 + lane];
        const float su0 = F.SU[e0], su1 = F.SU[e1], sv0 = F.SV[e0], sv1 = F.SV[e1];
        float tot0 = 0.f, tot1 = 0.f;
#pragma unroll
        for (int x = 0; x < 8; ++x) { const bf16* pp = (const bf16*)F.PART + ((size_t)x * M + t) * PKN; tot0 += bf2f(pp[lane]); tot1 += bf2f(pp[64 + lane]); }
        const float hs = F.HS[t];
        const float w0 = gelu_t(tot0 * (su0 * hs)) * g0 * sv0, w1 = gelu_t(tot1 * (su1 * hs)) * g1 * sv1;
        f32x2 acc[16];
#pragma unroll
        for (int i = 0; i < 16; ++i) acc[i] = (f32x2){0.f, 0.f};
        PV6_BATCH(e0, w0);
        PV6_BATCH(e1, w1);
#pragma unroll
        for (int i = 0; i < 16; ++i) {
            auto rx = __builtin_amdgcn_permlane32_swap(__float_as_uint(acc[i].x), __float_as_uint(acc[i].x), false, false);
            auto ry = __builtin_amdgcn_permlane32_swap(__float_as_uint(acc[i].y), __float_as_uint(acc[i].y), false, false);
            acc[i] = (f32x2){__uint_as_float(rx[0]) + __uint_as_float(rx[1]), __uint_as_float(ry[0]) + __uint_as_float(ry[1])};
        }
        float y[16];
#pragma unroll
        for (int j = 0; j < 16; ++j) {
#if FP6_INTERLEAVED
            const float lo = (j & 1) ? acc[j].x : acc[j].x;
            const float hi_ = acc[j].y;
            y[j] = half ? hi_ : lo;
#else
            const float lo = (j & 1) ? acc[j >> 1].y : acc[j >> 1].x;
            const float hi_ = (j & 1) ? acc[8 + (j >> 1)].y : acc[8 + (j >> 1)].x;
            y[j] = half ? hi_ : lo;
#endif
        }
        float ss = 0.f;
#pragma unroll
        for (int j = 0; j < 16; ++j) ss += y[j] * y[j];
        const float rstd = rsqrtf(wave_sum_dpp(ss) * (1.f / D) + EPS);
        const float* md = F.mod + b * 6144 + 5120;
        const float* g3 = F.norm_g + 3072;
        int lane_e = lane; asm volatile("" : "+v"(lane_e));
        const int col0 = (lane_e & 31) * 32 + (lane_e >> 5) * 16;
        float* orow = F.out + (size_t)t * D + col0;
        const v4u xa = *(const v4u*)(F.X1B + (size_t)t * D + col0), xb = *(const v4u*)(F.X1B + (size_t)t * D + col0 + 8);
        const unsigned xw[8] = {xa.x, xa.y, xa.z, xa.w, xb.x, xb.y, xb.z, xb.w};
#pragma unroll
        for (int q4 = 0; q4 < 4; ++q4) { const int c = col0 + q4 * 4;
            const f32x4 x1 = (f32x4){bflo(xw[2 * q4]), bfhi(xw[2 * q4]), bflo(xw[2 * q4 + 1]), bfhi(xw[2 * q4 + 1])}, gt = *(const f32x4*)(md + c), gg = *(const f32x4*)(g3 + c);
            const f32x4 yv = (f32x4){y[q4 * 4], y[q4 * 4 + 1], y[q4 * 4 + 2], y[q4 * 4 + 3]};
            if (!DRY) *(f32x4*)(orow + q4 * 4) = x1 + gt * (yv * rstd * gg); else if (rstd == 123.456f) *(f32x4*)(orow + q4 * 4) = yv; }
    }
}
#undef PE_W
#undef PV6_LOAD
#undef PV6_ACC
#undef PV6_BATCH

__device__ __forceinline__ void u_rows4(Frame& F, int r0, int stride, int nvalid, int lane) {
    f32x4 v[4][4];
#pragma unroll
    for (int q = 0; q < 4; ++q) { const int row = r0 + (q < nvalid ? q : 0) * stride; const f32x4* s = (const f32x4*)(F.peer_u + (size_t)row * D) + lane * 4;
#pragma unroll
        for (int i = 0; i < 4; ++i) v[q][i] = s[i]; }
#pragma unroll
    for (int q = 0; q < 4; ++q) { if (q >= nvalid) break; const int row = r0 + q * stride;
        float am = 0.f;
#pragma unroll
        for (int i = 0; i < 4; ++i) am = fmaxf(am, fmaxf(fmaxf(fabsf(v[q][i].x), fabsf(v[q][i].y)), fmaxf(fabsf(v[q][i].z), fabsf(v[q][i].w))));
        am = wave_max_dpp(am);
        const float sc = am > 0.f ? 127.f / am : 1.f;
        int w[4];
#pragma unroll
        for (int i = 0; i < 4; ++i) { const int q0 = (int)rintf(v[q][i].x * sc), q1 = (int)rintf(v[q][i].y * sc), q2 = (int)rintf(v[q][i].z * sc), q3 = (int)rintf(v[q][i].w * sc);
            w[i] = (q0 & 255) | ((q1 & 255) << 8) | ((q2 & 255) << 16) | (q3 << 24); }
        *(v4u*)(F.UT8 + (size_t)(lane >> 3) * NEXP * 128 + (size_t)row * 128 + (lane & 7) * 16) = (v4u){(unsigned)w[0], (unsigned)w[1], (unsigned)w[2], (unsigned)w[3]};
        if (lane == 0) F.SU[row] = 1.f / sc; }
}
__device__ __forceinline__ void v_pairs2(Frame& F, int p0, int stride, int nvalid, int lane) {
    const int L = lane & 31, hf = lane >> 5;
    f32x4 f[2][8];
#pragma unroll
    for (int q = 0; q < 2; ++q) { const int row = 2 * (p0 + (q < nvalid ? q : 0) * stride) + hf; const f32x4* sp = (const f32x4*)(F.peer_v + (size_t)row * D + L * 32);
#pragma unroll
        for (int i = 0; i < 8; ++i) f[q][i] = sp[i]; }
#pragma unroll
    for (int q = 0; q < 2; ++q) { if (q >= nvalid) break; const int row = 2 * (p0 + q * stride) + hf;
        float am = 0.f;
#pragma unroll
        for (int i = 0; i < 8; ++i) am = fmaxf(am, fmaxf(fmaxf(fabsf(f[q][i].x), fabsf(f[q][i].y)), fmaxf(fabsf(f[q][i].z), fabsf(f[q][i].w))));
        am = half_max_dpp(am);
        const float sc = am > 0.f ? exp2f(floorf(log2f(7.0f / am))) : 1.f;
        v16f a, b;
#pragma unroll
        for (int i = 0; i < 4; ++i) { a[4 * i] = f[q][i].x * sc; a[4 * i + 1] = f[q][i].y * sc; a[4 * i + 2] = f[q][i].z * sc; a[4 * i + 3] = f[q][i].w * sc;
            b[4 * i] = f[q][4 + i].x * sc; b[4 * i + 1] = f[q][4 + i].y * sc; b[4 * i + 2] = f[q][4 + i].z * sc; b[4 * i + 3] = f[q][4 + i].w * sc; }
        const v6u w = __builtin_amdgcn_cvt_scalef32_2xpk16_fp6_f32(a, b, 1.0f);
        unsigned char* rp = F.VT6 + (size_t)row * 768;
        *(v4u*)(rp + L * 16) = (v4u){w[0], w[1], w[2], w[3]};
        *(v2u*)(rp + 512 + L * 8) = (v2u){w[4], w[5]};
        if (L == 0) F.SV[row] = 1.f / sc; }
}
__device__ __forceinline__ void prologue_tables(Frame& F, int gw, int NGW, int lane) {
    for (int r = gw; r < NEXP; r += 4 * NGW) { const int left = (NEXP - r + NGW - 1) / NGW; u_rows4(F, r, NGW, left < 4 ? left : 4, lane); }
    for (int p = gw; p < NEXP / 2; p += 2 * NGW) { const int left = (NEXP / 2 - p + NGW - 1) / NGW; v_pairs2(F, p, NGW, left < 2 ? left : 2, lane); }
}
}

__device__ __forceinline__ void prologue_tables_fwd(Frame& F, int gw, int NGW, int lane) { pe::prologue_tables(F, gw, NGW, lane); }
struct Args { const float* in[18]; float* out; unsigned char* ws; int ph_lo, ph_hi, li, pad; };
__global__ void __launch_bounds__(NTHR, 2) fwd(Args args) {
    extern __shared__ __attribute__((aligned(16))) unsigned char lds[];
    Frame F;
    F.lds = (LAS unsigned char*)lds;
    F.MISC = (volatile LAS unsigned*)(F.lds + MISC_OFF);
    F.wave = __builtin_amdgcn_readfirstlane((int)threadIdx.x >> 6); F.G = gridDim.x;
    unsigned char* ws = args.ws;
    F.ctl = (gu32*)(ws + WS_CTL);
    F.x = args.in[0]; F.c = args.in[1]; F.w_ada = args.in[2]; F.b_ada = args.in[3]; F.norm_g = args.in[4]; F.w_in = args.in[5]; F.sgu_ln_g = args.in[6]; F.sgu_ln_b = args.in[7];
    F.sgu_w = args.in[8]; F.sgu_b = args.in[9]; F.diff_lambda = args.in[10]; F.subln_g = args.in[11]; F.rel_bias = args.in[12]; F.w_out = args.in[13]; F.w_query = args.in[14];
    F.sub_keys = args.in[15]; F.peer_u = args.in[16]; F.peer_v = args.in[17]; F.out = args.out;
    F.mod = (float*)(ws + WS_MOD); F.WIN = (bf16*)(ws + WS_WIN); F.WOUT = (bf16*)(ws + WS_WOUT); F.WQ = (bf16*)(ws + WS_WQ); F.KEYS = (bf16*)(ws + WS_KEYS); F.SGW = (bf16*)(ws + WS_SGW);
    F.UT8 = ws + WS_UT; F.H8 = ws + WS_H8; F.HS = (float*)(ws + WS_SU) + 2 * NEXP; F.HAS = (float*)(ws + WS_SU) + 2 * NEXP + M; F.WS8 = (float*)(ws + WS_SU) + 2 * NEXP + 2 * M; F.HA8 = ws + WS_H; F.W8 = ws + WS_WIN; F.WQ8 = ws + WS_WQ; F.WQS8 = (float*)(ws + WS_SU) + 2 * NEXP + 2 * M + INC; F.VT6 = ws + WS_VT; F.PART = (float*)(ws + WS_QP); F.STASH = (unsigned*)(ws + WS_H); F.SU = (float*)(ws + WS_SU); F.SV = (float*)(ws + WS_SU) + NEXP; F.H = (bf16*)(ws + WS_H); F.Y = (bf16*)(ws + WS_Y); F.Z = (bf16*)(ws + WS_Z); F.QP = (bf16*)(ws + WS_QP); F.CAT = (bf16*)(ws + WS_CAT); F.X1B = (bf16*)(ws + WS_CAT);
    F.IDX = (int*)(ws + WS_IDX); F.GATE = (float*)(ws + WS_GATE);
    for (int u = threadIdx.x; u < (LDS_BYTES - LDSCTL_OFF) / 4; u += NTHR) ((LAS unsigned*)(F.lds + LDSCTL_OFF))[u] = 0u;
    __syncthreads();
    XcdBarrier bar = xcd_barrier_post((unsigned*)(F.ctl + CW_BAR) + args.li * XCD_BAR_WORDS, F.MISC + 8);
    const int lo = args.ph_lo, hi = args.ph_hi;
#ifndef ONLY_PHASE
#define ONLY_PHASE -1
#endif
#define IN(k) (lo <= (k) && (k) < hi && (ONLY_PHASE < 0 || ONLY_PHASE == (k)))
#define SEAM(k) do { if ((k) + 1 < hi) xcd_barrier(bar); } while (0)
    if (IN(0)) { for (int rep = 0; rep < (PROBE_PHASE == 0 ? 2 : 1); ++rep) ph_prologue(F); SEAM(0); }
    if (IN(1)) { for (int rep = 0; rep < (PROBE_PHASE == 1 ? 2 : 1); ++rep) ph_hrows(F); SEAM(1); }
    if (IN(2)) {
        pg8::Gemm g{(const pg8::bf16_t*)F.HA8, (const pg8::bf16_t*)F.W8, M, INC, D / 2}; pg8::StaticOrder S; S.init(M, INC, F.G, (int)blockIdx.x);
        pg8::EpiI8<1> E{F.Z, INC, F.HAS, F.WS8, 1024};
        for (int rep = 0; rep < (PROBE_PHASE == 2 ? 2 : 1); ++rep) pg8::gemm_phase<pg8::EpiI8<1>, pg8::StaticOrder, true, true>(F.lds, g, S, E, F.wave);
        SEAM(2);
    }
    if (IN(3)) { for (int rep = 0; rep < (PROBE_PHASE == 30 ? 2 : 1); ++rep) sgu::sgu_phase(F); for (int rep = 0; rep < (PROBE_PHASE == 3 ? 2 : 1); ++rep) att::attn_phase(F); SEAM(3); }
    if (IN(4)) {
        pg8::Gemm g{F.CAT, F.WOUT, M, D, D}; pg8::StaticOrder S; S.init(M, D, F.G, (int)blockIdx.x);
        pg8::EpiBf16<0> E{F.Y, D, nullptr, 0, 0, 1.f, 0};
        for (int rep = 0; rep < (PROBE_PHASE == 4 ? 2 : 1); ++rep) pg8::gemm_phase<pg8::EpiBf16<0>, pg8::StaticOrder, true, true>(F.lds, g, S, E, F.wave);
        SEAM(4);
    }
    if (IN(5)) { for (int rep = 0; rep < (PROBE_PHASE == 5 ? 2 : 1); ++rep) ph_x1rows(F); SEAM(5); }
    if (IN(6)) {
        pg8::Gemm g{(const pg8::bf16_t*)F.H8, (const pg8::bf16_t*)F.WQ8, M, NQ, D / 2}; pg8::StaticOrder S; S.init(M, NQ, F.G, (int)blockIdx.x);
        pg8::EpiI8<0> E{F.QP, NQ, F.HS, F.WQS8, 0};
        for (int rep = 0; rep < (PROBE_PHASE == 6 ? 2 : 1); ++rep) pg8::gemm_phase<pg8::EpiI8<0>, pg8::StaticOrder, true, true>(F.lds, g, S, E, F.wave);
        SEAM(6);
    }
    if (IN(7)) { if (TABLES_IN_PHASE == 7) prologue_tables_fwd(F, blockIdx.x * NWAVES + F.wave, F.G * NWAVES, lane_id()); for (int rep = 0; rep < (PROBE_PHASE == 7 ? 2 : 1); ++rep) tk::topk_phase(F); SEAM(7); }
    if (IN(8)) { for (int rep = 0; rep < (PROBE_PHASE == 8 ? 2 : 1); ++rep) pe::peer_u_phase(F, 0, M, 0, 8); SEAM(8); }
    if (IN(9)) { if (PROBE_PHASE == 9) pe::peer_phase<true>(F, 0, M, 0, 8); pe::peer_phase<false>(F, 0, M, 0, 8); }
#undef IN
#undef SEAM
}

extern "C" void kernel_launch(void* const* d_in, const int* in_sizes, int n_in, void* d_out, int out_size, void* d_ws, size_t ws_size, hipStream_t stream) {
    static int grid = 0;
    if (grid == 0) {
        if (n_in != 18 || in_sizes[0] != M * D || out_size != M * D || ws_size < WS_END) { fprintf(stderr, "kernel_launch: unexpected shapes (n_in %d, in0 %d, out %d, ws %zu)\n", n_in, n_in > 0 ? in_sizes[0] : -1, out_size, ws_size); grid = -1; return; }
        int dev = 0, cus = 0, per_cu = 0;
        if (hipGetDevice(&dev) != hipSuccess || hipDeviceGetAttribute(&cus, hipDeviceAttributeMultiprocessorCount, dev) != hipSuccess) { grid = -1; return; }
        if (hipFuncSetAttribute((const void*)fwd, hipFuncAttributeMaxDynamicSharedMemorySize, LDS_BYTES) != hipSuccess) { fprintf(stderr, "kernel_launch: hipFuncSetAttribute failed\n"); grid = -1; return; }
        if (hipOccupancyMaxActiveBlocksPerMultiprocessor(&per_cu, (const void*)fwd, NTHR, LDS_BYTES) != hipSuccess || per_cu < 1) fprintf(stderr, "kernel_launch: occupancy query reports %d\n", per_cu);
        (void)hipGetLastError();
        grid = cus;
    }
    if (grid < 0) return;
    if (hipMemsetAsync((char*)d_ws + WS_CTL, 0, CTL_ZERO_BYTES, stream) != hipSuccess) return;
    Args a{};
    for (int i = 0; i < 18; ++i) a.in[i] = (const float*)d_in[i];
    a.out = (float*)d_out; a.ws = (unsigned char*)d_ws;
#if MK_PER_PHASE
    for (int p = 0; p < NPHASE; ++p) { a.ph_lo = p; a.ph_hi = p + 1; a.li = p; hipLaunchKernelGGL(fwd, dim3(grid), dim3(NTHR), LDS_BYTES, stream, a); }
#else
    a.ph_lo = 0; a.ph_hi = NPHASE; a.li = 0; hipLaunchKernelGGL(fwd, dim3(grid), dim3(NTHR), LDS_BYTES, stream, a);
#endif
}
```

```cpp
#define MK_PER_PHASE 0
#include <hip/hip_runtime.h>
#include <cstdio>
#include <cstdint>
namespace pg8 {
#define PG8_LAS __attribute__((address_space(3)))
typedef unsigned short bf16_t;
typedef short bf16x8 __attribute__((ext_vector_type(8)));
typedef float f32x4 __attribute__((ext_vector_type(4)));
typedef unsigned u32x4 __attribute__((ext_vector_type(4)));
typedef int i32x4 __attribute__((ext_vector_type(4)));
constexpr int BM = 256, BK = 64, HALF = 128, HTB = HALF * BK * 2  , STAGE_BYTES = 8 * HTB, NXCD = 8, WGM = 8;

__host__ __device__ __forceinline__ int lds_byte(int r, int c) { const int st = (r >> 4) * 2 + (c >> 5), rr = r & 15, cc = c & 31, ob = rr * 64 + cc * 2; return st * 1024 + (ob ^ (((ob >> 9) & 1) << 5)); }
__host__ __device__ __forceinline__ void stage_rc(int b, int& R, int& C) { const int st = b / 1024, sb = b % 1024, swz = sb ^ (((sb >> 9) & 1) << 5); R = (st >> 1) * 16 + swz / 64; C = (st & 1) * 32 + (swz % 64) / 2; }
__host__ __device__ __forceinline__ int perm32(int rho) { const int n = rho >> 4, i = rho & 15; return 8 * (i >> 2) + 4 * n + (i & 3); }

struct Unit { int pm, pn; };
struct Gemm { const bf16_t* A; const bf16_t* Bt; int M, N, K; };

struct StaticOrder {
    int nM, nN, nwg, G, c;
    __host__ __device__ void init(int M, int N, int G_, int c_) { nM = M / BM; nN = N / BM; nwg = nM * nN; G = G_; c = c_; }
    __host__ __device__ bool next(int i, Unit& u) const {
        const long L = (long)i * G + c; if (L >= nwg) return false;
        int wgid = (int)L; { const int q = nwg / NXCD, r = nwg % NXCD, xcd = wgid % NXCD, off = wgid / NXCD; wgid = (xcd < r ? xcd * (q + 1) : r * (q + 1) + (xcd - r) * q) + off; }
        const int nig = WGM * nN, gid = wgid / nig, fm = gid * WGM, gsz = (nM - fm) < WGM ? (nM - fm) : WGM;
        u.pm = fm + ((wgid % nig) % gsz); u.pn = (wgid % nig) / gsz; return true;
    }
    __device__ __forceinline__ void a_ready(const Unit&) const {}
    __device__ __forceinline__ void done(const Unit&) const {}
};

__device__ __forceinline__ unsigned cvt_pk_bf16(float lo, float hi) { unsigned r; asm volatile("v_cvt_pk_bf16_f32 %0, %1, %2" : "=v"(r) : "v"(lo), "v"(hi)); return r; }
typedef float f32x2 __attribute__((ext_vector_type(2)));
__device__ __forceinline__ f32x2 gelu_pk(f32x2 v) {
    const f32x2 u = v * (v * v * 0.044715f + 1.0f);
    const f32x2 s = u * (-2.302208198f);
    f32x2 e; e.x = __builtin_amdgcn_exp2f(s.x); e.y = __builtin_amdgcn_exp2f(s.y);
    const f32x2 d = e + 1.0f;
    f32x2 r; r.x = __builtin_amdgcn_rcpf(d.x); r.y = __builtin_amdgcn_rcpf(d.y);
    return v * r;
}

template <int ACT  > struct EpiBf16 {
    static constexpr bool PERM = true, AFTER_DRAIN = false; typedef f32x4 acc_t;
    bf16_t* O; int ldc; const float* bias; int split_cols; size_t split_stride; float scale0; int act_cols;
    __device__ __forceinline__ void operator()(const f32x4 (&acc)[2][2][4][2], const Unit& u, int wr, int wc, int fr, int fq) const {
        const int row0 = u.pm * BM + wr * 64 + fr; int colt = u.pn * BM; bf16_t* base = O;
        float sc = 1.f; if (split_cols) { const int t = colt / split_cols; base += (size_t)t * split_stride; colt -= t * split_cols; if (t == 0) sc = scale0; }
        const int col0 = colt + wc * 32 + 8 * fq, bcol0 = u.pn * BM + wc * 32 + 8 * fq;
        f32x4 bv[2][2];
#pragma unroll
        for (int bj = 0; bj < 2; ++bj)
#pragma unroll
            for (int n = 0; n < 2; ++n) bv[bj][n] = bias ? *(const f32x4*)(bias + bcol0 + bj * HALF + 4 * n) : (f32x4){0.f, 0.f, 0.f, 0.f};
#pragma unroll
        for (int ai = 0; ai < 2; ++ai)
#pragma unroll
            for (int m = 0; m < 4; ++m) { bf16_t* rowp = base + (size_t)(row0 + ai * HALF + m * 16) * ldc + col0;
#pragma unroll
                for (int bj = 0; bj < 2; ++bj) { f32x4 v0 = acc[ai][bj][m][0] + bv[bj][0], v1 = acc[ai][bj][m][1] + bv[bj][1];
                    if (ACT == 1 && u.pn * BM < act_cols) { f32x2 a = gelu_pk((f32x2){v0[0], v0[1]}), b = gelu_pk((f32x2){v0[2], v0[3]}), c = gelu_pk((f32x2){v1[0], v1[1]}), d = gelu_pk((f32x2){v1[2], v1[3]});
                        v0 = (f32x4){a.x, a.y, b.x, b.y}; v1 = (f32x4){c.x, c.y, d.x, d.y}; }
                    v0 = v0 * sc; v1 = v1 * sc; u32x4 w; w.x = cvt_pk_bf16(v0[0], v0[1]); w.y = cvt_pk_bf16(v0[2], v0[3]); w.z = cvt_pk_bf16(v1[0], v1[1]); w.w = cvt_pk_bf16(v1[2], v1[3]);
                    *(u32x4*)(rowp + bj * HALF) = w; } }
    }
};


template <int ACT> struct EpiI8 {
    static constexpr bool PERM = true, AFTER_DRAIN = false; typedef i32x4 acc_t;
    bf16_t* O; int ldc; const float* rs; const float* cs; int act_cols;
    __device__ __forceinline__ void operator()(const i32x4 (&acc)[2][2][4][2], const Unit& u, int wr, int wc, int fr, int fq) const {
        const int row0 = u.pm * BM + wr * 64 + fr, col0 = u.pn * BM + wc * 32 + 8 * fq;
        f32x4 cv[2][2];
#pragma unroll
        for (int bj = 0; bj < 2; ++bj)
#pragma unroll
            for (int n = 0; n < 2; ++n) cv[bj][n] = *(const f32x4*)(cs + col0 + bj * HALF + 4 * n);
#pragma unroll
        for (int ai = 0; ai < 2; ++ai)
#pragma unroll
            for (int m = 0; m < 4; ++m) { const int row = row0 + ai * HALF + m * 16; const float ra = rs[row]; bf16_t* rowp = O + (size_t)row * ldc + col0;
#pragma unroll
                for (int bj = 0; bj < 2; ++bj) {
                    f32x4 v0 = __builtin_convertvector(acc[ai][bj][m][0], f32x4) * ra * cv[bj][0], v1 = __builtin_convertvector(acc[ai][bj][m][1], f32x4) * ra * cv[bj][1];
                    if (ACT == 1 && u.pn * BM < act_cols) { f32x2 a = gelu_pk((f32x2){v0[0], v0[1]}), b = gelu_pk((f32x2){v0[2], v0[3]}), c = gelu_pk((f32x2){v1[0], v1[1]}), d = gelu_pk((f32x2){v1[2], v1[3]});
                        v0 = (f32x4){a.x, a.y, b.x, b.y}; v1 = (f32x4){c.x, c.y, d.x, d.y}; }
                    u32x4 w; w.x = cvt_pk_bf16(v0[0], v0[1]); w.y = cvt_pk_bf16(v0[2], v0[3]); w.z = cvt_pk_bf16(v1[0], v1[1]); w.w = cvt_pk_bf16(v1[2], v1[3]);
                    *(u32x4*)(rowp + bj * HALF) = w; } }
    }
};

__device__ __forceinline__ f32x4 mma16(bf16x8 a, bf16x8 b, f32x4 c) { return __builtin_amdgcn_mfma_f32_16x16x32_bf16(a, b, c, 0, 0, 0); }
__device__ __forceinline__ i32x4 mma16(bf16x8 a, bf16x8 b, i32x4 c) { return __builtin_amdgcn_mfma_i32_16x16x64_i8(__builtin_bit_cast(i32x4, a), __builtin_bit_cast(i32x4, b), c, 0, 0, 0); }
template <class Epi, class Sched, bool ALIGN_EPI = false, bool SP2 = false>
__device__ __forceinline__ void gemm_phase(PG8_LAS unsigned char* lds, const Gemm g, const Sched& S, const Epi& E, const int wid  ) {
    const int lane = (int)__builtin_amdgcn_mbcnt_hi(~0u, __builtin_amdgcn_mbcnt_lo(~0u, 0u)), tid = wid * 64 + lane, wr = wid >> 2, wc = wid & 3, fr = lane & 15, fq = lane >> 4;
    const int K = g.K, nt = K / BK;
    unsigned voffA[2], voffB[2];
#pragma unroll
    for (int i = 0; i < 2; ++i) { int R, C; stage_rc(tid * 16 + i * 8192, R, C); const int Rb = Epi::PERM ? ((R & ~31) + perm32(R & 31)) : R;
        voffA[i] = (unsigned)(R * K + C) * 2u; voffB[i] = (unsigned)(Rb * K + C) * 2u; }
    const size_t kstep = (size_t)(BK * 2);
    const size_t hstep = (size_t)HALF * K * 2;
    const size_t tstep = 2 * hstep;
    const unsigned ldsw = (unsigned)wid * 1024u;
    const int aoff = lds_byte(wr * 64 + fr, fq * 8), boff = lds_byte(wc * 32 + fr, fq * 8);
#define PG8_SA(b, h) (((b) * 2 + (h)) * HTB)
#define PG8_SB(b, h) ((4 + (b) * 2 + (h)) * HTB)
#define PG8_STAGE(bufoff, gbase, voff) do { _Pragma("unroll") for (int _i = 0; _i < 2; ++_i) \
        __builtin_amdgcn_global_load_lds((const unsigned*)((const char*)(gbase) + (voff)[_i]), (PG8_LAS unsigned*)(lds + (bufoff) + ldsw + _i * 8192), 16, 0, 0); } while (0)
#define PG8_LDA(dst, b, h) do { _Pragma("unroll") for (int m = 0; m < 4; ++m) _Pragma("unroll") for (int k = 0; k < 2; ++k) dst[m][k] = *(const PG8_LAS bf16x8*)(lds + PG8_SA(b, h) + aoff + m * 2048 + k * 1024); } while (0)
#define PG8_LDB(dst, b, h) do { _Pragma("unroll") for (int n = 0; n < 2; ++n) _Pragma("unroll") for (int k = 0; k < 2; ++k) dst[n][k] = *(const PG8_LAS bf16x8*)(lds + PG8_SB(b, h) + boff + n * 2048 + k * 1024); } while (0)
#define PG8_MMA(ai, bj, At, Bt) do { __builtin_amdgcn_s_setprio(1); _Pragma("unroll") for (int m = 0; m < 4; ++m) _Pragma("unroll") for (int n = 0; n < 2; ++n) _Pragma("unroll") for (int k = 0; k < 2; ++k) \
        acc[ai][bj][m][n] = mma16(Bt[n][k], At[m][k], acc[ai][bj][m][n]); __builtin_amdgcn_s_setprio(0); } while (0)
#define PG8_WAIT_V(n) asm volatile("s_waitcnt vmcnt(" #n ")" ::: "memory")
#define PG8_WAIT_L(n) asm volatile("s_waitcnt lgkmcnt(" #n ")" ::: "memory")
#define PG8_BAR __builtin_amdgcn_s_barrier()
#define PG8_SCHED __builtin_amdgcn_sched_barrier(0)
    Unit cur, nxt; int ui = 0;
    if (!S.next(0, cur)) return;
    typedef typename Epi::acc_t acc_t;
    acc_t acc[2][2][4][2];
#pragma unroll
    for (int a = 0; a < 2; ++a)
#pragma unroll
        for (int b = 0; b < 2; ++b)
#pragma unroll
            for (int m = 0; m < 4; ++m)
#pragma unroll
                for (int n = 0; n < 2; ++n) acc[a][b][m][n] = acc_t{};
    bf16x8 At[4][2], B0[2][2], B1[2][2];
    const char* cA = (const char*)g.A + (size_t)cur.pm * tstep; const char* cB = (const char*)g.Bt + (size_t)cur.pn * tstep;
    S.a_ready(cur);
    if constexpr (SP2) {
        PG8_STAGE(PG8_SB(0, 0), cB, voffB); PG8_STAGE(PG8_SB(0, 1), cB + hstep, voffB); PG8_STAGE(PG8_SA(0, 0), cA, voffA); PG8_STAGE(PG8_SA(0, 1), cA + hstep, voffA);
        if (wr == 1) PG8_BAR;
        PG8_WAIT_V(2); PG8_BAR;
        PG8_STAGE(PG8_SB(1, 0), cB + kstep, voffB); PG8_STAGE(PG8_SA(1, 0), cA + kstep, voffA); PG8_STAGE(PG8_SB(1, 1), cB + hstep + kstep, voffB);
        PG8_WAIT_V(6); PG8_BAR;
    } else {
        PG8_STAGE(PG8_SB(0, 0), cB, voffB); PG8_STAGE(PG8_SA(0, 0), cA, voffA); PG8_STAGE(PG8_SB(0, 1), cB + hstep, voffB); PG8_STAGE(PG8_SA(0, 1), cA + hstep, voffA);
        if (wr == 1) PG8_BAR;
        PG8_WAIT_V(4); PG8_BAR;
        PG8_STAGE(PG8_SB(1, 0), cB + kstep, voffB); PG8_STAGE(PG8_SA(1, 0), cA + kstep, voffA); PG8_STAGE(PG8_SB(1, 1), cB + hstep + kstep, voffB);
        PG8_WAIT_V(6); PG8_BAR;
    }
    for (;;) {
        const bool has_next = S.next(ui + 1, nxt);
        const char* nA = has_next ? (const char*)g.A + (size_t)nxt.pm * tstep : cA; const char* nB = has_next ? (const char*)g.Bt + (size_t)nxt.pn * tstep : cB;
        for (int t = 0; t < nt; t += 2) {
            const bool last = (t == nt - 2);
            const char* a1 = cA + (size_t)(t + 1) * kstep;
            const char* a2 = last ? nA : cA + (size_t)(t + 2) * kstep; const char* b2 = last ? nB : cB + (size_t)(t + 2) * kstep;
            const char* a3 = a2 + kstep; const char* b3 = b2 + kstep;
            if (last && has_next) S.a_ready(nxt);
            if constexpr (SP2) {
            PG8_LDB(B0, 0, 0); PG8_LDB(B1, 0, 1); PG8_SCHED; PG8_LDA(At, 0, 0); PG8_STAGE(PG8_SA(1, 1), a1 + hstep, voffA);
            PG8_WAIT_V(8); PG8_WAIT_L(0); PG8_BAR; PG8_MMA(0, 0, At, B0); PG8_MMA(0, 1, At, B1); PG8_BAR; PG8_SCHED;
            PG8_LDA(At, 0, 1); PG8_STAGE(PG8_SB(0, 0), b2, voffB); PG8_STAGE(PG8_SB(0, 1), b2 + hstep, voffB); PG8_STAGE(PG8_SA(0, 0), a2, voffA);
            PG8_WAIT_V(8); PG8_WAIT_L(0); PG8_BAR; PG8_MMA(1, 0, At, B0); PG8_MMA(1, 1, At, B1); PG8_BAR; PG8_SCHED;
            PG8_LDB(B0, 1, 0); PG8_LDB(B1, 1, 1); PG8_SCHED; PG8_LDA(At, 1, 0); PG8_STAGE(PG8_SA(0, 1), a2 + hstep, voffA);
            PG8_WAIT_V(8); PG8_WAIT_L(0); PG8_BAR; PG8_MMA(0, 0, At, B0); PG8_MMA(0, 1, At, B1); PG8_BAR; PG8_SCHED;
            PG8_LDA(At, 1, 1); PG8_STAGE(PG8_SB(1, 0), b3, voffB); PG8_STAGE(PG8_SB(1, 1), b3 + hstep, voffB); PG8_STAGE(PG8_SA(1, 0), a3, voffA);
            PG8_WAIT_V(8); PG8_WAIT_L(0); PG8_BAR; PG8_MMA(1, 0, At, B0); PG8_MMA(1, 1, At, B1); PG8_BAR; PG8_SCHED;
            } else {
            PG8_LDB(B0, 0, 0); PG8_SCHED; PG8_LDA(At, 0, 0); PG8_STAGE(PG8_SA(1, 1), a1 + hstep, voffA);
            PG8_WAIT_L(8); PG8_BAR; PG8_WAIT_L(0); PG8_MMA(0, 0, At, B0); PG8_BAR; PG8_SCHED;
            PG8_LDB(B1, 0, 1); PG8_STAGE(PG8_SB(0, 0), b2, voffB);
            PG8_BAR; PG8_WAIT_L(0); PG8_MMA(0, 1, At, B1); PG8_BAR;
            PG8_LDA(At, 0, 1); PG8_STAGE(PG8_SA(0, 0), a2, voffA);
            PG8_BAR; PG8_WAIT_L(0); PG8_MMA(1, 0, At, B0); PG8_BAR; PG8_SCHED;
            PG8_STAGE(PG8_SB(0, 1), b2 + hstep, voffB);
            PG8_WAIT_V(6); PG8_BAR; PG8_MMA(1, 1, At, B1); PG8_BAR;
            PG8_LDB(B0, 1, 0); PG8_SCHED; PG8_LDA(At, 1, 0); PG8_STAGE(PG8_SA(0, 1), a2 + hstep, voffA);
            PG8_WAIT_L(8); PG8_BAR; PG8_WAIT_L(0); PG8_MMA(0, 0, At, B0); PG8_BAR; PG8_SCHED;
            PG8_LDB(B1, 1, 1); PG8_STAGE(PG8_SB(1, 0), b3, voffB);
            PG8_BAR; PG8_WAIT_L(0); PG8_MMA(0, 1, At, B1); PG8_BAR;
            PG8_LDA(At, 1, 1); PG8_STAGE(PG8_SA(1, 0), a3, voffA);
            PG8_BAR; PG8_WAIT_L(0); PG8_MMA(1, 0, At, B0); PG8_BAR; PG8_SCHED;
            PG8_STAGE(PG8_SB(1, 1), b3 + hstep, voffB);
            PG8_WAIT_V(6); PG8_BAR; PG8_MMA(1, 1, At, B1); PG8_BAR;
            }
        }
        if constexpr (ALIGN_EPI) { if (wr == 0) PG8_BAR; }
        if constexpr (!Epi::AFTER_DRAIN) { E(acc, cur, wr, wc, fr, fq); S.done(cur); }
        if (!has_next) break;
#pragma unroll
        for (int a = 0; a < 2; ++a)
#pragma unroll
            for (int b = 0; b < 2; ++b)
#pragma unroll
                for (int m = 0; m < 4; ++m)
#pragma unroll
                    for (int n = 0; n < 2; ++n) acc[a][b][m][n] = acc_t{};
        cur = nxt; cA = nA; cB = nB; ++ui;
        if constexpr (ALIGN_EPI) { if (wr == 1) PG8_BAR; }
    }
    PG8_WAIT_V(0);
    if constexpr (!ALIGN_EPI) { if (wr == 0) PG8_BAR; }
    PG8_BAR;
    if constexpr (Epi::AFTER_DRAIN) { E.fused(acc, cur, wr, wc, fr, fq, lds, wid, lane); S.done(cur); }
#undef PG8_SA
#undef PG8_SB
#undef PG8_STAGE
#undef PG8_LDA
#undef PG8_LDB
#undef PG8_MMA
#undef PG8_WAIT_V
#undef PG8_WAIT_L
#undef PG8_BAR
#undef PG8_SCHED
}
}
#ifndef MK_PER_PHASE
#define MK_PER_PHASE 0
#endif
#ifndef PROBE_PHASE
#define PROBE_PHASE -1
#endif
#ifndef X1_NR
#define X1_NR 2
#endif
#ifndef TABLES_IN_PHASE
#define TABLES_IN_PHASE 0
#endif
constexpr int NWAVES = 8, NTHR = NWAVES * 64;
constexpr int BATCH = 8, SEQ = 4096, D = 1024, M = BATCH * SEQ;
constexpr int INC = 2560;
constexpr int NEXP = 16384, PKN = 128;
constexpr int NQ = 2048;
constexpr float EPS = 1e-6f;
constexpr size_t MiB = 1u << 20;
constexpr size_t WS_CTL = 0, CTL_ZERO_BYTES = MK_PER_PHASE ? (1u << 20) : 64 * 1024;
constexpr size_t WS_MOD = 1 * MiB, WS_WIN = 2 * MiB, WS_WOUT = 7 * MiB, WS_WQ = 9 * MiB, WS_KEYS = 13 * MiB, WS_SGW = 13 * MiB + 512 * 1024;
constexpr size_t WS_SU = 14 * MiB, WS_UT = 16 * MiB, WS_VT = 48 * MiB, WS_H = 80 * MiB, WS_Y = 144 * MiB, WS_OATT = 80 * MiB, WS_Z = 208 * MiB, WS_QP = 208 * MiB;
constexpr size_t WS_H8 = 336 * MiB;
constexpr size_t WS_CAT = 368 * MiB, WS_IDX = 432 * MiB, WS_GATE = 448 * MiB, WS_END = 464 * MiB;
constexpr int CW_BAR = 4096;
constexpr int RING_BYTES = 131072, LDSCTL_OFF = RING_BYTES, MISC_OFF = LDSCTL_OFF + 320, LDS_BYTES = 147456;
constexpr int NPHASE = 10;

#define GAS __attribute__((address_space(1)))
#define LAS __attribute__((address_space(3)))
typedef unsigned short bf16;
typedef unsigned v4u __attribute__((ext_vector_type(4)));
typedef unsigned v2u __attribute__((ext_vector_type(2)));
typedef float f32x4 __attribute__((ext_vector_type(4)));
typedef short bf16x8 __attribute__((ext_vector_type(8)));
typedef GAS unsigned gu32;
typedef GAS unsigned long long gu64;
#define RLX_AGENT __ATOMIC_RELAXED, __HIP_MEMORY_SCOPE_AGENT
#define LDS_WAIT() asm volatile("s_waitcnt lgkmcnt(0)" ::: "memory")
#define VM_WAIT() asm volatile("s_waitcnt vmcnt(0)" ::: "memory")
__device__ __forceinline__ unsigned f2bf(float f) { unsigned u = __builtin_bit_cast(unsigned, f); return (u + 0x7fffu + ((u >> 16) & 1u)) >> 16; }
__device__ __forceinline__ unsigned pk2(float lo, float hi) { return f2bf(lo) | (f2bf(hi) << 16); }
__device__ __forceinline__ float bflo(unsigned w) { return __uint_as_float(w << 16); }
__device__ __forceinline__ float bfhi(unsigned w) { return __uint_as_float(w & 0xffff0000u); }
__device__ __forceinline__ float bf2f(bf16 b) { return __uint_as_float((unsigned)b << 16); }
typedef __bf16 bf16x2_t __attribute__((ext_vector_type(2)));
__device__ __forceinline__ float dot2(unsigned a, unsigned b, float acc) { return __builtin_amdgcn_fdot2_f32_bf16(__builtin_bit_cast(bf16x2_t, a), __builtin_bit_cast(bf16x2_t, b), acc, false); }
__device__ __forceinline__ float gelu_t(float v) { const float u = v * (1.f + 0.044715f * v * v); return v * __builtin_amdgcn_rcpf(1.f + __builtin_amdgcn_exp2f(-2.302208198f * u)); }
__device__ __forceinline__ int lane_id() { return (int)__builtin_amdgcn_mbcnt_hi(~0u, __builtin_amdgcn_mbcnt_lo(~0u, 0u)); }
__device__ __forceinline__ float wave_sum(float v) {
#pragma unroll
    for (int o = 1; o < 64; o <<= 1) v += __shfl_xor(v, o);
    return v;
}
#define DPP_SUM_ROW(v) do { v += __uint_as_float((unsigned)__builtin_amdgcn_update_dpp(0, (int)__float_as_uint(v), 0xB1, 0xF, 0xF, false)); \
        v += __uint_as_float((unsigned)__builtin_amdgcn_update_dpp(0, (int)__float_as_uint(v), 0x4E, 0xF, 0xF, false)); \
        v += __uint_as_float((unsigned)__builtin_amdgcn_update_dpp(0, (int)__float_as_uint(v), 0x141, 0xF, 0xF, false)); \
        v += __uint_as_float((unsigned)__builtin_amdgcn_update_dpp(0, (int)__float_as_uint(v), 0x140, 0xF, 0xF, false)); } while (0)
__device__ __forceinline__ float dpp_xor1(float v) { return __uint_as_float((unsigned)__builtin_amdgcn_update_dpp(0, (int)__float_as_uint(v), 0xB1, 0xF, 0xF, false)); }
__device__ __forceinline__ float wave_sum_dpp(float v) {
    DPP_SUM_ROW(v);
    const float r0 = __uint_as_float(__builtin_amdgcn_readlane(__float_as_uint(v), 0)), r1 = __uint_as_float(__builtin_amdgcn_readlane(__float_as_uint(v), 16));
    const float r2 = __uint_as_float(__builtin_amdgcn_readlane(__float_as_uint(v), 32)), r3 = __uint_as_float(__builtin_amdgcn_readlane(__float_as_uint(v), 48));
    return (r0 + r1) + (r2 + r3);
}
__device__ __forceinline__ float wave_max_dpp(float v) {
    v = fmaxf(v, __uint_as_float((unsigned)__builtin_amdgcn_update_dpp(0, (int)__float_as_uint(v), 0xB1, 0xF, 0xF, false)));
    v = fmaxf(v, __uint_as_float((unsigned)__builtin_amdgcn_update_dpp(0, (int)__float_as_uint(v), 0x4E, 0xF, 0xF, false)));
    v = fmaxf(v, __uint_as_float((unsigned)__builtin_amdgcn_update_dpp(0, (int)__float_as_uint(v), 0x141, 0xF, 0xF, false)));
    v = fmaxf(v, __uint_as_float((unsigned)__builtin_amdgcn_update_dpp(0, (int)__float_as_uint(v), 0x140, 0xF, 0xF, false)));
    const float r0 = __uint_as_float(__builtin_amdgcn_readlane(__float_as_uint(v), 0)), r1 = __uint_as_float(__builtin_amdgcn_readlane(__float_as_uint(v), 16));
    const float r2 = __uint_as_float(__builtin_amdgcn_readlane(__float_as_uint(v), 32)), r3 = __uint_as_float(__builtin_amdgcn_readlane(__float_as_uint(v), 48));
    return fmaxf(fmaxf(r0, r1), fmaxf(r2, r3));
}
__device__ __forceinline__ float half_max_dpp(float v) {
    v = fmaxf(v, __uint_as_float((unsigned)__builtin_amdgcn_update_dpp(0, (int)__float_as_uint(v), 0xB1, 0xF, 0xF, false)));
    v = fmaxf(v, __uint_as_float((unsigned)__builtin_amdgcn_update_dpp(0, (int)__float_as_uint(v), 0x4E, 0xF, 0xF, false)));
    v = fmaxf(v, __uint_as_float((unsigned)__builtin_amdgcn_update_dpp(0, (int)__float_as_uint(v), 0x141, 0xF, 0xF, false)));
    v = fmaxf(v, __uint_as_float((unsigned)__builtin_amdgcn_update_dpp(0, (int)__float_as_uint(v), 0x140, 0xF, 0xF, false)));
    const float r0 = __uint_as_float(__builtin_amdgcn_readlane(__float_as_uint(v), 0)), r1 = __uint_as_float(__builtin_amdgcn_readlane(__float_as_uint(v), 16));
    const float r2 = __uint_as_float(__builtin_amdgcn_readlane(__float_as_uint(v), 32)), r3 = __uint_as_float(__builtin_amdgcn_readlane(__float_as_uint(v), 48));
    return (lane_id() < 32) ? fmaxf(r0, r1) : fmaxf(r2, r3);
}
__device__ __forceinline__ float wave_max(float v) {
#pragma unroll
    for (int o = 1; o < 64; o <<= 1) v = fmaxf(v, __shfl_xor(v, o));
    return v;
}
#define XB_TMO      128
#define XB_XCNT(j)  (256  + 64 * (j))
#define XB_XSUB(j)  (1280 + 64 * (j))
#define XB_XGEN(j)  (2304 + 64 * (j))
#define XB_TOP      3328
#define XB_TOPGEN   3392
#define XCD_BAR_WORDS 3456
#define XB_SPIN_CAP (1u << 18)

__device__ __forceinline__ unsigned xb_ld(unsigned* p)              { return __hip_atomic_load(p, __ATOMIC_RELAXED, __HIP_MEMORY_SCOPE_AGENT); }
__device__ __forceinline__ unsigned xb_add(unsigned* p, unsigned v) { return __hip_atomic_fetch_add(p, v, __ATOMIC_RELAXED, __HIP_MEMORY_SCOPE_AGENT); }
__device__ __forceinline__ unsigned xb_xcc_id() { return (unsigned)__builtin_amdgcn_s_getreg((3 << 11) | 20) & 0xFu; }
#define XB_SPIN(cond, bar) do { unsigned _sp = 0; while (cond) { __builtin_amdgcn_s_sleep(1); \
    if ((++_sp & 255u) == 0u) { if (xb_ld(&(bar)[XB_TMO])) break; if (_sp > XB_SPIN_CAP) { atomicAdd(&(bar)[XB_TMO], 1u); break; } } } } while (0)

struct XcdBarrier {
    unsigned* bar; unsigned x;
    volatile LAS unsigned* st;
};

__device__ __forceinline__ XcdBarrier xcd_barrier_post(unsigned* bar, volatile LAS unsigned* st) {
    XcdBarrier b; b.bar = bar; b.x = xb_xcc_id(); b.st = st;
    if (threadIdx.x == 0) (void)xb_add(&bar[XB_XCNT(b.x)], 1u);
    return b;
}
__device__ __forceinline__ void xcd_barrier_complete(unsigned* bar, unsigned x, unsigned& nloc, unsigned& nx) {
    const unsigned G = gridDim.x * gridDim.y * gridDim.z;
    unsigned sum, cnt, mine, sp = 0u;
    for (;;) {
        sum = 0u; cnt = 0u; mine = 0u;
#pragma unroll
        for (unsigned j = 0; j < 16; ++j) { const unsigned c = xb_ld(&bar[XB_XCNT(j)]); sum += c; cnt += (c > 0u) ? 1u : 0u; mine = (j == x) ? c : mine; }
        if (sum == G) break;
        __builtin_amdgcn_s_sleep(1);
        if ((++sp & 255u) == 0u) { if (xb_ld(&bar[XB_TMO])) break; if (sp > XB_SPIN_CAP) { atomicAdd(&bar[XB_TMO], 1u); break; } }
    }
    nloc = mine > 0u ? mine : 1u; nx = cnt > 0u ? cnt : 1u;
}

__device__ __forceinline__ void xcd_barrier(const XcdBarrier& b) {
    asm volatile("s_waitcnt vmcnt(0)" ::: "memory");
    __syncthreads();
    if (threadIdx.x == 0) {
        unsigned* bar = b.bar;
        __builtin_amdgcn_s_waitcnt(0);
        unsigned nloc = b.st[0], nx = b.st[1];
        if (nloc == 0u) { xcd_barrier_complete(bar, b.x, nloc, nx); b.st[0] = nloc; b.st[1] = nx; }
        const unsigned old = xb_add(&bar[XB_XSUB(b.x)], 1u);
        const unsigned gen = old / nloc;
        if (old + 1u == (gen + 1u) * nloc) {
            __builtin_amdgcn_fence(__ATOMIC_RELEASE, "agent");
            asm volatile("s_waitcnt vmcnt(0)" ::: "memory");
            const unsigned og = xb_add(&bar[XB_TOP], 1u);
            const unsigned tg = og / nx;
            if (og + 1u == (tg + 1u) * nx) xb_add(&bar[XB_TOPGEN], 1u);
            else XB_SPIN(xb_ld(&bar[XB_TOPGEN]) == tg, bar);
            __builtin_amdgcn_fence(__ATOMIC_ACQUIRE, "agent");
            xb_add(&bar[XB_XGEN(b.x)], 1u);
            asm volatile("s_waitcnt vmcnt(0)" ::: "memory");
        } else {
            XB_SPIN(xb_ld(&bar[XB_XGEN(b.x)]) == gen, bar);
            __builtin_amdgcn_fence(__ATOMIC_ACQUIRE, "agent");
            asm volatile("s_waitcnt vmcnt(0)" ::: "memory");
        }
    }
    __syncthreads();
}
struct Frame {
    LAS unsigned char* lds;
    volatile LAS unsigned* MISC;
    gu32* ctl;
    int wave, G;
    const float *x, *c, *w_ada, *b_ada, *norm_g, *w_in, *sgu_ln_g, *sgu_ln_b, *sgu_w, *sgu_b, *diff_lambda, *subln_g, *rel_bias, *w_out, *w_query, *sub_keys, *peer_u, *peer_v;
    float* out;
    float* mod; bf16 *WIN, *WOUT, *WQ, *KEYS, *SGW, *H, *Y, *Z, *QP, *CAT; unsigned char *UT8, *VT6, *H8, *HA8, *W8, *WQ8; float *HS, *HAS, *WS8, *WQS8; float *SU, *SV, *PART; unsigned* STASH; int* IDX; float* GATE; bf16* X1B;
};

__device__ __forceinline__ void p0_transpose_item(const float* W, int K, int N, bf16* WT, int row_off, LAS float* scr, int item, int lane) {
    const int nblk = N / 32, kb = item / nblk, nb = item % nblk, k0 = 64 * kb, n0 = 32 * nb;
#pragma unroll 8
    for (int i = 0; i < 32; ++i) { const int kk = 2 * i + (lane >> 5); scr[kk * 33 + (lane & 31)] = W[(size_t)(k0 + kk) * N + n0 + (lane & 31)]; }
    LDS_WAIT(); asm volatile("" ::: "memory");
    const int c = lane & 7;
#pragma unroll
    for (int j = 0; j < 4; ++j) { const int n = (lane >> 3) + 8 * j; const LAS float* s = scr + (8 * c) * 33 + n;
        v4u o; o.x = pk2(s[0 * 33], s[1 * 33]); o.y = pk2(s[2 * 33], s[3 * 33]); o.z = pk2(s[4 * 33], s[5 * 33]); o.w = pk2(s[6 * 33], s[7 * 33]);
        *(GAS v4u*)(WT + (size_t)(row_off + n0 + n) * K + k0 + 8 * c) = o; }
    LDS_WAIT(); asm volatile("" ::: "memory");
}

__device__ __forceinline__ void prologue_tables_fwd(Frame& F, int gw, int NGW, int lane);
__device__ __forceinline__ void ph_prologue(Frame& F) {
    const int lane = lane_id(), wave = F.wave, tid = wave * 64 + lane, G = F.G;
    const int gw = blockIdx.x * NWAVES + wave, NGW = G * NWAVES;
    for (int rep_ = 0; rep_ < (PROBE_PHASE == 100 ? 2 : 1); ++rep_) {
        LAS float* sil = (LAS float*)F.lds;
        LAS float* red = sil + 8192;
        for (int i = tid; i < 8192; i += NTHR) { const float cv = F.c[i]; sil[i] = cv / (1.f + __expf(-cv)); }
        __syncthreads();
        for (int u = blockIdx.x; u < 384; u += G) {
            const int j = u * 16 + (lane & 15), kr = lane >> 4, k0 = wave * 128;
            float acc[8];
#pragma unroll
            for (int b = 0; b < 8; ++b) acc[b] = 0.f;
            const float* wp = F.w_ada + (size_t)(k0 + kr) * 6144 + j;
#pragma unroll 16
            for (int i = 0; i < 32; ++i) { const float w = wp[(size_t)i * 4 * 6144]; const int k = k0 + 4 * i + kr;
#pragma unroll
                for (int b = 0; b < 8; ++b) acc[b] += sil[b * 1024 + k] * w; }
#pragma unroll
            for (int b = 0; b < 8; ++b) { acc[b] += __shfl_xor(acc[b], 16); acc[b] += __shfl_xor(acc[b], 32); }
            if (lane < 16) {
#pragma unroll
                for (int b = 0; b < 8; ++b) red[(wave * 8 + b) * 16 + lane] = acc[b]; }
            __syncthreads();
            if (tid < 128) { const int b = tid >> 4, c = tid & 15; float s = 0.f;
#pragma unroll
                for (int w = 0; w < 8; ++w) s += red[(w * 8 + b) * 16 + c];
                F.mod[b * 6144 + u * 16 + c] = s + F.b_ada[u * 16 + c]; }
            __syncthreads();
        }
    }
    LAS float* scr = (LAS float*)(F.lds + wave * 16384);
    {
        LAS float* part = (LAS float*)(F.lds + 7 * 16384 + 8704);
        LAS float* fin = part + 256;
        const int rr = lane >> 3, cc = lane & 7;
        for (int u = blockIdx.x; u < (INC + NQ) / 32; u += G) {
            const bool isq = u >= INC / 32;
            const float* Wsrc = isq ? F.w_query : F.w_in; const int Nw = isq ? NQ : INC; unsigned char* Wdst = isq ? F.WQ8 : F.W8; float* Sdst = isq ? F.WQS8 : F.WS8;
            const int n0 = (isq ? u - INC / 32 : u) * 32;
            f32x4 wv[16];
            { const float* wp = Wsrc + (size_t)(wave * 128 + rr * 16) * Nw + n0 + cc * 4;
#pragma unroll
              for (int i = 0; i < 16; ++i) wv[i] = *(const f32x4*)(wp + (size_t)i * Nw); }
            f32x4 am = {0.f, 0.f, 0.f, 0.f};
#pragma unroll
            for (int i = 0; i < 16; ++i) { am.x = fmaxf(am.x, fabsf(wv[i].x)); am.y = fmaxf(am.y, fabsf(wv[i].y)); am.z = fmaxf(am.z, fabsf(wv[i].z)); am.w = fmaxf(am.w, fabsf(wv[i].w)); }
#pragma unroll
            for (int o = 8; o < 64; o <<= 1) { am.x = fmaxf(am.x, __shfl_xor(am.x, o)); am.y = fmaxf(am.y, __shfl_xor(am.y, o)); am.z = fmaxf(am.z, __shfl_xor(am.z, o)); am.w = fmaxf(am.w, __shfl_xor(am.w, o)); }
            if (lane < 8) *(LAS f32x4*)(part + wave * 32 + cc * 4) = am;
            __syncthreads();
            if (tid < 32) { float mx = 0.f;
#pragma unroll
                for (int w = 0; w < 8; ++w) mx = fmaxf(mx, part[w * 32 + tid]);
                const float qsc = (!isq && n0 >= 1024 && n0 < 1536) ? 0.125f * 1.4426950408889634f : 1.f;
                fin[tid] = mx; Sdst[n0 + tid] = (mx > 0.f ? mx * (1.f / 127.f) : 1.f) * qsc; }
            __syncthreads();
            const f32x4 cm = *(const LAS f32x4*)(fin + cc * 4);
            const f32x4 sc = {cm.x > 0.f ? 127.f / cm.x : 1.f, cm.y > 0.f ? 127.f / cm.y : 1.f, cm.z > 0.f ? 127.f / cm.z : 1.f, cm.w > 0.f ? 127.f / cm.w : 1.f};
            unsigned char* op = Wdst + (size_t)(n0 + cc * 4) * D + wave * 128 + rr * 16;
#define Q8PK(e_, s_) ({ unsigned w4_[4]; _Pragma("unroll") for (int d_ = 0; d_ < 4; ++d_) { \
                const int q0 = (int)rintf(wv[4 * d_].e_ * s_), q1 = (int)rintf(wv[4 * d_ + 1].e_ * s_), q2 = (int)rintf(wv[4 * d_ + 2].e_ * s_), q3 = (int)rintf(wv[4 * d_ + 3].e_ * s_); \
                w4_[d_] = (unsigned)((q0 & 255) | ((q1 & 255) << 8) | ((q2 & 255) << 16) | (q3 << 24)); } (v4u){w4_[0], w4_[1], w4_[2], w4_[3]}; })
            *(GAS v4u*)(op) = Q8PK(x, sc.x); *(GAS v4u*)(op + D) = Q8PK(y, sc.y); *(GAS v4u*)(op + 2 * D) = Q8PK(z, sc.z); *(GAS v4u*)(op + 3 * D) = Q8PK(w, sc.w);
#undef Q8PK
            __syncthreads();
        }
    }
    constexpr int I_IN = 0, I_OUT = (D / 64) * (D / 32), I_Q = 0;
    for (int rep_ = 0; rep_ < (PROBE_PHASE == 101 ? 2 : 1); ++rep_)
    for (int it = gw; it < I_IN + I_OUT + I_Q; it += NGW) {
        int r = it;
        if (r < I_IN) { p0_transpose_item(F.w_in, D, INC, F.WIN, 0, scr, r, lane); continue; } r -= I_IN;
        if (r < I_OUT) { p0_transpose_item(F.w_out, D, D, F.WOUT, 0, scr, r, lane); continue; } r -= I_OUT;
        (void)r;
    }
    const int gt = blockIdx.x * NTHR + tid, NT = G * NTHR;
    if (TABLES_IN_PHASE == 0) for (int rep_ = 0; rep_ < (PROBE_PHASE == 102 ? 2 : 1); ++rep_) prologue_tables_fwd(F, gw, NGW, lane);
    for (int i = gt; i < 16 * 16 * 128; i += NT) {
        const int hc = i >> 11, dg = (i >> 7) & 15, n = i & 127;
        const float* s = F.sub_keys + ((size_t)(hc * 128 + n)) * 128 + dg * 8;
        const f32x4 a = *(const f32x4*)s, b = *(const f32x4*)(s + 4);
        v4u o; o.x = pk2(a.x, a.y); o.y = pk2(a.z, a.w); o.z = pk2(b.x, b.y); o.w = pk2(b.z, b.w); ((v4u*)F.KEYS)[i] = o;
    }
    for (int i = gt; i < 8 * 128 * 16; i += NT) {
        const int t = (i >> 4) & 127, s0 = (i & 15) * 8;
        const float* s = F.sgu_w + (size_t)i * 8;
        const f32x4 a = *(const f32x4*)s, b = *(const f32x4*)(s + 4);
        float f[8] = {a.x, a.y, a.z, a.w, b.x, b.y, b.z, b.w};
#pragma unroll
        for (int e = 0; e < 8; ++e) f[e] = (s0 + e <= t) ? f[e] : 0.f;
        v4u o; o.x = pk2(f[0], f[1]); o.y = pk2(f[2], f[3]); o.z = pk2(f[4], f[5]); o.w = pk2(f[6], f[7]); ((v4u*)F.SGW)[i] = o;
    }
}

#define RLDS16(g_, lb_) do { unsigned sv_; asm volatile("s_mov_b32 %0, m0\n\ts_mov_b32 m0, %2\n\ts_nop 0\n\tglobal_load_lds_dwordx4 %1, off\n\ts_mov_b32 m0, %0" : "=&s"(sv_) : "v"(g_), "s"(lb_) : "memory"); } while (0)
#define VMW(n) asm volatile("s_waitcnt vmcnt(" #n ")" ::: "memory")
__device__ __forceinline__ void ph_hrows(Frame& F) {
    const int lane = lane_id(); const int gw = blockIdx.x * NWAVES + F.wave, NGW = F.G * NWAVES;
    const int rpw = (M + NGW - 1) / NGW, rbeg = gw * rpw, rend = (rbeg + rpw < M) ? rbeg + rpw : M;
    const int nrows = rend - rbeg;
    if (nrows <= 0) return;
    constexpr int NSL = 3;
    LAS unsigned char* ring = F.lds + F.wave * 16384;
    const unsigned rbase = (unsigned)__builtin_amdgcn_readfirstlane((int)(uintptr_t)ring);
    f32x4 s1[4], sh1[4]; int cb = -1;
#define HR_FILL(i_) do { const char* src_ = (const char*)(F.x + (size_t)(rbeg + (i_)) * D) + lane * 16; const unsigned lb_ = rbase + (unsigned)((i_) % NSL) * 4096u; \
        _Pragma("unroll") for (int j = 0; j < 4; ++j) RLDS16(src_ + j * 1024, lb_ + (unsigned)j * 1024u); } while (0)
    for (int i = 0; i < NSL && i < nrows; ++i) HR_FILL(i);
    for (int i = 0; i < nrows; ++i) { const int m = rbeg + i;
        if (i + 2 >= nrows) VMW(0); else VMW(8);
        if ((m >> 12) != cb) { cb = m >> 12; const float* md = F.mod + cb * 6144;
#pragma unroll
            for (int j = 0; j < 4; ++j) { const int c = 256 * j + 4 * lane;
                const f32x4 g = *(const f32x4*)(F.norm_g + c), sc = *(const f32x4*)(md + 1024 + c);
                s1[j] = g * (sc + 1.f); sh1[j] = *(const f32x4*)(md + c); }
            VMW(0); }
        f32x4 v[4];
        { const LAS unsigned char* sp = ring + (i % NSL) * 4096 + lane * 16;
#pragma unroll
          for (int j = 0; j < 4; ++j) v[j] = *(const LAS f32x4*)(sp + j * 1024); }
        float ss = 0.f;
#pragma unroll
        for (int j = 0; j < 4; ++j) ss += (v[j].x * v[j].x + v[j].y * v[j].y) + (v[j].z * v[j].z + v[j].w * v[j].w);
        const float rstd = rsqrtf(wave_sum_dpp(ss) * (1.f / D) + EPS);
        float am = 0.f;
#pragma unroll
        for (int j = 0; j < 4; ++j) { const f32x4 hv = (v[j] * rstd) * s1[j] + sh1[j]; v[j] = hv;
            am = fmaxf(am, fmaxf(fmaxf(fabsf(hv.x), fabsf(hv.y)), fmaxf(fabsf(hv.z), fabsf(hv.w)))); }
        am = wave_max_dpp(am);
        const float s8 = am > 0.f ? 127.f / am : 1.f;
        unsigned* h8 = (unsigned*)(F.HA8 + (size_t)m * D) + lane;
        unsigned q8[4];
#pragma unroll
        for (int j = 0; j < 4; ++j) { const int q0 = (int)rintf(v[j].x * s8), q1 = (int)rintf(v[j].y * s8), q2 = (int)rintf(v[j].z * s8), q3 = (int)rintf(v[j].w * s8);
            q8[j] = (unsigned)((q0 & 255) | ((q1 & 255) << 8) | ((q2 & 255) << 16) | (q3 << 24)); }
        asm volatile("s_waitcnt lgkmcnt(0)" ::: "memory");
#pragma unroll
        for (int j = 0; j < 4; ++j) h8[64 * j] = q8[j];
        { float* hp = F.HAS + m; const float hv_ = 1.f / s8; asm volatile("global_store_dword %0, %1, off" :: "v"(hp), "v"(hv_) : "memory"); }
        if (i + NSL < nrows) HR_FILL(i + NSL);
    }
    VMW(0);
#undef HR_FILL
}

__device__ __forceinline__ void ph_x1rows(Frame& F) {
    const int lane = lane_id(); const int gw = blockIdx.x * NWAVES + F.wave, NGW = F.G * NWAVES;
    const int rpw = (M + NGW - 1) / NGW, rbeg = gw * rpw, rend = (rbeg + rpw < M) ? rbeg + rpw : M;
    if (rbeg >= rend) return;
    f32x4 gg1[4], s2[4], sh2[4]; int cb = -1;
    f32x4 xv[4], xn[4]; v2u yw[4], yn[4];
#define XR_LOAD(dx, dy, m_) do { const f32x4* xr = (const f32x4*)(F.x + (size_t)(m_) * D) + lane; const v2u* yr = (const v2u*)(F.Y + (size_t)(m_) * D) + lane; \
        _Pragma("unroll") for (int j = 0; j < 4; ++j) { dx[j] = xr[64 * j]; dy[j] = yr[64 * j]; } } while (0)
    XR_LOAD(xv, yw, rbeg);
    for (int m = rbeg; m < rend; ++m) {
        if ((m >> 12) != cb) { cb = m >> 12; const float* md = F.mod + cb * 6144;
#pragma unroll
            for (int j = 0; j < 4; ++j) { const int c = 256 * j + 4 * lane;
                const f32x4 g1 = *(const f32x4*)(F.norm_g + 1024 + c), gt = *(const f32x4*)(md + 2048 + c);
                const f32x4 g2 = *(const f32x4*)(F.norm_g + 2048 + c), sc = *(const f32x4*)(md + 4096 + c);
                gg1[j] = gt * g1; s2[j] = g2 * (sc + 1.f); sh2[j] = *(const f32x4*)(md + 3072 + c); } }
        { const int mn = (m + 1 < rend) ? m + 1 : m; XR_LOAD(xn, yn, mn); }
        f32x4 yv[4]; float ss = 0.f;
#pragma unroll
        for (int j = 0; j < 4; ++j) { const v2u w = yw[j]; yv[j] = (f32x4){bflo(w.x), bfhi(w.x), bflo(w.y), bfhi(w.y)};
            ss += (yv[j].x * yv[j].x + yv[j].y * yv[j].y) + (yv[j].z * yv[j].z + yv[j].w * yv[j].w); }
        const float rstd = rsqrtf(wave_sum_dpp(ss) * (1.f / D) + EPS);
        v2u* orow = (v2u*)(F.X1B + (size_t)m * D) + lane; float s1 = 0.f;
#pragma unroll
        for (int j = 0; j < 4; ++j) { xv[j] = xv[j] + (yv[j] * rstd) * gg1[j]; orow[64 * j] = (v2u){pk2(xv[j].x, xv[j].y), pk2(xv[j].z, xv[j].w)};
            s1 += (xv[j].x * xv[j].x + xv[j].y * xv[j].y) + (xv[j].z * xv[j].z + xv[j].w * xv[j].w); }
        const float r1 = rsqrtf(wave_sum_dpp(s1) * (1.f / D) + EPS);
        float am = 0.f;
#pragma unroll
        for (int j = 0; j < 4; ++j) { const f32x4 hv = (xv[j] * r1) * s2[j] + sh2[j]; xv[j] = hv;
            am = fmaxf(am, fmaxf(fmaxf(fabsf(hv.x), fabsf(hv.y)), fmaxf(fabsf(hv.z), fabsf(hv.w)))); }
        am = wave_max_dpp(am);
        const float s8 = am > 0.f ? 127.f / am : 1.f;
        unsigned* h8 = (unsigned*)(F.H8 + (size_t)m * D) + lane;
#pragma unroll
        for (int j = 0; j < 4; ++j) { const int q0 = (int)rintf(xv[j].x * s8), q1 = (int)rintf(xv[j].y * s8), q2 = (int)rintf(xv[j].z * s8), q3 = (int)rintf(xv[j].w * s8);
            h8[64 * j] = (unsigned)((q0 & 255) | ((q1 & 255) << 8) | ((q2 & 255) << 16) | (q3 << 24)); }
        if (lane == 0) F.HS[m] = 1.f / s8;
#pragma unroll
        for (int j = 0; j < 4; ++j) { xv[j] = xn[j]; yw[j] = yn[j]; }
    }
#undef XR_LOAD
}

namespace att {
typedef float f32x16 __attribute__((ext_vector_type(16)));
typedef short s16x4 __attribute__((ext_vector_type(4)));
typedef short v4i16_t __attribute__((ext_vector_type(4)));
constexpr int QB = 256, KVB = 64;
constexpr int NS = 4;
constexpr int BTO = 288, BTN = 416;
constexpr int L_V = 0, L_K = NS * 16384, L_WS = L_K + NS * 8192, L_BT = L_WS + 2048, L_END = L_BT + 2048;
constexpr float C2 = 0.125f * 1.4426950408889634f;
__device__ __forceinline__ int v_st(int k, int c) { const int kk = (k & ~0xC) | ((k & 4) << 1) | ((k & 8) >> 1); return ((kk >> 3) * 4 + (c >> 5)) * 512 + ((kk & 7) * 32 + (c & 31)) * 2; }
__device__ __forceinline__ int v_rd_base(int lane) { return ((lane & 3) << 3) | (((lane >> 2) & 3) << 6) | (((lane >> 4) & 1) << 5) | (((lane >> 5) & 1) << 8); }
__device__ __forceinline__ unsigned v_src(int p) { const int sub = p >> 5, q = p & 31, kk = (sub >> 2) * 8 + (q >> 2), c = (sub & 3) * 32 + (q & 3) * 8;
    const int k = kk; return (unsigned)(k * INC + c) * 2u; }
__device__ __forceinline__ int crow(int r, int hi) { return (r & 3) + 8 * (r >> 2) + 4 * hi; }
typedef float f32x2_t __attribute__((ext_vector_type(2))); typedef __bf16 bf16x2_t __attribute__((ext_vector_type(2)));
__device__ __forceinline__ unsigned cvtpk(float lo, float hi) { const f32x2_t v = {lo, hi}; const bf16x2_t b = __builtin_convertvector(v, bf16x2_t); return __builtin_bit_cast(unsigned, b); }

__device__ __forceinline__ void attn_unit(Frame& F, int b, int h, int qb, float lam) {
    int tid = F.wave * 64 + lane_id(); asm volatile("" : "+v"(tid));
    const int lane = tid & 63, wid = F.wave, r32 = lane & 31, hi = lane >> 5;
    LAS unsigned char* lds = F.lds;
    LAS float* wsf = (LAS float*)(lds + L_WS) + wid * 64;
    const LAS float* bt = (const LAS float*)(lds + L_BT);
    const int q0 = qb * QB, qlo = q0 + wid * 32, qpos = qlo + r32;
    const size_t rowb = (size_t)b * SEQ;
    const int NT = (q0 + QB) / KVB;
    const unsigned kdoff = (unsigned)((tid >> 3) * INC + (((tid & 7) ^ ((tid >> 3) & 7)) * 8)) * 2u;
    const unsigned vdoff0 = v_src(tid), vdoff1 = v_src(tid + 512);
    const unsigned qoff = (unsigned)(r32 * INC + hi * 8) * 2u;
#define GLDS16(g_, lb_) do { unsigned sv_; asm volatile("s_mov_b32 %0, m0\n\ts_mov_b32 m0, %2\n\ts_nop 0\n\tglobal_load_lds_dwordx4 %1, off\n\ts_mov_b32 m0, %0" : "=&s"(sv_) : "v"(g_), "s"(lb_) : "memory"); } while (0)
#define DMA_K(t_, buf_) do { unsigned kd_ = kdoff; asm volatile("" : "+v"(kd_)); GLDS16(Kb + (size_t)(t_) * (KVB * INC * 2) + kd_, (unsigned)__builtin_amdgcn_readfirstlane((int)(uintptr_t)(lds + L_K + (buf_) * 8192 + wid * 1024))); } while (0)
#define DMA_V(t_, buf_) do { unsigned v0_ = vdoff0, v1_ = vdoff1; asm volatile("" : "+v"(v0_), "+v"(v1_)); const unsigned lb_ = (unsigned)__builtin_amdgcn_readfirstlane((int)(uintptr_t)(lds + L_V + (buf_) * 16384 + wid * 1024)); \
        GLDS16(Vb + (size_t)(t_) * (KVB * INC * 2) + v0_, lb_); GLDS16(Vb + (size_t)(t_) * (KVB * INC * 2) + v1_, lb_ + 8192u); } while (0)
#define DMA_TILE(t_) do { const int sl_ = (t_) & (NS - 1); DMA_K(t_, sl_); DMA_V(t_, sl_); } while (0)
#define ABAR() do { asm volatile("s_waitcnt lgkmcnt(0)" ::: "memory"); __builtin_amdgcn_s_barrier(); asm volatile("" ::: "memory"); } while (0)
    const int vbase = (int)(uintptr_t)(lds + L_V) + v_rd_base(lane);
    const int kroff = r32 * 128, kx = (r32 & 7) << 4;
#pragma unroll
    for (int c = 0; c < 2; ++c) {
        const char* Kb = (const char*)(F.Z + rowb * INC + 1536 + h * 128 + c * 64);
        const char* Vb = (const char*)(F.Z + rowb * INC + 2048 + h * 128);
        const char* Qb = (const char*)(F.Z + (rowb + qlo) * INC + 1024 + h * 128 + c * 64);
        bf16x8 qr[4];
#pragma unroll
        for (int d0 = 0; d0 < 4; ++d0) qr[d0] = *(const bf16x8*)(Qb + d0 * 32 + qoff);
        DMA_K(0, 0); DMA_V(0, 0); DMA_K(1, 1); DMA_K(2, 2); DMA_V(1, 1); DMA_K(3, 3); DMA_V(2, 2);
        asm volatile("s_waitcnt vmcnt(9)" ::: "memory");
        ABAR();
        float mhat, l = 0.f; bool resc = false;
        f32x16 o[4];
#pragma unroll
        for (int d0 = 0; d0 < 4; ++d0) o[d0] = f32x16{};
        f32x16 pA0, pA1, pB0, pB1; bf16x8 kf[4]; s16x4 vlo[4], vhi[4]; v4u pw0, pw1, pw2, pw3;
        f32x16 negm; { float z_ = 0.f; asm volatile("" : "+v"(z_));
#pragma unroll
          for (int r = 0; r < 16; ++r) negm[r] = z_; }
        asm volatile("" : "+v"(negm));
#define SBAR() __builtin_amdgcn_sched_barrier(0)
#define PIN(x) asm volatile("" : "+v"(x))
#define MFMA32(a_, b_, c_) __builtin_amdgcn_mfma_f32_32x32x16_bf16(a_, b_, c_, 0, 0, 0)
#define KLD2(su, d0) do { const LAS unsigned char* a_ = lds + L_K + (su) * 8192 + kroff + (((d0) * 32 + hi * 16) ^ kx); kf[2 * ((d0) & 1)] = *(const LAS bf16x8*)a_; kf[2 * ((d0) & 1) + 1] = *(const LAS bf16x8*)(a_ + 4096); } while (0)
#define VTR(p_) __builtin_bit_cast(s16x4, __builtin_amdgcn_ds_read_tr16_b64_v4i16((LAS v4i16_t*)(p_)))
#define VRD(i) do { const LAS unsigned char* p_ = vp_ + ((i) >> 2) * 512 + ((i) & 3) * 4096; vlo[(i) & 3] = VTR(p_); vhi[(i) & 3] = VTR(p_ + 2048); } while (0)
#define VFR(i) (bf16x8){vlo[(i) & 3][0], vlo[(i) & 3][1], vlo[(i) & 3][2], vlo[(i) & 3][3], vhi[(i) & 3][0], vhi[(i) & 3][1], vhi[(i) & 3][2], vhi[(i) & 3][3]}
#define PAF(k) __builtin_bit_cast(bf16x8, pw##k)
#define MX3(a_, b_, c_) fmaxf(fmaxf((a_), (b_)), (c_))
#define ROWMAX(P0, P1, OUT) do { float a_ = MX3(P0[0], P0[1], P1[0]), b_ = MX3(P0[2], P0[3], P1[1]); a_ = MX3(a_, P1[2], P1[3]); \
        _Pragma("unroll") for (int r = 4; r < 16; r += 4) { a_ = MX3(a_, P0[r], P0[r + 1]); b_ = MX3(b_, P0[r + 2], P0[r + 3]); a_ = MX3(a_, P1[r], P1[r + 1]); b_ = MX3(b_, P1[r + 2], P1[r + 3]); } \
        float m_ = fmaxf(a_, b_); auto rr_ = __builtin_amdgcn_permlane32_swap(__float_as_uint(m_), __float_as_uint(m_), false, false); OUT = fmaxf(__uint_as_float(rr_[0]), __uint_as_float(rr_[1])); } while (0)
#define FIX_TILE(N0, N1, u) do { if (qlo - (u) * KVB - 63 < 113) { int qp_ = qpos - 4 * hi; asm volatile("" : "+v"(qp_)); const int dq_ = qp_ - (u) * KVB + BTO;     \
        _Pragma("unroll") for (int r = 0; r < 16; ++r) { const int i0_ = dq_ - ((r & 3) + 8 * (r >> 2)), i1_ = i0_ - 32; \
            N0[r] += bt[i0_ > BTN - 1 ? BTN - 1 : i0_]; N1[r] += bt[i1_ > BTN - 1 ? BTN - 1 : (i1_ < 0 ? 0 : i1_)]; } } } while (0)
#define EX(v) __builtin_amdgcn_exp2f(v)
#define RESC() do { if (resc) { _Pragma("unroll") for (int r = 0; r < 16; ++r) { const float a_ = wsf[crow(r, hi)]; _Pragma("unroll") for (int d0 = 0; d0 < 4; ++d0) o[d0][r] *= a_; } } } while (0)
#define PKH0(P, B_, PW) do { PW.x = cvtpk(P[B_ + 0], P[B_ + 1]); PW.y = cvtpk(P[B_ + 2], P[B_ + 3]); } while (0)
#define PKH1(P, B_, PW) do { PW.z = cvtpk(P[B_ + 4], P[B_ + 5]); PW.w = cvtpk(P[B_ + 6], P[B_ + 7]); } while (0)
#define GAPA(MF, a0, a1, a2, a3, PK, PW) do { MF; sacc += a0; sacc += a1; sacc += a2; sacc += a3; PK; PIN(PW); PIN(sacc); SBAR(); } while (0)
#define GAPB(MF, X, i) do { MF; X[i] = EX(X[i]); X[i + 1] = EX(X[i + 1]); PIN(X); SBAR(); } while (0)
        KLD2(0, 0); KLD2(0, 1);
        pA0 = MFMA32(kf[0], qr[0], negm); pA1 = MFMA32(kf[1], qr[0], negm); pA0 = MFMA32(kf[2], qr[1], pA0); pA1 = MFMA32(kf[3], qr[1], pA1);
        KLD2(0, 2); KLD2(0, 3);
        pA0 = MFMA32(kf[0], qr[2], pA0); pA1 = MFMA32(kf[1], qr[2], pA1); pA0 = MFMA32(kf[2], qr[3], pA0); pA1 = MFMA32(kf[3], qr[3], pA1);
        FIX_TILE(pA0, pA1, 0);
        { float rm; ROWMAX(pA0, pA1, rm); mhat = rm;
#pragma unroll
          for (int r = 0; r < 16; ++r) negm[r] = -mhat;
          asm volatile("" : "+v"(negm));
#pragma unroll
          for (int r = 0; r < 16; ++r) { pA0[r] = EX(pA0[r] - rm); pA1[r] = EX(pA1[r] - rm); } }
        asm volatile("s_waitcnt vmcnt(5)" ::: "memory");
        ABAR();
        KLD2(1, 0); KLD2(1, 1);
#define STEP(C0, C1, P0, P1, t) do { SBAR(); \
        if ((t) + 3 < NT) DMA_K((t) + 3, ((t) + 3) & (NS - 1)); if ((t) + 2 < NT) DMA_V((t) + 2, ((t) + 2) & (NS - 1)); \
        const LAS unsigned char* vp_ = (const LAS unsigned char*)(uintptr_t)(vbase + (((t) - 1) & (NS - 1)) * 16384); \
        const int ksl_ = ((t) + 1) & (NS - 1); const bool gl_ = (t) + 1 < NT; \
        float sacc = 0.f; \
                        GAPA(C0 = MFMA32(kf[0], qr[0], negm), P0[0], P0[1], P0[2], P0[3],     PKH0(P0, 0, pw0), pw0); \
                        GAPA(C1 = MFMA32(kf[1], qr[0], negm), P0[4], P0[5], P0[6], P0[7],     PKH1(P0, 0, pw0), pw0); KLD2((t) & (NS - 1), 2); SBAR();     \
                        GAPA(C0 = MFMA32(kf[2], qr[1], C0),   P0[8], P0[9], P0[10], P0[11],   PKH0(P0, 8, pw1), pw1); \
                        GAPA(C1 = MFMA32(kf[3], qr[1], C1),   P0[12], P0[13], P0[14], P0[15], PKH1(P0, 8, pw1), pw1); KLD2((t) & (NS - 1), 3); SBAR(); \
        VRD(0); SBAR(); GAPA(C0 = MFMA32(kf[0], qr[2], C0),   P1[0], P1[1], P1[2], P1[3],     PKH0(P1, 0, pw2), pw2); \
        VRD(1); SBAR(); GAPA(C1 = MFMA32(kf[1], qr[2], C1),   P1[4], P1[5], P1[6], P1[7],     PKH1(P1, 0, pw2), pw2); \
        VRD(2); SBAR(); GAPA(C0 = MFMA32(kf[2], qr[3], C0),   P1[8], P1[9], P1[10], P1[11],   PKH0(P1, 8, pw3), pw3); \
        VRD(3); SBAR(); GAPA(C1 = MFMA32(kf[3], qr[3], C1),   P1[12], P1[13], P1[14], P1[15], PKH1(P1, 8, pw3), pw3); \
        l += sacc; \
        FIX_TILE(C0, C1, t); \
        { float rm_; ROWMAX(C0, C1, rm_); resc = false;                                                    \
          if (__builtin_expect(__any(rm_ > 8.0f), 0)) { const float dl_ = fmaxf(rm_, 0.f); mhat += dl_;     \
              _Pragma("unroll") for (int r = 0; r < 16; ++r) { C0[r] -= dl_; C1[r] -= dl_; } \
              _Pragma("unroll") for (int r = 0; r < 16; ++r) negm[r] = -mhat; \
              asm volatile("" : "+v"(negm)); \
              const float f_ = __builtin_amdgcn_exp2f(-dl_); l *= f_; if (hi == 0) wsf[r32] = f_; resc = true; } } \
        SBAR(); \
        GAPB(o[0] = MFMA32(PAF(0), VFR(0), o[0]), C0, 0);   VRD(4);  SBAR(); \
        GAPB(o[0] = MFMA32(PAF(1), VFR(1), o[0]), C0, 2);   VRD(5);  SBAR(); \
        GAPB(o[0] = MFMA32(PAF(2), VFR(2), o[0]), C0, 4);   VRD(6);  SBAR(); \
        GAPB(o[0] = MFMA32(PAF(3), VFR(3), o[0]), C0, 6);   VRD(7);  SBAR(); \
        GAPB(o[1] = MFMA32(PAF(0), VFR(4), o[1]), C0, 8);   VRD(8);  SBAR(); \
        GAPB(o[1] = MFMA32(PAF(1), VFR(5), o[1]), C0, 10);  VRD(9);  SBAR(); \
        GAPB(o[1] = MFMA32(PAF(2), VFR(6), o[1]), C0, 12);  VRD(10); SBAR(); \
        GAPB(o[1] = MFMA32(PAF(3), VFR(7), o[1]), C0, 14);  VRD(11); SBAR(); \
        GAPB(o[2] = MFMA32(PAF(0), VFR(8), o[2]), C1, 0);   VRD(12); SBAR(); \
        GAPB(o[2] = MFMA32(PAF(1), VFR(9), o[2]), C1, 2);   VRD(13); SBAR(); \
        GAPB(o[2] = MFMA32(PAF(2), VFR(10), o[2]), C1, 4);  VRD(14); SBAR(); \
        GAPB(o[2] = MFMA32(PAF(3), VFR(11), o[2]), C1, 6);  VRD(15); SBAR(); \
        GAPB(o[3] = MFMA32(PAF(0), VFR(12), o[3]), C1, 8);  if (gl_) { KLD2(ksl_, 0); SBAR(); } \
        GAPB(o[3] = MFMA32(PAF(1), VFR(13), o[3]), C1, 10); if (gl_) { KLD2(ksl_, 1); SBAR(); } \
        GAPB(o[3] = MFMA32(PAF(2), VFR(14), o[3]), C1, 12); \
        GAPB(o[3] = MFMA32(PAF(3), VFR(15), o[3]), C1, 14); \
        if ((t) + 3 < NT) asm volatile("s_waitcnt vmcnt(5)" ::: "memory"); else asm volatile("s_waitcnt vmcnt(0)" ::: "memory"); \
        ABAR(); RESC(); } while (0)
        if (wid >= 4) __builtin_amdgcn_s_setprio(1);
        {
            int t = 1;
            for (; t + 1 < NT; t += 2) {
                STEP(pB0, pB1, pA0, pA1, t);
                STEP(pA0, pA1, pB0, pB1, t + 1);
            }
            STEP(pB0, pB1, pA0, pA1, NT - 1);
        }
        __builtin_amdgcn_s_setprio(0);
        { float sacc = 0.f;
#pragma unroll
          for (int r = 0; r < 16; ++r) sacc += pB0[r];
#pragma unroll
          for (int r = 0; r < 16; ++r) sacc += pB1[r];
          l += sacc;
          PKH0(pB0, 0, pw0); PKH1(pB0, 0, pw0); PKH0(pB0, 8, pw1); PKH1(pB0, 8, pw1); PKH0(pB1, 0, pw2); PKH1(pB1, 0, pw2); PKH0(pB1, 8, pw3); PKH1(pB1, 8, pw3);
          const LAS unsigned char* vp_ = (const LAS unsigned char*)(uintptr_t)(vbase + ((NT - 1) & (NS - 1)) * 16384);
#pragma unroll
          for (int db = 0; db < 4; ++db) { VRD(0); VRD(1); VRD(2); VRD(3);
              o[db] = MFMA32(PAF(0), VFR(0), o[db]); o[db] = MFMA32(PAF(1), VFR(1), o[db]); o[db] = MFMA32(PAF(2), VFR(2), o[db]); o[db] = MFMA32(PAF(3), VFR(3), o[db]); vp_ += 512; } }
        { auto rr_ = __builtin_amdgcn_permlane32_swap(__float_as_uint(l), __float_as_uint(l), false, false); l = __uint_as_float(rr_[0]) + __uint_as_float(rr_[1]); }
#undef SBAR
#undef PIN
#undef MFMA32
#undef KLD2
#undef VTR
#undef VRD
#undef VFR
#undef PAF
#undef MX3
#undef ROWMAX
#undef FIX_TILE
#undef EX
#undef RESC
#undef PKH0
#undef PKH1
#undef GAPA
#undef GAPB
#undef STEP
        int lane_e = lane_id(); asm volatile("" : "+v"(lane_e));
        const int r32e = lane_e & 31, hie = lane_e >> 5;
        const unsigned o0off = (unsigned)((blockIdx.x * NTHR + wid * 64 + lane_e) * 128);
        if (hie == 0) wsf[32 + r32e] = l;
        float rl[16];
#pragma unroll
        for (int r = 0; r < 16; ++r) rl[r] = __builtin_amdgcn_rcpf(wsf[32 + crow(r, hie)]);
        if (c == 0) {
#pragma unroll
            for (int d0 = 0; d0 < 4; ++d0)
#pragma unroll
                for (int j = 0; j < 2; ++j) { v4u w;
                    w.x = cvtpk(o[d0][8 * j + 0] * rl[8 * j + 0], o[d0][8 * j + 1] * rl[8 * j + 1]); w.y = cvtpk(o[d0][8 * j + 2] * rl[8 * j + 2], o[d0][8 * j + 3] * rl[8 * j + 3]);
                    w.z = cvtpk(o[d0][8 * j + 4] * rl[8 * j + 4], o[d0][8 * j + 5] * rl[8 * j + 5]); w.w = cvtpk(o[d0][8 * j + 6] * rl[8 * j + 6], o[d0][8 * j + 7] * rl[8 * j + 7]);
                    *(v4u*)((char*)F.STASH + o0off + (d0 * 2 + j) * 16) = w; }
        } else {
            float ss[16];
#pragma unroll
            for (int r = 0; r < 16; ++r) ss[r] = 0.f;
#pragma unroll
            for (int d0 = 0; d0 < 4; ++d0)
#pragma unroll
                for (int j = 0; j < 2; ++j) { const v4u w = *(const v4u*)((const char*)F.STASH + o0off + (d0 * 2 + j) * 16); const unsigned ww[4] = {w.x, w.y, w.z, w.w};
#pragma unroll
                    for (int k = 0; k < 4; ++k) { const int i = 4 * j + k;
                        const float a0 = bflo(ww[k]) - lam * (o[d0][2 * i] * rl[2 * i]), a1 = bfhi(ww[k]) - lam * (o[d0][2 * i + 1] * rl[2 * i + 1]);
                        o[d0][2 * i] = a0; o[d0][2 * i + 1] = a1; ss[2 * i] += a0 * a0; ss[2 * i + 1] += a1 * a1; } }
#pragma unroll
            for (int r = 0; r < 16; ++r) {
                { DPP_SUM_ROW(ss[r]); ss[r] += __shfl_xor(ss[r], 16); }
                ss[r] = rsqrtf(ss[r] * (1.f / 128.f) + EPS) * 0.8f;
            }
            bf16* Cw = F.CAT + (rowb + qlo) * 1024 + 512 + h * 128;
#pragma unroll
            for (int d0 = 0; d0 < 4; ++d0) { const float g = F.subln_g[d0 * 32 + r32e];
                unsigned off = (unsigned)((4 * hie * 1024 + d0 * 32 + r32e) * 2);
#pragma unroll
                for (int r = 0; r < 16; ++r) { const float v = o[d0][r] * ss[r] * g; const float vn = dpp_xor1(v);
                    if ((r32e & 1) == 0) *(unsigned*)((char*)Cw + off) = cvtpk(v, vn);
                    off += ((r & 3) == 3) ? 5u * 2048u : 2048u; asm volatile("" : "+v"(off)); } }
        }
        __syncthreads();
    }
#undef DMA_K
#undef DMA_V
#undef DMA_TILE
#undef ABAR
}

__device__ __forceinline__ void attn_phase(Frame& F) {
    const int lane = lane_id(), tid = F.wave * 64 + lane;
    const float s01 = wave_sum(F.diff_lambda[lane] * F.diff_lambda[64 + lane]), s23 = wave_sum(F.diff_lambda[128 + lane] * F.diff_lambda[192 + lane]);
    const float lam = __expf(s01) - __expf(s23) + 0.2f;
    const int G = F.G;
    for (int it = ((G % 8 == 0) ? ((int)(blockIdx.x % 8) * (G / 8) + (int)blockIdx.x / 8) : (int)blockIdx.x); it < 256; it += G) {
        const int bh = it >> 3, x = it & 7, b = bh >> 2, h = bh & 3;
        LAS float* bt = (LAS float*)(F.lds + L_BT);
        __syncthreads();
        if (tid < BTN) { const int d = tid - BTO; int bk = d; if (d >= 16) { bk = 16 + (int)(__log2f((float)d * (1.f / 16.f)) * (16.f / 3.f)); bk = bk > 31 ? 31 : bk; }
            bt[tid] = d < 0 ? -__builtin_inff() : (F.rel_bias[bk * 4 + h] - F.rel_bias[31 * 4 + h]) * 1.4426950408889634f; }
        __syncthreads();
        attn_unit(F, b, h, x, lam);
        attn_unit(F, b, h, 15 - x, lam);
    }
}
}

namespace sgu {
typedef float f32x16 __attribute__((ext_vector_type(16)));
typedef short s16x4 __attribute__((ext_vector_type(4)));
constexpr int L_T = 0, L_ST = 65536;
__device__ __forceinline__ void sgu_chunk(Frame& F, int chunk) {
    int tid = F.wave * 64 + lane_id(); asm volatile("" : "+v"(tid));
    const int lane = tid & 63, g = F.wave, r32 = lane & 31, hi = lane >> 5;
    LAS unsigned char* lds = F.lds;
    LAS float* st = (LAS float*)(lds + L_ST);
    const size_t t0 = (size_t)chunk * 128;
    for (int i = 0; i < 16; i += 2) {
        v4u raw[2];
#pragma unroll
        for (int u = 0; u < 2; ++u) raw[u] = *(const v4u*)(F.Z + (t0 + g * 16 + i + u) * INC + 512 + lane * 8);
#pragma unroll
        for (int u = 0; u < 2; ++u) { const int tl = g * 16 + i + u;
            float f[8] = {bflo(raw[u].x), bfhi(raw[u].x), bflo(raw[u].y), bfhi(raw[u].y), bflo(raw[u].z), bfhi(raw[u].z), bflo(raw[u].w), bfhi(raw[u].w)};
            float s = 0.f;
#pragma unroll
            for (int e = 0; e < 8; ++e) s += f[e];
            const float mean = wave_sum_dpp(s) * (1.f / 512.f); float q = 0.f;
#pragma unroll
            for (int e = 0; e < 8; ++e) { f[e] -= mean; q += f[e] * f[e]; }
            const float rstd = rsqrtf(wave_sum_dpp(q) * (1.f / 512.f) + EPS);
            if (lane == 0) { st[2 * tl] = mean; st[2 * tl + 1] = rstd; } }
    }
    __syncthreads();
    f32x16 acc[2][2];
    const int sr = tid >> 4, sc = (tid & 15) * 8;
    const int vb0 = (int)(uintptr_t)(lds + L_T) + (g >> 1) * 16384 + att::v_rd_base(lane);
#define SGU_STAGE(sh) do { _Pragma("unroll") for (int tile = 0; tile < 4; ++tile) { const int ch = tile * 128 + sc; \
            const f32x4 g0 = *(const f32x4*)(F.sgu_ln_g + ch), g1 = *(const f32x4*)(F.sgu_ln_g + ch + 4), b0 = *(const f32x4*)(F.sgu_ln_b + ch), b1 = *(const f32x4*)(F.sgu_ln_b + ch + 4); \
            _Pragma("unroll") for (int rr = 0; rr < 2; ++rr) { const int s = (sh) * 64 + sr + 32 * rr; \
                const v4u raw = *(const v4u*)(F.Z + (t0 + s) * INC + 512 + ch); const float mean = st[2 * s], rstd = st[2 * s + 1]; v4u o; \
                o.x = pk2((bflo(raw.x) - mean) * rstd * g0.x + b0.x, (bfhi(raw.x) - mean) * rstd * g0.y + b0.y); \
                o.y = pk2((bflo(raw.y) - mean) * rstd * g0.z + b0.z, (bfhi(raw.y) - mean) * rstd * g0.w + b0.w); \
                o.z = pk2((bflo(raw.z) - mean) * rstd * g1.x + b1.x, (bfhi(raw.z) - mean) * rstd * g1.y + b1.y); \
                o.w = pk2((bflo(raw.w) - mean) * rstd * g1.z + b1.z, (bfhi(raw.w) - mean) * rstd * g1.w + b1.w); \
                *(LAS v4u*)(lds + L_T + tile * 16384 + att::v_st(sr + 32 * rr, sc)) = o; } } } while (0)
#define TRRD(dst, off) asm volatile("ds_read_b64_tr_b16 %0, %1 offset:%2" : "=&v"(dst) : "v"(vb0), "i"(off) : "memory")
#define SGU_MMA(sh, tb0) do { _Pragma("unroll") for (int ks = 0; ks < 4; ++ks) { s16x4 l0, h0, l1, h1; \
            if ((g & 1) == 0) { TRRD(l0, 0 * 512 + ks * 4096); TRRD(h0, 0 * 512 + ks * 4096 + 2048); TRRD(l1, 1 * 512 + ks * 4096); TRRD(h1, 1 * 512 + ks * 4096 + 2048); } \
            else              { TRRD(l0, 2 * 512 + ks * 4096); TRRD(h0, 2 * 512 + ks * 4096 + 2048); TRRD(l1, 3 * 512 + ks * 4096); TRRD(h1, 3 * 512 + ks * 4096 + 2048); } \
            asm volatile("s_waitcnt lgkmcnt(0)" ::: "memory"); __builtin_amdgcn_sched_barrier(0); \
            const bf16x8 B0 = (bf16x8){l0[0], l0[1], l0[2], l0[3], h0[0], h0[1], h0[2], h0[3]}, B1 = (bf16x8){l1[0], l1[1], l1[2], l1[3], h1[0], h1[1], h1[2], h1[3]}; \
            _Pragma("unroll") for (int tl = 0; tl < 2; ++tl) { const int tb = (tb0) + tl; if ((sh) * 64 + 16 * ks > tb * 32 + 31) continue; \
                const bf16x8 A = *(const bf16x8*)(F.SGW + ((size_t)(g * 128 + tb * 32 + r32)) * 128 + (sh) * 64 + 16 * ks + 8 * hi); \
                acc[tl][0] = __builtin_amdgcn_mfma_f32_32x32x16_bf16(A, B0, acc[tl][0], 0, 0, 0); \
                acc[tl][1] = __builtin_amdgcn_mfma_f32_32x32x16_bf16(A, B1, acc[tl][1], 0, 0, 0); } } } while (0)
#define SGU_EPI(tb0) do { _Pragma("unroll") for (int tl = 0; tl < 2; ++tl) _Pragma("unroll") for (int r = 0; r < 16; ++r) { \
            const int t = ((tb0) + tl) * 32 + att::crow(r, hi); const float bs = F.sgu_b[g * 128 + t]; \
            _Pragma("unroll") for (int db = 0; db < 2; ++db) { const int ch = g * 64 + db * 32 + r32; \
                const float u = bf2f(F.Z[(t0 + t) * INC + ch]); const float v = u * (acc[tl][db][r] + bs); const float vn = dpp_xor1(v); \
                if ((r32 & 1) == 0) *(unsigned*)(F.CAT + (t0 + t) * 1024 + ch) = att::cvtpk(v, vn); } } } while (0)
#define SGU_ZERO() do { acc[0][0] = f32x16{}; acc[0][1] = f32x16{}; acc[1][0] = f32x16{}; acc[1][1] = f32x16{}; } while (0)
    SGU_STAGE(0);
    __syncthreads();
    SGU_ZERO(); SGU_MMA(0, 0); SGU_EPI(0);
    SGU_ZERO(); SGU_MMA(0, 2);
    __syncthreads();
    SGU_STAGE(1);
    __syncthreads();
    SGU_MMA(1, 2); SGU_EPI(2);
#undef SGU_STAGE
#undef TRRD
#undef SGU_MMA
#undef SGU_EPI
#undef SGU_ZERO
}
__device__ __forceinline__ void sgu_phase(Frame& F) { for (int ck = blockIdx.x; ck < M / 128; ck += F.G) { sgu_chunk(F, ck); __syncthreads(); } }
}

namespace tk {
typedef float f32x16 __attribute__((ext_vector_type(16)));
__device__ __forceinline__ float vmax(float a, float b) { float r; asm("v_max_f32 %0, %1, %2" : "=v"(r) : "v"(a), "v"(b)); return r; }
__device__ __forceinline__ float vmin(float a, float b) { float r; asm("v_min_f32 %0, %1, %2" : "=v"(r) : "v"(a), "v"(b)); return r; }
#define TK_CE(a, b) do { const float _mx = vmax(a, b), _mn = vmin(a, b); a = _mx; b = _mn; } while (0)
template <int N> __device__ __forceinline__ void sort_desc(float (&a)[N]) {
#pragma unroll
    for (int k = 2; k <= N; k <<= 1)
#pragma unroll
        for (int j = k >> 1; j > 0; j >>= 1)
#pragma unroll
            for (int i = 0; i < N; ++i) { const int l = i ^ j; if (l > i) { if ((i & k) == 0) TK_CE(a[i], a[l]); else TK_CE(a[l], a[i]); } }
}
template <int N> __device__ __forceinline__ void merge_desc(float (&a)[N]) {
#pragma unroll
    for (int j = N >> 1; j > 0; j >>= 1)
#pragma unroll
        for (int i = 0; i < N; ++i) { const int l = i ^ j; if (l > i) TK_CE(a[i], a[l]); }
}
__device__ __forceinline__ void top16_merge(float (&a)[16], const float (&b)[16]) {
#pragma unroll
    for (int i = 0; i < 16; ++i) a[i] = vmax(a[i], b[15 - i]);
    merge_desc<16>(a);
}
__device__ __forceinline__ float embed(float v, unsigned mask, unsigned code) { return __uint_as_float((__float_as_uint(v) & mask) | code); }

__device__ __forceinline__ void topk_phase(Frame& F) {
    int lane = lane_id(); asm volatile("" : "+v"(lane));
    const int r32 = lane & 31, hi = lane >> 5;
    const int gw = blockIdx.x * NWAVES + F.wave, NGW = F.G * NWAVES;
    LAS unsigned* tab = (LAS unsigned*)(F.lds + F.wave * 8192) + lane;
    const float NEG = -__builtin_inff();
    constexpr int NTASK = (M / 32) * 8; const int per = (NTASK + NGW - 1) / NGW;
    unsigned code16[16];
#pragma unroll
    for (int r = 0; r < 16; ++r) code16[r] = (unsigned)((r & 3) + 8 * (r >> 2) + 4 * hi);
    const unsigned qoff = (unsigned)(r32 * NQ + hi * 8), koff = (unsigned)((hi * 128 + r32) * 8);
#define TK_QP(task_, c_) (F.QP + (size_t)((task_) >> 3) * 32 * NQ + ((task_) & 7) * 256 + (c_) * 128)
#define TK_KP(task_, c_) (F.KEYS + (size_t)((((task_) & 7) * 2 + (c_)) * 16) * 128 * 8)
#define TK_LDQ(dst, task_, c_) do { const bf16* qp_ = TK_QP(task_, c_); _Pragma("unroll") for (int ks = 0; ks < 8; ++ks) dst[ks] = *(const bf16x8*)(qp_ + ks * 16 + qoff); } while (0)
#define TK_LDK(dst, task_, c_, nb_) do { const bf16* kp_ = TK_KP(task_, c_); _Pragma("unroll") for (int ks = 0; ks < 8; ++ks) dst[ks] = *(const bf16x8*)(kp_ + ((2 * ks) * 128 + (nb_) * 32) * 8 + koff); } while (0)
    const int task_beg = gw * per, task_end = (gw * per + per < NTASK) ? gw * per + per : NTASK;
    bf16x8 qcur[8], kcur[8];
    if (task_beg < task_end) { TK_LDQ(qcur, task_beg, 0); TK_LDK(kcur, task_beg, 0, 0); }
    for (int task = task_beg; task < task_end; ++task) {
        const int tb = task >> 3, h = task & 7;
        const size_t trow = (size_t)tb * 32 + r32;
        float sk[2][16];
        float best[16];
#pragma unroll
        for (int st = 0; st < 8; ++st) {
            const int c = st >> 2, nb = st & 3;
            bf16x8 knxt[8], qnxt[8];
            if (st < 7) TK_LDK(knxt, task, (st + 1) >> 2, (st + 1) & 3);
            if (st == 3) TK_LDQ(qnxt, task, 1);
            f32x16 acc = f32x16{};
#pragma unroll
            for (int ks = 0; ks < 8; ++ks) acc = __builtin_amdgcn_mfma_f32_32x32x16_bf16(kcur[ks], qcur[ks], acc, 0, 0, 0);
            float cur[16];
#pragma unroll
            for (int r = 0; r < 16; ++r) { cur[r] = embed(acc[r], 0xFFFFFF80u, code16[r]); if (nb) cur[r] = __uint_as_float(__float_as_uint(cur[r]) | (unsigned)(nb * 32)); }
            sort_desc<16>(cur);
            if (nb == 0) {
#pragma unroll
                for (int i = 0; i < 16; ++i) best[i] = cur[i];
            } else top16_merge(best, cur);
            if (st < 7) {
#pragma unroll
                for (int ks = 0; ks < 8; ++ks) kcur[ks] = knxt[ks];
            }
            if (st == 3) {
#pragma unroll
                for (int ks = 0; ks < 8; ++ks) qcur[ks] = qnxt[ks];
            }
            if (nb == 3) {
                float pr[16];
#pragma unroll
                for (int i = 0; i < 16; ++i) { auto rr = __builtin_amdgcn_permlane32_swap(__float_as_uint(best[i]), __float_as_uint(best[i]), false, false);
                    pr[i] = __uint_as_float(hi ? rr[0] : rr[1]); }
                top16_merge(best, pr);
#pragma unroll
                for (int i = 0; i < 16; ++i) sk[c][i] = best[i];
            }
            __builtin_amdgcn_sched_barrier(0);
        }
        { const int tn = (task + 1 < task_end) ? task + 1 : task; TK_LDQ(qcur, tn, 0); TK_LDK(kcur, tn, 0, 0); }
#pragma unroll
        for (int i = 0; i < 16; ++i) { tab[i * 64] = __float_as_uint(sk[0][i]); tab[(16 + i) * 64] = __float_as_uint(sk[1][i]); }
        float T[16], G1[16], G2[16];
#pragma unroll
        for (int j = 0; j < 16; ++j) T[j] = embed(sk[0][0] + sk[1][j], 0xFFFFFF00u, (unsigned)j);
#pragma unroll
        for (int j = 0; j < 8; ++j) { G1[j] = embed(sk[0][1] + sk[1][j], 0xFFFFFF00u, (unsigned)(16 + j)); G1[8 + j] = embed(sk[0][15 - j] + sk[1][0], 0xFFFFFF00u, (unsigned)((15 - j) << 4)); }
        merge_desc<16>(G1);
        top16_merge(T, G1);
#pragma unroll
        for (int j = 0; j < 5; ++j) G2[j] = embed(sk[0][2] + sk[1][j], 0xFFFFFF00u, (unsigned)(32 + j));
#pragma unroll
        for (int j = 0; j < 4; ++j) G2[5 + j] = embed(sk[0][3] + sk[1][j], 0xFFFFFF00u, (unsigned)(48 + j));
#pragma unroll
        for (int j = 0; j < 3; ++j) G2[9 + j] = embed(sk[0][4] + sk[1][j], 0xFFFFFF00u, (unsigned)(64 + j));
#pragma unroll
        for (int j = 0; j < 2; ++j) { G2[12 + j] = embed(sk[0][5] + sk[1][j], 0xFFFFFF00u, (unsigned)(80 + j)); G2[14 + j] = embed(sk[0][6] + sk[1][j], 0xFFFFFF00u, (unsigned)(96 + j)); }
        sort_desc<16>(G2);
        top16_merge(T, G2);
        T[15] = vmax(T[15], embed(sk[0][7] + sk[1][0], 0xFFFFFF00u, 112u)); T[14] = vmax(T[14], embed(sk[0][7] + sk[1][1], 0xFFFFFF00u, 113u));
        merge_desc<16>(T);
        const float mx = __uint_as_float(__float_as_uint(T[0]) & 0xFFFFFF00u);
        float e[16]; float den = 0.f;
#pragma unroll
        for (int k = 0; k < 16; ++k) { e[k] = __builtin_amdgcn_exp2f((__uint_as_float(__float_as_uint(T[k]) & 0xFFFFFF00u) - mx) * 1.4426950408889634f); den += e[k]; }
        const float rden = 1.f / den;
        int eo[8]; float go[8];
#pragma unroll
        for (int k = 0; k < 8; ++k) {
            const unsigned code = __float_as_uint(hi ? T[k + 8] : T[k]) & 255u;
            const unsigned a1 = tab[(code >> 4) * 64] & 127u, a2 = tab[(16 + (code & 15u)) * 64] & 127u;
            eo[k] = (int)(a1 * 128u + a2); go[k] = (hi ? e[k + 8] : e[k]) * rden;
        }
        int* ip = F.IDX + trow * PKN + h * 16 + hi * 8; float* gp = F.GATE + trow * PKN + h * 16 + hi * 8;
        *(v4u*)ip = (v4u){(unsigned)eo[0], (unsigned)eo[1], (unsigned)eo[2], (unsigned)eo[3]}; *(v4u*)(ip + 4) = (v4u){(unsigned)eo[4], (unsigned)eo[5], (unsigned)eo[6], (unsigned)eo[7]};
        *(f32x4*)gp = (f32x4){go[0], go[1], go[2], go[3]}; *(f32x4*)(gp + 4) = (f32x4){go[4], go[5], go[6], go[7]};
    }
    (void)NEG;
}
#undef TK_CE
#undef TK_QP
#undef TK_KP
#undef TK_LDQ
#undef TK_LDK
}

namespace pe {
typedef float f32x2 __attribute__((ext_vector_type(2)));
__device__ __forceinline__ f32x2 cvlo(unsigned w) { return __builtin_amdgcn_cvt_pk_f32_fp8((int)w, false); }
__device__ __forceinline__ f32x2 cvhi(unsigned w) { return __builtin_amdgcn_cvt_pk_f32_fp8((int)w, true); }
__device__ __forceinline__ float dot16(const v4u r, const f32x2 (&hf)[8]) {
    f32x2 a = cvlo(r.x) * hf[0]; f32x2 b = cvhi(r.x) * hf[1];
    a = cvlo(r.y) * hf[2] + a; b = cvhi(r.y) * hf[3] + b; a = cvlo(r.z) * hf[4] + a; b = cvhi(r.z) * hf[5] + b; a = cvlo(r.w) * hf[6] + a; b = cvhi(r.w) * hf[7] + b;
    a = a + b; return a.x + a.y;
}
#define PE_W(WREG, i) __uint_as_float(__builtin_amdgcn_readlane(__float_as_uint(WREG), (i)))
#ifndef FP6_INTERLEAVED
#define FP6_INTERLEAVED 1
#endif
typedef unsigned v6u __attribute__((ext_vector_type(6)));
typedef float v32f __attribute__((ext_vector_type(32)));
typedef float v16f __attribute__((ext_vector_type(16)));
struct Row6 { v4u q4; v2u q2; };
struct Row12 { v4u p0, p1, p2; };
#ifndef PV4_R
#define PV4_R 3
#endif
#define PV4_SRC(i) ((((i) & 15) * 16) + g4)
#define PV4_LOAD(dst, i) do { const int er_ = __builtin_amdgcn_ds_bpermute(PV4_SRC(i), ((i) < 16) ? e0 : e1); \
        const unsigned char* rp_ = F.VT6 + (size_t)er_ * 768 + c16; dst.p0 = *(const v4u*)rp_; dst.p1 = *(const v4u*)(rp_ + 256); dst.p2 = *(const v4u*)(rp_ + 512); } while (0)
#define PV4_ACC(src, i) do { const float w_ = __uint_as_float((unsigned)__builtin_amdgcn_ds_bpermute(PV4_SRC(i), (int)__float_as_uint(((i) < 16) ? w0 : w1))); const f32x2 ww_ = {w_, w_}; \
        { const v6u pk_ = {src.p0.x, src.p0.y, src.p0.z, src.p0.w, src.p1.x, src.p1.y}; const v32f d_ = __builtin_amdgcn_cvt_scalef32_pk32_f32_fp6(pk_, 1.0f); \
          _Pragma("unroll") for (int k = 0; k < 16; ++k) acc0[k] = (f32x2){d_[2 * k], d_[2 * k + 1]} * ww_ + acc0[k]; __builtin_amdgcn_sched_barrier(0); } \
        { const v6u pk_ = {src.p1.z, src.p1.w, src.p2.x, src.p2.y, src.p2.z, src.p2.w}; const v32f d_ = __builtin_amdgcn_cvt_scalef32_pk32_f32_fp6(pk_, 1.0f); \
          _Pragma("unroll") for (int k = 0; k < 16; ++k) acc1[k] = (f32x2){d_[2 * k], d_[2 * k + 1]} * ww_ + acc1[k]; __builtin_amdgcn_sched_barrier(0); } } while (0)
#define PV4_TOKEN() do { Row12 ring[PV4_R]; \
        _Pragma("unroll") for (int i = 0; i < PV4_R; ++i) PV4_LOAD(ring[i], i); \
        _Pragma("unroll") for (int i = 0; i < 32; ++i) { PV4_ACC(ring[i % PV4_R], i); \
            if (i + PV4_R < 32) PV4_LOAD(ring[i % PV4_R], i + PV4_R); } } while (0)

#define PU_IDX(dst, tt) do { const v4u* ip_ = (const v4u*)(F.IDX + (size_t)(tt) * PKN + (lane >> 3) * 16); _Pragma("unroll") for (int q_ = 0; q_ < 4; ++q_) { const v4u w_ = ip_[q_]; dst[4 * q_] = (int)w_.x; dst[4 * q_ + 1] = (int)w_.y; dst[4 * q_ + 2] = (int)w_.z; dst[4 * q_ + 3] = (int)w_.w; } } while (0)
#define PU_GATHER(dst, idx) do { _Pragma("unroll") for (int i = 0; i < 16; ++i) dst[i] = *(const v4u*)(ub + (unsigned)idx[i] * 128u + coff); } while (0)
#define PU_HS(dst, tt) do { dst[0] = *(const v4u*)(F.H8 + (size_t)(tt) * D + x * 128 + (lane & 7) * 16); } while (0)
#define PU_COMPUTE(seg, hraw, tt) do { int p[16]; \
        _Pragma("unroll") for (int i = 0; i < 16; ++i) { int a_ = __builtin_amdgcn_sdot4((int)seg[i].x, (int)hraw[0].x, 0, false); a_ = __builtin_amdgcn_sdot4((int)seg[i].y, (int)hraw[0].y, a_, false); \
            a_ = __builtin_amdgcn_sdot4((int)seg[i].z, (int)hraw[0].z, a_, false); p[i] = __builtin_amdgcn_sdot4((int)seg[i].w, (int)hraw[0].w, a_, false); }     \
          \
        _Pragma("unroll") for (int i = 0; i < 8; ++i) { const bool bt = (lane & 4) != 0; const int sd = bt ? p[i] : p[i + 8], kp = bt ? p[i + 8] : p[i]; p[i] = kp + __builtin_amdgcn_update_dpp(0, sd, 0x141, 0xF, 0xF, false); } \
        _Pragma("unroll") for (int i = 0; i < 4; ++i) { const bool bt = (lane & 2) != 0; const int sd = bt ? p[i] : p[i + 4], kp = bt ? p[i + 4] : p[i]; p[i] = kp + __builtin_amdgcn_update_dpp(0, sd, 0x4E, 0xF, 0xF, false); } \
        _Pragma("unroll") for (int i = 0; i < 2; ++i) { const bool bt = (lane & 1) != 0; const int sd = bt ? p[i] : p[i + 2], kp = bt ? p[i + 2] : p[i]; p[i] = kp + __builtin_amdgcn_update_dpp(0, sd, 0xB1, 0xF, 0xF, false); } \
        ((unsigned*)F.PART)[((size_t)x * M + (tt)) * 64 + lane] = att::cvtpk((float)p[0], (float)p[1]); } while (0)
__device__ __forceinline__ void peer_u_phase(Frame& F, const int c0, const int cn, const int w0, const int nw) {
    int lane = lane_id(); asm volatile("" : "+v"(lane));
    const int wave = F.wave;
    if (wave < w0 || wave >= w0 + nw) return;
    const unsigned coff = (unsigned)(lane & 7) * 16u;
    const int per_blk = cn / 32, per_wave = per_blk / nw;
    for (int unit = blockIdx.x; unit < 256; unit += F.G) {
        const int x = unit & 7, rk = unit >> 3;
        const unsigned char* ub = F.UT8 + (size_t)x * NEXP * 128;
        const int tbeg = c0 + rk * per_blk + (wave - w0) * per_wave, tend = tbeg + per_wave;
        int idxA[16], idxB[16]; v4u segA[16], segB[16]; v4u hA[1], hB[1];
        PU_IDX(idxA, tbeg); PU_GATHER(segA, idxA); PU_HS(hA, tbeg); PU_IDX(idxB, tbeg + 1);
        for (int t = tbeg; t < tend; t += 2) {
            PU_GATHER(segB, idxB); PU_HS(hB, t + 1);
            { const int tn = (t + 2 < tend) ? t + 2 : t; PU_IDX(idxA, tn); }
            PU_COMPUTE(segA, hA, t);
            { const int tn = (t + 2 < tend) ? t + 2 : t; PU_GATHER(segA, idxA); PU_HS(hA, tn); }
            { const int tn = (t + 3 < tend) ? t + 3 : t + 1; PU_IDX(idxB, tn); }
            PU_COMPUTE(segB, hB, t + 1);
        }
    }
}
#undef PU_IDX
#undef PU_GATHER
#undef PU_HS
#undef PU_COMPUTE

template <bool DRY> __device__ __forceinline__ void peer_phase(Frame& F, const int c0, const int cn, const int w0, const int nw) {
    int lane = lane_id(); asm volatile("" : "+v"(lane));
    if (F.wave < w0 || F.wave >= w0 + nw) return;
    const int gw = blockIdx.x * nw + (F.wave - w0), NGW = F.G * nw;
    const int g4 = (lane >> 4) * 4; const unsigned c16 = (unsigned)(lane & 15) * 16u;
    for (int t = c0 + gw; t < c0 + cn; t += NGW) {
        const int b = t >> 12;
        int e0 = F.IDX[(size_t)t * PKN + lane], e1 = F.IDX[(size_t)t * PKN + 64 + lane];
        if (DRY && PROBE_PHASE == 91) { e0 &= 8191; e1 &= 8191; }
        if (DRY && PROBE_PHASE == 92) { e0 &= 4095; e1 &= 4095; }
        if (DRY && PROBE_PHASE == 94) { e0 &= 7; e1 &= 7; }
        const float g0 = F.GATE[(size_t)t * PKN + lane], g1 = F.GATE[(size_t)t * PKN + 64 + lane];
        const float su0 = F.SU[e0], su1 = F.SU[e1], sv0 = F.SV[e0], sv1 = F.SV[e1];
        float tot0 = 0.f, tot1 = 0.f;
#pragma unroll
        for (int x = 0; x < 8; ++x) { const bf16* pp = (const bf16*)F.PART + ((size_t)x * M + t) * PKN; tot0 += bf2f(pp[lane]); tot1 += bf2f(pp[64 + lane]); }
        const float hs = F.HS[t];
        const float w0 = gelu_t(tot0 * (su0 * hs)) * g0 * sv0, w1 = gelu_t(tot1 * (su1 * hs)) * g1 * sv1;
        f32x2 acc0[16], acc1[16];
#pragma unroll
        for (int i = 0; i < 16; ++i) { acc0[i] = (f32x2){0.f, 0.f}; acc1[i] = (f32x2){0.f, 0.f}; }
        PV4_TOKEN();
        float y[16];
#pragma unroll
        for (int k = 0; k < 16; ++k) {
            auto sx = __builtin_amdgcn_permlane32_swap(__float_as_uint(acc0[k].x), __float_as_uint(acc1[k].x), false, false);
            auto sy = __builtin_amdgcn_permlane32_swap(__float_as_uint(acc0[k].y), __float_as_uint(acc1[k].y), false, false);
            const float rx = __uint_as_float(sx[0]) + __uint_as_float(sx[1]), ry = __uint_as_float(sy[0]) + __uint_as_float(sy[1]);
            const bool odd = (g4 & 4) != 0;
            const float keep = odd ? ry : rx, send = odd ? rx : ry;
            const float recv = __uint_as_float((unsigned)__builtin_amdgcn_ds_swizzle((int)__float_as_uint(send), 0x401F));
            y[k] = keep + recv; }
        float ss = 0.f;
#pragma unroll
        for (int j = 0; j < 16; ++j) ss += y[j] * y[j];
        const float rstd = rsqrtf(wave_sum_dpp(ss) * (1.f / D) + EPS);
        const float* md = F.mod + b * 6144 + 5120;
        const float* g3 = F.norm_g + 3072;
        int lane_e = lane; asm volatile("" : "+v"(lane_e));
        const int col0 = (lane_e & 15) * 64 + (lane_e >> 4) * 16;
        float* orow = F.out + (size_t)t * D + col0;
        const v4u xa = *(const v4u*)(F.X1B + (size_t)t * D + col0), xb = *(const v4u*)(F.X1B + (size_t)t * D + col0 + 8);
        const unsigned xw[8] = {xa.x, xa.y, xa.z, xa.w, xb.x, xb.y, xb.z, xb.w};
#pragma unroll
        for (int q4 = 0; q4 < 4; ++q4) { const int c = col0 + q4 * 4;
            const f32x4 x1 = (f32x4){bflo(xw[2 * q4]), bfhi(xw[2 * q4]), bflo(xw[2 * q4 + 1]), bfhi(xw[2 * q4 + 1])}, gt = *(const f32x4*)(md + c), gg = *(const f32x4*)(g3 + c);
            const f32x4 yv = (f32x4){y[q4 * 4], y[q4 * 4 + 1], y[q4 * 4 + 2], y[q4 * 4 + 3]};
            if (!DRY) *(f32x4*)(orow + q4 * 4) = x1 + gt * (yv * rstd * gg); else if (rstd == 123.456f) *(f32x4*)(orow + q4 * 4) = yv; }
    }
}
#undef PE_W
#undef PV4_SRC
#undef PV4_LOAD
#undef PV4_ACC
#undef PV4_TOKEN

#define U_LOAD4(v, r0_, nvalid_) do { _Pragma("unroll") for (int q = 0; q < 4; ++q) { const int row = (r0_) + (q < (nvalid_) ? q : 0) * stride; const f32x4* s = (const f32x4*)(F.peer_u + (size_t)row * D) + lane * 4; \
        _Pragma("unroll") for (int i = 0; i < 4; ++i) v[q][i] = s[i]; } } while (0)
#define U_PROC4(v, r0_, nvalid_) do { _Pragma("unroll") for (int q = 0; q < 4; ++q) { if (q >= (nvalid_)) break; const int row = (r0_) + q * stride; \
        float am = 0.f; \
        _Pragma("unroll") for (int i = 0; i < 4; ++i) am = fmaxf(am, fmaxf(fmaxf(fabsf(v[q][i].x), fabsf(v[q][i].y)), fmaxf(fabsf(v[q][i].z), fabsf(v[q][i].w)))); \
        am = wave_max_dpp(am); \
        const float sc = am > 0.f ? 127.f / am : 1.f;                    \
        int w[4]; \
        _Pragma("unroll") for (int i = 0; i < 4; ++i) { const int q0 = (int)rintf(v[q][i].x * sc), q1 = (int)rintf(v[q][i].y * sc), q2 = (int)rintf(v[q][i].z * sc), q3 = (int)rintf(v[q][i].w * sc); \
            w[i] = (q0 & 255) | ((q1 & 255) << 8) | ((q2 & 255) << 16) | (q3 << 24); } \
        *(v4u*)(F.UT8 + (size_t)(lane >> 3) * NEXP * 128 + (size_t)row * 128 + (lane & 7) * 16) = (v4u){(unsigned)w[0], (unsigned)w[1], (unsigned)w[2], (unsigned)w[3]};     \
        if (lane == 0) F.SU[row] = 1.f / sc; } } while (0)
#define V_LOAD2(f, p0_, nvalid_) do { _Pragma("unroll") for (int q = 0; q < 2; ++q) { const int row = 2 * ((p0_) + (q < (nvalid_) ? q : 0) * stride) + hf; const f32x4* sp = (const f32x4*)(F.peer_v + (size_t)row * D + L * 32); \
        _Pragma("unroll") for (int i = 0; i < 8; ++i) f[q][i] = sp[i]; } } while (0)
#define V_PROC2(f, p0_, nvalid_) do { _Pragma("unroll") for (int q = 0; q < 2; ++q) { if (q >= (nvalid_)) break; const int row = 2 * ((p0_) + q * stride) + hf; \
        float am = 0.f; \
        _Pragma("unroll") for (int i = 0; i < 8; ++i) am = fmaxf(am, fmaxf(fmaxf(fabsf(f[q][i].x), fabsf(f[q][i].y)), fmaxf(fabsf(f[q][i].z), fabsf(f[q][i].w)))); \
        am = half_max_dpp(am); \
        const float sc = am > 0.f ? exp2f(floorf(log2f(7.0f / am))) : 1.f; \
        v16f a, b; \
        _Pragma("unroll") for (int i = 0; i < 4; ++i) { a[4 * i] = f[q][i].x * sc; a[4 * i + 1] = f[q][i].y * sc; a[4 * i + 2] = f[q][i].z * sc; a[4 * i + 3] = f[q][i].w * sc; \
            b[4 * i] = f[q][4 + i].x * sc; b[4 * i + 1] = f[q][4 + i].y * sc; b[4 * i + 2] = f[q][4 + i].z * sc; b[4 * i + 3] = f[q][4 + i].w * sc; } \
        const v6u w = __builtin_amdgcn_cvt_scalef32_2xpk16_fp6_f32(a, b, 1.0f); \
        unsigned char* rp = F.VT6 + (size_t)row * 768; \
          \
        { unsigned char* pk_ = rp + (L >> 1) * 16; \
          if ((L & 1) == 0) { *(v4u*)pk_ = (v4u){w[0], w[1], w[2], w[3]}; *(v2u*)(pk_ + 256) = (v2u){w[4], w[5]}; } \
          else { *(v2u*)(pk_ + 256 + 8) = (v2u){w[0], w[1]}; *(v4u*)(pk_ + 512) = (v4u){w[2], w[3], w[4], w[5]}; } } \
        if (L == 0) F.SV[row] = 1.f / sc; } } while (0)
__device__ __forceinline__ void prologue_tables(Frame& F, int gw, int NGW, int lane) {
    const int stride = NGW; const int L = lane & 31, hf = lane >> 5;
    f32x4 va[4][4], vb[4][4];
    int r = gw;
    if (r < NEXP) { int left = (NEXP - r + NGW - 1) / NGW; int nva = left < 4 ? left : 4; U_LOAD4(va, r, nva);
        for (;;) {
            const int r2 = r + 4 * NGW; int nvb = 0;
            if (r2 < NEXP) { left = (NEXP - r2 + NGW - 1) / NGW; nvb = left < 4 ? left : 4; U_LOAD4(vb, r2, nvb); }
            U_PROC4(va, r, nva);
            if (r2 >= NEXP) break;
            const int r3 = r2 + 4 * NGW; nva = 0;
            if (r3 < NEXP) { left = (NEXP - r3 + NGW - 1) / NGW; nva = left < 4 ? left : 4; U_LOAD4(va, r3, nva); }
            U_PROC4(vb, r2, nvb);
            if (r3 >= NEXP) break;
            r = r3;
        } }
    f32x4 fa[2][8], fb[2][8];
    int p = gw;
    if (p < NEXP / 2) { int left = (NEXP / 2 - p + NGW - 1) / NGW; int nva = left < 2 ? left : 2; V_LOAD2(fa, p, nva);
        for (;;) {
            const int p2 = p + 2 * NGW; int nvb = 0;
            if (p2 < NEXP / 2) { left = (NEXP / 2 - p2 + NGW - 1) / NGW; nvb = left < 2 ? left : 2; V_LOAD2(fb, p2, nvb); }
            V_PROC2(fa, p, nva);
            if (p2 >= NEXP / 2) break;
            const int p3 = p2 + 2 * NGW; nva = 0;
            if (p3 < NEXP / 2) { left = (NEXP / 2 - p3 + NGW - 1) / NGW; nva = left < 2 ? left : 2; V_LOAD2(fa, p3, nva); }
            V_PROC2(fb, p2, nvb);
            if (p3 >= NEXP / 2) break;
            p = p3;
        } }
}
#undef U_LOAD4
#undef U_PROC4
#undef V_LOAD2
#undef V_PROC2
}

__device__ __forceinline__ void prologue_tables_fwd(Frame& F, int gw, int NGW, int lane) { pe::prologue_tables(F, gw, NGW, lane); }
struct Args { const float* in[18]; float* out; unsigned char* ws; int ph_lo, ph_hi, li, pad; };
__global__ void __launch_bounds__(NTHR, 2) fwd(Args args) {
    extern __shared__ __attribute__((aligned(16))) unsigned char lds[];
    Frame F;
    F.lds = (LAS unsigned char*)lds;
    F.MISC = (volatile LAS unsigned*)(F.lds + MISC_OFF);
    F.wave = __builtin_amdgcn_readfirstlane((int)threadIdx.x >> 6); F.G = gridDim.x;
    unsigned char* ws = args.ws;
    F.ctl = (gu32*)(ws + WS_CTL);
    F.x = args.in[0]; F.c = args.in[1]; F.w_ada = args.in[2]; F.b_ada = args.in[3]; F.norm_g = args.in[4]; F.w_in = args.in[5]; F.sgu_ln_g = args.in[6]; F.sgu_ln_b = args.in[7];
    F.sgu_w = args.in[8]; F.sgu_b = args.in[9]; F.diff_lambda = args.in[10]; F.subln_g = args.in[11]; F.rel_bias = args.in[12]; F.w_out = args.in[13]; F.w_query = args.in[14];
    F.sub_keys = args.in[15]; F.peer_u = args.in[16]; F.peer_v = args.in[17]; F.out = args.out;
    F.mod = (float*)(ws + WS_MOD); F.WIN = (bf16*)(ws + WS_WIN); F.WOUT = (bf16*)(ws + WS_WOUT); F.WQ = (bf16*)(ws + WS_WQ); F.KEYS = (bf16*)(ws + WS_KEYS); F.SGW = (bf16*)(ws + WS_SGW);
    F.UT8 = ws + WS_UT; F.H8 = ws + WS_H8; F.HS = (float*)(ws + WS_SU) + 2 * NEXP; F.HAS = (float*)(ws + WS_SU) + 2 * NEXP + M; F.WS8 = (float*)(ws + WS_SU) + 2 * NEXP + 2 * M; F.HA8 = ws + WS_H; F.W8 = ws + WS_WIN; F.WQ8 = ws + WS_WQ; F.WQS8 = (float*)(ws + WS_SU) + 2 * NEXP + 2 * M + INC; F.VT6 = ws + WS_VT; F.PART = (float*)(ws + WS_QP); F.STASH = (unsigned*)(ws + WS_H); F.SU = (float*)(ws + WS_SU); F.SV = (float*)(ws + WS_SU) + NEXP; F.H = (bf16*)(ws + WS_H); F.Y = (bf16*)(ws + WS_Y); F.Z = (bf16*)(ws + WS_Z); F.QP = (bf16*)(ws + WS_QP); F.CAT = (bf16*)(ws + WS_CAT); F.X1B = (bf16*)(ws + WS_CAT);
    F.IDX = (int*)(ws + WS_IDX); F.GATE = (float*)(ws + WS_GATE);
    for (int u = threadIdx.x; u < (LDS_BYTES - LDSCTL_OFF) / 4; u += NTHR) ((LAS unsigned*)(F.lds + LDSCTL_OFF))[u] = 0u;
    __syncthreads();
    XcdBarrier bar = xcd_barrier_post((unsigned*)(F.ctl + CW_BAR) + args.li * XCD_BAR_WORDS, F.MISC + 8);
    const int lo = args.ph_lo, hi = args.ph_hi;
#ifndef ONLY_PHASE
#define ONLY_PHASE -1
#endif
#define IN(k) (lo <= (k) && (k) < hi && (ONLY_PHASE < 0 || ONLY_PHASE == (k)))
#define SEAM(k) do { if ((k) + 1 < hi) xcd_barrier(bar); } while (0)
    if (IN(0)) { for (int rep = 0; rep < (PROBE_PHASE == 0 ? 2 : 1); ++rep) ph_prologue(F); SEAM(0); }
    if (IN(1)) { for (int rep = 0; rep < (PROBE_PHASE == 1 ? 2 : 1); ++rep) ph_hrows(F); SEAM(1); }
    if (IN(2)) {
        pg8::Gemm g{(const pg8::bf16_t*)F.HA8, (const pg8::bf16_t*)F.W8, M, INC, D / 2}; pg8::StaticOrder S; S.init(M, INC, F.G, (int)blockIdx.x);
        pg8::EpiI8<1> E{F.Z, INC, F.HAS, F.WS8, 1024};
        for (int rep = 0; rep < (PROBE_PHASE == 2 ? 2 : 1); ++rep) pg8::gemm_phase<pg8::EpiI8<1>, pg8::StaticOrder, true, true>(F.lds, g, S, E, F.wave);
        SEAM(2);
    }
    if (IN(3)) { for (int rep = 0; rep < (PROBE_PHASE == 30 ? 2 : 1); ++rep) sgu::sgu_phase(F); for (int rep = 0; rep < (PROBE_PHASE == 3 ? 2 : 1); ++rep) att::attn_phase(F); SEAM(3); }
    if (IN(4)) {
        pg8::Gemm g{F.CAT, F.WOUT, M, D, D}; pg8::StaticOrder S; S.init(M, D, F.G, (int)blockIdx.x);
        pg8::EpiBf16<0> E{F.Y, D, nullptr, 0, 0, 1.f, 0};
        for (int rep = 0; rep < (PROBE_PHASE == 4 ? 2 : 1); ++rep) pg8::gemm_phase<pg8::EpiBf16<0>, pg8::StaticOrder, true, true>(F.lds, g, S, E, F.wave);
        SEAM(4);
    }
    if (IN(5)) { for (int rep = 0; rep < (PROBE_PHASE == 5 ? 2 : 1); ++rep) ph_x1rows(F); SEAM(5); }
    if (IN(6)) {
        pg8::Gemm g{(const pg8::bf16_t*)F.H8, (const pg8::bf16_t*)F.WQ8, M, NQ, D / 2}; pg8::StaticOrder S; S.init(M, NQ, F.G, (int)blockIdx.x);
        pg8::EpiI8<0> E{F.QP, NQ, F.HS, F.WQS8, 0};
        for (int rep = 0; rep < (PROBE_PHASE == 6 ? 2 : 1); ++rep) pg8::gemm_phase<pg8::EpiI8<0>, pg8::StaticOrder, true, true>(F.lds, g, S, E, F.wave);
        SEAM(6);
    }
    if (IN(7)) { if (TABLES_IN_PHASE == 7) prologue_tables_fwd(F, blockIdx.x * NWAVES + F.wave, F.G * NWAVES, lane_id()); for (int rep = 0; rep < (PROBE_PHASE == 7 ? 2 : 1); ++rep) tk::topk_phase(F); SEAM(7); }
    if (IN(8)) { for (int rep = 0; rep < (PROBE_PHASE == 8 ? 2 : 1); ++rep) pe::peer_u_phase(F, 0, M, 0, 8); SEAM(8); }
    if (IN(9)) { if (PROBE_PHASE == 9 || PROBE_PHASE == 91 || PROBE_PHASE == 92 || PROBE_PHASE == 93 || PROBE_PHASE == 94) pe::peer_phase<true>(F, 0, M, 0, 8); pe::peer_phase<false>(F, 0, M, 0, 8); }
#undef IN
#undef SEAM
}

extern "C" void kernel_launch(void* const* d_in, const int* in_sizes, int n_in, void* d_out, int out_size, void* d_ws, size_t ws_size, hipStream_t stream) {
    static int grid = 0;
    if (grid == 0) {
        if (n_in != 18 || in_sizes[0] != M * D || out_size != M * D || ws_size < WS_END) { fprintf(stderr, "kernel_launch: unexpected shapes (n_in %d, in0 %d, out %d, ws %zu)\n", n_in, n_in > 0 ? in_sizes[0] : -1, out_size, ws_size); grid = -1; return; }
        int dev = 0, cus = 0, per_cu = 0;
        if (hipGetDevice(&dev) != hipSuccess || hipDeviceGetAttribute(&cus, hipDeviceAttributeMultiprocessorCount, dev) != hipSuccess) { grid = -1; return; }
        if (hipFuncSetAttribute((const void*)fwd, hipFuncAttributeMaxDynamicSharedMemorySize, LDS_BYTES) != hipSuccess) { fprintf(stderr, "kernel_launch: hipFuncSetAttribute failed\n"); grid = -1; return; }
        if (hipOccupancyMaxActiveBlocksPerMultiprocessor(&per_cu, (const void*)fwd, NTHR, LDS_BYTES) != hipSuccess || per_cu < 1) fprintf(stderr, "kernel_launch: occupancy query reports %d\n", per_cu);
        (void)hipGetLastError();
        grid = cus;
    }
    if (grid < 0) return;
    if (hipMemsetAsync((char*)d_ws + WS_CTL, 0, CTL_ZERO_BYTES, stream) != hipSuccess) return;
    Args a{};
    for (int i = 0; i < 18; ++i) a.in[i] = (const float*)d_in[i];
    a.out = (float*)d_out; a.ws = (unsigned char*)d_ws;
#if MK_PER_PHASE
    for (int p = 0; p < NPHASE; ++p) { a.ph_lo = p; a.ph_hi = p + 1; a.li = p; hipLaunchKernelGGL(fwd, dim3(grid), dim3(NTHR), LDS_BYTES, stream, a); }
#else
    a.ph_lo = 0; a.ph_hi = NPHASE; a.li = 0; hipLaunchKernelGGL(fwd, dim3(grid), dim3(NTHR), LDS_BYTES, stream, a);
#endif
}
```

```cpp
#define MK_PER_PHASE 0
#include <hip/hip_runtime.h>
#include <cstdio>
#include <cstdint>
namespace pg8 {
#define PG8_LAS __attribute__((address_space(3)))
typedef unsigned short bf16_t;
typedef short bf16x8 __attribute__((ext_vector_type(8)));
typedef float f32x4 __attribute__((ext_vector_type(4)));
typedef unsigned u32x4 __attribute__((ext_vector_type(4)));
typedef int i32x4 __attribute__((ext_vector_type(4)));
constexpr int BM = 256, BK = 64, HALF = 128, HTB = HALF * BK * 2  , STAGE_BYTES = 8 * HTB, NXCD = 8, WGM = 8;

__host__ __device__ __forceinline__ int lds_byte(int r, int c) { const int st = (r >> 4) * 2 + (c >> 5), rr = r & 15, cc = c & 31, ob = rr * 64 + cc * 2; return st * 1024 + (ob ^ (((ob >> 9) & 1) << 5)); }
__host__ __device__ __forceinline__ void stage_rc(int b, int& R, int& C) { const int st = b / 1024, sb = b % 1024, swz = sb ^ (((sb >> 9) & 1) << 5); R = (st >> 1) * 16 + swz / 64; C = (st & 1) * 32 + (swz % 64) / 2; }
__host__ __device__ __forceinline__ int perm32(int rho) { const int n = rho >> 4, i = rho & 15; return 8 * (i >> 2) + 4 * n + (i & 3); }

struct Unit { int pm, pn; };
struct Gemm { const bf16_t* A; const bf16_t* Bt; int M, N, K; };

struct StaticOrder {
    int nM, nN, nwg, G, c;
    __host__ __device__ void init(int M, int N, int G_, int c_) { nM = M / BM; nN = N / BM; nwg = nM * nN; G = G_; c = c_; }
    __host__ __device__ bool next(int i, Unit& u) const {
        const long L = (long)i * G + c; if (L >= nwg) return false;
        int wgid = (int)L; { const int q = nwg / NXCD, r = nwg % NXCD, xcd = wgid % NXCD, off = wgid / NXCD; wgid = (xcd < r ? xcd * (q + 1) : r * (q + 1) + (xcd - r) * q) + off; }
        const int nig = WGM * nN, gid = wgid / nig, fm = gid * WGM, gsz = (nM - fm) < WGM ? (nM - fm) : WGM;
        u.pm = fm + ((wgid % nig) % gsz); u.pn = (wgid % nig) / gsz; return true;
    }
    __device__ __forceinline__ void a_ready(const Unit&) const {}
    __device__ __forceinline__ void done(const Unit&) const {}
};

__device__ __forceinline__ unsigned cvt_pk_bf16(float lo, float hi) { unsigned r; asm volatile("v_cvt_pk_bf16_f32 %0, %1, %2" : "=v"(r) : "v"(lo), "v"(hi)); return r; }
typedef float f32x2 __attribute__((ext_vector_type(2)));
__device__ __forceinline__ f32x2 gelu_pk(f32x2 v) {
    const f32x2 u = v * (v * v * 0.044715f + 1.0f);
    const f32x2 s = u * (-2.302208198f);
    f32x2 e; e.x = __builtin_amdgcn_exp2f(s.x); e.y = __builtin_amdgcn_exp2f(s.y);
    const f32x2 d = e + 1.0f;
    f32x2 r; r.x = __builtin_amdgcn_rcpf(d.x); r.y = __builtin_amdgcn_rcpf(d.y);
    return v * r;
}

template <int ACT  > struct EpiBf16 {
    static constexpr bool PERM = true, AFTER_DRAIN = false; typedef f32x4 acc_t;
    bf16_t* O; int ldc; const float* bias; int split_cols; size_t split_stride; float scale0; int act_cols;
    __device__ __forceinline__ void operator()(const f32x4 (&acc)[2][2][4][2], const Unit& u, int wr, int wc, int fr, int fq) const {
        const int row0 = u.pm * BM + wr * 64 + fr; int colt = u.pn * BM; bf16_t* base = O;
        float sc = 1.f; if (split_cols) { const int t = colt / split_cols; base += (size_t)t * split_stride; colt -= t * split_cols; if (t == 0) sc = scale0; }
        const int col0 = colt + wc * 32 + 8 * fq, bcol0 = u.pn * BM + wc * 32 + 8 * fq;
        f32x4 bv[2][2];
#pragma unroll
        for (int bj = 0; bj < 2; ++bj)
#pragma unroll
            for (int n = 0; n < 2; ++n) bv[bj][n] = bias ? *(const f32x4*)(bias + bcol0 + bj * HALF + 4 * n) : (f32x4){0.f, 0.f, 0.f, 0.f};
#pragma unroll
        for (int ai = 0; ai < 2; ++ai)
#pragma unroll
            for (int m = 0; m < 4; ++m) { bf16_t* rowp = base + (size_t)(row0 + ai * HALF + m * 16) * ldc + col0;
#pragma unroll
                for (int bj = 0; bj < 2; ++bj) { f32x4 v0 = acc[ai][bj][m][0] + bv[bj][0], v1 = acc[ai][bj][m][1] + bv[bj][1];
                    if (ACT == 1 && u.pn * BM < act_cols) { f32x2 a = gelu_pk((f32x2){v0[0], v0[1]}), b = gelu_pk((f32x2){v0[2], v0[3]}), c = gelu_pk((f32x2){v1[0], v1[1]}), d = gelu_pk((f32x2){v1[2], v1[3]});
                        v0 = (f32x4){a.x, a.y, b.x, b.y}; v1 = (f32x4){c.x, c.y, d.x, d.y}; }
                    v0 = v0 * sc; v1 = v1 * sc; u32x4 w; w.x = cvt_pk_bf16(v0[0], v0[1]); w.y = cvt_pk_bf16(v0[2], v0[3]); w.z = cvt_pk_bf16(v1[0], v1[1]); w.w = cvt_pk_bf16(v1[2], v1[3]);
                    *(u32x4*)(rowp + bj * HALF) = w; } }
    }
};


template <int ACT> struct EpiI8 {
    static constexpr bool PERM = true, AFTER_DRAIN = false; typedef i32x4 acc_t;
    bf16_t* O; int ldc; const float* rs; const float* cs; int act_cols;
    __device__ __forceinline__ void operator()(const i32x4 (&acc)[2][2][4][2], const Unit& u, int wr, int wc, int fr, int fq) const {
        const int row0 = u.pm * BM + wr * 64 + fr, col0 = u.pn * BM + wc * 32 + 8 * fq;
        f32x4 cv[2][2];
#pragma unroll
        for (int bj = 0; bj < 2; ++bj)
#pragma unroll
            for (int n = 0; n < 2; ++n) cv[bj][n] = *(const f32x4*)(cs + col0 + bj * HALF + 4 * n);
#pragma unroll
        for (int ai = 0; ai < 2; ++ai)
#pragma unroll
            for (int m = 0; m < 4; ++m) { const int row = row0 + ai * HALF + m * 16; const float ra = rs[row]; bf16_t* rowp = O + (size_t)row * ldc + col0;
#pragma unroll
                for (int bj = 0; bj < 2; ++bj) {
                    f32x4 v0 = __builtin_convertvector(acc[ai][bj][m][0], f32x4) * ra * cv[bj][0], v1 = __builtin_convertvector(acc[ai][bj][m][1], f32x4) * ra * cv[bj][1];
                    if (ACT == 1 && u.pn * BM < act_cols) { f32x2 a = gelu_pk((f32x2){v0[0], v0[1]}), b = gelu_pk((f32x2){v0[2], v0[3]}), c = gelu_pk((f32x2){v1[0], v1[1]}), d = gelu_pk((f32x2){v1[2], v1[3]});
                        v0 = (f32x4){a.x, a.y, b.x, b.y}; v1 = (f32x4){c.x, c.y, d.x, d.y}; }
                    u32x4 w; w.x = cvt_pk_bf16(v0[0], v0[1]); w.y = cvt_pk_bf16(v0[2], v0[3]); w.z = cvt_pk_bf16(v1[0], v1[1]); w.w = cvt_pk_bf16(v1[2], v1[3]);
                    *(u32x4*)(rowp + bj * HALF) = w; } }
    }
};

__device__ __forceinline__ f32x4 mma16(bf16x8 a, bf16x8 b, f32x4 c) { return __builtin_amdgcn_mfma_f32_16x16x32_bf16(a, b, c, 0, 0, 0); }
__device__ __forceinline__ i32x4 mma16(bf16x8 a, bf16x8 b, i32x4 c) { return __builtin_amdgcn_mfma_i32_16x16x64_i8(__builtin_bit_cast(i32x4, a), __builtin_bit_cast(i32x4, b), c, 0, 0, 0); }
template <class Epi, class Sched, bool ALIGN_EPI = false, bool SP2 = false>
__device__ __forceinline__ void gemm_phase(PG8_LAS unsigned char* lds, const Gemm g, const Sched& S, const Epi& E, const int wid  ) {
    const int lane = (int)__builtin_amdgcn_mbcnt_hi(~0u, __builtin_amdgcn_mbcnt_lo(~0u, 0u)), tid = wid * 64 + lane, wr = wid >> 2, wc = wid & 3, fr = lane & 15, fq = lane >> 4;
    const int K = g.K, nt = K / BK;
    unsigned voffA[2], voffB[2];
#pragma unroll
    for (int i = 0; i < 2; ++i) { int R, C; stage_rc(tid * 16 + i * 8192, R, C); const int Rb = Epi::PERM ? ((R & ~31) + perm32(R & 31)) : R;
        voffA[i] = (unsigned)(R * K + C) * 2u; voffB[i] = (unsigned)(Rb * K + C) * 2u; }
    const size_t kstep = (size_t)(BK * 2);
    const size_t hstep = (size_t)HALF * K * 2;
    const size_t tstep = 2 * hstep;
    const unsigned ldsw = (unsigned)wid * 1024u;
    const int aoff = lds_byte(wr * 64 + fr, fq * 8), boff = lds_byte(wc * 32 + fr, fq * 8);
#define PG8_SA(b, h) (((b) * 2 + (h)) * HTB)
#define PG8_SB(b, h) ((4 + (b) * 2 + (h)) * HTB)
#define PG8_STAGE(bufoff, gbase, voff) do { _Pragma("unroll") for (int _i = 0; _i < 2; ++_i) \
        __builtin_amdgcn_global_load_lds((const unsigned*)((const char*)(gbase) + (voff)[_i]), (PG8_LAS unsigned*)(lds + (bufoff) + ldsw + _i * 8192), 16, 0, 0); } while (0)
#define PG8_LDA(dst, b, h) do { _Pragma("unroll") for (int m = 0; m < 4; ++m) _Pragma("unroll") for (int k = 0; k < 2; ++k) dst[m][k] = *(const PG8_LAS bf16x8*)(lds + PG8_SA(b, h) + aoff + m * 2048 + k * 1024); } while (0)
#define PG8_LDB(dst, b, h) do { _Pragma("unroll") for (int n = 0; n < 2; ++n) _Pragma("unroll") for (int k = 0; k < 2; ++k) dst[n][k] = *(const PG8_LAS bf16x8*)(lds + PG8_SB(b, h) + boff + n * 2048 + k * 1024); } while (0)
#define PG8_MMA(ai, bj, At, Bt) do { __builtin_amdgcn_s_setprio(1); _Pragma("unroll") for (int m = 0; m < 4; ++m) _Pragma("unroll") for (int n = 0; n < 2; ++n) _Pragma("unroll") for (int k = 0; k < 2; ++k) \
        acc[ai][bj][m][n] = mma16(Bt[n][k], At[m][k], acc[ai][bj][m][n]); __builtin_amdgcn_s_setprio(0); } while (0)
#define PG8_WAIT_V(n) asm volatile("s_waitcnt vmcnt(" #n ")" ::: "memory")
#define PG8_WAIT_L(n) asm volatile("s_waitcnt lgkmcnt(" #n ")" ::: "memory")
#define PG8_BAR __builtin_amdgcn_s_barrier()
#define PG8_SCHED __builtin_amdgcn_sched_barrier(0)
    Unit cur, nxt; int ui = 0;
    if (!S.next(0, cur)) return;
    typedef typename Epi::acc_t acc_t;
    acc_t acc[2][2][4][2];
#pragma unroll
    for (int a = 0; a < 2; ++a)
#pragma unroll
        for (int b = 0; b < 2; ++b)
#pragma unroll
            for (int m = 0; m < 4; ++m)
#pragma unroll
                for (int n = 0; n < 2; ++n) acc[a][b][m][n] = acc_t{};
    bf16x8 At[4][2], B0[2][2], B1[2][2];
    const char* cA = (const char*)g.A + (size_t)cur.pm * tstep; const char* cB = (const char*)g.Bt + (size_t)cur.pn * tstep;
    S.a_ready(cur);
    if constexpr (SP2) {
        PG8_STAGE(PG8_SB(0, 0), cB, voffB); PG8_STAGE(PG8_SB(0, 1), cB + hstep, voffB); PG8_STAGE(PG8_SA(0, 0), cA, voffA); PG8_STAGE(PG8_SA(0, 1), cA + hstep, voffA);
        if (wr == 1) PG8_BAR;
        PG8_WAIT_V(2); PG8_BAR;
        PG8_STAGE(PG8_SB(1, 0), cB + kstep, voffB); PG8_STAGE(PG8_SA(1, 0), cA + kstep, voffA); PG8_STAGE(PG8_SB(1, 1), cB + hstep + kstep, voffB);
        PG8_WAIT_V(6); PG8_BAR;
    } else {
        PG8_STAGE(PG8_SB(0, 0), cB, voffB); PG8_STAGE(PG8_SA(0, 0), cA, voffA); PG8_STAGE(PG8_SB(0, 1), cB + hstep, voffB); PG8_STAGE(PG8_SA(0, 1), cA + hstep, voffA);
        if (wr == 1) PG8_BAR;
        PG8_WAIT_V(4); PG8_BAR;
        PG8_STAGE(PG8_SB(1, 0), cB + kstep, voffB); PG8_STAGE(PG8_SA(1, 0), cA + kstep, voffA); PG8_STAGE(PG8_SB(1, 1), cB + hstep + kstep, voffB);
        PG8_WAIT_V(6); PG8_BAR;
    }
    for (;;) {
        const bool has_next = S.next(ui + 1, nxt);
        const char* nA = has_next ? (const char*)g.A + (size_t)nxt.pm * tstep : cA; const char* nB = has_next ? (const char*)g.Bt + (size_t)nxt.pn * tstep : cB;
        for (int t = 0; t < nt; t += 2) {
            const bool last = (t == nt - 2);
            const char* a1 = cA + (size_t)(t + 1) * kstep;
            const char* a2 = last ? nA : cA + (size_t)(t + 2) * kstep; const char* b2 = last ? nB : cB + (size_t)(t + 2) * kstep;
            const char* a3 = a2 + kstep; const char* b3 = b2 + kstep;
            if (last && has_next) S.a_ready(nxt);
            if constexpr (SP2) {
            PG8_LDB(B0, 0, 0); PG8_LDB(B1, 0, 1); PG8_SCHED; PG8_LDA(At, 0, 0); PG8_STAGE(PG8_SA(1, 1), a1 + hstep, voffA);
            PG8_WAIT_V(8); PG8_WAIT_L(0); PG8_BAR; PG8_MMA(0, 0, At, B0); PG8_MMA(0, 1, At, B1); PG8_BAR; PG8_SCHED;
            PG8_LDA(At, 0, 1); PG8_STAGE(PG8_SB(0, 0), b2, voffB); PG8_STAGE(PG8_SB(0, 1), b2 + hstep, voffB); PG8_STAGE(PG8_SA(0, 0), a2, voffA);
            PG8_WAIT_V(8); PG8_WAIT_L(0); PG8_BAR; PG8_MMA(1, 0, At, B0); PG8_MMA(1, 1, At, B1); PG8_BAR; PG8_SCHED;
            PG8_LDB(B0, 1, 0); PG8_LDB(B1, 1, 1); PG8_SCHED; PG8_LDA(At, 1, 0); PG8_STAGE(PG8_SA(0, 1), a2 + hstep, voffA);
            PG8_WAIT_V(8); PG8_WAIT_L(0); PG8_BAR; PG8_MMA(0, 0, At, B0); PG8_MMA(0, 1, At, B1); PG8_BAR; PG8_SCHED;
            PG8_LDA(At, 1, 1); PG8_STAGE(PG8_SB(1, 0), b3, voffB); PG8_STAGE(PG8_SB(1, 1), b3 + hstep, voffB); PG8_STAGE(PG8_SA(1, 0), a3, voffA);
            PG8_WAIT_V(8); PG8_WAIT_L(0); PG8_BAR; PG8_MMA(1, 0, At, B0); PG8_MMA(1, 1, At, B1); PG8_BAR; PG8_SCHED;
            } else {
            PG8_LDB(B0, 0, 0); PG8_SCHED; PG8_LDA(At, 0, 0); PG8_STAGE(PG8_SA(1, 1), a1 + hstep, voffA);
            PG8_WAIT_L(8); PG8_BAR; PG8_WAIT_L(0); PG8_MMA(0, 0, At, B0); PG8_BAR; PG8_SCHED;
            PG8_LDB(B1, 0, 1); PG8_STAGE(PG8_SB(0, 0), b2, voffB);
            PG8_BAR; PG8_WAIT_L(0); PG8_MMA(0, 1, At, B1); PG8_BAR;
            PG8_LDA(At, 0, 1); PG8_STAGE(PG8_SA(0, 0), a2, voffA);
            PG8_BAR; PG8_WAIT_L(0); PG8_MMA(1, 0, At, B0); PG8_BAR; PG8_SCHED;
            PG8_STAGE(PG8_SB(0, 1), b2 + hstep, voffB);
            PG8_WAIT_V(6); PG8_BAR; PG8_MMA(1, 1, At, B1); PG8_BAR;
            PG8_LDB(B0, 1, 0); PG8_SCHED; PG8_LDA(At, 1, 0); PG8_STAGE(PG8_SA(0, 1), a2 + hstep, voffA);
            PG8_WAIT_L(8); PG8_BAR; PG8_WAIT_L(0); PG8_MMA(0, 0, At, B0); PG8_BAR; PG8_SCHED;
            PG8_LDB(B1, 1, 1); PG8_STAGE(PG8_SB(1, 0), b3, voffB);
            PG8_BAR; PG8_WAIT_L(0); PG8_MMA(0, 1, At, B1); PG8_BAR;
            PG8_LDA(At, 1, 1); PG8_STAGE(PG8_SA(1, 0), a3, voffA);
            PG8_BAR; PG8_WAIT_L(0); PG8_MMA(1, 0, At, B0); PG8_BAR; PG8_SCHED;
            PG8_STAGE(PG8_SB(1, 1), b3 + hstep, voffB);
            PG8_WAIT_V(6); PG8_BAR; PG8_MMA(1, 1, At, B1); PG8_BAR;
            }
        }
        if constexpr (ALIGN_EPI) { if (wr == 0) PG8_BAR; }
        if constexpr (!Epi::AFTER_DRAIN) { E(acc, cur, wr, wc, fr, fq); S.done(cur); }
        if (!has_next) break;
#pragma unroll
        for (int a = 0; a < 2; ++a)
#pragma unroll
            for (int b = 0; b < 2; ++b)
#pragma unroll
                for (int m = 0; m < 4; ++m)
#pragma unroll
                    for (int n = 0; n < 2; ++n) acc[a][b][m][n] = acc_t{};
        cur = nxt; cA = nA; cB = nB; ++ui;
        if constexpr (ALIGN_EPI) { if (wr == 1) PG8_BAR; }
    }
    PG8_WAIT_V(0);
    if constexpr (!ALIGN_EPI) { if (wr == 0) PG8_BAR; }
    PG8_BAR;
    if constexpr (Epi::AFTER_DRAIN) { E.fused(acc, cur, wr, wc, fr, fq, lds, wid, lane); S.done(cur); }
#undef PG8_SA
#undef PG8_SB
#undef PG8_STAGE
#undef PG8_LDA
#undef PG8_LDB
#undef PG8_MMA
#undef PG8_WAIT_V
#undef PG8_WAIT_L
#undef PG8_BAR
#undef PG8_SCHED
}
}
#ifndef MK_PER_PHASE
#define MK_PER_PHASE 0
#endif
#ifndef PROBE_PHASE
#define PROBE_PHASE -1
#endif
#ifndef X1_NR
#define X1_NR 2
#endif
#ifndef TABLES_IN_PHASE
#define TABLES_IN_PHASE 0
#endif
constexpr int NWAVES = 8, NTHR = NWAVES * 64;
constexpr int BATCH = 8, SEQ = 4096, D = 1024, M = BATCH * SEQ;
constexpr int INC = 2560;
constexpr int NEXP = 16384, PKN = 128;
constexpr int NQ = 2048;
constexpr float EPS = 1e-6f;
constexpr size_t MiB = 1u << 20;
constexpr size_t WS_CTL = 0, CTL_ZERO_BYTES = MK_PER_PHASE ? (1u << 20) : 64 * 1024;
constexpr size_t WS_MOD = 1 * MiB, WS_WIN = 2 * MiB, WS_WOUT = 7 * MiB, WS_WQ = 9 * MiB, WS_KEYS = 13 * MiB, WS_SGW = 13 * MiB + 512 * 1024;
constexpr size_t WS_SU = 14 * MiB, WS_UT = 16 * MiB, WS_VT = 48 * MiB, WS_H = 80 * MiB, WS_Y = 144 * MiB, WS_OATT = 80 * MiB, WS_Z = 208 * MiB, WS_QP = 208 * MiB;
constexpr size_t WS_H8 = 336 * MiB;
constexpr size_t WS_CAT = 368 * MiB, WS_IDX = 432 * MiB, WS_GATE = 448 * MiB, WS_END = 464 * MiB;
constexpr int CW_BAR = 4096;
constexpr int RING_BYTES = 131072, LDSCTL_OFF = RING_BYTES, MISC_OFF = LDSCTL_OFF + 320, LDS_BYTES = 147456;
constexpr int NPHASE = 10;

#define GAS __attribute__((address_space(1)))
#define LAS __attribute__((address_space(3)))
typedef unsigned short bf16;
typedef unsigned v4u __attribute__((ext_vector_type(4)));
typedef unsigned v2u __attribute__((ext_vector_type(2)));
typedef float f32x4 __attribute__((ext_vector_type(4)));
typedef short bf16x8 __attribute__((ext_vector_type(8)));
typedef GAS unsigned gu32;
typedef GAS unsigned long long gu64;
#define RLX_AGENT __ATOMIC_RELAXED, __HIP_MEMORY_SCOPE_AGENT
#define LDS_WAIT() asm volatile("s_waitcnt lgkmcnt(0)" ::: "memory")
#define VM_WAIT() asm volatile("s_waitcnt vmcnt(0)" ::: "memory")
__device__ __forceinline__ unsigned f2bf(float f) { unsigned u = __builtin_bit_cast(unsigned, f); return (u + 0x7fffu + ((u >> 16) & 1u)) >> 16; }
__device__ __forceinline__ unsigned pk2(float lo, float hi) { return f2bf(lo) | (f2bf(hi) << 16); }
__device__ __forceinline__ float bflo(unsigned w) { return __uint_as_float(w << 16); }
__device__ __forceinline__ float bfhi(unsigned w) { return __uint_as_float(w & 0xffff0000u); }
__device__ __forceinline__ float bf2f(bf16 b) { return __uint_as_float((unsigned)b << 16); }
typedef __bf16 bf16x2_t __attribute__((ext_vector_type(2)));
__device__ __forceinline__ float dot2(unsigned a, unsigned b, float acc) { return __builtin_amdgcn_fdot2_f32_bf16(__builtin_bit_cast(bf16x2_t, a), __builtin_bit_cast(bf16x2_t, b), acc, false); }
__device__ __forceinline__ float gelu_t(float v) { const float u = v * (1.f + 0.044715f * v * v); return v * __builtin_amdgcn_rcpf(1.f + __builtin_amdgcn_exp2f(-2.302208198f * u)); }
__device__ __forceinline__ int lane_id() { return (int)__builtin_amdgcn_mbcnt_hi(~0u, __builtin_amdgcn_mbcnt_lo(~0u, 0u)); }
__device__ __forceinline__ float wave_sum(float v) {
#pragma unroll
    for (int o = 1; o < 64; o <<= 1) v += __shfl_xor(v, o);
    return v;
}
#define DPP_SUM_ROW(v) do { v += __uint_as_float((unsigned)__builtin_amdgcn_update_dpp(0, (int)__float_as_uint(v), 0xB1, 0xF, 0xF, false)); \
        v += __uint_as_float((unsigned)__builtin_amdgcn_update_dpp(0, (int)__float_as_uint(v), 0x4E, 0xF, 0xF, false)); \
        v += __uint_as_float((unsigned)__builtin_amdgcn_update_dpp(0, (int)__float_as_uint(v), 0x141, 0xF, 0xF, false)); \
        v += __uint_as_float((unsigned)__builtin_amdgcn_update_dpp(0, (int)__float_as_uint(v), 0x140, 0xF, 0xF, false)); } while (0)
__device__ __forceinline__ float dpp_xor1(float v) { return __uint_as_float((unsigned)__builtin_amdgcn_update_dpp(0, (int)__float_as_uint(v), 0xB1, 0xF, 0xF, false)); }
__device__ __forceinline__ float wave_sum_dpp(float v) {
    DPP_SUM_ROW(v);
    const float r0 = __uint_as_float(__builtin_amdgcn_readlane(__float_as_uint(v), 0)), r1 = __uint_as_float(__builtin_amdgcn_readlane(__float_as_uint(v), 16));
    const float r2 = __uint_as_float(__builtin_amdgcn_readlane(__float_as_uint(v), 32)), r3 = __uint_as_float(__builtin_amdgcn_readlane(__float_as_uint(v), 48));
    return (r0 + r1) + (r2 + r3);
}
__device__ __forceinline__ float wave_max_dpp(float v) {
    v = fmaxf(v, __uint_as_float((unsigned)__builtin_amdgcn_update_dpp(0, (int)__float_as_uint(v), 0xB1, 0xF, 0xF, false)));
    v = fmaxf(v, __uint_as_float((unsigned)__builtin_amdgcn_update_dpp(0, (int)__float_as_uint(v), 0x4E, 0xF, 0xF, false)));
    v = fmaxf(v, __uint_as_float((unsigned)__builtin_amdgcn_update_dpp(0, (int)__float_as_uint(v), 0x141, 0xF, 0xF, false)));
    v = fmaxf(v, __uint_as_float((unsigned)__builtin_amdgcn_update_dpp(0, (int)__float_as_uint(v), 0x140, 0xF, 0xF, false)));
    const float r0 = __uint_as_float(__builtin_amdgcn_readlane(__float_as_uint(v), 0)), r1 = __uint_as_float(__builtin_amdgcn_readlane(__float_as_uint(v), 16));
    const float r2 = __uint_as_float(__builtin_amdgcn_readlane(__float_as_uint(v), 32)), r3 = __uint_as_float(__builtin_amdgcn_readlane(__float_as_uint(v), 48));
    return fmaxf(fmaxf(r0, r1), fmaxf(r2, r3));
}
__device__ __forceinline__ float half_max_dpp(float v) {
    v = fmaxf(v, __uint_as_float((unsigned)__builtin_amdgcn_update_dpp(0, (int)__float_as_uint(v), 0xB1, 0xF, 0xF, false)));
    v = fmaxf(v, __uint_as_float((unsigned)__builtin_amdgcn_update_dpp(0, (int)__float_as_uint(v), 0x4E, 0xF, 0xF, false)));
    v = fmaxf(v, __uint_as_float((unsigned)__builtin_amdgcn_update_dpp(0, (int)__float_as_uint(v), 0x141, 0xF, 0xF, false)));
    v = fmaxf(v, __uint_as_float((unsigned)__builtin_amdgcn_update_dpp(0, (int)__float_as_uint(v), 0x140, 0xF, 0xF, false)));
    const float r0 = __uint_as_float(__builtin_amdgcn_readlane(__float_as_uint(v), 0)), r1 = __uint_as_float(__builtin_amdgcn_readlane(__float_as_uint(v), 16));
    const float r2 = __uint_as_float(__builtin_amdgcn_readlane(__float_as_uint(v), 32)), r3 = __uint_as_float(__builtin_amdgcn_readlane(__float_as_uint(v), 48));
    return (lane_id() < 32) ? fmaxf(r0, r1) : fmaxf(r2, r3);
}
__device__ __forceinline__ float wave_max(float v) {
#pragma unroll
    for (int o = 1; o < 64; o <<= 1) v = fmaxf(v, __shfl_xor(v, o));
    return v;
}
#define XB_TMO      128
#define XB_XCNT(j)  (256  + 64 * (j))
#define XB_XSUB(j)  (1280 + 64 * (j))
#define XB_XGEN(j)  (2304 + 64 * (j))
#define XB_TOP      3328
#define XB_TOPGEN   3392
#define XCD_BAR_WORDS 3456
#define XB_SPIN_CAP (1u << 18)

__device__ __forceinline__ unsigned xb_ld(unsigned* p)              { return __hip_atomic_load(p, __ATOMIC_RELAXED, __HIP_MEMORY_SCOPE_AGENT); }
__device__ __forceinline__ unsigned xb_add(unsigned* p, unsigned v) { return __hip_atomic_fetch_add(p, v, __ATOMIC_RELAXED, __HIP_MEMORY_SCOPE_AGENT); }
__device__ __forceinline__ unsigned xb_xcc_id() { return (unsigned)__builtin_amdgcn_s_getreg((3 << 11) | 20) & 0xFu; }
#define XB_SPIN(cond, bar) do { unsigned _sp = 0; while (cond) { __builtin_amdgcn_s_sleep(1); \
    if ((++_sp & 255u) == 0u) { if (xb_ld(&(bar)[XB_TMO])) break; if (_sp > XB_SPIN_CAP) { atomicAdd(&(bar)[XB_TMO], 1u); break; } } } } while (0)

struct XcdBarrier {
    unsigned* bar; unsigned x;
    volatile LAS unsigned* st;
};

__device__ __forceinline__ XcdBarrier xcd_barrier_post(unsigned* bar, volatile LAS unsigned* st) {
    XcdBarrier b; b.bar = bar; b.x = xb_xcc_id(); b.st = st;
    if (threadIdx.x == 0) (void)xb_add(&bar[XB_XCNT(b.x)], 1u);
    return b;
}
__device__ __forceinline__ void xcd_barrier_complete(unsigned* bar, unsigned x, unsigned& nloc, unsigned& nx) {
    const unsigned G = gridDim.x * gridDim.y * gridDim.z;
    unsigned sum, cnt, mine, sp = 0u;
    for (;;) {
        sum = 0u; cnt = 0u; mine = 0u;
#pragma unroll
        for (unsigned j = 0; j < 16; ++j) { const unsigned c = xb_ld(&bar[XB_XCNT(j)]); sum += c; cnt += (c > 0u) ? 1u : 0u; mine = (j == x) ? c : mine; }
        if (sum == G) break;
        __builtin_amdgcn_s_sleep(1);
        if ((++sp & 255u) == 0u) { if (xb_ld(&bar[XB_TMO])) break; if (sp > XB_SPIN_CAP) { atomicAdd(&bar[XB_TMO], 1u); break; } }
    }
    nloc = mine > 0u ? mine : 1u; nx = cnt > 0u ? cnt : 1u;
}

__device__ __forceinline__ void xcd_barrier(const XcdBarrier& b) {
    asm volatile("s_waitcnt vmcnt(0)" ::: "memory");
    __syncthreads();
    if (threadIdx.x == 0) {
        unsigned* bar = b.bar;
        __builtin_amdgcn_s_waitcnt(0);
        unsigned nloc = b.st[0], nx = b.st[1];
        if (nloc == 0u) { xcd_barrier_complete(bar, b.x, nloc, nx); b.st[0] = nloc; b.st[1] = nx; }
        const unsigned old = xb_add(&bar[XB_XSUB(b.x)], 1u);
        const unsigned gen = old / nloc;
        if (old + 1u == (gen + 1u) * nloc) {
            __builtin_amdgcn_fence(__ATOMIC_RELEASE, "agent");
            asm volatile("s_waitcnt vmcnt(0)" ::: "memory");
            const unsigned og = xb_add(&bar[XB_TOP], 1u);
            const unsigned tg = og / nx;
            if (og + 1u == (tg + 1u) * nx) xb_add(&bar[XB_TOPGEN], 1u);
            else XB_SPIN(xb_ld(&bar[XB_TOPGEN]) == tg, bar);
            __builtin_amdgcn_fence(__ATOMIC_ACQUIRE, "agent");
            xb_add(&bar[XB_XGEN(b.x)], 1u);
            asm volatile("s_waitcnt vmcnt(0)" ::: "memory");
        } else {
            XB_SPIN(xb_ld(&bar[XB_XGEN(b.x)]) == gen, bar);
            __builtin_amdgcn_fence(__ATOMIC_ACQUIRE, "agent");
            asm volatile("s_waitcnt vmcnt(0)" ::: "memory");
        }
    }
    __syncthreads();
}
struct Frame {
    LAS unsigned char* lds;
    volatile LAS unsigned* MISC;
    gu32* ctl;
    int wave, G;
    const float *x, *c, *w_ada, *b_ada, *norm_g, *w_in, *sgu_ln_g, *sgu_ln_b, *sgu_w, *sgu_b, *diff_lambda, *subln_g, *rel_bias, *w_out, *w_query, *sub_keys, *peer_u, *peer_v;
    float* out;
    float* mod; bf16 *WIN, *WOUT, *WQ, *KEYS, *SGW, *H, *Y, *Z, *QP, *CAT; unsigned char *UT8, *VT6, *H8, *HA8, *W8, *WQ8; float *HS, *HAS, *WS8, *WQS8; float *SU, *SV, *PART; unsigned* STASH; int* IDX; float* GATE; bf16* X1B;
};

__device__ __forceinline__ void p0_transpose_item(const float* W, int K, int N, bf16* WT, int row_off, LAS float* scr, int item, int lane) {
    const int nblk = N / 32, kb = item / nblk, nb = item % nblk, k0 = 64 * kb, n0 = 32 * nb;
#pragma unroll 8
    for (int i = 0; i < 32; ++i) { const int kk = 2 * i + (lane >> 5); scr[kk * 33 + (lane & 31)] = W[(size_t)(k0 + kk) * N + n0 + (lane & 31)]; }
    LDS_WAIT(); asm volatile("" ::: "memory");
    const int c = lane & 7;
#pragma unroll
    for (int j = 0; j < 4; ++j) { const int n = (lane >> 3) + 8 * j; const LAS float* s = scr + (8 * c) * 33 + n;
        v4u o; o.x = pk2(s[0 * 33], s[1 * 33]); o.y = pk2(s[2 * 33], s[3 * 33]); o.z = pk2(s[4 * 33], s[5 * 33]); o.w = pk2(s[6 * 33], s[7 * 33]);
        *(GAS v4u*)(WT + (size_t)(row_off + n0 + n) * K + k0 + 8 * c) = o; }
    LDS_WAIT(); asm volatile("" ::: "memory");
}

__device__ __forceinline__ void prologue_tables_fwd(Frame& F, int gw, int NGW, int lane);
__device__ __forceinline__ void ph_prologue(Frame& F) {
    const int lane = lane_id(), wave = F.wave, tid = wave * 64 + lane, G = F.G;
    const int gw = blockIdx.x * NWAVES + wave, NGW = G * NWAVES;
    for (int rep_ = 0; rep_ < (PROBE_PHASE == 100 ? 2 : 1); ++rep_) {
        LAS float* sil = (LAS float*)F.lds;
        LAS float* red = sil + 8192;
        for (int i = tid; i < 8192; i += NTHR) { const float cv = F.c[i]; sil[i] = cv / (1.f + __expf(-cv)); }
        __syncthreads();
        for (int u = blockIdx.x; u < 384; u += G) {
            const int j = u * 16 + (lane & 15), kr = lane >> 4, k0 = wave * 128;
            float acc[8];
#pragma unroll
            for (int b = 0; b < 8; ++b) acc[b] = 0.f;
            const float* wp = F.w_ada + (size_t)(k0 + kr) * 6144 + j;
#pragma unroll 16
            for (int i = 0; i < 32; ++i) { const float w = wp[(size_t)i * 4 * 6144]; const int k = k0 + 4 * i + kr;
#pragma unroll
                for (int b = 0; b < 8; ++b) acc[b] += sil[b * 1024 + k] * w; }
#pragma unroll
            for (int b = 0; b < 8; ++b) { acc[b] += __shfl_xor(acc[b], 16); acc[b] += __shfl_xor(acc[b], 32); }
            if (lane < 16) {
#pragma unroll
                for (int b = 0; b < 8; ++b) red[(wave * 8 + b) * 16 + lane] = acc[b]; }
            __syncthreads();
            if (tid < 128) { const int b = tid >> 4, c = tid & 15; float s = 0.f;
#pragma unroll
                for (int w = 0; w < 8; ++w) s += red[(w * 8 + b) * 16 + c];
                F.mod[b * 6144 + u * 16 + c] = s + F.b_ada[u * 16 + c]; }
            __syncthreads();
        }
    }
    LAS float* scr = (LAS float*)(F.lds + wave * 16384);
    {
        LAS float* part = (LAS float*)(F.lds + 7 * 16384 + 8704);
        LAS float* fin = part + 256;
        const int rr = lane >> 3, cc = lane & 7;
        for (int rep_ = 0; rep_ < (PROBE_PHASE == 103 ? 2 : 1); ++rep_)
        for (int u = G - 1 - blockIdx.x; u < (INC + NQ) / 32; u += G) {
            const bool isq = u >= INC / 32;
            const float* Wsrc = isq ? F.w_query : F.w_in; const int Nw = isq ? NQ : INC; unsigned char* Wdst = isq ? F.WQ8 : F.W8; float* Sdst = isq ? F.WQS8 : F.WS8;
            const int n0 = (isq ? u - INC / 32 : u) * 32;
            f32x4 wv[16];
            { const float* wp = Wsrc + (size_t)(wave * 128 + rr * 16) * Nw + n0 + cc * 4;
#pragma unroll
              for (int i = 0; i < 16; ++i) wv[i] = *(const f32x4*)(wp + (size_t)i * Nw); }
            f32x4 am = {0.f, 0.f, 0.f, 0.f};
#pragma unroll
            for (int i = 0; i < 16; ++i) { am.x = fmaxf(am.x, fabsf(wv[i].x)); am.y = fmaxf(am.y, fabsf(wv[i].y)); am.z = fmaxf(am.z, fabsf(wv[i].z)); am.w = fmaxf(am.w, fabsf(wv[i].w)); }
#pragma unroll
            for (int o = 8; o < 64; o <<= 1) { am.x = fmaxf(am.x, __shfl_xor(am.x, o)); am.y = fmaxf(am.y, __shfl_xor(am.y, o)); am.z = fmaxf(am.z, __shfl_xor(am.z, o)); am.w = fmaxf(am.w, __shfl_xor(am.w, o)); }
            if (lane < 8) *(LAS f32x4*)(part + wave * 32 + cc * 4) = am;
            __syncthreads();
            if (tid < 32) { float mx = 0.f;
#pragma unroll
                for (int w = 0; w < 8; ++w) mx = fmaxf(mx, part[w * 32 + tid]);
                const float qsc = (!isq && n0 >= 1024 && n0 < 1536) ? 0.125f * 1.4426950408889634f : 1.f;
                fin[tid] = mx; Sdst[n0 + tid] = (mx > 0.f ? mx * (1.f / 127.f) : 1.f) * qsc; }
            __syncthreads();
            const f32x4 cm = *(const LAS f32x4*)(fin + cc * 4);
            const f32x4 sc = {cm.x > 0.f ? 127.f / cm.x : 1.f, cm.y > 0.f ? 127.f / cm.y : 1.f, cm.z > 0.f ? 127.f / cm.z : 1.f, cm.w > 0.f ? 127.f / cm.w : 1.f};
            unsigned char* op = Wdst + (size_t)(n0 + cc * 4) * D + wave * 128 + rr * 16;
#define Q8PK(e_, s_) ({ unsigned w4_[4]; _Pragma("unroll") for (int d_ = 0; d_ < 4; ++d_) { \
                const int q0 = (int)rintf(wv[4 * d_].e_ * s_), q1 = (int)rintf(wv[4 * d_ + 1].e_ * s_), q2 = (int)rintf(wv[4 * d_ + 2].e_ * s_), q3 = (int)rintf(wv[4 * d_ + 3].e_ * s_); \
                w4_[d_] = (unsigned)((q0 & 255) | ((q1 & 255) << 8) | ((q2 & 255) << 16) | (q3 << 24)); } (v4u){w4_[0], w4_[1], w4_[2], w4_[3]}; })
            *(GAS v4u*)(op) = Q8PK(x, sc.x); *(GAS v4u*)(op + D) = Q8PK(y, sc.y); *(GAS v4u*)(op + 2 * D) = Q8PK(z, sc.z); *(GAS v4u*)(op + 3 * D) = Q8PK(w, sc.w);
#undef Q8PK
            __syncthreads();
        }
    }
    constexpr int I_IN = 0, I_OUT = (D / 64) * (D / 32), I_Q = 0;
    for (int rep_ = 0; rep_ < (PROBE_PHASE == 101 ? 2 : 1); ++rep_)
    for (int it = wave * G + blockIdx.x; it < I_IN + I_OUT + I_Q; it += NGW) {
        int r = it;
        if (r < I_IN) { p0_transpose_item(F.w_in, D, INC, F.WIN, 0, scr, r, lane); continue; } r -= I_IN;
        if (r < I_OUT) { p0_transpose_item(F.w_out, D, D, F.WOUT, 0, scr, r, lane); continue; } r -= I_OUT;
        (void)r;
    }
    const int gt = blockIdx.x * NTHR + tid, NT = G * NTHR;
    if (TABLES_IN_PHASE == 0) for (int rep_ = 0; rep_ < (PROBE_PHASE == 102 ? 2 : 1); ++rep_) prologue_tables_fwd(F, gw, NGW, lane);
    for (int i = gt; i < 16 * 16 * 128; i += NT) {
        const int hc = i >> 11, dg = (i >> 7) & 15, n = i & 127;
        const float* s = F.sub_keys + ((size_t)(hc * 128 + n)) * 128 + dg * 8;
        const f32x4 a = *(const f32x4*)s, b = *(const f32x4*)(s + 4);
        v4u o; o.x = pk2(a.x, a.y); o.y = pk2(a.z, a.w); o.z = pk2(b.x, b.y); o.w = pk2(b.z, b.w); ((v4u*)F.KEYS)[i] = o;
    }
    for (int i = gt; i < 8 * 128 * 16; i += NT) {
        const int t = (i >> 4) & 127, s0 = (i & 15) * 8;
        const float* s = F.sgu_w + (size_t)i * 8;
        const f32x4 a = *(const f32x4*)s, b = *(const f32x4*)(s + 4);
        float f[8] = {a.x, a.y, a.z, a.w, b.x, b.y, b.z, b.w};
#pragma unroll
        for (int e = 0; e < 8; ++e) f[e] = (s0 + e <= t) ? f[e] : 0.f;
        v4u o; o.x = pk2(f[0], f[1]); o.y = pk2(f[2], f[3]); o.z = pk2(f[4], f[5]); o.w = pk2(f[6], f[7]); ((v4u*)F.SGW)[i] = o;
    }
}

__device__ __forceinline__ void ph_hrows(Frame& F) {
    const int lane = lane_id(); const int gw = blockIdx.x * NWAVES + F.wave, NGW = F.G * NWAVES;
    const int rpw = (M + NGW - 1) / NGW, rbeg = gw * rpw, rend = (rbeg + rpw < M) ? rbeg + rpw : M;
    if (rbeg >= rend) return;
    f32x4 s1[4], sh1[4]; int cb = -1;
    f32x4 v[4], vn[4], vnn[4];
#define HR_LOAD(dst, m_) do { const f32x4* xr = (const f32x4*)(F.x + (size_t)(m_) * D) + lane; _Pragma("unroll") for (int j = 0; j < 4; ++j) dst[j] = __builtin_nontemporal_load(xr + 64 * j); } while (0)
    HR_LOAD(v, rbeg); { const int m1 = (rbeg + 1 < rend) ? rbeg + 1 : rbeg; HR_LOAD(vn, m1); }
    for (int m = rbeg; m < rend; ++m) {
        if ((m >> 12) != cb) { cb = m >> 12; const float* md = F.mod + cb * 6144;
#pragma unroll
            for (int j = 0; j < 4; ++j) { const int c = 256 * j + 4 * lane;
                const f32x4 g = *(const f32x4*)(F.norm_g + c), sc = *(const f32x4*)(md + 1024 + c);
                s1[j] = g * (sc + 1.f); sh1[j] = *(const f32x4*)(md + c); } }
        { const int mn = (m + 2 < rend) ? m + 2 : m; HR_LOAD(vnn, mn); }
        float ss = 0.f;
#pragma unroll
        for (int j = 0; j < 4; ++j) ss += (v[j].x * v[j].x + v[j].y * v[j].y) + (v[j].z * v[j].z + v[j].w * v[j].w);
        const float rstd = rsqrtf(wave_sum_dpp(ss) * (1.f / D) + EPS);
        float am = 0.f;
#pragma unroll
        for (int j = 0; j < 4; ++j) { const f32x4 hv = (v[j] * rstd) * s1[j] + sh1[j]; v[j] = hv;
            am = fmaxf(am, fmaxf(fmaxf(fabsf(hv.x), fabsf(hv.y)), fmaxf(fabsf(hv.z), fabsf(hv.w)))); }
        am = wave_max_dpp(am);
        const float s8 = am > 0.f ? 127.f / am : 1.f;
        unsigned* h8 = (unsigned*)(F.HA8 + (size_t)m * D) + lane;
#pragma unroll
        for (int j = 0; j < 4; ++j) { const int q0 = (int)rintf(v[j].x * s8), q1 = (int)rintf(v[j].y * s8), q2 = (int)rintf(v[j].z * s8), q3 = (int)rintf(v[j].w * s8);
            h8[64 * j] = (unsigned)((q0 & 255) | ((q1 & 255) << 8) | ((q2 & 255) << 16) | (q3 << 24)); }
        if (lane == 0) F.HAS[m] = 1.f / s8;
#pragma unroll
        for (int j = 0; j < 4; ++j) { v[j] = vn[j]; vn[j] = vnn[j]; }
    }
#undef HR_LOAD
}

__device__ __forceinline__ void ph_x1rows(Frame& F) {
    const int lane = lane_id(); const int gw = blockIdx.x * NWAVES + F.wave, NGW = F.G * NWAVES;
    const int rpw = (M + NGW - 1) / NGW, rbeg = gw * rpw, rend = (rbeg + rpw < M) ? rbeg + rpw : M;
    if (rbeg >= rend) return;
    f32x4 gg1[4], s2[4], sh2[4]; int cb = -1;
    f32x4 xv[4], xn[4]; v2u yw[4], yn[4];
#define XR_LOAD(dx, dy, m_) do { const f32x4* xr = (const f32x4*)(F.x + (size_t)(m_) * D) + lane; const v2u* yr = (const v2u*)(F.Y + (size_t)(m_) * D) + lane; \
        _Pragma("unroll") for (int j = 0; j < 4; ++j) { dx[j] = xr[64 * j]; dy[j] = yr[64 * j]; } } while (0)
    XR_LOAD(xv, yw, rbeg);
    for (int m = rbeg; m < rend; ++m) {
        if ((m >> 12) != cb) { cb = m >> 12; const float* md = F.mod + cb * 6144;
#pragma unroll
            for (int j = 0; j < 4; ++j) { const int c = 256 * j + 4 * lane;
                const f32x4 g1 = *(const f32x4*)(F.norm_g + 1024 + c), gt = *(const f32x4*)(md + 2048 + c);
                const f32x4 g2 = *(const f32x4*)(F.norm_g + 2048 + c), sc = *(const f32x4*)(md + 4096 + c);
                gg1[j] = gt * g1; s2[j] = g2 * (sc + 1.f); sh2[j] = *(const f32x4*)(md + 3072 + c); } }
        { const int mn = (m + 1 < rend) ? m + 1 : m; XR_LOAD(xn, yn, mn); }
        f32x4 yv[4]; float ss = 0.f;
#pragma unroll
        for (int j = 0; j < 4; ++j) { const v2u w = yw[j]; yv[j] = (f32x4){bflo(w.x), bfhi(w.x), bflo(w.y), bfhi(w.y)};
            ss += (yv[j].x * yv[j].x + yv[j].y * yv[j].y) + (yv[j].z * yv[j].z + yv[j].w * yv[j].w); }
        const float rstd = rsqrtf(wave_sum_dpp(ss) * (1.f / D) + EPS);
        v2u* orow = (v2u*)(F.X1B + (size_t)m * D) + lane; float s1 = 0.f;
#pragma unroll
        for (int j = 0; j < 4; ++j) { xv[j] = xv[j] + (yv[j] * rstd) * gg1[j]; orow[64 * j] = (v2u){pk2(xv[j].x, xv[j].y), pk2(xv[j].z, xv[j].w)};
            s1 += (xv[j].x * xv[j].x + xv[j].y * xv[j].y) + (xv[j].z * xv[j].z + xv[j].w * xv[j].w); }
        const float r1 = rsqrtf(wave_sum_dpp(s1) * (1.f / D) + EPS);
        float am = 0.f;
#pragma unroll
        for (int j = 0; j < 4; ++j) { const f32x4 hv = (xv[j] * r1) * s2[j] + sh2[j]; xv[j] = hv;
            am = fmaxf(am, fmaxf(fmaxf(fabsf(hv.x), fabsf(hv.y)), fmaxf(fabsf(hv.z), fabsf(hv.w)))); }
        am = wave_max_dpp(am);
        const float s8 = am > 0.f ? 119.f / am : 1.f;
        unsigned* h8 = (unsigned*)(F.H8 + (size_t)m * D) + lane;
#pragma unroll
        for (int j = 0; j < 4; ++j) { const int q0 = (int)rintf(xv[j].x * s8), q1 = (int)rintf(xv[j].y * s8), q2 = (int)rintf(xv[j].z * s8), q3 = (int)rintf(xv[j].w * s8);
            h8[64 * j] = (unsigned)((q0 & 255) | ((q1 & 255) << 8) | ((q2 & 255) << 16) | (q3 << 24)); }
        if (lane == 0) F.HS[m] = 1.f / s8;
#pragma unroll
        for (int j = 0; j < 4; ++j) { xv[j] = xn[j]; yw[j] = yn[j]; }
    }
#undef XR_LOAD
}

namespace att {
typedef float f32x16 __attribute__((ext_vector_type(16)));
typedef short s16x4 __attribute__((ext_vector_type(4)));
typedef short v4i16_t __attribute__((ext_vector_type(4)));
constexpr int QB = 256, KVB = 64;
constexpr int NS = 4;
constexpr int BTO = 288, BTN = 416;
constexpr int L_V = 0, L_K = NS * 16384, L_WS = L_K + NS * 8192, L_BT = L_WS + 2048, L_END = L_BT + 2048;
constexpr float C2 = 0.125f * 1.4426950408889634f;
__device__ __forceinline__ int v_st(int k, int c) { const int kk = (k & ~0xC) | ((k & 4) << 1) | ((k & 8) >> 1); return ((kk >> 3) * 4 + (c >> 5)) * 512 + ((kk & 7) * 32 + (c & 31)) * 2; }
__device__ __forceinline__ int v_rd_base(int lane) { return ((lane & 3) << 3) | (((lane >> 2) & 3) << 6) | (((lane >> 4) & 1) << 5) | (((lane >> 5) & 1) << 8); }
__device__ __forceinline__ unsigned v_src(int p) { const int sub = p >> 5, q = p & 31, kk = (sub >> 2) * 8 + (q >> 2), c = (sub & 3) * 32 + (q & 3) * 8;
    const int k = kk; return (unsigned)(k * INC + c) * 2u; }
__device__ __forceinline__ int crow(int r, int hi) { return (r & 3) + 8 * (r >> 2) + 4 * hi; }
typedef float f32x2_t __attribute__((ext_vector_type(2))); typedef __bf16 bf16x2_t __attribute__((ext_vector_type(2)));
__device__ __forceinline__ unsigned cvtpk(float lo, float hi) { const f32x2_t v = {lo, hi}; const bf16x2_t b = __builtin_convertvector(v, bf16x2_t); return __builtin_bit_cast(unsigned, b); }

__device__ __forceinline__ void attn_unit(Frame& F, int b, int h, int qb, float lam) {
    int tid = F.wave * 64 + lane_id(); asm volatile("" : "+v"(tid));
    const int lane = tid & 63, wid = F.wave, r32 = lane & 31, hi = lane >> 5;
    LAS unsigned char* lds = F.lds;
    LAS float* wsf = (LAS float*)(lds + L_WS) + wid * 64;
    const LAS float* bt = (const LAS float*)(lds + L_BT);
    const int q0 = qb * QB, qlo = q0 + wid * 32, qpos = qlo + r32;
    const size_t rowb = (size_t)b * SEQ;
    const int NT = (q0 + QB) / KVB;
    const unsigned kdoff = (unsigned)((tid >> 3) * INC + (((tid & 7) ^ ((tid >> 3) & 7)) * 8)) * 2u;
    const unsigned vdoff0 = v_src(tid), vdoff1 = v_src(tid + 512);
    const unsigned qoff = (unsigned)(r32 * INC + hi * 8) * 2u;
#define GLDS16(g_, lb_) do { unsigned sv_; asm volatile("s_mov_b32 %0, m0\n\ts_mov_b32 m0, %2\n\ts_nop 0\n\tglobal_load_lds_dwordx4 %1, off\n\ts_mov_b32 m0, %0" : "=&s"(sv_) : "v"(g_), "s"(lb_) : "memory"); } while (0)
#define DMA_K(t_, buf_) do { unsigned kd_ = kdoff; asm volatile("" : "+v"(kd_)); GLDS16(Kb + (size_t)(t_) * (KVB * INC * 2) + kd_, (unsigned)__builtin_amdgcn_readfirstlane((int)(uintptr_t)(lds + L_K + (buf_) * 8192 + wid * 1024))); } while (0)
#define DMA_V(t_, buf_) do { unsigned v0_ = vdoff0, v1_ = vdoff1; asm volatile("" : "+v"(v0_), "+v"(v1_)); const unsigned lb_ = (unsigned)__builtin_amdgcn_readfirstlane((int)(uintptr_t)(lds + L_V + (buf_) * 16384 + wid * 1024)); \
        GLDS16(Vb + (size_t)(t_) * (KVB * INC * 2) + v0_, lb_); GLDS16(Vb + (size_t)(t_) * (KVB * INC * 2) + v1_, lb_ + 8192u); } while (0)
#define DMA_TILE(t_) do { const int sl_ = (t_) & (NS - 1); DMA_K(t_, sl_); DMA_V(t_, sl_); } while (0)
#define ABAR() do { asm volatile("s_waitcnt lgkmcnt(0)" ::: "memory"); __builtin_amdgcn_s_barrier(); asm volatile("" ::: "memory"); } while (0)
    const int vbase = (int)(uintptr_t)(lds + L_V) + v_rd_base(lane);
    const int kroff = r32 * 128, kx = (r32 & 7) << 4;
#pragma unroll
    for (int c = 0; c < 2; ++c) {
        const char* Kb = (const char*)(F.Z + rowb * INC + 1536 + h * 128 + c * 64);
        const char* Vb = (const char*)(F.Z + rowb * INC + 2048 + h * 128);
        const char* Qb = (const char*)(F.Z + (rowb + qlo) * INC + 1024 + h * 128 + c * 64);
        bf16x8 qr[4];
#pragma unroll
        for (int d0 = 0; d0 < 4; ++d0) qr[d0] = *(const bf16x8*)(Qb + d0 * 32 + qoff);
        DMA_K(0, 0); DMA_V(0, 0); DMA_K(1, 1); DMA_K(2, 2); DMA_V(1, 1); DMA_K(3, 3); DMA_V(2, 2);
        asm volatile("s_waitcnt vmcnt(9)" ::: "memory");
        ABAR();
        float mhat, l = 0.f; bool resc = false;
        f32x16 o[4];
#pragma unroll
        for (int d0 = 0; d0 < 4; ++d0) o[d0] = f32x16{};
        f32x16 pA0, pA1, pB0, pB1; bf16x8 kf[4]; s16x4 vlo[4], vhi[4]; v4u pw0, pw1, pw2, pw3;
        f32x16 negm; { float z_ = 0.f; asm volatile("" : "+v"(z_));
#pragma unroll
          for (int r = 0; r < 16; ++r) negm[r] = z_; }
        asm volatile("" : "+v"(negm));
#define SBAR() __builtin_amdgcn_sched_barrier(0)
#define PIN(x) asm volatile("" : "+v"(x))
#define MFMA32(a_, b_, c_) __builtin_amdgcn_mfma_f32_32x32x16_bf16(a_, b_, c_, 0, 0, 0)
#define KLD2(su, d0) do { const LAS unsigned char* a_ = lds + L_K + (su) * 8192 + kroff + (((d0) * 32 + hi * 16) ^ kx); kf[2 * ((d0) & 1)] = *(const LAS bf16x8*)a_; kf[2 * ((d0) & 1) + 1] = *(const LAS bf16x8*)(a_ + 4096); } while (0)
#define VTR(p_) __builtin_bit_cast(s16x4, __builtin_amdgcn_ds_read_tr16_b64_v4i16((LAS v4i16_t*)(p_)))
#define VRD(i) do { const LAS unsigned char* p_ = vp_ + ((i) >> 2) * 512 + ((i) & 3) * 4096; vlo[(i) & 3] = VTR(p_); vhi[(i) & 3] = VTR(p_ + 2048); } while (0)
#define VFR(i) (bf16x8){vlo[(i) & 3][0], vlo[(i) & 3][1], vlo[(i) & 3][2], vlo[(i) & 3][3], vhi[(i) & 3][0], vhi[(i) & 3][1], vhi[(i) & 3][2], vhi[(i) & 3][3]}
#define PAF(k) __builtin_bit_cast(bf16x8, pw##k)
#define MX3(a_, b_, c_) fmaxf(fmaxf((a_), (b_)), (c_))
#define ROWMAX(P0, P1, OUT) do { float a_ = MX3(P0[0], P0[1], P1[0]), b_ = MX3(P0[2], P0[3], P1[1]); a_ = MX3(a_, P1[2], P1[3]); \
        _Pragma("unroll") for (int r = 4; r < 16; r += 4) { a_ = MX3(a_, P0[r], P0[r + 1]); b_ = MX3(b_, P0[r + 2], P0[r + 3]); a_ = MX3(a_, P1[r], P1[r + 1]); b_ = MX3(b_, P1[r + 2], P1[r + 3]); } \
        float m_ = fmaxf(a_, b_); auto rr_ = __builtin_amdgcn_permlane32_swap(__float_as_uint(m_), __float_as_uint(m_), false, false); OUT = fmaxf(__uint_as_float(rr_[0]), __uint_as_float(rr_[1])); } while (0)
#define FIX_TILE(N0, N1, u) do { if (qlo - (u) * KVB - 63 < 113) { int qp_ = qpos - 4 * hi; asm volatile("" : "+v"(qp_)); const int dq_ = qp_ - (u) * KVB + BTO;     \
        _Pragma("unroll") for (int r = 0; r < 16; ++r) { const int i0_ = dq_ - ((r & 3) + 8 * (r >> 2)), i1_ = i0_ - 32; \
            N0[r] += bt[i0_ > BTN - 1 ? BTN - 1 : i0_]; N1[r] += bt[i1_ > BTN - 1 ? BTN - 1 : (i1_ < 0 ? 0 : i1_)]; } } } while (0)
#define EX(v) __builtin_amdgcn_exp2f(v)
#define RESC() do { if (resc) { _Pragma("unroll") for (int r = 0; r < 16; ++r) { const float a_ = wsf[crow(r, hi)]; _Pragma("unroll") for (int d0 = 0; d0 < 4; ++d0) o[d0][r] *= a_; } } } while (0)
#define PKH0(P, B_, PW) do { PW.x = cvtpk(P[B_ + 0], P[B_ + 1]); PW.y = cvtpk(P[B_ + 2], P[B_ + 3]); } while (0)
#define PKH1(P, B_, PW) do { PW.z = cvtpk(P[B_ + 4], P[B_ + 5]); PW.w = cvtpk(P[B_ + 6], P[B_ + 7]); } while (0)
#define GAPA(MF, a0, a1, a2, a3, PK, PW) do { MF; sacc += a0; sacc += a1; sacc += a2; sacc += a3; PK; PIN(PW); PIN(sacc); SBAR(); } while (0)
#define GAPB(MF, X, i) do { MF; X[i] = EX(X[i]); X[i + 1] = EX(X[i + 1]); PIN(X); SBAR(); } while (0)
        KLD2(0, 0); KLD2(0, 1);
        pA0 = MFMA32(kf[0], qr[0], negm); pA1 = MFMA32(kf[1], qr[0], negm); pA0 = MFMA32(kf[2], qr[1], pA0); pA1 = MFMA32(kf[3], qr[1], pA1);
        KLD2(0, 2); KLD2(0, 3);
        pA0 = MFMA32(kf[0], qr[2], pA0); pA1 = MFMA32(kf[1], qr[2], pA1); pA0 = MFMA32(kf[2], qr[3], pA0); pA1 = MFMA32(kf[3], qr[3], pA1);
        FIX_TILE(pA0, pA1, 0);
        { float rm; ROWMAX(pA0, pA1, rm); mhat = rm;
#pragma unroll
          for (int r = 0; r < 16; ++r) negm[r] = -mhat;
          asm volatile("" : "+v"(negm));
#pragma unroll
          for (int r = 0; r < 16; ++r) { pA0[r] = EX(pA0[r] - rm); pA1[r] = EX(pA1[r] - rm); } }
        asm volatile("s_waitcnt vmcnt(5)" ::: "memory");
        ABAR();
        KLD2(1, 0); KLD2(1, 1);
#define STEP(C0, C1, P0, P1, t) do { SBAR(); \
        if ((t) + 3 < NT) DMA_K((t) + 3, ((t) + 3) & (NS - 1)); if ((t) + 2 < NT) DMA_V((t) + 2, ((t) + 2) & (NS - 1)); \
        const LAS unsigned char* vp_ = (const LAS unsigned char*)(uintptr_t)(vbase + (((t) - 1) & (NS - 1)) * 16384); \
        const int ksl_ = ((t) + 1) & (NS - 1); const bool gl_ = (t) + 1 < NT; \
        float sacc = 0.f; \
                        GAPA(C0 = MFMA32(kf[0], qr[0], negm), P0[0], P0[1], P0[2], P0[3],     PKH0(P0, 0, pw0), pw0); \
                        GAPA(C1 = MFMA32(kf[1], qr[0], negm), P0[4], P0[5], P0[6], P0[7],     PKH1(P0, 0, pw0), pw0); KLD2((t) & (NS - 1), 2); SBAR();     \
                        GAPA(C0 = MFMA32(kf[2], qr[1], C0),   P0[8], P0[9], P0[10], P0[11],   PKH0(P0, 8, pw1), pw1); \
                        GAPA(C1 = MFMA32(kf[3], qr[1], C1),   P0[12], P0[13], P0[14], P0[15], PKH1(P0, 8, pw1), pw1); KLD2((t) & (NS - 1), 3); SBAR(); \
        VRD(0); SBAR(); GAPA(C0 = MFMA32(kf[0], qr[2], C0),   P1[0], P1[1], P1[2], P1[3],     PKH0(P1, 0, pw2), pw2); \
        VRD(1); SBAR(); GAPA(C1 = MFMA32(kf[1], qr[2], C1),   P1[4], P1[5], P1[6], P1[7],     PKH1(P1, 0, pw2), pw2); \
        VRD(2); SBAR(); GAPA(C0 = MFMA32(kf[2], qr[3], C0),   P1[8], P1[9], P1[10], P1[11],   PKH0(P1, 8, pw3), pw3); \
        VRD(3); SBAR(); GAPA(C1 = MFMA32(kf[3], qr[3], C1),   P1[12], P1[13], P1[14], P1[15], PKH1(P1, 8, pw3), pw3); \
        l += sacc; \
        FIX_TILE(C0, C1, t); \
        { float rm_; ROWMAX(C0, C1, rm_); resc = false;                                                    \
          if (__builtin_expect(__any(rm_ > 8.0f), 0)) { const float dl_ = fmaxf(rm_, 0.f); mhat += dl_;     \
              _Pragma("unroll") for (int r = 0; r < 16; ++r) { C0[r] -= dl_; C1[r] -= dl_; } \
              _Pragma("unroll") for (int r = 0; r < 16; ++r) negm[r] = -mhat; \
              asm volatile("" : "+v"(negm)); \
              const float f_ = __builtin_amdgcn_exp2f(-dl_); l *= f_; if (hi == 0) wsf[r32] = f_; resc = true; } } \
        SBAR(); \
        GAPB(o[0] = MFMA32(PAF(0), VFR(0), o[0]), C0, 0);   VRD(4);  SBAR(); \
        GAPB(o[0] = MFMA32(PAF(1), VFR(1), o[0]), C0, 2);   VRD(5);  SBAR(); \
        GAPB(o[0] = MFMA32(PAF(2), VFR(2), o[0]), C0, 4);   VRD(6);  SBAR(); \
        GAPB(o[0] = MFMA32(PAF(3), VFR(3), o[0]), C0, 6);   VRD(7);  SBAR(); \
        GAPB(o[1] = MFMA32(PAF(0), VFR(4), o[1]), C0, 8);   VRD(8);  SBAR(); \
        GAPB(o[1] = MFMA32(PAF(1), VFR(5), o[1]), C0, 10);  VRD(9);  SBAR(); \
        GAPB(o[1] = MFMA32(PAF(2), VFR(6), o[1]), C0, 12);  VRD(10); SBAR(); \
        GAPB(o[1] = MFMA32(PAF(3), VFR(7), o[1]), C0, 14);  VRD(11); SBAR(); \
        GAPB(o[2] = MFMA32(PAF(0), VFR(8), o[2]), C1, 0);   VRD(12); SBAR(); \
        GAPB(o[2] = MFMA32(PAF(1), VFR(9), o[2]), C1, 2);   VRD(13); SBAR(); \
        GAPB(o[2] = MFMA32(PAF(2), VFR(10), o[2]), C1, 4);  VRD(14); SBAR(); \
        GAPB(o[2] = MFMA32(PAF(3), VFR(11), o[2]), C1, 6);  VRD(15); SBAR(); \
        GAPB(o[3] = MFMA32(PAF(0), VFR(12), o[3]), C1, 8);  if (gl_) { KLD2(ksl_, 0); SBAR(); } \
        GAPB(o[3] = MFMA32(PAF(1), VFR(13), o[3]), C1, 10); if (gl_) { KLD2(ksl_, 1); SBAR(); } \
        GAPB(o[3] = MFMA32(PAF(2), VFR(14), o[3]), C1, 12); \
        GAPB(o[3] = MFMA32(PAF(3), VFR(15), o[3]), C1, 14); \
        if ((t) + 3 < NT) asm volatile("s_waitcnt vmcnt(5)" ::: "memory"); else asm volatile("s_waitcnt vmcnt(0)" ::: "memory"); \
        ABAR(); RESC(); } while (0)
        if (wid >= 4) __builtin_amdgcn_s_setprio(1);
        {
            int t = 1;
            for (; t + 1 < NT; t += 2) {
                STEP(pB0, pB1, pA0, pA1, t);
                STEP(pA0, pA1, pB0, pB1, t + 1);
            }
            STEP(pB0, pB1, pA0, pA1, NT - 1);
        }
        __builtin_amdgcn_s_setprio(0);
        { float sacc = 0.f;
#pragma unroll
          for (int r = 0; r < 16; ++r) sacc += pB0[r];
#pragma unroll
          for (int r = 0; r < 16; ++r) sacc += pB1[r];
          l += sacc;
          PKH0(pB0, 0, pw0); PKH1(pB0, 0, pw0); PKH0(pB0, 8, pw1); PKH1(pB0, 8, pw1); PKH0(pB1, 0, pw2); PKH1(pB1, 0, pw2); PKH0(pB1, 8, pw3); PKH1(pB1, 8, pw3);
          const LAS unsigned char* vp_ = (const LAS unsigned char*)(uintptr_t)(vbase + ((NT - 1) & (NS - 1)) * 16384);
#pragma unroll
          for (int db = 0; db < 4; ++db) { VRD(0); VRD(1); VRD(2); VRD(3);
              o[db] = MFMA32(PAF(0), VFR(0), o[db]); o[db] = MFMA32(PAF(1), VFR(1), o[db]); o[db] = MFMA32(PAF(2), VFR(2), o[db]); o[db] = MFMA32(PAF(3), VFR(3), o[db]); vp_ += 512; } }
        { auto rr_ = __builtin_amdgcn_permlane32_swap(__float_as_uint(l), __float_as_uint(l), false, false); l = __uint_as_float(rr_[0]) + __uint_as_float(rr_[1]); }
#undef SBAR
#undef PIN
#undef MFMA32
#undef KLD2
#undef VTR
#undef VRD
#undef VFR
#undef PAF
#undef MX3
#undef ROWMAX
#undef FIX_TILE
#undef EX
#undef RESC
#undef PKH0
#undef PKH1
#undef GAPA
#undef GAPB
#undef STEP
        int lane_e = lane_id(); asm volatile("" : "+v"(lane_e));
        const int r32e = lane_e & 31, hie = lane_e >> 5;
        const unsigned o0off = (unsigned)((blockIdx.x * NTHR + wid * 64 + lane_e) * 128);
        if (hie == 0) wsf[32 + r32e] = l;
        float rl[16];
#pragma unroll
        for (int r = 0; r < 16; ++r) rl[r] = __builtin_amdgcn_rcpf(wsf[32 + crow(r, hie)]);
        if (c == 0) {
#pragma unroll
            for (int d0 = 0; d0 < 4; ++d0)
#pragma unroll
                for (int j = 0; j < 2; ++j) { v4u w;
                    w.x = cvtpk(o[d0][8 * j + 0] * rl[8 * j + 0], o[d0][8 * j + 1] * rl[8 * j + 1]); w.y = cvtpk(o[d0][8 * j + 2] * rl[8 * j + 2], o[d0][8 * j + 3] * rl[8 * j + 3]);
                    w.z = cvtpk(o[d0][8 * j + 4] * rl[8 * j + 4], o[d0][8 * j + 5] * rl[8 * j + 5]); w.w = cvtpk(o[d0][8 * j + 6] * rl[8 * j + 6], o[d0][8 * j + 7] * rl[8 * j + 7]);
                    *(v4u*)((char*)F.STASH + o0off + (d0 * 2 + j) * 16) = w; }
        } else {
            float ss[16];
#pragma unroll
            for (int r = 0; r < 16; ++r) ss[r] = 0.f;
#pragma unroll
            for (int d0 = 0; d0 < 4; ++d0)
#pragma unroll
                for (int j = 0; j < 2; ++j) { const v4u w = *(const v4u*)((const char*)F.STASH + o0off + (d0 * 2 + j) * 16); const unsigned ww[4] = {w.x, w.y, w.z, w.w};
#pragma unroll
                    for (int k = 0; k < 4; ++k) { const int i = 4 * j + k;
                        const float a0 = bflo(ww[k]) - lam * (o[d0][2 * i] * rl[2 * i]), a1 = bfhi(ww[k]) - lam * (o[d0][2 * i + 1] * rl[2 * i + 1]);
                        o[d0][2 * i] = a0; o[d0][2 * i + 1] = a1; ss[2 * i] += a0 * a0; ss[2 * i + 1] += a1 * a1; } }
#pragma unroll
            for (int r = 0; r < 16; ++r) {
                { DPP_SUM_ROW(ss[r]); ss[r] += __shfl_xor(ss[r], 16); }
                ss[r] = rsqrtf(ss[r] * (1.f / 128.f) + EPS) * 0.8f;
            }
            bf16* Cw = F.CAT + (rowb + qlo) * 1024 + 512 + h * 128;
#pragma unroll
            for (int d0 = 0; d0 < 4; ++d0) { const float g = F.subln_g[d0 * 32 + r32e];
                unsigned off = (unsigned)((4 * hie * 1024 + d0 * 32 + r32e) * 2);
#pragma unroll
                for (int r = 0; r < 16; ++r) { const float v = o[d0][r] * ss[r] * g; const float vn = dpp_xor1(v);
                    if ((r32e & 1) == 0) *(unsigned*)((char*)Cw + off) = cvtpk(v, vn);
                    off += ((r & 3) == 3) ? 5u * 2048u : 2048u; asm volatile("" : "+v"(off)); } }
        }
        __syncthreads();
    }
#undef DMA_K
#undef DMA_V
#undef DMA_TILE
#undef ABAR
}

__device__ __forceinline__ void attn_phase(Frame& F) {
    const int lane = lane_id(), tid = F.wave * 64 + lane;
    const float s01 = wave_sum(F.diff_lambda[lane] * F.diff_lambda[64 + lane]), s23 = wave_sum(F.diff_lambda[128 + lane] * F.diff_lambda[192 + lane]);
    const float lam = __expf(s01) - __expf(s23) + 0.2f;
    const int G = F.G;
    for (int it = ((G % 8 == 0) ? ((int)(blockIdx.x % 8) * (G / 8) + (int)blockIdx.x / 8) : (int)blockIdx.x); it < 256; it += G) {
        const int bh = it >> 3, x = it & 7, b = bh >> 2, h = bh & 3;
        LAS float* bt = (LAS float*)(F.lds + L_BT);
        __syncthreads();
        if (tid < BTN) { const int d = tid - BTO; int bk = d; if (d >= 16) { bk = 16 + (int)(__log2f((float)d * (1.f / 16.f)) * (16.f / 3.f)); bk = bk > 31 ? 31 : bk; }
            bt[tid] = d < 0 ? -__builtin_inff() : (F.rel_bias[bk * 4 + h] - F.rel_bias[31 * 4 + h]) * 1.4426950408889634f; }
        __syncthreads();
        attn_unit(F, b, h, x, lam);
        attn_unit(F, b, h, 15 - x, lam);
    }
}
}

namespace sgu {
typedef float f32x16 __attribute__((ext_vector_type(16)));
typedef short s16x4 __attribute__((ext_vector_type(4)));
constexpr int L_T = 0, L_ST = 65536;
__device__ __forceinline__ void sgu_chunk(Frame& F, int chunk) {
    int tid = F.wave * 64 + lane_id(); asm volatile("" : "+v"(tid));
    const int lane = tid & 63, g = F.wave, r32 = lane & 31, hi = lane >> 5;
    LAS unsigned char* lds = F.lds;
    LAS float* st = (LAS float*)(lds + L_ST);
    const size_t t0 = (size_t)chunk * 128;
    for (int i = 0; i < 16; i += 2) {
        v4u raw[2];
#pragma unroll
        for (int u = 0; u < 2; ++u) raw[u] = *(const v4u*)(F.Z + (t0 + g * 16 + i + u) * INC + 512 + lane * 8);
#pragma unroll
        for (int u = 0; u < 2; ++u) { const int tl = g * 16 + i + u;
            float f[8] = {bflo(raw[u].x), bfhi(raw[u].x), bflo(raw[u].y), bfhi(raw[u].y), bflo(raw[u].z), bfhi(raw[u].z), bflo(raw[u].w), bfhi(raw[u].w)};
            float s = 0.f;
#pragma unroll
            for (int e = 0; e < 8; ++e) s += f[e];
            const float mean = wave_sum_dpp(s) * (1.f / 512.f); float q = 0.f;
#pragma unroll
            for (int e = 0; e < 8; ++e) { f[e] -= mean; q += f[e] * f[e]; }
            const float rstd = rsqrtf(wave_sum_dpp(q) * (1.f / 512.f) + EPS);
            if (lane == 0) { st[2 * tl] = mean; st[2 * tl + 1] = rstd; } }
    }
    __syncthreads();
    f32x16 acc[2][2];
    LAS unsigned char* stg = lds + 69632 + g * 4096;
    const float bsv0 = F.sgu_b[g * 128 + lane], bsv1 = F.sgu_b[g * 128 + 64 + lane];
    const int sr = tid >> 4, sc = (tid & 15) * 8;
    const int vb0 = (int)(uintptr_t)(lds + L_T) + (g >> 1) * 16384 + att::v_rd_base(lane);
#define SGU_STAGE(sh) do { _Pragma("unroll") for (int tile = 0; tile < 4; ++tile) { const int ch = tile * 128 + sc; \
            const f32x4 g0 = *(const f32x4*)(F.sgu_ln_g + ch), g1 = *(const f32x4*)(F.sgu_ln_g + ch + 4), b0 = *(const f32x4*)(F.sgu_ln_b + ch), b1 = *(const f32x4*)(F.sgu_ln_b + ch + 4); \
            _Pragma("unroll") for (int rr = 0; rr < 2; ++rr) { const int s = (sh) * 64 + sr + 32 * rr; \
                const v4u raw = *(const v4u*)(F.Z + (t0 + s) * INC + 512 + ch); const float mean = st[2 * s], rstd = st[2 * s + 1]; v4u o; \
                o.x = pk2((bflo(raw.x) - mean) * rstd * g0.x + b0.x, (bfhi(raw.x) - mean) * rstd * g0.y + b0.y); \
                o.y = pk2((bflo(raw.y) - mean) * rstd * g0.z + b0.z, (bfhi(raw.y) - mean) * rstd * g0.w + b0.w); \
                o.z = pk2((bflo(raw.z) - mean) * rstd * g1.x + b1.x, (bfhi(raw.z) - mean) * rstd * g1.y + b1.y); \
                o.w = pk2((bflo(raw.w) - mean) * rstd * g1.z + b1.z, (bfhi(raw.w) - mean) * rstd * g1.w + b1.w); \
                *(LAS v4u*)(lds + L_T + tile * 16384 + att::v_st(sr + 32 * rr, sc)) = o; } } } while (0)
#define TRRD(dst, off) asm volatile("ds_read_b64_tr_b16 %0, %1 offset:%2" : "=&v"(dst) : "v"(vb0), "i"(off) : "memory")
#define SGU_MMA(sh, tb0) do { _Pragma("unroll") for (int ks = 0; ks < 4; ++ks) { s16x4 l0, h0, l1, h1; \
            if ((g & 1) == 0) { TRRD(l0, 0 * 512 + ks * 4096); TRRD(h0, 0 * 512 + ks * 4096 + 2048); TRRD(l1, 1 * 512 + ks * 4096); TRRD(h1, 1 * 512 + ks * 4096 + 2048); } \
            else              { TRRD(l0, 2 * 512 + ks * 4096); TRRD(h0, 2 * 512 + ks * 4096 + 2048); TRRD(l1, 3 * 512 + ks * 4096); TRRD(h1, 3 * 512 + ks * 4096 + 2048); } \
            asm volatile("s_waitcnt lgkmcnt(0)" ::: "memory"); __builtin_amdgcn_sched_barrier(0); \
            const bf16x8 B0 = (bf16x8){l0[0], l0[1], l0[2], l0[3], h0[0], h0[1], h0[2], h0[3]}, B1 = (bf16x8){l1[0], l1[1], l1[2], l1[3], h1[0], h1[1], h1[2], h1[3]}; \
            _Pragma("unroll") for (int tl = 0; tl < 2; ++tl) { const int tb = (tb0) + tl; if ((sh) * 64 + 16 * ks > tb * 32 + 31) continue; \
                const bf16x8 A = *(const bf16x8*)(F.SGW + ((size_t)(g * 128 + tb * 32 + r32)) * 128 + (sh) * 64 + 16 * ks + 8 * hi); \
                acc[tl][0] = __builtin_amdgcn_mfma_f32_32x32x16_bf16(A, B0, acc[tl][0], 0, 0, 0); \
                acc[tl][1] = __builtin_amdgcn_mfma_f32_32x32x16_bf16(A, B1, acc[tl][1], 0, 0, 0); } } } while (0)
#define SGU_EPI(tb0) do { _Pragma("unroll") for (int tl = 0; tl < 2; ++tl) { const int tb = (tb0) + tl; \
            { v4u ur_[4]; \
              _Pragma("unroll") for (int i = 0; i < 4; ++i) ur_[i] = *(const v4u*)(F.Z + (t0 + tb * 32 + 8 * i + (lane >> 3)) * INC + g * 64 + (lane & 7) * 8); \
              _Pragma("unroll") for (int i = 0; i < 4; ++i) *(LAS v4u*)(stg + (8 * i + (lane >> 3)) * 128 + (lane & 7) * 16) = ur_[i]; } \
            asm volatile("" ::: "memory");                                        \
            float vv_[2][16]; \
            _Pragma("unroll") for (int r = 0; r < 16; ++r) { const int row = att::crow(r, hi); \
                const float bs = __uint_as_float((unsigned)__builtin_amdgcn_ds_bpermute(4 * ((tb & 1) * 32 + (r & 3) + 8 * (r >> 2)) + 16 * hi, (int)__float_as_uint((tb < 2) ? bsv0 : bsv1))); \
                _Pragma("unroll") for (int db = 0; db < 2; ++db) { const float u = bf2f(*(const LAS bf16*)(stg + row * 128 + (db * 32 + r32) * 2)); vv_[db][r] = u * (acc[tl][db][r] + bs); } } \
            asm volatile("" ::: "memory"); \
            _Pragma("unroll") for (int r = 0; r < 16; ++r) { const int row = att::crow(r, hi); \
                _Pragma("unroll") for (int db = 0; db < 2; ++db) { const float v = vv_[db][r], vn = dpp_xor1(v); \
                    if ((r32 & 1) == 0) *(LAS unsigned*)(stg + row * 128 + (db * 32 + r32) * 2) = att::cvtpk(v, vn); } } \
            asm volatile("" ::: "memory"); \
            _Pragma("unroll") for (int i = 0; i < 4; ++i) { const v4u o_ = *(const LAS v4u*)(stg + (8 * i + (lane >> 3)) * 128 + (lane & 7) * 16); \
                *(v4u*)(F.CAT + (t0 + tb * 32 + 8 * i + (lane >> 3)) * 1024 + g * 64 + (lane & 7) * 8) = o_; } \
            asm volatile("" ::: "memory"); } } while (0)
#define SGU_ZERO() do { acc[0][0] = f32x16{}; acc[0][1] = f32x16{}; acc[1][0] = f32x16{}; acc[1][1] = f32x16{}; } while (0)
    SGU_STAGE(0);
    __syncthreads();
    SGU_ZERO(); SGU_MMA(0, 0); SGU_EPI(0);
    SGU_ZERO(); SGU_MMA(0, 2);
    __syncthreads();
    SGU_STAGE(1);
    __syncthreads();
    SGU_MMA(1, 2); SGU_EPI(2);
#undef SGU_STAGE
#undef TRRD
#undef SGU_MMA
#undef SGU_EPI
#undef SGU_ZERO
}
__device__ __forceinline__ void sgu_phase(Frame& F) { for (int ck = blockIdx.x; ck < M / 128; ck += F.G) { sgu_chunk(F, ck); __syncthreads(); } }
}

namespace tk {
typedef float f32x16 __attribute__((ext_vector_type(16)));
__device__ __forceinline__ float vmax(float a, float b) { float r; asm("v_max_f32 %0, %1, %2" : "=v"(r) : "v"(a), "v"(b)); return r; }
__device__ __forceinline__ float vmin(float a, float b) { float r; asm("v_min_f32 %0, %1, %2" : "=v"(r) : "v"(a), "v"(b)); return r; }
#define TK_CE(a, b) do { const float _mx = vmax(a, b), _mn = vmin(a, b); a = _mx; b = _mn; } while (0)
template <int N> __device__ __forceinline__ void sort_desc(float (&a)[N]) {
#pragma unroll
    for (int k = 2; k <= N; k <<= 1)
#pragma unroll
        for (int j = k >> 1; j > 0; j >>= 1)
#pragma unroll
            for (int i = 0; i < N; ++i) { const int l = i ^ j; if (l > i) { if ((i & k) == 0) TK_CE(a[i], a[l]); else TK_CE(a[l], a[i]); } }
}
__device__ __forceinline__ void sort16_desc(float (&a)[16]) {
    TK_CE(a[0], a[13]); TK_CE(a[1], a[12]); TK_CE(a[2], a[15]); TK_CE(a[3], a[14]); TK_CE(a[4], a[8]); TK_CE(a[5], a[6]); TK_CE(a[7], a[11]); TK_CE(a[9], a[10]);
    TK_CE(a[0], a[5]); TK_CE(a[1], a[7]); TK_CE(a[2], a[9]); TK_CE(a[3], a[4]); TK_CE(a[6], a[13]); TK_CE(a[8], a[14]); TK_CE(a[10], a[15]); TK_CE(a[11], a[12]);
    TK_CE(a[0], a[1]); TK_CE(a[2], a[3]); TK_CE(a[4], a[5]); TK_CE(a[6], a[8]); TK_CE(a[7], a[9]); TK_CE(a[10], a[11]); TK_CE(a[12], a[13]); TK_CE(a[14], a[15]);
    TK_CE(a[0], a[2]); TK_CE(a[1], a[3]); TK_CE(a[4], a[10]); TK_CE(a[5], a[11]); TK_CE(a[6], a[7]); TK_CE(a[8], a[9]); TK_CE(a[12], a[14]); TK_CE(a[13], a[15]);
    TK_CE(a[1], a[2]); TK_CE(a[3], a[12]); TK_CE(a[4], a[6]); TK_CE(a[5], a[7]); TK_CE(a[8], a[10]); TK_CE(a[9], a[11]); TK_CE(a[13], a[14]);
    TK_CE(a[1], a[4]); TK_CE(a[2], a[6]); TK_CE(a[5], a[8]); TK_CE(a[7], a[10]); TK_CE(a[9], a[13]); TK_CE(a[11], a[14]);
    TK_CE(a[2], a[4]); TK_CE(a[3], a[6]); TK_CE(a[9], a[12]); TK_CE(a[11], a[13]);
    TK_CE(a[3], a[5]); TK_CE(a[6], a[8]); TK_CE(a[7], a[9]); TK_CE(a[10], a[12]);
    TK_CE(a[3], a[4]); TK_CE(a[5], a[6]); TK_CE(a[7], a[8]); TK_CE(a[9], a[10]); TK_CE(a[11], a[12]);
    TK_CE(a[6], a[7]); TK_CE(a[8], a[9]);
}
template <int N> __device__ __forceinline__ void merge_desc(float (&a)[N]) {
#pragma unroll
    for (int j = N >> 1; j > 0; j >>= 1)
#pragma unroll
        for (int i = 0; i < N; ++i) { const int l = i ^ j; if (l > i) TK_CE(a[i], a[l]); }
}
__device__ __forceinline__ void top16_merge(float (&a)[16], const float (&b)[16]) {
#pragma unroll
    for (int i = 0; i < 16; ++i) a[i] = vmax(a[i], b[15 - i]);
    merge_desc<16>(a);
}
__device__ __forceinline__ float embed(float v, unsigned mask, unsigned code) { return __uint_as_float((__float_as_uint(v) & mask) | code); }

__device__ __forceinline__ void topk_phase(Frame& F) {
    int lane = lane_id(); asm volatile("" : "+v"(lane));
    const int r32 = lane & 31, hi = lane >> 5;
    const int gw = blockIdx.x * NWAVES + F.wave, NGW = F.G * NWAVES;
    LAS unsigned* tab = (LAS unsigned*)(F.lds + F.wave * 8192) + lane;
    const float NEG = -__builtin_inff();
    constexpr int NTB = M / 32;
    const bool hsplit = (F.G & 7) == 0;
    const int nbh = hsplit ? (F.G >> 3) : F.G, bih = hsplit ? (int)(blockIdx.x >> 3) : (int)blockIdx.x;
    const int gwh = bih * NWAVES + F.wave, NGWH = nbh * NWAVES, per = (NTB + NGWH - 1) / NGWH;
    LAS bf16* klds = (LAS bf16*)(F.lds + 65536);
    unsigned code16[16];
#pragma unroll
    for (int r = 0; r < 16; ++r) code16[r] = (unsigned)((r & 3) + 8 * (r >> 2) + 4 * hi);
    const unsigned qoff = (unsigned)(r32 * NQ + hi * 8), koff = (unsigned)((hi * 128 + r32) * 8);
#define TK_QP(task_, c_) (F.QP + (size_t)(task_) * 32 * NQ + h * 256 + (c_) * 128)
#define TK_LDQ(dst, task_, c_) do { const bf16* qp_ = TK_QP(task_, c_); _Pragma("unroll") for (int ks = 0; ks < 8; ++ks) dst[ks] = *(const bf16x8*)(qp_ + ks * 16 + qoff); } while (0)
#define TK_LDK(dst, task_, c_, nb_) do { const LAS bf16* kp_ = klds + (c_) * 16 * 128 * 8; _Pragma("unroll") for (int ks = 0; ks < 8; ++ks) dst[ks] = *(const LAS bf16x8*)(kp_ + ((2 * ks) * 128 + (nb_) * 32) * 8 + koff); } while (0)
    const int task_beg = gwh * per, task_end = (gwh * per + per < NTB) ? gwh * per + per : NTB;
    for (int h = hsplit ? (int)(blockIdx.x & 7) : 0; h < 8; h += hsplit ? 8 : 1) {
    __syncthreads();
    { const v4u* ksrc = (const v4u*)(F.KEYS + (size_t)(h * 2) * 16 * 128 * 8); const int tid_ = F.wave * 64 + lane;
#pragma unroll
      for (int i = 0; i < 8; ++i) ((LAS v4u*)klds)[tid_ + 512 * i] = ksrc[tid_ + 512 * i]; }
    __syncthreads();
    bf16x8 qcur[8], kcur[8];
    if (task_beg < task_end) { TK_LDQ(qcur, task_beg, 0); TK_LDK(kcur, task_beg, 0, 0); }
    for (int task = task_beg; task < task_end; ++task) {
        const int tb = task;
        const size_t trow = (size_t)tb * 32 + r32;
        float sk[2][16];
        float best[16];
#pragma unroll
        for (int st = 0; st < 8; ++st) {
            const int c = st >> 2, nb = st & 3;
            bf16x8 knxt[8], qnxt[8];
            if (st < 7) TK_LDK(knxt, task, (st + 1) >> 2, (st + 1) & 3);
            if (st == 3) TK_LDQ(qnxt, task, 1);
            f32x16 acc = f32x16{};
#pragma unroll
            for (int ks = 0; ks < 8; ++ks) acc = __builtin_amdgcn_mfma_f32_32x32x16_bf16(kcur[ks], qcur[ks], acc, 0, 0, 0);
            float cur[16];
#pragma unroll
            for (int r = 0; r < 16; ++r) { cur[r] = embed(acc[r], 0xFFFFFF80u, code16[r]); if (nb) cur[r] = __uint_as_float(__float_as_uint(cur[r]) | (unsigned)(nb * 32)); }
            sort16_desc(cur);
            if (nb == 0) {
#pragma unroll
                for (int i = 0; i < 16; ++i) best[i] = cur[i];
            } else top16_merge(best, cur);
            if (st < 7) {
#pragma unroll
                for (int ks = 0; ks < 8; ++ks) kcur[ks] = knxt[ks];
            }
            if (st == 3) {
#pragma unroll
                for (int ks = 0; ks < 8; ++ks) qcur[ks] = qnxt[ks];
            }
            if (nb == 3) {
                float pr[16];
#pragma unroll
                for (int i = 0; i < 16; ++i) { auto rr = __builtin_amdgcn_permlane32_swap(__float_as_uint(best[i]), __float_as_uint(best[i]), false, false);
                    pr[i] = __uint_as_float(hi ? rr[0] : rr[1]); }
                top16_merge(best, pr);
#pragma unroll
                for (int i = 0; i < 16; ++i) sk[c][i] = best[i];
            }
            __builtin_amdgcn_sched_barrier(0);
        }
        { const int tn = (task + 1 < task_end) ? task + 1 : task; TK_LDQ(qcur, tn, 0); TK_LDK(kcur, tn, 0, 0); }
#pragma unroll
        for (int i = 0; i < 16; ++i) { tab[i * 64] = __float_as_uint(sk[0][i]); tab[(16 + i) * 64] = __float_as_uint(sk[1][i]); }
        float T[16], G1[16], G2[16];
#pragma unroll
        for (int j = 0; j < 16; ++j) T[j] = embed(sk[0][0] + sk[1][j], 0xFFFFFF00u, (unsigned)j);
#pragma unroll
        for (int j = 0; j < 8; ++j) { G1[j] = embed(sk[0][1] + sk[1][j], 0xFFFFFF00u, (unsigned)(16 + j)); G1[8 + j] = embed(sk[0][15 - j] + sk[1][0], 0xFFFFFF00u, (unsigned)((15 - j) << 4)); }
        merge_desc<16>(G1);
        top16_merge(T, G1);
#pragma unroll
        for (int j = 0; j < 5; ++j) G2[j] = embed(sk[0][2] + sk[1][j], 0xFFFFFF00u, (unsigned)(32 + j));
#pragma unroll
        for (int j = 0; j < 4; ++j) G2[5 + j] = embed(sk[0][3] + sk[1][j], 0xFFFFFF00u, (unsigned)(48 + j));
#pragma unroll
        for (int j = 0; j < 3; ++j) G2[9 + j] = embed(sk[0][4] + sk[1][j], 0xFFFFFF00u, (unsigned)(64 + j));
#pragma unroll
        for (int j = 0; j < 2; ++j) { G2[12 + j] = embed(sk[0][5] + sk[1][j], 0xFFFFFF00u, (unsigned)(80 + j)); G2[14 + j] = embed(sk[0][6] + sk[1][j], 0xFFFFFF00u, (unsigned)(96 + j)); }
        sort16_desc(G2);
        top16_merge(T, G2);
        T[15] = vmax(T[15], embed(sk[0][7] + sk[1][0], 0xFFFFFF00u, 112u)); T[14] = vmax(T[14], embed(sk[0][7] + sk[1][1], 0xFFFFFF00u, 113u));
        merge_desc<16>(T);
        const float mx = __uint_as_float(__float_as_uint(T[0]) & 0xFFFFFF00u);
        float e[16]; float den = 0.f;
#pragma unroll
        for (int k = 0; k < 16; ++k) { e[k] = __builtin_amdgcn_exp2f((__uint_as_float(__float_as_uint(T[k]) & 0xFFFFFF00u) - mx) * 1.4426950408889634f); den += e[k]; }
        const float rden = 1.f / den;
        int eo[8]; float go[8];
#pragma unroll
        for (int k = 0; k < 8; ++k) {
            const unsigned code = __float_as_uint(hi ? T[k + 8] : T[k]) & 255u;
            const unsigned a1 = tab[(code >> 4) * 64] & 127u, a2 = tab[(16 + (code & 15u)) * 64] & 127u;
            eo[k] = (int)(a1 * 128u + a2); go[k] = (hi ? e[k + 8] : e[k]) * rden;
        }
        int* ip = F.IDX + trow * PKN + h * 16 + hi * 8; float* gp = F.GATE + trow * PKN + h * 16 + hi * 8;
        *(v4u*)ip = (v4u){(unsigned)eo[0], (unsigned)eo[1], (unsigned)eo[2], (unsigned)eo[3]}; *(v4u*)(ip + 4) = (v4u){(unsigned)eo[4], (unsigned)eo[5], (unsigned)eo[6], (unsigned)eo[7]};
        *(f32x4*)gp = (f32x4){go[0], go[1], go[2], go[3]}; *(f32x4*)(gp + 4) = (f32x4){go[4], go[5], go[6], go[7]};
    }
    }
    (void)NEG;
}
#undef TK_CE
#undef TK_QP
#undef TK_LDQ
#undef TK_LDK
}

namespace pe {
typedef float f32x2 __attribute__((ext_vector_type(2)));
typedef _Float16 h16x2 __attribute__((ext_vector_type(2)));
typedef _Float16 h16x4 __attribute__((ext_vector_type(4)));
typedef int v8i __attribute__((ext_vector_type(8)));
__device__ __forceinline__ f32x2 cvlo(unsigned w) { return __builtin_amdgcn_cvt_pk_f32_fp8((int)w, false); }
__device__ __forceinline__ f32x2 cvhi(unsigned w) { return __builtin_amdgcn_cvt_pk_f32_fp8((int)w, true); }
__device__ __forceinline__ float dot16(const v4u r, const f32x2 (&hf)[8]) {
    f32x2 a = cvlo(r.x) * hf[0]; f32x2 b = cvhi(r.x) * hf[1];
    a = cvlo(r.y) * hf[2] + a; b = cvhi(r.y) * hf[3] + b; a = cvlo(r.z) * hf[4] + a; b = cvhi(r.z) * hf[5] + b; a = cvlo(r.w) * hf[6] + a; b = cvhi(r.w) * hf[7] + b;
    a = a + b; return a.x + a.y;
}
#define PE_W(WREG, i) __uint_as_float(__builtin_amdgcn_readlane(__float_as_uint(WREG), (i)))
#ifndef FP6_INTERLEAVED
#define FP6_INTERLEAVED 1
#endif
typedef unsigned v6u __attribute__((ext_vector_type(6)));
typedef float v32f __attribute__((ext_vector_type(32)));
typedef float v16f __attribute__((ext_vector_type(16)));
struct Row6 { v4u q4; v2u q2; };
struct Row12 { v4u p0, p1; };
#ifndef PV4_R
#define PV4_R 4
#endif
#define PV4_BP(dst, data, i) asm volatile("ds_bpermute_b32 %0, %1, %2 offset:%3" : "=v"(dst) : "v"(g4), "v"(data), "n"((((i) & 15) * 16)))
#define PV4_WAIT2(a, b) asm volatile("s_waitcnt lgkmcnt(0)" : "+v"(a), "+v"(b))
#define PV4_WAIT1(a) asm volatile("s_waitcnt lgkmcnt(0)" : "+v"(a))
#define PV4_LOADE(dst, er_) do { const unsigned char* rp_ = F.VT6 + (size_t)(er_) * 512 + c16; dst.p0 = *(const v4u*)rp_; dst.p1 = *(const v4u*)(rp_ + 256); } while (0)
#define PV4_ACCW(src, wa_, wb_) do { const unsigned Wa_ = (unsigned)(wa_), Wb_ = (unsigned)(wb_); \
        const v8i A_ = {(int)(Wa_ & de0), (int)(Wa_ & de1), (int)(Wa_ & de2), (int)(Wa_ & de3), (int)(Wb_ & de0), (int)(Wb_ & de1), (int)(Wb_ & de2), (int)(Wb_ & de3)}; \
        const v8i A2_ = {(int)(Wa_ & do0), (int)(Wa_ & do1), (int)(Wa_ & do2), (int)(Wa_ & do3), (int)(Wb_ & do0), (int)(Wb_ & do1), (int)(Wb_ & do2), (int)(Wb_ & do3)}; \
        const v8i B0_ = {(int)src.p0.x, (int)src.p0.y, (int)src.p0.z, (int)src.p0.w, 0, 0, 0, 0}, B1_ = {(int)src.p1.x, (int)src.p1.y, (int)src.p1.z, (int)src.p1.w, 0, 0, 0, 0}; \
        acc[0] = __builtin_amdgcn_mfma_scale_f32_16x16x128_f8f6f4(A_, B0_, acc[0], 0, 4, 0, 0x7F7F7F7F, 0, 0x7F7F7F7F); acc[1] = __builtin_amdgcn_mfma_scale_f32_16x16x128_f8f6f4(A2_, B0_, acc[1], 0, 4, 0, 0x7F7F7F7F, 0, 0x7F7F7F7F); \
        acc[2] = __builtin_amdgcn_mfma_scale_f32_16x16x128_f8f6f4(A_, B1_, acc[2], 0, 4, 0, 0x7F7F7F7F, 0, 0x7F7F7F7F); acc[3] = __builtin_amdgcn_mfma_scale_f32_16x16x128_f8f6f4(A2_, B1_, acc[3], 0, 4, 0, 0x7F7F7F7F, 0, 0x7F7F7F7F); \
        __builtin_amdgcn_sched_barrier(0); } while (0)
#define PV4_BPW(dst, data, i, x) asm volatile("ds_bpermute_b32 %0, %1, %2 offset:%3" : "=v"(dst) : "v"(gw4), "v"(data), "n"((((i) & 15) * 16) + (x)))
#define PV4_WAIT3(a, b, c) asm volatile("s_waitcnt lgkmcnt(0)" : "+v"(a), "+v"(b), "+v"(c))
#define PV4_E(i) (((i) < 16) ? e0 : e1)
#define PV4_W(i) (((i) < 16) ? W0r : W1r)
#define PV4_FILL() do { \
        _Pragma("unroll") for (int i = 0; i < PV4_R; ++i) { int er_; PV4_BP(er_, PV4_E(i), i); PV4_WAIT1(er_); PV4_LOADE(ring[i], er_); } } while (0)
#define PV4_LOOP() do { \
        PV4_BPW(wNa_, PV4_W(0), 0, 0); PV4_BPW(wNb_, PV4_W(0), 0, 8); PV4_BP(eN_, PV4_E(PV4_R), PV4_R); \
        _Pragma("unroll") for (int i = 0; i < 32; ++i) { PV4_WAIT3(eN_, wNa_, wNb_); const int eC_ = eN_, wCa_ = wNa_, wCb_ = wNb_; \
            if (i + 1 < 32) { PV4_BPW(wNa_, PV4_W(i + 1), i + 1, 0); PV4_BPW(wNb_, PV4_W(i + 1), i + 1, 8); } \
            if (i + 1 + PV4_R < 32) PV4_BP(eN_, PV4_E(i + 1 + PV4_R), i + 1 + PV4_R); \
            PV4_ACCW(ring[i % PV4_R], wCa_, wCb_); \
            if (i + PV4_R < 32) PV4_LOADE(ring[i % PV4_R], eC_); } } while (0)

#define PU_IDX(dst, tt) do { const v2u w_ = *(const v2u*)(F.IDX + (size_t)(tt) * PKN + 2 * lane); const int ba_ = (lane & ~7) * 4; \
        _Pragma("unroll") for (int k_ = 0; k_ < 8; ++k_) { dst[2 * k_] = __builtin_amdgcn_ds_bpermute(ba_ + 4 * k_, (int)w_.x); dst[2 * k_ + 1] = __builtin_amdgcn_ds_bpermute(ba_ + 4 * k_, (int)w_.y); } } while (0)
#define PU_GATHER(dst, idx) do { _Pragma("unroll") for (int i = 0; i < 16; ++i) dst[i] = *(const v4u*)(ub + (unsigned)idx[i] * 128u + coff); } while (0)
#define PU_HS(dst, tt) do { const unsigned hw_ = *(const unsigned*)(F.H8 + (size_t)(tt) * D + x * 256 + lane * 4); const int hb_ = (lane & 7) * 32;     \
        unsigned r_[8]; \
        _Pragma("unroll") for (int j_ = 0; j_ < 8; ++j_) { const unsigned v_ = (unsigned)__builtin_amdgcn_ds_bpermute(hb_ + 4 * j_, (int)hw_); r_[j_] = ((v_ & 0x7F7F7F7Fu) + 0x08080808u) ^ (v_ & 0x80808080u); }     \
        unsigned hh_[4], hl_[4]; \
        _Pragma("unroll") for (int m_ = 0; m_ < 4; ++m_) { const unsigned A_ = r_[2 * m_], B_ = r_[2 * m_ + 1];     \
            hh_[m_] = (B_ & 0xF0F0F0F0u) | ((A_ >> 4) & 0x0F0F0F0Fu); hl_[m_] = ((A_ & 0x0F0F0F0Fu) | ((B_ << 4) & 0xF0F0F0F0u)) ^ 0x88888888u; } \
        dst[0] = (v4u){hh_[0], hh_[1], hh_[2], hh_[3]}; dst[1] = (v4u){hl_[0], hl_[1], hl_[2], hl_[3]}; } while (0)
#define PU_COMPUTE(seg, hraw, tt) do { int p[16]; \
        _Pragma("unroll") for (int i = 0; i < 16; ++i) { int a_ = __builtin_amdgcn_sdot8((int)seg[i].x, (int)hraw[0].x, 0, false); a_ = __builtin_amdgcn_sdot8((int)seg[i].y, (int)hraw[0].y, a_, false); \
            a_ = __builtin_amdgcn_sdot8((int)seg[i].z, (int)hraw[0].z, a_, false); a_ = __builtin_amdgcn_sdot8((int)seg[i].w, (int)hraw[0].w, a_, false); \
            int b_ = __builtin_amdgcn_sdot8((int)seg[i].x, (int)hraw[1].x, 0, false); b_ = __builtin_amdgcn_sdot8((int)seg[i].y, (int)hraw[1].y, b_, false); \
            b_ = __builtin_amdgcn_sdot8((int)seg[i].z, (int)hraw[1].z, b_, false); b_ = __builtin_amdgcn_sdot8((int)seg[i].w, (int)hraw[1].w, b_, false); p[i] = (a_ << 4) + b_; }     \
          \
        _Pragma("unroll") for (int i = 0; i < 8; ++i) { const bool bt = (lane & 4) != 0; const int sd = bt ? p[i] : p[i + 8], kp = bt ? p[i + 8] : p[i]; p[i] = kp + __builtin_amdgcn_update_dpp(0, sd, 0x141, 0xF, 0xF, false); } \
        _Pragma("unroll") for (int i = 0; i < 4; ++i) { const bool bt = (lane & 2) != 0; const int sd = bt ? p[i] : p[i + 4], kp = bt ? p[i + 4] : p[i]; p[i] = kp + __builtin_amdgcn_update_dpp(0, sd, 0x4E, 0xF, 0xF, false); } \
        _Pragma("unroll") for (int i = 0; i < 2; ++i) { const bool bt = (lane & 1) != 0; const int sd = bt ? p[i] : p[i + 2], kp = bt ? p[i + 2] : p[i]; p[i] = kp + __builtin_amdgcn_update_dpp(0, sd, 0xB1, 0xF, 0xF, false); } \
        ((unsigned*)F.PART)[((size_t)x * M + (tt)) * 64 + lane] = att::cvtpk((float)p[0], (float)p[1]); } while (0)
__device__ __forceinline__ void peer_u_phase(Frame& F, const int c0, const int cn, const int w0, const int nw) {
    int lane = lane_id(); asm volatile("" : "+v"(lane));
    const int wave = F.wave;
    if (wave < w0 || wave >= w0 + nw) return;
    const unsigned coff = (unsigned)(lane & 7) * 16u;
    const int per_blk = cn / 64, per_wave = per_blk / nw;
    for (int unit = blockIdx.x; unit < 256; unit += F.G) {
        const int x = unit & 3, rk = unit >> 2;
        const unsigned char* ub = F.UT8 + (size_t)x * NEXP * 128;
        const int tbeg = c0 + rk * per_blk + (wave - w0) * per_wave, tend = tbeg + per_wave;
        int idxA[16], idxB[16]; v4u segA[16], segB[16]; v4u hA[2], hB[2];
        PU_IDX(idxA, tbeg); PU_GATHER(segA, idxA); PU_HS(hA, tbeg); PU_IDX(idxB, tbeg + 1);
        for (int t = tbeg; t < tend; t += 2) {
            PU_GATHER(segB, idxB); PU_HS(hB, t + 1);
            { const int tn = (t + 2 < tend) ? t + 2 : t; PU_IDX(idxA, tn); }
            PU_COMPUTE(segA, hA, t);
            { const int tn = (t + 2 < tend) ? t + 2 : t; PU_GATHER(segA, idxA); PU_HS(hA, tn); }
            { const int tn = (t + 3 < tend) ? t + 3 : t + 1; PU_IDX(idxB, tn); }
            PU_COMPUTE(segB, hB, t + 1);
        }
    }
}
#undef PU_IDX
#undef PU_GATHER
#undef PU_HS
#undef PU_COMPUTE

__device__ __forceinline__ void peer_fill(Frame& F) {
    int lane = lane_id(); asm volatile("" : "+v"(lane));
    LAS unsigned* suv = (LAS unsigned*)F.lds;
    LAS float* gql = (LAS float*)(F.lds + 65536);
    __syncthreads();
    for (int i = F.wave * 64 + lane; i < NEXP; i += NTHR) suv[i] = ((((__float_as_uint(F.SU[i]) + 0x4000u) >> 15) & 0xFFFFu) << 16) | (((__float_as_uint(F.SV[i]) + 0x4000u) >> 15) & 0xFFFFu);
    for (int i = F.wave * 64 + lane; i < 8 * D; i += NTHR) gql[i] = F.mod[(i >> 10) * 6144 + 5120 + (i & 1023)] * F.norm_g[3072 + (i & 1023)];
    __syncthreads();
}
template <bool DRY> __device__ __forceinline__ void peer_phase(Frame& F, const int c0, const int cn, const int w0, const int nw, const bool fill) {
    int lane = lane_id(); asm volatile("" : "+v"(lane));
    if (fill) peer_fill(F);
    LAS unsigned* suv = (LAS unsigned*)F.lds;
    LAS float* gql = (LAS float*)(F.lds + 65536);
    if (F.wave < w0 || F.wave >= w0 + nw) return;
    const int gw = blockIdx.x * nw + (F.wave - w0), NGW = F.G * nw;
    const int g4 = (lane >> 4) * 4; const unsigned c16 = (unsigned)(lane & 15) * 16u;
    const unsigned dmb = 0xFFu << (8 * (lane & 3)); const int dmi = (lane >> 2) & 3;
    const unsigned dm0 = dmi == 0 ? dmb : 0u, dm1 = dmi == 1 ? dmb : 0u, dm2 = dmi == 2 ? dmb : 0u, dm3 = dmi == 3 ? dmb : 0u;
    const bool qodd = ((lane >> 4) & 1) != 0; const int gw4 = (lane >> 5) * 4;
    const unsigned de0 = qodd ? 0u : dm0, de1 = qodd ? 0u : dm1, de2 = qodd ? 0u : dm2, de3 = qodd ? 0u : dm3, do0 = qodd ? dm0 : 0u, do1 = qodd ? dm1 : 0u, do2 = qodd ? dm2 : 0u, do3 = qodd ? dm3 : 0u;
    const int per = (cn + NGW - 1) / NGW, tbeg = c0 + gw * per, tend = (tbeg + per < c0 + cn) ? tbeg + per : c0 + cn;
    int e0n, e1n; float g0n, g1n, hsn; unsigned pn[8];
#define PV_HDR(tt) do { const size_t o_ = (size_t)(tt) * PKN + lane; e0n = F.IDX[o_]; e1n = F.IDX[o_ + 64]; g0n = F.GATE[o_]; g1n = F.GATE[o_ + 64]; hsn = F.HS[tt]; \
        _Pragma("unroll") for (int x = 0; x < 4; ++x) { const unsigned short* pp = (const unsigned short*)F.PART + ((size_t)x * M + (tt)) * PKN + lane; pn[2 * x] = pp[0]; pn[2 * x + 1] = pp[64]; } } while (0)
    if (tbeg < tend) PV_HDR(tbeg);
    for (int t = tbeg; t < tend; ++t) {
        const int b = t >> 12;
        const int e0 = e0n, e1 = e1n; const float g0 = g0n, g1 = g1n, hs = hsn;
        float tot0 = 0.f, tot1 = 0.f;
#pragma unroll
        for (int x = 0; x < 4; ++x) { tot0 += __uint_as_float(pn[2 * x] << 16); tot1 += __uint_as_float(pn[2 * x + 1] << 16); }
        Row12 ring[PV4_R]; int eN_, wNa_, wNb_;
        PV4_FILL();
        const int col0 = lane * 4;
        v2u xq[4];
#pragma unroll
        for (int m = 0; m < 4; ++m) xq[m] = __builtin_nontemporal_load((const v2u*)(F.X1B + (size_t)t * D + 256 * m + col0));
        { const int tn = (t + 1 < tend) ? t + 1 : t; PV_HDR(tn); }
        const unsigned s0 = suv[e0], s1 = suv[e1];
        const float su0 = __uint_as_float((s0 >> 16) << 15), sv0 = __uint_as_float((s0 & 0xFFFFu) << 15), su1 = __uint_as_float((s1 >> 16) << 15), sv1 = __uint_as_float((s1 & 0xFFFFu) << 15);
        const float w0 = gelu_t(tot0 * (su0 * hs)) * g0 * (sv0 * 1024.f), w1 = gelu_t(tot1 * (su1 * hs)) * g1 * (sv1 * 1024.f);
        const float w0c = fminf(fmaxf(w0, -440.f), 440.f), w1c = fminf(fmaxf(w1, -440.f), 440.f);
        int W0r = __builtin_amdgcn_cvt_pk_fp8_f32(w0c, w0c, 0, false); W0r = __builtin_amdgcn_cvt_pk_fp8_f32(w0c, w0c, W0r, true);
        int W1r = __builtin_amdgcn_cvt_pk_fp8_f32(w1c, w1c, 0, false); W1r = __builtin_amdgcn_cvt_pk_fp8_f32(w1c, w1c, W1r, true);
        f32x4 acc[4];
#pragma unroll
        for (int i = 0; i < 4; ++i) acc[i] = (f32x4){0.f, 0.f, 0.f, 0.f};
        PV4_LOOP();
        float y[16];
#pragma unroll
        for (int k = 0; k < 16; ++k) y[k] = acc[k >> 2][k & 3] * (1.f / 1024.f);
        float ss = 0.f;
#pragma unroll
        for (int j = 0; j < 16; ++j) ss += y[j] * y[j];
        const float rstd = rsqrtf(wave_sum_dpp(ss) * (1.f / D) + EPS);
        const LAS float* gqp = gql + b * D + col0;
        float* orow = F.out + (size_t)t * D + col0;
#pragma unroll
        for (int q4 = 0; q4 < 4; ++q4) {
            const f32x4 x1 = (f32x4){bflo(xq[q4].x), bfhi(xq[q4].x), bflo(xq[q4].y), bfhi(xq[q4].y)};
            const f32x4 yv = (f32x4){y[q4 * 4], y[q4 * 4 + 1], y[q4 * 4 + 2], y[q4 * 4 + 3]};
            const f32x4 gqv = *(const LAS f32x4*)(gqp + 256 * q4);
            if (!DRY) __builtin_nontemporal_store(x1 + gqv * (yv * rstd), (f32x4*)(orow + 256 * q4)); else if (rstd == 123.456f) *(f32x4*)(orow + 256 * q4) = yv; }
    }
}
#undef PE_W
#undef PV4_BP
#undef PV4_WAIT1
#undef PV4_WAIT2
#undef PV4_LOADE
#undef PV4_ACCW
#undef PV4_BPW
#undef PV4_WAIT3
#undef PV4_E
#undef PV4_W
#undef PV4_FILL
#undef PV4_LOOP
#undef PV_HDR

#define U_LOAD4(v, r0_, nvalid_) do { _Pragma("unroll") for (int q = 0; q < 4; ++q) { const int row = (r0_) + (q < (nvalid_) ? q : 0) * stride; const f32x4* s = (const f32x4*)(F.peer_u + (size_t)row * D) + lane * 4; \
        _Pragma("unroll") for (int i = 0; i < 4; ++i) v[q][i] = s[i]; } } while (0)
#define U_PROC4(v, r0_, nvalid_) do { _Pragma("unroll") for (int q = 0; q < 4; ++q) { if (q >= (nvalid_)) break; const int row = (r0_) + q * stride; \
        float ss = 0.f; \
        _Pragma("unroll") for (int i = 0; i < 4; ++i) ss += v[q][i].x * v[q][i].x + v[q][i].y * v[q][i].y + v[q][i].z * v[q][i].z + v[q][i].w * v[q][i].w; \
        ss = wave_sum_dpp(ss); \
        const float step = 0.35f * sqrtf(ss * (1.f / D));                \
        const float sc = step > 0.f ? 1.f / step : 1.f; \
        unsigned w[2]; \
        _Pragma("unroll") for (int d = 0; d < 2; ++d) { const f32x4 lo_ = v[q][2 * d], hi_ = v[q][2 * d + 1]; \
            const float lf[4] = {lo_.x, lo_.y, lo_.z, lo_.w}, hf_[4] = {hi_.x, hi_.y, hi_.z, hi_.w}; unsigned r_ = 0u; \
            _Pragma("unroll") for (int n = 0; n < 4; ++n) { int qa = (int)rintf(lf[n] * sc), qb = (int)rintf(hf_[n] * sc); qa = qa < -8 ? -8 : (qa > 7 ? 7 : qa); qb = qb < -8 ? -8 : (qb > 7 ? 7 : qb); \
                r_ |= ((unsigned)(qa & 15) << (8 * n)) | ((unsigned)(qb & 15) << (8 * n + 4)); }     \
            w[d] = r_; } \
        *(v2u*)(F.UT8 + (size_t)(lane >> 4) * NEXP * 128 + (size_t)row * 128 + (lane & 15) * 8) = (v2u){w[0], w[1]};     \
        if (lane == 0) F.SU[row] = step > 0.f ? step : 1.f; } } while (0)
#define V_LOAD2(f, p0_, nvalid_) do { _Pragma("unroll") for (int q = 0; q < 2; ++q) { const int row = 2 * ((p0_) + (q < (nvalid_) ? q : 0) * stride) + hf; const f32x4* sp = (const f32x4*)(F.peer_v + (size_t)row * D + L * 32); \
        _Pragma("unroll") for (int i = 0; i < 8; ++i) f[q][i] = sp[i]; } } while (0)
#define V_PROC2(f, p0_, nvalid_) do { _Pragma("unroll") for (int q = 0; q < 2; ++q) { if (q >= (nvalid_)) break; const int row = 2 * ((p0_) + q * stride) + hf; \
        float am = 0.f; \
        _Pragma("unroll") for (int i = 0; i < 8; ++i) am = fmaxf(am, fmaxf(fmaxf(fabsf(f[q][i].x), fabsf(f[q][i].y)), fmaxf(fabsf(f[q][i].z), fabsf(f[q][i].w)))); \
        am = half_max_dpp(am); \
        const float sc = am > 0.f ? 6.0f / am : 1.f;                    \
          \
        { unsigned char* rp_ = F.VT6 + (size_t)row * 512 + (L >> 4) * 256 + (L & 1) * 128 + ((L >> 3) & 1) * 8 + ((L >> 1) & 3) * 2; \
          _Pragma("unroll") for (int i = 0; i < 8; ++i) { unsigned r_ = __builtin_amdgcn_cvt_scalef32_pk_fp4_f32(0u, f[q][i].x * sc, f[q][i].y * sc, 1.0f, 0); \
              r_ = __builtin_amdgcn_cvt_scalef32_pk_fp4_f32(r_, f[q][i].z * sc, f[q][i].w * sc, 1.0f, 1); *(unsigned short*)(rp_ + i * 16) = (unsigned short)r_; } } \
        if (L == 0) F.SV[row] = 1.f / sc; } } while (0)
__device__ __forceinline__ void prologue_tables(Frame& F, int gw, int NGW, int lane) {
    const int stride = NGW; const int L = lane & 31, hf = lane >> 5;
    f32x4 va[4][4], vb[4][4];
    int r = gw;
    if (r < NEXP) { int left = (NEXP - r + NGW - 1) / NGW; int nva = left < 4 ? left : 4; U_LOAD4(va, r, nva);
        for (;;) {
            const int r2 = r + 4 * NGW; int nvb = 0;
            if (r2 < NEXP) { left = (NEXP - r2 + NGW - 1) / NGW; nvb = left < 4 ? left : 4; U_LOAD4(vb, r2, nvb); }
            U_PROC4(va, r, nva);
            if (r2 >= NEXP) break;
            const int r3 = r2 + 4 * NGW; nva = 0;
            if (r3 < NEXP) { left = (NEXP - r3 + NGW - 1) / NGW; nva = left < 4 ? left : 4; U_LOAD4(va, r3, nva); }
            U_PROC4(vb, r2, nvb);
            if (r3 >= NEXP) break;
            r = r3;
        } }
    f32x4 fa[2][8], fb[2][8];
    int p = gw;
    if (p < NEXP / 2) { int left = (NEXP / 2 - p + NGW - 1) / NGW; int nva = left < 2 ? left : 2; V_LOAD2(fa, p, nva);
        for (;;) {
            const int p2 = p + 2 * NGW; int nvb = 0;
            if (p2 < NEXP / 2) { left = (NEXP / 2 - p2 + NGW - 1) / NGW; nvb = left < 2 ? left : 2; V_LOAD2(fb, p2, nvb); }
            V_PROC2(fa, p, nva);
            if (p2 >= NEXP / 2) break;
            const int p3 = p2 + 2 * NGW; nva = 0;
            if (p3 < NEXP / 2) { left = (NEXP / 2 - p3 + NGW - 1) / NGW; nva = left < 2 ? left : 2; V_LOAD2(fa, p3, nva); }
            V_PROC2(fb, p2, nvb);
            if (p3 >= NEXP / 2) break;
            p = p3;
        } }
}
#undef U_LOAD4
#undef U_PROC4
#undef V_LOAD2
#undef V_PROC2
}

__device__ __forceinline__ void prologue_tables_fwd(Frame& F, int gw, int NGW, int lane) { pe::prologue_tables(F, gw, NGW, lane); }
struct Args { const float* in[18]; float* out; unsigned char* ws; int ph_lo, ph_hi, li, pad; };
__global__ void __launch_bounds__(NTHR, 2) fwd(Args args) {
    extern __shared__ __attribute__((aligned(16))) unsigned char lds[];
    Frame F;
    F.lds = (LAS unsigned char*)lds;
    F.MISC = (volatile LAS unsigned*)(F.lds + MISC_OFF);
    F.wave = __builtin_amdgcn_readfirstlane((int)threadIdx.x >> 6); F.G = gridDim.x;
    unsigned char* ws = args.ws;
    F.ctl = (gu32*)(ws + WS_CTL);
    F.x = args.in[0]; F.c = args.in[1]; F.w_ada = args.in[2]; F.b_ada = args.in[3]; F.norm_g = args.in[4]; F.w_in = args.in[5]; F.sgu_ln_g = args.in[6]; F.sgu_ln_b = args.in[7];
    F.sgu_w = args.in[8]; F.sgu_b = args.in[9]; F.diff_lambda = args.in[10]; F.subln_g = args.in[11]; F.rel_bias = args.in[12]; F.w_out = args.in[13]; F.w_query = args.in[14];
    F.sub_keys = args.in[15]; F.peer_u = args.in[16]; F.peer_v = args.in[17]; F.out = args.out;
    F.mod = (float*)(ws + WS_MOD); F.WIN = (bf16*)(ws + WS_WIN); F.WOUT = (bf16*)(ws + WS_WOUT); F.WQ = (bf16*)(ws + WS_WQ); F.KEYS = (bf16*)(ws + WS_KEYS); F.SGW = (bf16*)(ws + WS_SGW);
    F.UT8 = ws + WS_UT; F.H8 = ws + WS_H8; F.HS = (float*)(ws + WS_SU) + 2 * NEXP; F.HAS = (float*)(ws + WS_SU) + 2 * NEXP + M; F.WS8 = (float*)(ws + WS_SU) + 2 * NEXP + 2 * M; F.HA8 = ws + WS_H; F.W8 = ws + WS_WIN; F.WQ8 = ws + WS_WQ; F.WQS8 = (float*)(ws + WS_SU) + 2 * NEXP + 2 * M + INC; F.VT6 = ws + WS_VT; F.PART = (float*)(ws + WS_QP); F.STASH = (unsigned*)(ws + WS_H); F.SU = (float*)(ws + WS_SU); F.SV = (float*)(ws + WS_SU) + NEXP; F.H = (bf16*)(ws + WS_H); F.Y = (bf16*)(ws + WS_Y); F.Z = (bf16*)(ws + WS_Z); F.QP = (bf16*)(ws + WS_QP); F.CAT = (bf16*)(ws + WS_CAT); F.X1B = (bf16*)(ws + WS_CAT);
    F.IDX = (int*)(ws + WS_IDX); F.GATE = (float*)(ws + WS_GATE);
    for (int u = threadIdx.x; u < (LDS_BYTES - LDSCTL_OFF) / 4; u += NTHR) ((LAS unsigned*)(F.lds + LDSCTL_OFF))[u] = 0u;
    __syncthreads();
    XcdBarrier bar = xcd_barrier_post((unsigned*)(F.ctl + CW_BAR) + args.li * XCD_BAR_WORDS, F.MISC + 8);
    const int lo = args.ph_lo, hi = args.ph_hi;
#ifndef ONLY_PHASE
#define ONLY_PHASE -1
#endif
#define IN(k) (lo <= (k) && (k) < hi && (ONLY_PHASE < 0 || ONLY_PHASE == (k)))
#define SEAM(k) do { if ((k) + 1 < hi) xcd_barrier(bar); } while (0)
    if (IN(0)) { for (int rep = 0; rep < (PROBE_PHASE == 0 ? 2 : 1); ++rep) ph_prologue(F); SEAM(0); }
    if (IN(1)) { for (int rep = 0; rep < (PROBE_PHASE == 1 ? 2 : 1); ++rep) ph_hrows(F); SEAM(1); }
    if (IN(2)) {
        pg8::Gemm g{(const pg8::bf16_t*)F.HA8, (const pg8::bf16_t*)F.W8, M, INC, D / 2}; pg8::StaticOrder S; S.init(M, INC, F.G, (int)blockIdx.x);
        pg8::EpiI8<1> E{F.Z, INC, F.HAS, F.WS8, 1024};
        for (int rep = 0; rep < (PROBE_PHASE == 2 ? 2 : 1); ++rep) pg8::gemm_phase<pg8::EpiI8<1>, pg8::StaticOrder, true, true>(F.lds, g, S, E, F.wave);
        SEAM(2);
    }
    if (IN(3)) { for (int rep = 0; rep < (PROBE_PHASE == 30 ? 2 : 1); ++rep) sgu::sgu_phase(F); for (int rep = 0; rep < (PROBE_PHASE == 3 ? 2 : 1); ++rep) att::attn_phase(F); SEAM(3); }
    if (IN(4)) {
        pg8::Gemm g{F.CAT, F.WOUT, M, D, D}; pg8::StaticOrder S; S.init(M, D, F.G, (int)blockIdx.x);
        pg8::EpiBf16<0> E{F.Y, D, nullptr, 0, 0, 1.f, 0};
        for (int rep = 0; rep < (PROBE_PHASE == 4 ? 2 : 1); ++rep) pg8::gemm_phase<pg8::EpiBf16<0>, pg8::StaticOrder, true, true>(F.lds, g, S, E, F.wave);
        SEAM(4);
    }
    if (IN(5)) { for (int rep = 0; rep < (PROBE_PHASE == 5 ? 2 : 1); ++rep) ph_x1rows(F); SEAM(5); }
    if (IN(6)) {
        pg8::Gemm g{(const pg8::bf16_t*)F.H8, (const pg8::bf16_t*)F.WQ8, M, NQ, D / 2}; pg8::StaticOrder S; S.init(M, NQ, F.G, (int)blockIdx.x);
        pg8::EpiI8<0> E{F.QP, NQ, F.HS, F.WQS8, 0};
        for (int rep = 0; rep < (PROBE_PHASE == 6 ? 2 : 1); ++rep) pg8::gemm_phase<pg8::EpiI8<0>, pg8::StaticOrder, true, true>(F.lds, g, S, E, F.wave);
        SEAM(6);
    }
    if (IN(7)) { if (TABLES_IN_PHASE == 7) prologue_tables_fwd(F, blockIdx.x * NWAVES + F.wave, F.G * NWAVES, lane_id()); for (int rep = 0; rep < (PROBE_PHASE == 7 ? 2 : 1); ++rep) tk::topk_phase(F); SEAM(7); }
    const bool vfill_early = IN(8) && IN(9);
    if (IN(8)) { for (int rep = 0; rep < (PROBE_PHASE == 8 ? 2 : 1); ++rep) pe::peer_u_phase(F, 0, M, 0, 8); if (vfill_early) pe::peer_fill(F); SEAM(8); }
    if (IN(9)) { if (PROBE_PHASE == 9) pe::peer_phase<true>(F, 0, M, 0, 8, !vfill_early); pe::peer_phase<false>(F, 0, M, 0, 8, !vfill_early && PROBE_PHASE != 9); }
#undef IN
#undef SEAM
}

extern "C" void kernel_launch(void* const* d_in, const int* in_sizes, int n_in, void* d_out, int out_size, void* d_ws, size_t ws_size, hipStream_t stream) {
    static int grid = 0;
    if (grid == 0) {
        if (n_in != 18 || in_sizes[0] != M * D || out_size != M * D || ws_size < WS_END) { fprintf(stderr, "kernel_launch: unexpected shapes (n_in %d, in0 %d, out %d, ws %zu)\n", n_in, n_in > 0 ? in_sizes[0] : -1, out_size, ws_size); grid = -1; return; }
        int dev = 0, cus = 0, per_cu = 0;
        if (hipGetDevice(&dev) != hipSuccess || hipDeviceGetAttribute(&cus, hipDeviceAttributeMultiprocessorCount, dev) != hipSuccess) { grid = -1; return; }
        if (hipFuncSetAttribute((const void*)fwd, hipFuncAttributeMaxDynamicSharedMemorySize, LDS_BYTES) != hipSuccess) { fprintf(stderr, "kernel_launch: hipFuncSetAttribute failed\n"); grid = -1; return; }
        if (hipOccupancyMaxActiveBlocksPerMultiprocessor(&per_cu, (const void*)fwd, NTHR, LDS_BYTES) != hipSuccess || per_cu < 1) fprintf(stderr, "kernel_launch: occupancy query reports %d\n", per_cu);
        (void)hipGetLastError();
        grid = cus;
    }
    if (grid < 0) return;
    if (hipMemsetAsync((char*)d_ws + WS_CTL, 0, CTL_ZERO_BYTES, stream) != hipSuccess) return;
    Args a{};
    for (int i = 0; i < 18; ++i) a.in[i] = (const float*)d_in[i];
    a.out = (float*)d_out; a.ws = (unsigned char*)d_ws;
#if MK_PER_PHASE
    for (int p = 0; p < NPHASE; ++p) { a.ph_lo = p; a.ph_hi = p + 1; a.li = p; hipLaunchKernelGGL(fwd, dim3(grid), dim3(NTHR), LDS_BYTES, stream, a); }
#else
    a.ph_lo = 0; a.ph_hi = NPHASE; a.li = 0; hipLaunchKernelGGL(fwd, dim3(grid), dim3(NTHR), LDS_BYTES, stream, a);
#endif
}
```
